# Optimizing an MI355X kernel written in HIP

```python
import jax, jax.numpy as jnp
from jax import lax
import numpy as np

D_MODEL = 1024
BATCH = 32
SEQ = 2048
DEPTH = 1

D_MIX = D_MODEL
POOL_WIDTH = D_MIX // 4
POOL_WINDOWS = (2, 4, 8, 16)
N_POOL_GROUPS = len(POOL_WINDOWS)
POOL_GROUP_DIM = POOL_WIDTH // N_POOL_GROUPS
SSD_WIDTH = D_MIX - POOL_WIDTH
SSD_HEAD_DIM = 64
SSD_HEADS = SSD_WIDTH // SSD_HEAD_DIM
SSD_GROUPS = 4
SSD_HEADS_PER_GROUP = SSD_HEADS // SSD_GROUPS
SSD_STATE = 128
SSD_CONV = 4
SSD_CHUNK = 128
SSD_CONV_DIM = SSD_WIDTH + 2 * SSD_GROUPS * SSD_STATE
IN_PROJ_DIM = POOL_WIDTH + SSD_WIDTH + SSD_CONV_DIM + SSD_HEADS
N_EXPERT_GROUPS = 4
EXPERTS_PER_GROUP = 8
N_EXPERTS = N_EXPERT_GROUPS * EXPERTS_PER_GROUP
TOP_K = 2
EXPERT_FF = 512
MOE_BLOCK = 128
NORM_EPS = 1e-6

kernel_name = "hymba_pool_ssd_hmoe_adaln"


def rms_norm(x, eps=NORM_EPS):
    xf = x.astype(jnp.float32)
    y = xf * lax.rsqrt(jnp.mean(xf * xf, axis=-1, keepdims=True) + eps)
    return y.astype(x.dtype)


def modulate(x, shift, scale):
    return rms_norm(x) * (1 + scale[:, None, :]) + shift[:, None, :]


def pool_mixer(u, w_pool, pool_scale):
    b, s, _ = u.shape
    ug = u.reshape(b, s, N_POOL_GROUPS, POOL_GROUP_DIM)
    cs = jnp.cumsum(ug.astype(jnp.float32), axis=1)
    pos = jnp.arange(1, s + 1, dtype=jnp.float32)
    means = []
    for g, w in enumerate(POOL_WINDOWS):
        csg = cs[:, :, g]
        lagged = jnp.pad(csg, ((0, 0), (w, 0), (0, 0)))[:, :s]
        cnt = jnp.minimum(pos, float(w))
        means.append((csg - lagged) / cnt[None, :, None])
    mean = jnp.stack(means, axis=2).astype(u.dtype)
    y = jnp.einsum('bsgc,gcd->bsgd', mean - ug, w_pool)
    return y.reshape(b, s, POOL_WIDTH) * pool_scale


def causal_depthwise_conv(x, w, bias):
    ch = x.shape[-1]
    y = lax.conv_general_dilated(
        x, w[:, None, :].astype(x.dtype), window_strides=(1,),
        padding=((SSD_CONV - 1, 0),), dimension_numbers=('NWC', 'WIO', 'NWC'),
        feature_group_count=ch)
    return y + bias


def ssd_scan(xh, dt, a, bmat, cmat):
    b, s = xh.shape[:2]
    L = SSD_CHUNK
    nc = s // L
    G, R, P, N = SSD_GROUPS, SSD_HEADS_PER_GROUP, SSD_HEAD_DIM, SSD_STATE
    xc = (xh.astype(jnp.float32) * dt[..., None]).reshape(b, nc, L, G, R, P)
    bc = bmat.astype(jnp.float32).reshape(b, nc, L, G, N)
    cc = cmat.astype(jnp.float32).reshape(b, nc, L, G, N)
    a_cs = jnp.cumsum((dt * a).reshape(b, nc, L, G, R), axis=2)
    causal = jnp.tril(jnp.ones((L, L), dtype=bool))
    seg = a_cs[:, :, :, None] - a_cs[:, :, None, :]
    decay = jnp.exp(jnp.where(causal[None, None, :, :, None, None], seg, -jnp.inf))
    cb = jnp.einsum('bclgn,bcsgn->bclsg', cc, bc)
    y_diag = jnp.einsum('bclsgr,bcsgrp->bclgrp', cb[..., None] * decay, xc)
    decay_to_end = jnp.exp(a_cs[:, :, -1:] - a_cs)
    chunk_states = jnp.einsum('bclgn,bclgrp->bcgrpn', bc, xc * decay_to_end[..., None])
    chunk_decay = jnp.exp(a_cs[:, :, -1])

    def step(state, inp):
        st, dec = inp
        return state * dec[..., None, None] + st, state

    init = jnp.zeros((b, G, R, P, N), jnp.float32)
    _, prev = lax.scan(step, init, (jnp.moveaxis(chunk_states, 1, 0),
                                    jnp.moveaxis(chunk_decay, 1, 0)))
    prev = jnp.moveaxis(prev, 0, 1)
    y_off = jnp.einsum('bclgn,bcgrpn->bclgrp', cc, prev) * jnp.exp(a_cs)[..., None]
    return (y_diag + y_off).reshape(b, s, G, R, P)


def ssd_mixer(z, xbc, dt_raw, conv_w, conv_b, dt_bias, a_log, d_skip, norm_w):
    b, s, _ = z.shape
    G, R, P, N = SSD_GROUPS, SSD_HEADS_PER_GROUP, SSD_HEAD_DIM, SSD_STATE
    xbc = jax.nn.silu(causal_depthwise_conv(xbc, conv_w, conv_b))
    xs, bm, cm = jnp.split(xbc, [SSD_WIDTH, SSD_WIDTH + G * N], axis=-1)
    xh = xs.reshape(b, s, G, R, P)
    bm = bm.reshape(b, s, G, N)
    cm = cm.reshape(b, s, G, N)
    dt = jax.nn.softplus(dt_raw.astype(jnp.float32) + dt_bias.astype(jnp.float32)).reshape(b, s, G, R)
    a = -jnp.exp(a_log.astype(jnp.float32)).reshape(G, R)
    y = ssd_scan(xh, dt, a, bm, cm) + xh.astype(jnp.float32) * d_skip.astype(jnp.float32).reshape(G, R)[..., None]
    y = y.reshape(b, s, SSD_WIDTH).astype(z.dtype) * jax.nn.silu(z)
    y = rms_norm(y.reshape(b, s, G, SSD_WIDTH // G)).reshape(b, s, SSD_WIDTH)
    return y * norm_w


def hier_moe(h, w_group, b_group, w_router, b_router, w13, w2):
    b, s, d = h.shape
    T = b * s
    hf = h.reshape(T, d)
    g_logits = (hf @ w_group + b_group).astype(jnp.float32)
    g_prob = jax.nn.softmax(g_logits, axis=-1)
    p_g, g_idx = lax.top_k(g_prob, 1)
    e_logits = (hf @ w_router + b_router).astype(jnp.float32).reshape(T, N_EXPERT_GROUPS, EXPERTS_PER_GROUP)
    within = jnp.take_along_axis(e_logits, g_idx[:, :, None], axis=1)[:, 0]
    top_v, top_i = lax.top_k(within, TOP_K)
    gate = p_g * jax.nn.softmax(top_v, axis=-1)
    expert_id = (g_idx * EXPERTS_PER_GROUP + top_i).astype(jnp.int32)
    A = T * TOP_K
    flat_e = expert_id.reshape(A)
    flat_tok = jnp.repeat(jnp.arange(T, dtype=jnp.int32), TOP_K)
    flat_w = gate.reshape(A)
    order = jnp.argsort(flat_e)
    se, stok, sw = flat_e[order], flat_tok[order], flat_w[order]
    counts = jnp.bincount(flat_e, length=N_EXPERTS)
    starts = jnp.cumsum(counts) - counts
    padded = ((counts + MOE_BLOCK - 1) // MOE_BLOCK) * MOE_BLOCK
    pends = jnp.cumsum(padded)
    pstarts = pends - padded
    dest = pstarts[se] + (jnp.arange(A, dtype=jnp.int32) - starts[se])
    R = A + N_EXPERTS * MOE_BLOCK
    n_blk = R // MOE_BLOCK
    row_tok = jnp.zeros((R,), jnp.int32).at[dest].set(stok)
    row_w = jnp.zeros((R,), h.dtype).at[dest].set(sw.astype(h.dtype))
    blk_start = jnp.arange(n_blk, dtype=jnp.int32) * MOE_BLOCK
    blk_e = jnp.clip(jnp.searchsorted(pends, blk_start, side='right'), 0, N_EXPERTS - 1)
    xs = hf[row_tok].reshape(n_blk, MOE_BLOCK, d)

    def expert_block(args):
        xb, e = args
        hu = xb @ w13[e]
        a_, b_ = jnp.split(hu, 2, axis=-1)
        return (jax.nn.silu(a_) * b_) @ w2[e]

    ys = lax.map(expert_block, (xs, blk_e)).reshape(R, d)
    out = jax.ops.segment_sum(ys * row_w[:, None], row_tok, num_segments=T)
    return out.reshape(b, s, d)


def setup_inputs(seed: int = 0) -> dict:
    key = jax.random.key(seed)
    ks = jax.random.split(key, 24)
    f32 = jnp.float32
    nrm = lambda k, shape, scale: jax.random.normal(k, shape, f32) * scale
    x = jax.random.normal(ks[0], (BATCH, SEQ, D_MODEL), f32)
    c = jax.random.normal(ks[1], (BATCH, D_MODEL), f32)
    w_ada = nrm(ks[2], (DEPTH, D_MODEL, 6 * D_MODEL), D_MODEL ** -0.5)
    b_ada = nrm(ks[3], (DEPTH, 6 * D_MODEL), 0.02)
    w_in = nrm(ks[4], (DEPTH, D_MODEL, IN_PROJ_DIM), D_MODEL ** -0.5)
    w_pool = nrm(ks[5], (DEPTH, N_POOL_GROUPS, POOL_GROUP_DIM, POOL_GROUP_DIM), POOL_GROUP_DIM ** -0.5)
    pool_scale = 1.0 + nrm(ks[6], (DEPTH, POOL_WIDTH), 0.1)
    conv_w = nrm(ks[7], (DEPTH, SSD_CONV, SSD_CONV_DIM), SSD_CONV ** -0.5)
    conv_b = nrm(ks[8], (DEPTH, SSD_CONV_DIM), 0.02)
    dt0 = jnp.exp(jax.random.uniform(ks[9], (DEPTH, SSD_HEADS), f32, np.log(1e-3), np.log(1e-1)))
    dt_bias = dt0 + jnp.log(-jnp.expm1(-dt0))
    a_log = jnp.log(jax.random.uniform(ks[10], (DEPTH, SSD_HEADS), f32, 1.0, 16.0))
    d_skip = 1.0 + nrm(ks[11], (DEPTH, SSD_HEADS), 0.1)
    ssd_norm_w = 1.0 + nrm(ks[12], (DEPTH, SSD_WIDTH), 0.1)
    w_out = nrm(ks[13], (DEPTH, D_MIX, D_MODEL), D_MIX ** -0.5)
    w_group = nrm(ks[14], (DEPTH, D_MODEL, N_EXPERT_GROUPS), D_MODEL ** -0.5)
    b_group = nrm(ks[15], (DEPTH, N_EXPERT_GROUPS), 0.01)
    w_router = nrm(ks[16], (DEPTH, D_MODEL, N_EXPERTS), D_MODEL ** -0.5)
    b_router = nrm(ks[17], (DEPTH, N_EXPERTS), 0.01)
    w13 = nrm(ks[18], (DEPTH, N_EXPERTS, D_MODEL, 2 * EXPERT_FF), D_MODEL ** -0.5)
    w2 = nrm(ks[19], (DEPTH, N_EXPERTS, EXPERT_FF, D_MODEL), EXPERT_FF ** -0.5)
    final_norm_w = 1.0 + nrm(ks[20], (D_MODEL,), 0.1)
    return {"x": x, "c": c, "w_ada": w_ada, "b_ada": b_ada, "w_in": w_in,
            "w_pool": w_pool, "pool_scale": pool_scale, "conv_w": conv_w, "conv_b": conv_b,
            "dt_bias": dt_bias, "a_log": a_log, "d_skip": d_skip, "ssd_norm_w": ssd_norm_w,
            "w_out": w_out, "w_group": w_group, "b_group": b_group, "w_router": w_router,
            "b_router": b_router, "w13": w13, "w2": w2, "final_norm_w": final_norm_w}


def reference(x, c, w_ada, b_ada, w_in, w_pool, pool_scale, conv_w, conv_b, dt_bias, a_log,
              d_skip, ssd_norm_w, w_out, w_group, b_group, w_router, b_router, w13, w2,
              final_norm_w):
    split_at = [POOL_WIDTH, POOL_WIDTH + SSD_WIDTH, POOL_WIDTH + SSD_WIDTH + SSD_CONV_DIM]
    for layer in range(DEPTH):
        mod = jax.nn.silu(c) @ w_ada[layer] + b_ada[layer]
        sh1, sc1, g1, sh2, sc2, g2 = jnp.split(mod, 6, axis=-1)
        h = modulate(x, sh1, sc1)
        proj = h @ w_in[layer]
        u, z, xbc, dt_raw = jnp.split(proj, split_at, axis=-1)
        y_pool = pool_mixer(u, w_pool[layer], pool_scale[layer])
        y_ssd = ssd_mixer(z, xbc, dt_raw, conv_w[layer], conv_b[layer], dt_bias[layer],
                          a_log[layer], d_skip[layer], ssd_norm_w[layer])
        mix = jnp.concatenate([y_pool, y_ssd], axis=-1) @ w_out[layer]
        x = x + g1[:, None, :] * mix
        h = modulate(x, sh2, sc2)
        x = x + g2[:, None, :] * hier_moe(h, w_group[layer], b_group[layer], w_router[layer],
                                           b_router[layer], w13[layer], w2[layer])
    return rms_norm(x) * final_norm_w
```

```cpp
#include <hip/hip_runtime.h>
#include <cstdio>
#include <cstdint>

#ifndef MK_ONE_LAUNCH
#define MK_ONE_LAUNCH 0
#endif

#define LAS __attribute__((address_space(3)))
typedef unsigned short bf16_t;
typedef short bf16x8 __attribute__((ext_vector_type(8)));
typedef float f32x4 __attribute__((ext_vector_type(4)));
typedef float f32x2 __attribute__((ext_vector_type(2)));
typedef unsigned u32x4 __attribute__((ext_vector_type(4)));
typedef unsigned u32x2 __attribute__((ext_vector_type(2)));

constexpr int BATCH = 32, SEQ = 2048, DM = 1024, T = BATCH * SEQ;
constexpr int NPROJ = 3072, NPROJ_REAL = 2828;
constexpr int COL_Z = 256, COL_XS = 1024, COL_B = 1792, COL_C = 2304, COL_DT = 2816;
constexpr int NEXP = 32, FF = 512, ECAP = 65536;
constexpr int NWAVES = 8, NTHREADS = 512;
constexpr float EPS = 1e-6f;

constexpr size_t MiB = 1u << 20;
constexpr size_t WS_CTL = 0, CTL_BYTES = 1 * MiB;
constexpr size_t WS_MOD = 1 * MiB;
constexpr size_t WS_WR = 2 * MiB;
constexpr size_t WS_GATE = 3 * MiB;
constexpr size_t WS_DTRAW = 4 * MiB;
constexpr size_t WS_LIST = 8 * MiB;
constexpr size_t WS_WIN = 16 * MiB;
constexpr size_t WS_WOUT = 22 * MiB;
constexpr size_t WS_W13 = 24 * MiB;
constexpr size_t WS_W2 = 88 * MiB;
constexpr size_t WS_H = 128 * MiB;
constexpr size_t WS_PROJ = 256 * MiB;
constexpr size_t WS_MIX = 640 * MiB;
constexpr size_t WS_X1 = 768 * MiB;
constexpr size_t WS_END = 1024 * MiB;
constexpr size_t WS_YBUF = WS_X1;
constexpr size_t WS_Y0 = 256 * MiB, WS_Y1 = 384 * MiB;
constexpr size_t WS_ACT = 512 * MiB;
constexpr int CW_GCOUNT = 256;
constexpr int CW_BAR = 4096;

constexpr int LDS_BYTES = 163840;
constexpr int MISC_OFF = 147456;

struct Params {
    const float* in[21];
    float* out;
    unsigned char* ws;
    int ph_lo, ph_hi;
};

__device__ __forceinline__ unsigned cvt_pk_bf16(float lo, float hi) { unsigned r; asm volatile("v_cvt_pk_bf16_f32 %0, %1, %2" : "=v"(r) : "v"(lo), "v"(hi)); return r; }
__device__ __forceinline__ float bf_lo(unsigned u) { return __uint_as_float(u << 16); }
__device__ __forceinline__ float bf_hi(unsigned u) { return __uint_as_float(u & 0xffff0000u); }
__device__ __forceinline__ float wave_sum(float v) {
#pragma unroll
    for (int o = 1; o < 64; o <<= 1) v += __shfl_xor(v, o);
    return v;
}
__device__ __forceinline__ float sigmoidf_(float v) { return __builtin_amdgcn_rcpf(1.0f + __expf(-v)); }
__device__ __forceinline__ float siluf_(float v) { return v * sigmoidf_(v); }

namespace pg8 {
constexpr int BM = 256, BK = 64, HALF = 128, HTB = HALF * BK * 2, STAGE_BYTES = 8 * HTB, NXCD = 8, WGM = 8;
__host__ __device__ __forceinline__ int lds_byte(int r, int c) { const int st = (r >> 4) * 2 + (c >> 5), rr = r & 15, cc = c & 31, ob = rr * 64 + cc * 2; return st * 1024 + (ob ^ (((ob >> 9) & 1) << 5)); }
__host__ __device__ __forceinline__ void stage_rc(int b, int& R, int& C) { const int st = b / 1024, sb = b % 1024, swz = sb ^ (((sb >> 9) & 1) << 5); R = (st >> 1) * 16 + swz / 64; C = (st & 1) * 32 + (swz % 64) / 2; }
__host__ __device__ __forceinline__ int perm32(int rho) { const int n = rho >> 4, i = rho & 15; return 8 * (i >> 2) + 4 * n + (i & 3); }

struct Unit { int pm, pn, e, cnt, slot0; };

struct DenseSched {
    const char* A; const char* Bt; int K;
    int nM, nN, nwg, G, c;
    __device__ void init(const void* A_, const void* Bt_, int M, int N, int K_, int G_, int c_) { A = (const char*)A_; Bt = (const char*)Bt_; K = K_; nM = M / BM; nN = N / BM; nwg = nM * nN; G = G_; c = c_; }
    __device__ __forceinline__ bool next(int i, Unit& u) const {
        const long L = (long)i * G + c; if (L >= nwg) return false;
        int wgid = (int)L; { const int q = nwg / NXCD, r = nwg % NXCD, xcd = wgid % NXCD, off = wgid / NXCD; wgid = (xcd < r ? xcd * (q + 1) : r * (q + 1) + (xcd - r) * q) + off; }
        const int nig = WGM * nN, gid = wgid / nig, fm = gid * WGM, gsz = (nM - fm) < WGM ? (nM - fm) : WGM;
        u.pm = fm + ((wgid % nig) % gsz); u.pn = (wgid % nig) / gsz; u.e = 0; u.cnt = 256; u.slot0 = 0; return true;
    }
    __device__ __forceinline__ const char* a_base() const { return A; }
    __device__ __forceinline__ void a_off(const Unit& u, const int (&R)[2], const int (&C)[2], unsigned (&o)[2][2]) const {
#pragma unroll
        for (int h = 0; h < 2; ++h)
#pragma unroll
            for (int i = 0; i < 2; ++i) o[h][i] = (unsigned)((u.pm * BM + h * HALF + R[i]) * K + C[i]) * 2u;
    }
    __device__ __forceinline__ const char* b_ptr(const Unit& u) const { return Bt + (size_t)u.pn * BM * K * 2; }
};

template <bool GATHER>
struct MoeSched {
    const char* A; const char* Bt; int K, nN, G, c;
    const LAS int* pref;
    const unsigned* list;
    __device__ __forceinline__ bool next(int i, Unit& u) const {
        const long L = (long)i * G + c; const int tot = pref[32] * nN; if (L >= tot) return false;
        const int ti = (int)L / nN; u.pn = (int)L % nN;
        int e = 0;
#pragma unroll 1
        for (int j = 1; j < 32; ++j) if (pref[j] <= ti) e = j;
        const int mt = ti - pref[e]; u.pm = ti; u.e = e; u.slot0 = mt * 256; const int rem = pref[33 + e] - mt * 256; u.cnt = rem < 256 ? rem : 256; return true;
    }
    __device__ __forceinline__ const char* a_base() const { return A; }
    __device__ __forceinline__ void a_off(const Unit& u, const int (&R)[2], const int (&C)[2], unsigned (&o)[2][2]) const {
#pragma unroll
        for (int h = 0; h < 2; ++h)
#pragma unroll
            for (int i = 0; i < 2; ++i) {
                const int r = h * HALF + R[i];
                if (GATHER) { unsigned tok = 0; if (r < u.cnt) tok = list[(size_t)u.e * ECAP + u.slot0 + r] >> 1; o[h][i] = (unsigned)(tok * K + C[i]) * 2u; }
                else o[h][i] = (unsigned)((u.pm * BM + r) * K + C[i]) * 2u;
            }
    }
    __device__ __forceinline__ const char* b_ptr(const Unit& u) const { return Bt + ((size_t)u.e * (nN * BM) + (size_t)u.pn * BM) * K * 2; }
};

template <class Epi, class Sched>
__device__ __forceinline__ void gemm_phase(LAS unsigned char* lds, const Sched& S, const Epi& E) {
    const int tid = threadIdx.x, wid = __builtin_amdgcn_readfirstlane(tid >> 6), lane = tid & 63, wr = wid >> 2, wc = wid & 3, fr = lane & 15, fq = lane >> 4;
    const int K = S.K, nt = K / BK;
    int sR[2], sC[2]; unsigned voffB[2];
#pragma unroll
    for (int i = 0; i < 2; ++i) { int R, C; stage_rc(tid * 16 + i * 8192, R, C); sR[i] = R; sC[i] = C; const int Rb = Epi::PERM ? ((R & ~31) + perm32(R & 31)) : R; voffB[i] = (unsigned)(Rb * K + C) * 2u; }
    const size_t kstep = (size_t)(BK * 2);
    const size_t hstep = (size_t)HALF * K * 2;
    const unsigned ldsw = (unsigned)wid * 1024u;
    const int aoff = lds_byte(wr * 64 + fr, fq * 8), boff = lds_byte(wc * 32 + fr, fq * 8);
#define PG8_SA(b, h) (((b) * 2 + (h)) * HTB)
#define PG8_SB(b, h) ((4 + (b) * 2 + (h)) * HTB)
#define PG8_STAGE(bufoff, gbase, voff) do { _Pragma("unroll") for (int _i = 0; _i < 2; ++_i) \
        __builtin_amdgcn_global_load_lds((const unsigned*)((const char*)(gbase) + (voff)[_i]), (LAS unsigned*)(lds + (bufoff) + ldsw + _i * 8192), 16, 0, 0); } while (0)
#define PG8_LDA(dst, b, h) do { _Pragma("unroll") for (int m = 0; m < 4; ++m) _Pragma("unroll") for (int k = 0; k < 2; ++k) dst[m][k] = *(const LAS bf16x8*)(lds + PG8_SA(b, h) + aoff + m * 2048 + k * 1024); } while (0)
#define PG8_LDB(dst, b, h) do { _Pragma("unroll") for (int n = 0; n < 2; ++n) _Pragma("unroll") for (int k = 0; k < 2; ++k) dst[n][k] = *(const LAS bf16x8*)(lds + PG8_SB(b, h) + boff + n * 2048 + k * 1024); } while (0)
#define PG8_MMA(ai, bj, At, Bt) do { __builtin_amdgcn_s_setprio(1); _Pragma("unroll") for (int m = 0; m < 4; ++m) _Pragma("unroll") for (int n = 0; n < 2; ++n) _Pragma("unroll") for (int k = 0; k < 2; ++k) \
        acc[ai][bj][m][n] = __builtin_amdgcn_mfma_f32_16x16x32_bf16(Bt[n][k], At[m][k], acc[ai][bj][m][n], 0, 0, 0); __builtin_amdgcn_s_setprio(0); } while (0)
#define PG8_WAIT_V(n) asm volatile("s_waitcnt vmcnt(" #n ")" ::: "memory")
#define PG8_WAIT_L(n) asm volatile("s_waitcnt lgkmcnt(" #n ")" ::: "memory")
#define PG8_BAR __builtin_amdgcn_s_barrier()
#define PG8_SCHED __builtin_amdgcn_sched_barrier(0)
    Unit cur, nxt; int ui = 0;
    if (!S.next(0, cur)) return;
    f32x4 acc[2][2][4][2];
#pragma unroll
    for (int a = 0; a < 2; ++a)
#pragma unroll
        for (int b = 0; b < 2; ++b)
#pragma unroll
            for (int m = 0; m < 4; ++m)
#pragma unroll
                for (int n = 0; n < 2; ++n) acc[a][b][m][n] = (f32x4){0.f, 0.f, 0.f, 0.f};
    bf16x8 At[4][2], B0[2][2], B1[2][2];
    unsigned aoC[2][2], aoN[2][2];
    S.a_off(cur, sR, sC, aoC);
    const char* const Ab = S.a_base();
    const char* cB = S.b_ptr(cur);
    PG8_STAGE(PG8_SB(0, 0), cB, voffB); PG8_STAGE(PG8_SB(0, 1), cB + hstep, voffB); PG8_STAGE(PG8_SA(0, 0), Ab, aoC[0]); PG8_STAGE(PG8_SA(0, 1), Ab, aoC[1]);
    if (wr == 1) PG8_BAR;
    PG8_WAIT_V(2); PG8_BAR;
    PG8_STAGE(PG8_SB(1, 0), cB + kstep, voffB); PG8_STAGE(PG8_SA(1, 0), Ab + kstep, aoC[0]); PG8_STAGE(PG8_SB(1, 1), cB + hstep + kstep, voffB);
    PG8_WAIT_V(6); PG8_BAR;
    for (;;) {
        const bool has_next = S.next(ui + 1, nxt);
        const char* nB = cB;
        if (has_next) { S.a_off(nxt, sR, sC, aoN); nB = S.b_ptr(nxt); }
        else {
#pragma unroll
            for (int h = 0; h < 2; ++h)
#pragma unroll
                for (int i = 0; i < 2; ++i) aoN[h][i] = aoC[h][i];
        }
        for (int t = 0; t < nt; t += 2) {
            const bool last = (t == nt - 2);
            const char* a1 = Ab + (size_t)(t + 1) * kstep;
            const char* a2 = last ? Ab : Ab + (size_t)(t + 2) * kstep; const char* b2 = last ? nB : cB + (size_t)(t + 2) * kstep;
            const char* a3 = a2 + kstep; const char* b3 = b2 + kstep;
            unsigned o2[2][2];
#pragma unroll
            for (int h = 0; h < 2; ++h)
#pragma unroll
                for (int i = 0; i < 2; ++i) o2[h][i] = last ? aoN[h][i] : aoC[h][i];
            PG8_LDB(B0, 0, 0); PG8_LDB(B1, 0, 1); PG8_SCHED; PG8_LDA(At, 0, 0); PG8_STAGE(PG8_SA(1, 1), a1, aoC[1]);
            PG8_WAIT_V(8); PG8_WAIT_L(0); PG8_BAR; PG8_MMA(0, 0, At, B0); PG8_MMA(0, 1, At, B1); PG8_BAR; PG8_SCHED;
            PG8_LDA(At, 0, 1); PG8_STAGE(PG8_SB(0, 0), b2, voffB); PG8_STAGE(PG8_SB(0, 1), b2 + hstep, voffB); PG8_STAGE(PG8_SA(0, 0), a2, o2[0]);
            PG8_WAIT_V(8); PG8_WAIT_L(0); PG8_BAR; PG8_MMA(1, 0, At, B0); PG8_MMA(1, 1, At, B1); PG8_BAR; PG8_SCHED;
            PG8_LDB(B0, 1, 0); PG8_LDB(B1, 1, 1); PG8_SCHED; PG8_LDA(At, 1, 0); PG8_STAGE(PG8_SA(0, 1), a2, o2[1]);
            PG8_WAIT_V(8); PG8_WAIT_L(0); PG8_BAR; PG8_MMA(0, 0, At, B0); PG8_MMA(0, 1, At, B1); PG8_BAR; PG8_SCHED;
            PG8_LDA(At, 1, 1); PG8_STAGE(PG8_SB(1, 0), b3, voffB); PG8_STAGE(PG8_SB(1, 1), b3 + hstep, voffB); PG8_STAGE(PG8_SA(1, 0), a3, o2[0]);
            PG8_WAIT_V(8); PG8_WAIT_L(0); PG8_BAR; PG8_MMA(1, 0, At, B0); PG8_MMA(1, 1, At, B1); PG8_BAR; PG8_SCHED;
        }
        if (wr == 0) PG8_BAR;
        E(acc, cur, wr, wc, fr, fq);
        if (!has_next) break;
#pragma unroll
        for (int a = 0; a < 2; ++a)
#pragma unroll
            for (int b = 0; b < 2; ++b)
#pragma unroll
                for (int m = 0; m < 4; ++m)
#pragma unroll
                    for (int n = 0; n < 2; ++n) acc[a][b][m][n] = (f32x4){0.f, 0.f, 0.f, 0.f};
        cur = nxt; cB = nB; ++ui;
#pragma unroll
        for (int h = 0; h < 2; ++h)
#pragma unroll
            for (int i = 0; i < 2; ++i) aoC[h][i] = aoN[h][i];
        if (wr == 1) PG8_BAR;
    }
    PG8_WAIT_V(0);
    PG8_BAR;
#undef PG8_SA
#undef PG8_SB
#undef PG8_STAGE
#undef PG8_LDA
#undef PG8_LDB
#undef PG8_MMA
#undef PG8_WAIT_V
#undef PG8_WAIT_L
#undef PG8_BAR
#undef PG8_SCHED
}

struct EpiProj {
    static constexpr bool PERM = true;
    bf16_t* O; float* dtraw;
    __device__ __forceinline__ void operator()(const f32x4 (&acc)[2][2][4][2], const Unit& u, int wr, int wc, int fr, int fq) const {
        const int row0 = u.pm * BM + wr * 64 + fr, col0 = u.pn * BM + wc * 32 + 8 * fq;
#pragma unroll
        for (int ai = 0; ai < 2; ++ai)
#pragma unroll
            for (int m = 0; m < 4; ++m) { const int row = row0 + ai * HALF + m * 16; bf16_t* rowp = O + (size_t)row * NPROJ + col0;
#pragma unroll
                for (int bj = 0; bj < 2; ++bj) { const f32x4 v0 = acc[ai][bj][m][0], v1 = acc[ai][bj][m][1];
                    u32x4 w; w.x = cvt_pk_bf16(v0[0], v0[1]); w.y = cvt_pk_bf16(v0[2], v0[3]); w.z = cvt_pk_bf16(v1[0], v1[1]); w.w = cvt_pk_bf16(v1[2], v1[3]);
                    *(u32x4*)(rowp + bj * HALF) = w; }
                if (u.pn == 11 && wc == 0 && fq < 2) { float* d = dtraw + (size_t)row * 16 + 8 * fq; *(f32x4*)d = acc[ai][0][m][0]; *(f32x4*)(d + 4) = acc[ai][0][m][1]; }
            }
    }
};
struct EpiX1 {
    static constexpr bool PERM = false;
    const float* x; const float* mod; float* x1;
    __device__ __forceinline__ void operator()(const f32x4 (&acc)[2][2][4][2], const Unit& u, int wr, int wc, int fr, int fq) const {
        const int row0 = u.pm * BM + wr * 64 + fr, col0 = u.pn * BM + wc * 32 + 4 * fq; const int b = (u.pm * BM) >> 11;
        f32x4 gv[2][2];
#pragma unroll
        for (int bj = 0; bj < 2; ++bj)
#pragma unroll
            for (int n = 0; n < 2; ++n) gv[bj][n] = *(const f32x4*)(mod + (size_t)b * 6144 + 2 * 1024 + col0 + bj * HALF + n * 16);
#pragma unroll
        for (int ai = 0; ai < 2; ++ai)
#pragma unroll
            for (int m = 0; m < 4; ++m) { const size_t off = (size_t)(row0 + ai * HALF + m * 16) * DM + col0;
#pragma unroll
                for (int bj = 0; bj < 2; ++bj)
#pragma unroll
                    for (int n = 0; n < 2; ++n) { const f32x4 xv = *(const f32x4*)(x + off + bj * HALF + n * 16); *(f32x4*)(x1 + off + bj * HALF + n * 16) = xv + gv[bj][n] * acc[ai][bj][m][n]; } }
    }
};
struct EpiAct {
    static constexpr bool PERM = true;
    bf16_t* act;
    __device__ __forceinline__ void operator()(const f32x4 (&acc)[2][2][4][2], const Unit& u, int wr, int wc, int fr, int fq) const {
        const int row0 = u.pm * BM + wr * 64 + fr, col0 = u.pn * HALF + wc * 32 + 8 * fq;
#pragma unroll
        for (int ai = 0; ai < 2; ++ai)
#pragma unroll
            for (int m = 0; m < 4; ++m) { bf16_t* p = act + (size_t)(row0 + ai * HALF + m * 16) * FF + col0; float o[8];
#pragma unroll
                for (int n = 0; n < 2; ++n)
#pragma unroll
                    for (int i = 0; i < 4; ++i) { const float a = acc[ai][0][m][n][i], b = acc[ai][1][m][n][i]; o[n * 4 + i] = siluf_(a) * b; }
                u32x4 w; w.x = cvt_pk_bf16(o[0], o[1]); w.y = cvt_pk_bf16(o[2], o[3]); w.z = cvt_pk_bf16(o[4], o[5]); w.w = cvt_pk_bf16(o[6], o[7]);
                *(u32x4*)p = w; }
    }
};
struct EpiY {
    static constexpr bool PERM = true;
    const unsigned* list; const float* gates; const float* mod; bf16_t* Y0; bf16_t* Y1;
    __device__ __forceinline__ void operator()(const f32x4 (&acc)[2][2][4][2], const Unit& u, int wr, int wc, int fr, int fq) const {
        const int col0 = u.pn * BM + wc * 32 + 8 * fq;
#pragma unroll
        for (int ai = 0; ai < 2; ++ai)
#pragma unroll
            for (int m = 0; m < 4; ++m) { const int r = ai * HALF + wr * 64 + m * 16 + fr;
                if (r < u.cnt) {
                    const unsigned ent = list[(size_t)u.e * ECAP + u.slot0 + r]; const unsigned tok = ent >> 1; const float gate = gates[ent];
                    bf16_t* yp = ((ent & 1u) ? Y1 : Y0) + (size_t)tok * DM + col0; const float* gp = mod + (size_t)(tok >> 11) * 6144 + 5 * 1024 + col0;
#pragma unroll
                    for (int bj = 0; bj < 2; ++bj) { const f32x4 g0 = *(const f32x4*)(gp + bj * HALF), g1 = *(const f32x4*)(gp + bj * HALF + 4);
                        const f32x4 v0 = acc[ai][bj][m][0] * g0 * gate, v1 = acc[ai][bj][m][1] * g1 * gate;
                        u32x4 w; w.x = cvt_pk_bf16(v0[0], v0[1]); w.y = cvt_pk_bf16(v0[2], v0[3]); w.z = cvt_pk_bf16(v1[0], v1[1]); w.w = cvt_pk_bf16(v1[2], v1[3]);
                        *(u32x4*)(yp + bj * HALF) = w; } } }
    }
};
}

struct Frame {
    unsigned char* lds; int tid, lane, wave, vcu, G, gw, NGW;
};

__device__ __forceinline__ void transpose_item(const float* W, int ldw, int nvalid, int k0, int n0, bf16_t* WT, int K, int dst_row0, float* scr, int lane) {
#pragma unroll 8
    for (int i = 0; i < 32; ++i) { const int kk = 2 * i + (lane >> 5); const int n = n0 + (lane & 31); scr[kk * 33 + (lane & 31)] = (n < nvalid) ? W[(size_t)(k0 + kk) * ldw + n] : 0.f; }
    asm volatile("s_waitcnt lgkmcnt(0)" ::: "memory");
    const int c = lane & 7;
#pragma unroll
    for (int j = 0; j < 4; ++j) { const int n = (lane >> 3) + 8 * j; const float* s = scr + (8 * c) * 33 + n;
        u32x4 o; o.x = cvt_pk_bf16(s[0 * 33], s[1 * 33]); o.y = cvt_pk_bf16(s[2 * 33], s[3 * 33]); o.z = cvt_pk_bf16(s[4 * 33], s[5 * 33]); o.w = cvt_pk_bf16(s[6 * 33], s[7 * 33]);
        *(u32x4*)(WT + (size_t)(dst_row0 + n0 + n) * K + k0 + 8 * c) = o; }
    asm volatile("s_waitcnt lgkmcnt(0)" ::: "memory");
}

__device__ __forceinline__ void p0_prep(const Frame& F, const Params& P) {
    unsigned char* ws = P.ws;
    {
        float* sct = (float*)F.lds;
        const float* c = P.in[1];
        for (int idx = F.tid; idx < 32 * 1024; idx += NTHREADS) { const int b = idx >> 10, k = idx & 1023; sct[k * 32 + b] = siluf_(c[idx]); }
        __syncthreads();
        const float* w_ada = P.in[2]; const float* b_ada = P.in[3]; float* mod = (float*)(ws + WS_MOD);
        for (int cg = F.vcu; cg < 256; cg += F.G) {
            const int j = F.tid % 24, kg = F.tid / 24;
            float acc[32];
#pragma unroll
            for (int b = 0; b < 32; ++b) acc[b] = 0.f;
            if (kg < 16) {
                for (int kk = 0; kk < 64; ++kk) { const int k = kg * 64 + kk; const float w = w_ada[(size_t)k * 6144 + cg * 24 + j];
#pragma unroll
                    for (int q = 0; q < 8; ++q) { const f32x4 s = *(const f32x4*)(sct + k * 32 + 4 * q); acc[4 * q] += s[0] * w; acc[4 * q + 1] += s[1] * w; acc[4 * q + 2] += s[2] * w; acc[4 * q + 3] += s[3] * w; } }
            }
            float* px = (float*)(F.lds + 131072);
            float tot[2] = {0.f, 0.f};
#pragma unroll 1
            for (int half = 0; half < 2; ++half) {
                if (kg < 16 && (kg >> 3) == half) {
#pragma unroll
                    for (int b = 0; b < 32; ++b) px[((kg & 7) * 24 + j) * 32 + b] = acc[b];
                }
                __syncthreads();
#pragma unroll
                for (int r = 0; r < 2; ++r) { const int o = F.tid + r * 512; if (o < 768) { float s = 0.f;
#pragma unroll
                        for (int q = 0; q < 8; ++q) s += px[q * 768 + o]; tot[r] += s; } }
                __syncthreads();
            }
#pragma unroll
            for (int r = 0; r < 2; ++r) { const int o = F.tid + r * 512; if (o < 768) { const int jj = o >> 5, b = o & 31; mod[(size_t)b * 6144 + cg * 24 + jj] = tot[r] + b_ada[cg * 24 + jj]; } }
        }
        __syncthreads();
    }
    {
        float* scr = (float*)(F.lds + F.wave * 16384);
        const float* w_in = P.in[4]; const float* w_out = P.in[13]; const float* w13 = P.in[18]; const float* w2 = P.in[19];
        bf16_t* WIN = (bf16_t*)(ws + WS_WIN); bf16_t* WOUT = (bf16_t*)(ws + WS_WOUT); bf16_t* W13 = (bf16_t*)(ws + WS_W13); bf16_t* W2 = (bf16_t*)(ws + WS_W2);
        constexpr int I0 = 16 * 88, I1 = 16 * 32, I2 = 32 * 16 * 32, I3 = 32 * 8 * 32, NIT = I0 + I1 + I2 + I3;
        for (int it = F.gw; it < NIT; it += F.NGW) {
            int r = it;
            if (r < I0) { const int kb = r / 88, nb = 8 + r % 88; transpose_item(w_in, NPROJ_REAL, NPROJ_REAL, kb * 64, nb * 32, WIN, 1024, 0, scr, F.lane); continue; } r -= I0;
            if (r < I1) { const int kb = r / 32, nb = r % 32; transpose_item(w_out, 1024, 1024, kb * 64, nb * 32, WOUT, 1024, 0, scr, F.lane); continue; } r -= I1;
            if (r < I2) { const int e = r / 512, q = r % 512, kb = q / 32, nb = q % 32; const int n0 = nb * 32, bj = n0 >> 9, rem = n0 & 511, pn = rem >> 7, j0 = rem & 127;
                transpose_item(w13 + (size_t)e * 1024 * 1024, 1024, 1024, kb * 64, n0, W13 + (size_t)e * 1024 * 1024, 1024, pn * 256 + bj * 128 + j0 - n0, scr, F.lane); continue; } r -= I2;
            { const int e = r / 256, q = r % 256, kb = q / 32, nb = q % 32;
                transpose_item(w2 + (size_t)e * 512 * 1024, 1024, 1024, kb * 64, nb * 32, W2 + (size_t)e * 1024 * 512, 512, 0, scr, F.lane); }
        }
    }
    {
        const float* w_in = P.in[4]; const float* w_pool = P.in[5]; const float* pscale = P.in[6]; bf16_t* WIN = (bf16_t*)(ws + WS_WIN);
        for (int idx = F.vcu * NTHREADS + F.tid; idx < 256 * 1024; idx += F.G * NTHREADS) {
            const int n = idx >> 10, k = idx & 1023, g = n >> 6, d = n & 63; const float* wi = w_in + (size_t)k * NPROJ_REAL + g * 64; const float* wp = w_pool + (size_t)g * 4096 + d;
            float s = 0.f;
#pragma unroll 8
            for (int cc = 0; cc < 64; ++cc) s += wi[cc] * wp[cc * 64];
            s *= pscale[n];
            WIN[(size_t)n * 1024 + k] = (bf16_t)(cvt_pk_bf16(s, 0.f) & 0xffffu);
        }
    }
    {
        const float* wg = P.in[14]; const float* wrt = P.in[16]; float* WR = (float*)(ws + WS_WR);
        for (int idx = F.vcu * NTHREADS + F.tid; idx < 36 * 1024; idx += F.G * NTHREADS) { const int j = idx >> 10, k = idx & 1023; WR[idx] = (j < 4) ? wg[k * 4 + j] : wrt[k * 32 + (j - 4)]; }
    }
}

__device__ __forceinline__ void p1_modulate(const Frame& F, const Params& P) {
    const float* x = P.in[0]; const float* mod = (const float*)(P.ws + WS_MOD); bf16_t* H = (bf16_t*)(P.ws + WS_H);
    for (int row = F.gw; row < T; row += F.NGW) {
        const int b = row >> 11; const f32x4* xr = (const f32x4*)(x + (size_t)row * DM) + F.lane;
        f32x4 v[4]; float s = 0.f;
#pragma unroll
        for (int j = 0; j < 4; ++j) { v[j] = xr[64 * j]; s += (v[j][0] * v[j][0] + v[j][1] * v[j][1]) + (v[j][2] * v[j][2] + v[j][3] * v[j][3]); }
        const float rstd = rsqrtf(wave_sum(s) * (1.f / DM) + EPS);
        const f32x4* sh = (const f32x4*)(mod + (size_t)b * 6144) + F.lane; const f32x4* sc = (const f32x4*)(mod + (size_t)b * 6144 + 1024) + F.lane;
        u32x2* o = (u32x2*)(H + (size_t)row * DM) + F.lane;
#pragma unroll
        for (int j = 0; j < 4; ++j) { const f32x4 a = sh[64 * j], m = sc[64 * j]; const f32x4 h = v[j] * rstd * (m + 1.0f) + a; u32x2 w; w.x = cvt_pk_bf16(h[0], h[1]); w.y = cvt_pk_bf16(h[2], h[3]); o[64 * j] = w; }
    }
}

__device__ __forceinline__ void p3a_ssd_naive(const Frame& F, const Params& P) {
    const bf16_t* proj = (const bf16_t*)(P.ws + WS_PROJ); const float* dtraw = (const float*)(P.ws + WS_DTRAW); float* ybuf = (float*)(P.ws + WS_YBUF);
    const float* conv_w = P.in[7]; const float* conv_b = P.in[8]; const float* dt_bias = P.in[9]; const float* a_log = P.in[10]; const float* d_skip = P.in[11];
    float* xs = (float*)F.lds; float* Bs = xs + 64 * 64; float* Cs = Bs + 64 * 128; float* dts = Cs + 64 * 128;
    for (int u = F.vcu; u < BATCH * 12; u += F.G) {
        const int b = u / 12, h = u % 12, g = h / 3;
        const float a = -__expf(a_log[h]), dsk = d_skip[h], dtb = dt_bias[h];
        const int p = F.tid >> 3, nq = F.tid & 7;
        float st[16];
#pragma unroll
        for (int i = 0; i < 16; ++i) st[i] = 0.f;
        for (int ck = 0; ck < 32; ++ck) {
            for (int idx = F.tid; idx < 64 * 160; idx += NTHREADS) {
                const int tl = idx / 160, cp = idx % 160; int ch; float* dst;
                if (cp < 32) { ch = h * 64 + 2 * cp; dst = xs + tl * 64 + 2 * cp; }
                else if (cp < 96) { ch = 768 + g * 128 + 2 * (cp - 32); dst = Bs + tl * 128 + 2 * (cp - 32); }
                else { ch = 1280 + g * 128 + 2 * (cp - 96); dst = Cs + tl * 128 + 2 * (cp - 96); }
                const int t = ck * 64 + tl; float a0 = conv_b[ch], a1 = conv_b[ch + 1];
#pragma unroll
                for (int j = 0; j < 4; ++j) { const int tt = t - 3 + j; if (tt >= 0) { const unsigned w = *(const unsigned*)(proj + (size_t)(b * SEQ + tt) * NPROJ + COL_XS + ch);
                        a0 += conv_w[j * 1792 + ch] * bf_lo(w); a1 += conv_w[j * 1792 + ch + 1] * bf_hi(w); } }
                dst[0] = siluf_(a0); dst[1] = siluf_(a1);
            }
            if (F.tid < 64) { const int t = ck * 64 + F.tid; const float v = dtraw[(size_t)(b * SEQ + t) * 16 + h] + dtb; dts[F.tid] = v > 20.f ? v : log1pf(__expf(v)); }
            __syncthreads();
            for (int tl = 0; tl < 64; ++tl) {
                const float dt = dts[tl], xv = xs[tl * 64 + p], dA = __expf(dt * a), xdt = xv * dt; float ys = 0.f;
                const f32x4* bp = (const f32x4*)(Bs + tl * 128 + nq * 16); const f32x4* cp4 = (const f32x4*)(Cs + tl * 128 + nq * 16);
#pragma unroll
                for (int q = 0; q < 4; ++q) { const f32x4 bv = bp[q], cv = cp4[q];
#pragma unroll
                    for (int i = 0; i < 4; ++i) { st[q * 4 + i] = st[q * 4 + i] * dA + xdt * bv[i]; ys += cv[i] * st[q * 4 + i]; } }
                ys += __shfl_xor(ys, 1); ys += __shfl_xor(ys, 2); ys += __shfl_xor(ys, 4);
                if (nq == 0) ybuf[(size_t)(b * SEQ + ck * 64 + tl) * 768 + h * 64 + p] = ys + dsk * xv;
            }
            __syncthreads();
        }
    }
}

__device__ __forceinline__ void p3b_gate_pool(const Frame& F, const Params& P) {
    const bf16_t* proj = (const bf16_t*)(P.ws + WS_PROJ); const float* ybuf = (const float*)(P.ws + WS_YBUF); bf16_t* mix = (bf16_t*)(P.ws + WS_MIX);
    const float* norm_w = P.in[12];
    float nw[12];
#pragma unroll
    for (int i = 0; i < 12; ++i) nw[i] = norm_w[12 * F.lane + i];
    for (int row = F.gw; row < T; row += F.NGW) {
        const f32x4* yp = (const f32x4*)(ybuf + (size_t)row * 768 + 12 * F.lane); const u32x2* zp = (const u32x2*)(proj + (size_t)row * NPROJ + COL_Z + 12 * F.lane);
        float v[12];
#pragma unroll
        for (int q = 0; q < 3; ++q) { const f32x4 y = yp[q]; const u32x2 z = zp[q]; const float z0 = bf_lo(z.x), z1 = bf_hi(z.x), z2 = bf_lo(z.y), z3 = bf_hi(z.y);
            v[4 * q] = y[0] * siluf_(z0); v[4 * q + 1] = y[1] * siluf_(z1); v[4 * q + 2] = y[2] * siluf_(z2); v[4 * q + 3] = y[3] * siluf_(z3); }
        float ss = 0.f;
#pragma unroll
        for (int i = 0; i < 12; ++i) ss += v[i] * v[i];
        ss += __shfl_xor(ss, 1); ss += __shfl_xor(ss, 2); ss += __shfl_xor(ss, 4); ss += __shfl_xor(ss, 8);
        const float rstd = rsqrtf(ss * (1.f / 192.f) + EPS);
        u32x2* op = (u32x2*)(mix + (size_t)row * DM + 256 + 12 * F.lane);
#pragma unroll
        for (int q = 0; q < 3; ++q) { u32x2 w; w.x = cvt_pk_bf16(v[4 * q] * rstd * nw[4 * q], v[4 * q + 1] * rstd * nw[4 * q + 1]); w.y = cvt_pk_bf16(v[4 * q + 2] * rstd * nw[4 * q + 2], v[4 * q + 3] * rstd * nw[4 * q + 3]); op[q] = w; }
        const int win = 2 << (F.lane >> 4), pos = row & (SEQ - 1); const int cnt = (pos + 1) < win ? (pos + 1) : win;
        const bf16_t* up = proj + (size_t)row * NPROJ + 4 * F.lane;
        float s0 = 0.f, s1 = 0.f, s2 = 0.f, s3 = 0.f, c0 = 0.f, c1 = 0.f, c2 = 0.f, c3 = 0.f;
        for (int j = 0; j < cnt; ++j) { const u32x2 w = *(const u32x2*)(up - (size_t)j * NPROJ); const float e0 = bf_lo(w.x), e1 = bf_hi(w.x), e2 = bf_lo(w.y), e3 = bf_hi(w.y);
            if (j == 0) { c0 = e0; c1 = e1; c2 = e2; c3 = e3; } s0 += e0; s1 += e1; s2 += e2; s3 += e3; }
        const float inv = 1.0f / (float)cnt; u32x2 w; w.x = cvt_pk_bf16(s0 * inv - c0, s1 * inv - c1); w.y = cvt_pk_bf16(s2 * inv - c2, s3 * inv - c3);
        *(u32x2*)(mix + (size_t)row * DM + 4 * F.lane) = w;
    }
}

__device__ __forceinline__ void p5_route(const Frame& F, const Params& P) {
    const float* x1 = (const float*)(P.ws + WS_X1); const float* mod = (const float*)(P.ws + WS_MOD); bf16_t* H = (bf16_t*)(P.ws + WS_H);
    const float* WR = (const float*)(P.ws + WS_WR); float* gates = (float*)(P.ws + WS_GATE); unsigned* list = (unsigned*)(P.ws + WS_LIST); unsigned* gcount = (unsigned*)(P.ws + WS_CTL) + CW_GCOUNT;
    const float* b_group = P.in[15]; const float* b_router = P.in[17];
    float* wl = (float*)F.lds;
    unsigned* lcount = (unsigned*)(F.lds + MISC_OFF);
    unsigned* lbase = lcount + 32;
    unsigned* tinfo = lcount + 64;
    float* twt = (float*)(tinfo + 256 * 4);
    for (int idx = F.tid; idx < 36 * 1024 / 4; idx += NTHREADS) ((f32x4*)wl)[idx] = ((const f32x4*)WR)[idx];
    float bg[4], br[32];
#pragma unroll
    for (int i = 0; i < 4; ++i) bg[i] = b_group[i];
#pragma unroll
    for (int i = 0; i < 32; ++i) br[i] = b_router[i];
    for (int rb = F.vcu; rb < T / 256; rb += F.G) {
        if (F.tid < 32) lcount[F.tid] = 0u;
        __syncthreads();
        for (int it = 0; it < 32; ++it) {
            const int rl = F.wave * 32 + it, row = rb * 256 + rl, b = row >> 11;
            const f32x4* xr = (const f32x4*)(x1 + (size_t)row * DM) + F.lane;
            f32x4 v[4]; float s = 0.f;
#pragma unroll
            for (int j = 0; j < 4; ++j) { v[j] = xr[64 * j]; s += (v[j][0] * v[j][0] + v[j][1] * v[j][1]) + (v[j][2] * v[j][2] + v[j][3] * v[j][3]); }
            const float rstd = rsqrtf(wave_sum(s) * (1.f / DM) + EPS);
            const f32x4* sh = (const f32x4*)(mod + (size_t)b * 6144 + 3 * 1024) + F.lane; const f32x4* sc = (const f32x4*)(mod + (size_t)b * 6144 + 4 * 1024) + F.lane;
            u32x2* o = (u32x2*)(H + (size_t)row * DM) + F.lane;
#pragma unroll
            for (int j = 0; j < 4; ++j) { const f32x4 a = sh[64 * j], m = sc[64 * j]; v[j] = v[j] * rstd * (m + 1.0f) + a; u32x2 w; w.x = cvt_pk_bf16(v[j][0], v[j][1]); w.y = cvt_pk_bf16(v[j][2], v[j][3]); o[64 * j] = w; }
            float lg[36];
#pragma unroll
            for (int q = 0; q < 36; ++q) { float pa = 0.f;
#pragma unroll
                for (int j = 0; j < 4; ++j) { const f32x4 w4 = *(const f32x4*)(wl + q * 1024 + 256 * j + 4 * F.lane); pa += (w4[0] * v[j][0] + w4[1] * v[j][1]) + (w4[2] * v[j][2] + w4[3] * v[j][3]); }
                lg[q] = wave_sum(pa); }
            float gl[4];
#pragma unroll
            for (int i = 0; i < 4; ++i) gl[i] = lg[i] + bg[i];
            int gi = 0; float gm = gl[0];
#pragma unroll
            for (int i = 1; i < 4; ++i) if (gl[i] > gm) { gm = gl[i]; gi = i; }
            float den = 0.f;
#pragma unroll
            for (int i = 0; i < 4; ++i) den += __expf(gl[i] - gm);
            const float pg = 1.0f / den;
            float el[8];
#pragma unroll
            for (int i = 0; i < 8; ++i) { const float e0 = lg[4 + i] + br[i], e1 = lg[12 + i] + br[8 + i], e2 = lg[20 + i] + br[16 + i], e3 = lg[28 + i] + br[24 + i]; el[i] = gi == 0 ? e0 : (gi == 1 ? e1 : (gi == 2 ? e2 : e3)); }
            int i0 = 0; float v0 = el[0];
#pragma unroll
            for (int i = 1; i < 8; ++i) if (el[i] > v0) { v0 = el[i]; i0 = i; }
            int i1 = -1; float v1 = -3.0e38f;
#pragma unroll
            for (int i = 0; i < 8; ++i) if (i != i0 && el[i] > v1) { v1 = el[i]; i1 = i; }
            const float ex = __expf(v1 - v0); const float w0 = pg / (1.0f + ex), w1 = pg * ex / (1.0f + ex);
            if (F.lane == 0) { const int e0 = gi * 8 + i0, e1 = gi * 8 + i1; const unsigned r0 = atomicAdd(&lcount[e0], 1u), r1 = atomicAdd(&lcount[e1], 1u);
                tinfo[rl * 4 + 0] = (unsigned)e0 | ((unsigned)e1 << 8); tinfo[rl * 4 + 1] = r0; tinfo[rl * 4 + 2] = r1; twt[rl * 2] = w0; twt[rl * 2 + 1] = w1; }
        }
        __syncthreads();
        if (F.tid < 32) lbase[F.tid] = atomicAdd(&gcount[64 * F.tid], lcount[F.tid]);
        __syncthreads();
        if (F.tid < 256) { const int rl = F.tid, row = rb * 256 + rl; const unsigned ee = tinfo[rl * 4], e0 = ee & 255u, e1 = ee >> 8;
            list[(size_t)e0 * ECAP + lbase[e0] + tinfo[rl * 4 + 1]] = (unsigned)row * 2u; list[(size_t)e1 * ECAP + lbase[e1] + tinfo[rl * 4 + 2]] = (unsigned)row * 2u + 1u;
            gates[row * 2] = twt[rl * 2]; gates[row * 2 + 1] = twt[rl * 2 + 1]; }
        __syncthreads();
    }
}

__device__ __forceinline__ void p8_final(const Frame& F, const Params& P) {
    const float* x1 = (const float*)(P.ws + WS_X1); const bf16_t* Y0 = (const bf16_t*)(P.ws + WS_Y0); const bf16_t* Y1 = (const bf16_t*)(P.ws + WS_Y1); const float* fw = P.in[20];
    f32x4 wv[4];
#pragma unroll
    for (int j = 0; j < 4; ++j) wv[j] = ((const f32x4*)fw)[F.lane + 64 * j];
    for (int row = F.gw; row < T; row += F.NGW) {
        const f32x4* xr = (const f32x4*)(x1 + (size_t)row * DM) + F.lane; const u32x2* y0 = (const u32x2*)(Y0 + (size_t)row * DM) + F.lane; const u32x2* y1 = (const u32x2*)(Y1 + (size_t)row * DM) + F.lane;
        f32x4 v[4]; float s = 0.f;
#pragma unroll
        for (int j = 0; j < 4; ++j) { const u32x2 a = y0[64 * j], c = y1[64 * j]; v[j] = xr[64 * j];
            v[j][0] += bf_lo(a.x) + bf_lo(c.x); v[j][1] += bf_hi(a.x) + bf_hi(c.x); v[j][2] += bf_lo(a.y) + bf_lo(c.y); v[j][3] += bf_hi(a.y) + bf_hi(c.y);
            s += (v[j][0] * v[j][0] + v[j][1] * v[j][1]) + (v[j][2] * v[j][2] + v[j][3] * v[j][3]); }
        const float rstd = rsqrtf(wave_sum(s) * (1.f / DM) + EPS);
        f32x4* o = (f32x4*)(P.out + (size_t)row * DM) + F.lane;
#pragma unroll
        for (int j = 0; j < 4; ++j) o[64 * j] = v[j] * rstd * wv[j];
    }
}

__device__ __forceinline__ void moe_prefix(const Frame& F, const Params& P, int* pref) {
    const unsigned* gcount = (const unsigned*)(P.ws + WS_CTL) + CW_GCOUNT;
    __syncthreads();
    if (F.tid == 0) { int acc = 0; for (int e = 0; e < 32; ++e) { const int c = (int)__hip_atomic_load(gcount + 64 * e, __ATOMIC_RELAXED, __HIP_MEMORY_SCOPE_AGENT); pref[e] = acc; pref[33 + e] = c; acc += (c + 255) >> 8; } pref[32] = acc; }
    __syncthreads();
}

__global__ void __launch_bounds__(NTHREADS, 2) fwd_kernel(Params P) {
    extern __shared__ __attribute__((aligned(16))) unsigned char lds[];
    Frame F; F.lds = lds; F.tid = threadIdx.x; F.lane = F.tid & 63; F.wave = __builtin_amdgcn_readfirstlane(F.tid >> 6);
    F.G = gridDim.x; { const int bx = blockIdx.x; F.vcu = (F.G % 8 == 0) ? (bx % 8) * (F.G / 8) + bx / 8 : bx; }
    F.gw = F.vcu * NWAVES + F.wave; F.NGW = F.G * NWAVES;
    unsigned char* ws = P.ws;
    const int lo = P.ph_lo, hi = P.ph_hi;
#define IN(k) (lo <= (k) && (k) < hi)
    if (IN(0)) p0_prep(F, P);
    if (IN(1)) p1_modulate(F, P);
    if (IN(2)) { pg8::DenseSched S; S.init(ws + WS_H, ws + WS_WIN, T, NPROJ, 1024, F.G, (int)blockIdx.x); pg8::EpiProj E{(bf16_t*)(ws + WS_PROJ), (float*)(ws + WS_DTRAW)}; pg8::gemm_phase(( LAS unsigned char*)lds, S, E); }
    if (IN(3)) p3a_ssd_naive(F, P);
    if (IN(4)) p3b_gate_pool(F, P);
    if (IN(5)) { pg8::DenseSched S; S.init(ws + WS_MIX, ws + WS_WOUT, T, 1024, 1024, F.G, (int)blockIdx.x); pg8::EpiX1 E{P.in[0], (const float*)(ws + WS_MOD), (float*)(ws + WS_X1)}; pg8::gemm_phase((LAS unsigned char*)lds, S, E); }
    if (IN(6)) p5_route(F, P);
    if (IN(7)) { int* pref = (int*)(lds + MISC_OFF); moe_prefix(F, P, pref);
        pg8::MoeSched<true> S; S.A = (const char*)(ws + WS_H); S.Bt = (const char*)(ws + WS_W13); S.K = 1024; S.nN = 4; S.G = F.G; S.c = F.vcu; S.pref = (const LAS int*)pref; S.list = (const unsigned*)(ws + WS_LIST);
        pg8::EpiAct E{(bf16_t*)(ws + WS_ACT)}; pg8::gemm_phase((LAS unsigned char*)lds, S, E); }
    if (IN(8)) { int* pref = (int*)(lds + MISC_OFF); moe_prefix(F, P, pref);
        pg8::MoeSched<false> S; S.A = (const char*)(ws + WS_ACT); S.Bt = (const char*)(ws + WS_W2); S.K = 512; S.nN = 4; S.G = F.G; S.c = F.vcu; S.pref = (const LAS int*)pref; S.list = (const unsigned*)(ws + WS_LIST);
        pg8::EpiY E{(const unsigned*)(ws + WS_LIST), (const float*)(ws + WS_GATE), (const float*)(ws + WS_MOD), (bf16_t*)(ws + WS_Y0), (bf16_t*)(ws + WS_Y1)}; pg8::gemm_phase((LAS unsigned char*)lds, S, E); }
    if (IN(9)) p8_final(F, P);
#undef IN
}

extern "C" void kernel_launch(void* const* d_in, const int* in_sizes, int n_in, void* d_out, int out_size, void* d_ws, size_t ws_size, hipStream_t stream) {
    static int grid = 0;
    if (grid == 0) {
        if (n_in != 21 || out_size != T * DM || ws_size < WS_END) { fprintf(stderr, "kernel_launch: unexpected sizes n_in %d out %d ws %zu\n", n_in, out_size, ws_size); grid = -1; return; }
        int dev = 0, cus = 0;
        if (hipGetDevice(&dev) != hipSuccess || hipDeviceGetAttribute(&cus, hipDeviceAttributeMultiprocessorCount, dev) != hipSuccess) { grid = -1; return; }
        if (hipFuncSetAttribute((const void*)fwd_kernel, hipFuncAttributeMaxDynamicSharedMemorySize, LDS_BYTES) != hipSuccess) { fprintf(stderr, "kernel_launch: hipFuncSetAttribute failed\n"); grid = -1; return; }
        grid = cus;
    }
    if (grid < 0) return;
    (void)hipMemsetAsync((char*)d_ws + WS_CTL, 0, CTL_BYTES, stream);
    Params p{};
    for (int i = 0; i < 21; ++i) p.in[i] = (const float*)d_in[i];
    p.out = (float*)d_out; p.ws = (unsigned char*)d_ws;
    for (int ph = 0; ph < 10; ++ph) { p.ph_lo = ph; p.ph_hi = ph + 1; hipLaunchKernelGGL(fwd_kernel, dim3(grid), dim3(NTHREADS), LDS_BYTES, stream, p); }
}
```

```cpp
#include <hip/hip_runtime.h>
#include <hip/hip_cooperative_groups.h>
#include <cstdio>
#include <cstdint>

#ifndef MK_ONE_LAUNCH
#define MK_ONE_LAUNCH 0
#endif

#define LAS __attribute__((address_space(3)))
typedef unsigned short bf16_t;
typedef short bf16x8 __attribute__((ext_vector_type(8)));
typedef float f32x4 __attribute__((ext_vector_type(4)));
typedef float f32x2 __attribute__((ext_vector_type(2)));
typedef unsigned u32x4 __attribute__((ext_vector_type(4)));
typedef unsigned u32x2 __attribute__((ext_vector_type(2)));

constexpr int BATCH = 32, SEQ = 2048, DM = 1024, T = BATCH * SEQ;
constexpr int NPROJ = 3072, NPROJ_REAL = 2828;
constexpr int COL_Z = 256, COL_XS = 1024, COL_B = 1792, COL_C = 2304, COL_DT = 2816;
constexpr int NEXP = 32, FF = 512, ECAP = 65536;
constexpr int NWAVES = 8, NTHREADS = 512;
constexpr float EPS = 1e-6f;

constexpr size_t MiB = 1u << 20;
constexpr size_t WS_CTL = 0, CTL_BYTES = 1 * MiB;
constexpr size_t WS_MOD = 1 * MiB;
constexpr size_t WS_WR = 2 * MiB;
constexpr size_t WS_GATE = 3 * MiB;
constexpr size_t WS_DTRAW = 4 * MiB;
constexpr size_t WS_LIST = 8 * MiB;
constexpr size_t WS_WIN = 16 * MiB;
constexpr size_t WS_WOUT = 22 * MiB;
constexpr size_t WS_W13 = 24 * MiB;
constexpr size_t WS_W2 = 88 * MiB;
constexpr size_t WS_H = 128 * MiB;
constexpr size_t WS_PROJ = 256 * MiB;
constexpr size_t WS_MIX = 640 * MiB;
constexpr size_t WS_X1 = 768 * MiB;
constexpr size_t WS_END = 1024 * MiB;
constexpr size_t WS_YBUF = WS_X1;
constexpr size_t WS_Y0 = 256 * MiB, WS_Y1 = 384 * MiB;
constexpr size_t WS_ACT = 512 * MiB;
constexpr int CW_GCOUNT = 256;
constexpr int CW_BAR = 4096;

constexpr int LDS_BYTES = 163840;
constexpr int MISC_OFF = 147456;

struct Params {
    const float* in[21];
    float* out;
    unsigned char* ws;
    int ph_lo, ph_hi;
};

__device__ __forceinline__ unsigned cvt_pk_bf16(float lo, float hi) { unsigned r; asm volatile("v_cvt_pk_bf16_f32 %0, %1, %2" : "=v"(r) : "v"(lo), "v"(hi)); return r; }
__device__ __forceinline__ float bf_lo(unsigned u) { return __uint_as_float(u << 16); }
__device__ __forceinline__ float bf_hi(unsigned u) { return __uint_as_float(u & 0xffff0000u); }
__device__ __forceinline__ float wave_sum(float v) {
#pragma unroll
    for (int o = 1; o < 64; o <<= 1) v += __shfl_xor(v, o);
    return v;
}
__device__ __forceinline__ float sigmoidf_(float v) { return __builtin_amdgcn_rcpf(1.0f + __expf(-v)); }
__device__ __forceinline__ float siluf_(float v) { return v * sigmoidf_(v); }

namespace pg8 {
constexpr int BM = 256, BK = 64, HALF = 128, HTB = HALF * BK * 2, STAGE_BYTES = 8 * HTB, NXCD = 8, WGM = 8;
__host__ __device__ __forceinline__ int lds_byte(int r, int c) { const int st = (r >> 4) * 2 + (c >> 5), rr = r & 15, cc = c & 31, ob = rr * 64 + cc * 2; return st * 1024 + (ob ^ (((ob >> 9) & 1) << 5)); }
__host__ __device__ __forceinline__ void stage_rc(int b, int& R, int& C) { const int st = b / 1024, sb = b % 1024, swz = sb ^ (((sb >> 9) & 1) << 5); R = (st >> 1) * 16 + swz / 64; C = (st & 1) * 32 + (swz % 64) / 2; }
__host__ __device__ __forceinline__ int perm32(int rho) { const int n = rho >> 4, i = rho & 15; return 8 * (i >> 2) + 4 * n + (i & 3); }

struct Unit { int pm, pn, e, cnt, slot0; };

struct DenseSched {
    const char* A; const char* Bt; int K;
    int nM, nN, nwg, G, c;
    __device__ void init(const void* A_, const void* Bt_, int M, int N, int K_, int G_, int c_) { A = (const char*)A_; Bt = (const char*)Bt_; K = K_; nM = M / BM; nN = N / BM; nwg = nM * nN; G = G_; c = c_; }
    __device__ __forceinline__ bool next(int i, Unit& u) const {
        const long L = (long)i * G + c; if (L >= nwg) return false;
        int wgid = (int)L; { const int q = nwg / NXCD, r = nwg % NXCD, xcd = wgid % NXCD, off = wgid / NXCD; wgid = (xcd < r ? xcd * (q + 1) : r * (q + 1) + (xcd - r) * q) + off; }
        const int nig = WGM * nN, gid = wgid / nig, fm = gid * WGM, gsz = (nM - fm) < WGM ? (nM - fm) : WGM;
        u.pm = fm + ((wgid % nig) % gsz); u.pn = (wgid % nig) / gsz; u.e = 0; u.cnt = 256; u.slot0 = 0; return true;
    }
    __device__ __forceinline__ const char* a_base() const { return A; }
    __device__ __forceinline__ void a_off(const Unit& u, const int (&R)[2], const int (&C)[2], unsigned (&o)[2][2]) const {
#pragma unroll
        for (int h = 0; h < 2; ++h)
#pragma unroll
            for (int i = 0; i < 2; ++i) o[h][i] = (unsigned)((u.pm * BM + h * HALF + R[i]) * K + C[i]) * 2u;
    }
    __device__ __forceinline__ const char* b_ptr(const Unit& u) const { return Bt + (size_t)u.pn * BM * K * 2; }
};

template <bool GATHER>
struct MoeSched {
    const char* A; const char* Bt; int K, nN, G, c;
    const LAS int* pref;
    const unsigned* list;
    __device__ __forceinline__ bool next(int i, Unit& u) const {
        const long L = (long)i * G + c; const int tot = pref[32] * nN; if (L >= tot) return false;
        const int ti = (int)L / nN; u.pn = (int)L % nN;
        int e = 0;
#pragma unroll 1
        for (int j = 1; j < 32; ++j) if (pref[j] <= ti) e = j;
        const int mt = ti - pref[e]; u.pm = ti; u.e = e; u.slot0 = mt * 256; const int rem = pref[33 + e] - mt * 256; u.cnt = rem < 256 ? rem : 256; return true;
    }
    __device__ __forceinline__ const char* a_base() const { return A; }
    __device__ __forceinline__ void a_off(const Unit& u, const int (&R)[2], const int (&C)[2], unsigned (&o)[2][2]) const {
#pragma unroll
        for (int h = 0; h < 2; ++h)
#pragma unroll
            for (int i = 0; i < 2; ++i) {
                const int r = h * HALF + R[i];
                if (GATHER) { unsigned tok = 0; if (r < u.cnt) tok = list[(size_t)u.e * ECAP + u.slot0 + r] >> 1; o[h][i] = (unsigned)(tok * K + C[i]) * 2u; }
                else o[h][i] = (unsigned)((u.pm * BM + r) * K + C[i]) * 2u;
            }
    }
    __device__ __forceinline__ const char* b_ptr(const Unit& u) const { return Bt + ((size_t)u.e * (nN * BM) + (size_t)u.pn * BM) * K * 2; }
};

template <class Epi, class Sched>
__device__ __forceinline__ void gemm_phase(LAS unsigned char* lds, const Sched& S, const Epi& E) {
    const int tid = threadIdx.x, wid = __builtin_amdgcn_readfirstlane(tid >> 6), lane = tid & 63, wr = wid >> 2, wc = wid & 3, fr = lane & 15, fq = lane >> 4;
    const int K = S.K, nt = K / BK;
    int sR[2], sC[2]; unsigned voffB[2];
#pragma unroll
    for (int i = 0; i < 2; ++i) { int R, C; stage_rc(tid * 16 + i * 8192, R, C); sR[i] = R; sC[i] = C; const int Rb = Epi::PERM ? ((R & ~31) + perm32(R & 31)) : R; voffB[i] = (unsigned)(Rb * K + C) * 2u; }
    const size_t kstep = (size_t)(BK * 2);
    const size_t hstep = (size_t)HALF * K * 2;
    const unsigned ldsw = (unsigned)wid * 1024u;
    const int aoff = lds_byte(wr * 64 + fr, fq * 8), boff = lds_byte(wc * 32 + fr, fq * 8);
#define PG8_SA(b, h) (((b) * 2 + (h)) * HTB)
#define PG8_SB(b, h) ((4 + (b) * 2 + (h)) * HTB)
#define PG8_STAGE(bufoff, gbase, voff) do { _Pragma("unroll") for (int _i = 0; _i < 2; ++_i) \
        __builtin_amdgcn_global_load_lds((const unsigned*)((const char*)(gbase) + (voff)[_i]), (LAS unsigned*)(lds + (bufoff) + ldsw + _i * 8192), 16, 0, 0); } while (0)
#define PG8_LDA(dst, b, h) do { _Pragma("unroll") for (int m = 0; m < 4; ++m) _Pragma("unroll") for (int k = 0; k < 2; ++k) dst[m][k] = *(const LAS bf16x8*)(lds + PG8_SA(b, h) + aoff + m * 2048 + k * 1024); } while (0)
#define PG8_LDB(dst, b, h) do { _Pragma("unroll") for (int n = 0; n < 2; ++n) _Pragma("unroll") for (int k = 0; k < 2; ++k) dst[n][k] = *(const LAS bf16x8*)(lds + PG8_SB(b, h) + boff + n * 2048 + k * 1024); } while (0)
#define PG8_MMA(ai, bj, At, Bt) do { __builtin_amdgcn_s_setprio(1); _Pragma("unroll") for (int m = 0; m < 4; ++m) _Pragma("unroll") for (int n = 0; n < 2; ++n) _Pragma("unroll") for (int k = 0; k < 2; ++k) \
        acc[ai][bj][m][n] = __builtin_amdgcn_mfma_f32_16x16x32_bf16(Bt[n][k], At[m][k], acc[ai][bj][m][n], 0, 0, 0); __builtin_amdgcn_s_setprio(0); } while (0)
#define PG8_WAIT_V(n) asm volatile("s_waitcnt vmcnt(" #n ")" ::: "memory")
#define PG8_WAIT_L(n) asm volatile("s_waitcnt lgkmcnt(" #n ")" ::: "memory")
#define PG8_BAR __builtin_amdgcn_s_barrier()
#define PG8_SCHED __builtin_amdgcn_sched_barrier(0)
    Unit cur, nxt; int ui = 0;
    if (!S.next(0, cur)) return;
    f32x4 acc[2][2][4][2];
#pragma unroll
    for (int a = 0; a < 2; ++a)
#pragma unroll
        for (int b = 0; b < 2; ++b)
#pragma unroll
            for (int m = 0; m < 4; ++m)
#pragma unroll
                for (int n = 0; n < 2; ++n) acc[a][b][m][n] = (f32x4){0.f, 0.f, 0.f, 0.f};
    bf16x8 At[4][2], B0[2][2], B1[2][2];
    unsigned aoC[2][2], aoN[2][2];
    S.a_off(cur, sR, sC, aoC);
    const char* const Ab = S.a_base();
    const char* cB = S.b_ptr(cur);
    PG8_STAGE(PG8_SB(0, 0), cB, voffB); PG8_STAGE(PG8_SB(0, 1), cB + hstep, voffB); PG8_STAGE(PG8_SA(0, 0), Ab, aoC[0]); PG8_STAGE(PG8_SA(0, 1), Ab, aoC[1]);
    if (wr == 1) PG8_BAR;
    PG8_WAIT_V(2); PG8_BAR;
    PG8_STAGE(PG8_SB(1, 0), cB + kstep, voffB); PG8_STAGE(PG8_SA(1, 0), Ab + kstep, aoC[0]); PG8_STAGE(PG8_SB(1, 1), cB + hstep + kstep, voffB);
    PG8_WAIT_V(6); PG8_BAR;
    for (;;) {
        const bool has_next = S.next(ui + 1, nxt);
        const char* nB = cB;
        if (has_next) { S.a_off(nxt, sR, sC, aoN); nB = S.b_ptr(nxt); }
        else {
#pragma unroll
            for (int h = 0; h < 2; ++h)
#pragma unroll
                for (int i = 0; i < 2; ++i) aoN[h][i] = aoC[h][i];
        }
        for (int t = 0; t < nt; t += 2) {
            const bool last = (t == nt - 2);
            const char* a1 = Ab + (size_t)(t + 1) * kstep;
            const char* a2 = last ? Ab : Ab + (size_t)(t + 2) * kstep; const char* b2 = last ? nB : cB + (size_t)(t + 2) * kstep;
            const char* a3 = a2 + kstep; const char* b3 = b2 + kstep;
            unsigned o2[2][2];
#pragma unroll
            for (int h = 0; h < 2; ++h)
#pragma unroll
                for (int i = 0; i < 2; ++i) o2[h][i] = last ? aoN[h][i] : aoC[h][i];
            PG8_LDB(B0, 0, 0); PG8_LDB(B1, 0, 1); PG8_SCHED; PG8_LDA(At, 0, 0); PG8_STAGE(PG8_SA(1, 1), a1, aoC[1]);
            PG8_WAIT_V(8); PG8_WAIT_L(0); PG8_BAR; PG8_MMA(0, 0, At, B0); PG8_MMA(0, 1, At, B1); PG8_BAR; PG8_SCHED;
            PG8_LDA(At, 0, 1); PG8_STAGE(PG8_SB(0, 0), b2, voffB); PG8_STAGE(PG8_SB(0, 1), b2 + hstep, voffB); PG8_STAGE(PG8_SA(0, 0), a2, o2[0]);
            PG8_WAIT_V(8); PG8_WAIT_L(0); PG8_BAR; PG8_MMA(1, 0, At, B0); PG8_MMA(1, 1, At, B1); PG8_BAR; PG8_SCHED;
            PG8_LDB(B0, 1, 0); PG8_LDB(B1, 1, 1); PG8_SCHED; PG8_LDA(At, 1, 0); PG8_STAGE(PG8_SA(0, 1), a2, o2[1]);
            PG8_WAIT_V(8); PG8_WAIT_L(0); PG8_BAR; PG8_MMA(0, 0, At, B0); PG8_MMA(0, 1, At, B1); PG8_BAR; PG8_SCHED;
            PG8_LDA(At, 1, 1); PG8_STAGE(PG8_SB(1, 0), b3, voffB); PG8_STAGE(PG8_SB(1, 1), b3 + hstep, voffB); PG8_STAGE(PG8_SA(1, 0), a3, o2[0]);
            PG8_WAIT_V(8); PG8_WAIT_L(0); PG8_BAR; PG8_MMA(1, 0, At, B0); PG8_MMA(1, 1, At, B1); PG8_BAR; PG8_SCHED;
        }
        if (wr == 0) PG8_BAR;
        E(acc, cur, wr, wc, fr, fq);
        if (!has_next) break;
#pragma unroll
        for (int a = 0; a < 2; ++a)
#pragma unroll
            for (int b = 0; b < 2; ++b)
#pragma unroll
                for (int m = 0; m < 4; ++m)
#pragma unroll
                    for (int n = 0; n < 2; ++n) acc[a][b][m][n] = (f32x4){0.f, 0.f, 0.f, 0.f};
        cur = nxt; cB = nB; ++ui;
#pragma unroll
        for (int h = 0; h < 2; ++h)
#pragma unroll
            for (int i = 0; i < 2; ++i) aoC[h][i] = aoN[h][i];
        if (wr == 1) PG8_BAR;
    }
    PG8_WAIT_V(0);
    PG8_BAR;
#undef PG8_SA
#undef PG8_SB
#undef PG8_STAGE
#undef PG8_LDA
#undef PG8_LDB
#undef PG8_MMA
#undef PG8_WAIT_V
#undef PG8_WAIT_L
#undef PG8_BAR
#undef PG8_SCHED
}

struct EpiProj {
    static constexpr bool PERM = true;
    bf16_t* O; float* dtraw;
    __device__ __forceinline__ void operator()(const f32x4 (&acc)[2][2][4][2], const Unit& u, int wr, int wc, int fr, int fq) const {
        const int row0 = u.pm * BM + wr * 64 + fr, col0 = u.pn * BM + wc * 32 + 8 * fq;
#pragma unroll
        for (int ai = 0; ai < 2; ++ai)
#pragma unroll
            for (int m = 0; m < 4; ++m) { const int row = row0 + ai * HALF + m * 16; bf16_t* rowp = O + (size_t)row * NPROJ + col0;
#pragma unroll
                for (int bj = 0; bj < 2; ++bj) { const f32x4 v0 = acc[ai][bj][m][0], v1 = acc[ai][bj][m][1];
                    u32x4 w; w.x = cvt_pk_bf16(v0[0], v0[1]); w.y = cvt_pk_bf16(v0[2], v0[3]); w.z = cvt_pk_bf16(v1[0], v1[1]); w.w = cvt_pk_bf16(v1[2], v1[3]);
                    *(u32x4*)(rowp + bj * HALF) = w; }
                if (u.pn == 11 && wc == 0 && fq < 2) { float* d = dtraw + (size_t)row * 16 + 8 * fq; *(f32x4*)d = acc[ai][0][m][0]; *(f32x4*)(d + 4) = acc[ai][0][m][1]; }
            }
    }
};
struct EpiX1 {
    static constexpr bool PERM = false;
    const float* x; const float* mod; float* x1;
    __device__ __forceinline__ void operator()(const f32x4 (&acc)[2][2][4][2], const Unit& u, int wr, int wc, int fr, int fq) const {
        const int row0 = u.pm * BM + wr * 64 + fr, col0 = u.pn * BM + wc * 32 + 4 * fq; const int b = (u.pm * BM) >> 11;
        f32x4 gv[2][2];
#pragma unroll
        for (int bj = 0; bj < 2; ++bj)
#pragma unroll
            for (int n = 0; n < 2; ++n) gv[bj][n] = *(const f32x4*)(mod + (size_t)b * 6144 + 2 * 1024 + col0 + bj * HALF + n * 16);
#pragma unroll
        for (int ai = 0; ai < 2; ++ai)
#pragma unroll
            for (int m = 0; m < 4; ++m) { const size_t off = (size_t)(row0 + ai * HALF + m * 16) * DM + col0;
#pragma unroll
                for (int bj = 0; bj < 2; ++bj)
#pragma unroll
                    for (int n = 0; n < 2; ++n) { const f32x4 xv = *(const f32x4*)(x + off + bj * HALF + n * 16); *(f32x4*)(x1 + off + bj * HALF + n * 16) = xv + gv[bj][n] * acc[ai][bj][m][n]; } }
    }
};
struct EpiAct {
    static constexpr bool PERM = true;
    bf16_t* act;
    __device__ __forceinline__ void operator()(const f32x4 (&acc)[2][2][4][2], const Unit& u, int wr, int wc, int fr, int fq) const {
        const int row0 = u.pm * BM + wr * 64 + fr, col0 = u.pn * HALF + wc * 32 + 8 * fq;
#pragma unroll
        for (int ai = 0; ai < 2; ++ai)
#pragma unroll
            for (int m = 0; m < 4; ++m) { bf16_t* p = act + (size_t)(row0 + ai * HALF + m * 16) * FF + col0; float o[8];
#pragma unroll
                for (int n = 0; n < 2; ++n)
#pragma unroll
                    for (int i = 0; i < 4; ++i) { const float a = acc[ai][0][m][n][i], b = acc[ai][1][m][n][i]; o[n * 4 + i] = siluf_(a) * b; }
                u32x4 w; w.x = cvt_pk_bf16(o[0], o[1]); w.y = cvt_pk_bf16(o[2], o[3]); w.z = cvt_pk_bf16(o[4], o[5]); w.w = cvt_pk_bf16(o[6], o[7]);
                *(u32x4*)p = w; }
    }
};
struct EpiY {
    static constexpr bool PERM = true;
    const unsigned* list; const float* gates; const float* mod; bf16_t* Y0; bf16_t* Y1;
    __device__ __forceinline__ void operator()(const f32x4 (&acc)[2][2][4][2], const Unit& u, int wr, int wc, int fr, int fq) const {
        const int col0 = u.pn * BM + wc * 32 + 8 * fq;
#pragma unroll
        for (int ai = 0; ai < 2; ++ai)
#pragma unroll
            for (int m = 0; m < 4; ++m) { const int r = ai * HALF + wr * 64 + m * 16 + fr;
                if (r < u.cnt) {
                    const unsigned ent = list[(size_t)u.e * ECAP + u.slot0 + r]; const unsigned tok = ent >> 1; const float gate = gates[ent];
                    bf16_t* yp = ((ent & 1u) ? Y1 : Y0) + (size_t)tok * DM + col0; const float* gp = mod + (size_t)(tok >> 11) * 6144 + 5 * 1024 + col0;
#pragma unroll
                    for (int bj = 0; bj < 2; ++bj) { const f32x4 g0 = *(const f32x4*)(gp + bj * HALF), g1 = *(const f32x4*)(gp + bj * HALF + 4);
                        const f32x4 v0 = acc[ai][bj][m][0] * g0 * gate, v1 = acc[ai][bj][m][1] * g1 * gate;
                        u32x4 w; w.x = cvt_pk_bf16(v0[0], v0[1]); w.y = cvt_pk_bf16(v0[2], v0[3]); w.z = cvt_pk_bf16(v1[0], v1[1]); w.w = cvt_pk_bf16(v1[2], v1[3]);
                        *(u32x4*)(yp + bj * HALF) = w; } } }
    }
};
}

struct Frame {
    unsigned char* lds; int tid, lane, wave, vcu, G, gw, NGW;
};

__device__ __forceinline__ void transpose_item(const float* W, int ldw, int nvalid, int k0, int n0, bf16_t* WT, int K, int dst_row0, float* scr, int lane) {
#pragma unroll 8
    for (int i = 0; i < 32; ++i) { const int kk = 2 * i + (lane >> 5); const int n = n0 + (lane & 31); scr[kk * 33 + (lane & 31)] = (n < nvalid) ? W[(size_t)(k0 + kk) * ldw + n] : 0.f; }
    asm volatile("s_waitcnt lgkmcnt(0)" ::: "memory");
    const int c = lane & 7;
#pragma unroll
    for (int j = 0; j < 4; ++j) { const int n = (lane >> 3) + 8 * j; const float* s = scr + (8 * c) * 33 + n;
        u32x4 o; o.x = cvt_pk_bf16(s[0 * 33], s[1 * 33]); o.y = cvt_pk_bf16(s[2 * 33], s[3 * 33]); o.z = cvt_pk_bf16(s[4 * 33], s[5 * 33]); o.w = cvt_pk_bf16(s[6 * 33], s[7 * 33]);
        *(u32x4*)(WT + (size_t)(dst_row0 + n0 + n) * K + k0 + 8 * c) = o; }
    asm volatile("s_waitcnt lgkmcnt(0)" ::: "memory");
}

__device__ __forceinline__ void p0_prep(const Frame& F, const Params& P) {
    unsigned char* ws = P.ws;
    {
        float* sct = (float*)F.lds;
        const float* c = P.in[1];
        for (int idx = F.tid; idx < 32 * 1024; idx += NTHREADS) { const int b = idx >> 10, k = idx & 1023; sct[k * 32 + b] = siluf_(c[idx]); }
        __syncthreads();
        const float* w_ada = P.in[2]; const float* b_ada = P.in[3]; float* mod = (float*)(ws + WS_MOD);
        for (int cg = F.vcu; cg < 256; cg += F.G) {
            const int j = F.tid % 24, kg = F.tid / 24;
            float acc[32];
#pragma unroll
            for (int b = 0; b < 32; ++b) acc[b] = 0.f;
            if (kg < 16) {
                for (int kk = 0; kk < 64; ++kk) { const int k = kg * 64 + kk; const float w = w_ada[(size_t)k * 6144 + cg * 24 + j];
#pragma unroll
                    for (int q = 0; q < 8; ++q) { const f32x4 s = *(const f32x4*)(sct + k * 32 + 4 * q); acc[4 * q] += s[0] * w; acc[4 * q + 1] += s[1] * w; acc[4 * q + 2] += s[2] * w; acc[4 * q + 3] += s[3] * w; } }
            }
            float* px = (float*)(F.lds + 131072);
            float tot[2] = {0.f, 0.f};
#pragma unroll 1
            for (int half = 0; half < 2; ++half) {
                if (kg < 16 && (kg >> 3) == half) {
#pragma unroll
                    for (int b = 0; b < 32; ++b) px[((kg & 7) * 24 + j) * 32 + b] = acc[b];
                }
                __syncthreads();
#pragma unroll
                for (int r = 0; r < 2; ++r) { const int o = F.tid + r * 512; if (o < 768) { float s = 0.f;
#pragma unroll
                        for (int q = 0; q < 8; ++q) s += px[q * 768 + o]; tot[r] += s; } }
                __syncthreads();
            }
#pragma unroll
            for (int r = 0; r < 2; ++r) { const int o = F.tid + r * 512; if (o < 768) { const int jj = o >> 5, b = o & 31; mod[(size_t)b * 6144 + cg * 24 + jj] = tot[r] + b_ada[cg * 24 + jj]; } }
        }
        __syncthreads();
    }
    {
        float* scr = (float*)(F.lds + F.wave * 16384);
        const float* w_in = P.in[4]; const float* w_out = P.in[13]; const float* w13 = P.in[18]; const float* w2 = P.in[19];
        bf16_t* WIN = (bf16_t*)(ws + WS_WIN); bf16_t* WOUT = (bf16_t*)(ws + WS_WOUT); bf16_t* W13 = (bf16_t*)(ws + WS_W13); bf16_t* W2 = (bf16_t*)(ws + WS_W2);
        constexpr int I0 = 16 * 88, I1 = 16 * 32, I2 = 32 * 16 * 32, I3 = 32 * 8 * 32, NIT = I0 + I1 + I2 + I3;
        for (int it = F.gw; it < NIT; it += F.NGW) {
            int r = it;
            if (r < I0) { const int kb = r / 88, nb = 8 + r % 88; transpose_item(w_in, NPROJ_REAL, NPROJ_REAL, kb * 64, nb * 32, WIN, 1024, 0, scr, F.lane); continue; } r -= I0;
            if (r < I1) { const int kb = r / 32, nb = r % 32; transpose_item(w_out, 1024, 1024, kb * 64, nb * 32, WOUT, 1024, 0, scr, F.lane); continue; } r -= I1;
            if (r < I2) { const int e = r / 512, q = r % 512, kb = q / 32, nb = q % 32; const int n0 = nb * 32, bj = n0 >> 9, rem = n0 & 511, pn = rem >> 7, j0 = rem & 127;
                transpose_item(w13 + (size_t)e * 1024 * 1024, 1024, 1024, kb * 64, n0, W13 + (size_t)e * 1024 * 1024, 1024, pn * 256 + bj * 128 + j0 - n0, scr, F.lane); continue; } r -= I2;
            { const int e = r / 256, q = r % 256, kb = q / 32, nb = q % 32;
                transpose_item(w2 + (size_t)e * 512 * 1024, 1024, 1024, kb * 64, nb * 32, W2 + (size_t)e * 1024 * 512, 512, 0, scr, F.lane); }
        }
    }
    {
        const float* w_in = P.in[4]; const float* w_pool = P.in[5]; const float* pscale = P.in[6]; bf16_t* WIN = (bf16_t*)(ws + WS_WIN);
        for (int idx = F.vcu * NTHREADS + F.tid; idx < 256 * 1024; idx += F.G * NTHREADS) {
            const int n = idx >> 10, k = idx & 1023, g = n >> 6, d = n & 63; const float* wi = w_in + (size_t)k * NPROJ_REAL + g * 64; const float* wp = w_pool + (size_t)g * 4096 + d;
            float s = 0.f;
#pragma unroll 8
            for (int cc = 0; cc < 64; ++cc) s += wi[cc] * wp[cc * 64];
            s *= pscale[n];
            WIN[(size_t)n * 1024 + k] = (bf16_t)(cvt_pk_bf16(s, 0.f) & 0xffffu);
        }
    }
    {
        const float* wg = P.in[14]; const float* wrt = P.in[16]; float* WR = (float*)(ws + WS_WR);
        for (int idx = F.vcu * NTHREADS + F.tid; idx < 36 * 1024; idx += F.G * NTHREADS) { const int j = idx >> 10, k = idx & 1023; WR[idx] = (j < 4) ? wg[k * 4 + j] : wrt[k * 32 + (j - 4)]; }
    }
}

__device__ __forceinline__ void p1_modulate(const Frame& F, const Params& P) {
    const float* x = P.in[0]; const float* mod = (const float*)(P.ws + WS_MOD); bf16_t* H = (bf16_t*)(P.ws + WS_H);
    for (int row = F.gw; row < T; row += F.NGW) {
        const int b = row >> 11; const f32x4* xr = (const f32x4*)(x + (size_t)row * DM) + F.lane;
        f32x4 v[4]; float s = 0.f;
#pragma unroll
        for (int j = 0; j < 4; ++j) { v[j] = xr[64 * j]; s += (v[j][0] * v[j][0] + v[j][1] * v[j][1]) + (v[j][2] * v[j][2] + v[j][3] * v[j][3]); }
        const float rstd = rsqrtf(wave_sum(s) * (1.f / DM) + EPS);
        const f32x4* sh = (const f32x4*)(mod + (size_t)b * 6144) + F.lane; const f32x4* sc = (const f32x4*)(mod + (size_t)b * 6144 + 1024) + F.lane;
        u32x2* o = (u32x2*)(H + (size_t)row * DM) + F.lane;
#pragma unroll
        for (int j = 0; j < 4; ++j) { const f32x4 a = sh[64 * j], m = sc[64 * j]; const f32x4 h = v[j] * rstd * (m + 1.0f) + a; u32x2 w; w.x = cvt_pk_bf16(h[0], h[1]); w.y = cvt_pk_bf16(h[2], h[3]); o[64 * j] = w; }
    }
}

__device__ __forceinline__ void p3a_ssd_naive(const Frame& F, const Params& P) {
    const bf16_t* proj = (const bf16_t*)(P.ws + WS_PROJ); const float* dtraw = (const float*)(P.ws + WS_DTRAW); float* ybuf = (float*)(P.ws + WS_YBUF);
    const float* conv_w = P.in[7]; const float* conv_b = P.in[8]; const float* dt_bias = P.in[9]; const float* a_log = P.in[10]; const float* d_skip = P.in[11];
    float* xs = (float*)F.lds; float* Bs = xs + 64 * 64; float* Cs = Bs + 64 * 128; float* dts = Cs + 64 * 128;
    for (int u = F.vcu; u < BATCH * 12; u += F.G) {
        const int b = u / 12, h = u % 12, g = h / 3;
        const float a = -__expf(a_log[h]), dsk = d_skip[h], dtb = dt_bias[h];
        const int p = F.tid >> 3, nq = F.tid & 7;
        float st[16];
#pragma unroll
        for (int i = 0; i < 16; ++i) st[i] = 0.f;
        for (int ck = 0; ck < 32; ++ck) {
            for (int idx = F.tid; idx < 64 * 160; idx += NTHREADS) {
                const int tl = idx / 160, cp = idx % 160; int ch; float* dst;
                if (cp < 32) { ch = h * 64 + 2 * cp; dst = xs + tl * 64 + 2 * cp; }
                else if (cp < 96) { ch = 768 + g * 128 + 2 * (cp - 32); dst = Bs + tl * 128 + 2 * (cp - 32); }
                else { ch = 1280 + g * 128 + 2 * (cp - 96); dst = Cs + tl * 128 + 2 * (cp - 96); }
                const int t = ck * 64 + tl; float a0 = conv_b[ch], a1 = conv_b[ch + 1];
#pragma unroll
                for (int j = 0; j < 4; ++j) { const int tt = t - 3 + j; if (tt >= 0) { const unsigned w = *(const unsigned*)(proj + (size_t)(b * SEQ + tt) * NPROJ + COL_XS + ch);
                        a0 += conv_w[j * 1792 + ch] * bf_lo(w); a1 += conv_w[j * 1792 + ch + 1] * bf_hi(w); } }
                dst[0] = siluf_(a0); dst[1] = siluf_(a1);
            }
            if (F.tid < 64) { const int t = ck * 64 + F.tid; const float v = dtraw[(size_t)(b * SEQ + t) * 16 + h] + dtb; dts[F.tid] = v > 20.f ? v : log1pf(__expf(v)); }
            __syncthreads();
            for (int tl = 0; tl < 64; ++tl) {
                const float dt = dts[tl], xv = xs[tl * 64 + p], dA = __expf(dt * a), xdt = xv * dt; float ys = 0.f;
                const f32x4* bp = (const f32x4*)(Bs + tl * 128 + nq * 16); const f32x4* cp4 = (const f32x4*)(Cs + tl * 128 + nq * 16);
#pragma unroll
                for (int q = 0; q < 4; ++q) { const f32x4 bv = bp[q], cv = cp4[q];
#pragma unroll
                    for (int i = 0; i < 4; ++i) { st[q * 4 + i] = st[q * 4 + i] * dA + xdt * bv[i]; ys += cv[i] * st[q * 4 + i]; } }
                ys += __shfl_xor(ys, 1); ys += __shfl_xor(ys, 2); ys += __shfl_xor(ys, 4);
                if (nq == 0) ybuf[(size_t)(b * SEQ + ck * 64 + tl) * 768 + h * 64 + p] = ys + dsk * xv;
            }
            __syncthreads();
        }
    }
}

__device__ __forceinline__ void p3b_gate_pool(const Frame& F, const Params& P) {
    const bf16_t* proj = (const bf16_t*)(P.ws + WS_PROJ); const float* ybuf = (const float*)(P.ws + WS_YBUF); bf16_t* mix = (bf16_t*)(P.ws + WS_MIX);
    const float* norm_w = P.in[12];
    float nw[12];
#pragma unroll
    for (int i = 0; i < 12; ++i) nw[i] = norm_w[12 * F.lane + i];
    for (int row = F.gw; row < T; row += F.NGW) {
        const f32x4* yp = (const f32x4*)(ybuf + (size_t)row * 768 + 12 * F.lane); const u32x2* zp = (const u32x2*)(proj + (size_t)row * NPROJ + COL_Z + 12 * F.lane);
        float v[12];
#pragma unroll
        for (int q = 0; q < 3; ++q) { const f32x4 y = yp[q]; const u32x2 z = zp[q]; const float z0 = bf_lo(z.x), z1 = bf_hi(z.x), z2 = bf_lo(z.y), z3 = bf_hi(z.y);
            v[4 * q] = y[0] * siluf_(z0); v[4 * q + 1] = y[1] * siluf_(z1); v[4 * q + 2] = y[2] * siluf_(z2); v[4 * q + 3] = y[3] * siluf_(z3); }
        float ss = 0.f;
#pragma unroll
        for (int i = 0; i < 12; ++i) ss += v[i] * v[i];
        ss += __shfl_xor(ss, 1); ss += __shfl_xor(ss, 2); ss += __shfl_xor(ss, 4); ss += __shfl_xor(ss, 8);
        const float rstd = rsqrtf(ss * (1.f / 192.f) + EPS);
        u32x2* op = (u32x2*)(mix + (size_t)row * DM + 256 + 12 * F.lane);
#pragma unroll
        for (int q = 0; q < 3; ++q) { u32x2 w; w.x = cvt_pk_bf16(v[4 * q] * rstd * nw[4 * q], v[4 * q + 1] * rstd * nw[4 * q + 1]); w.y = cvt_pk_bf16(v[4 * q + 2] * rstd * nw[4 * q + 2], v[4 * q + 3] * rstd * nw[4 * q + 3]); op[q] = w; }
        const int win = 2 << (F.lane >> 4), pos = row & (SEQ - 1); const int cnt = (pos + 1) < win ? (pos + 1) : win;
        const bf16_t* up = proj + (size_t)row * NPROJ + 4 * F.lane;
        float s0 = 0.f, s1 = 0.f, s2 = 0.f, s3 = 0.f, c0 = 0.f, c1 = 0.f, c2 = 0.f, c3 = 0.f;
        for (int j = 0; j < cnt; ++j) { const u32x2 w = *(const u32x2*)(up - (size_t)j * NPROJ); const float e0 = bf_lo(w.x), e1 = bf_hi(w.x), e2 = bf_lo(w.y), e3 = bf_hi(w.y);
            if (j == 0) { c0 = e0; c1 = e1; c2 = e2; c3 = e3; } s0 += e0; s1 += e1; s2 += e2; s3 += e3; }
        const float inv = 1.0f / (float)cnt; u32x2 w; w.x = cvt_pk_bf16(s0 * inv - c0, s1 * inv - c1); w.y = cvt_pk_bf16(s2 * inv - c2, s3 * inv - c3);
        *(u32x2*)(mix + (size_t)row * DM + 4 * F.lane) = w;
    }
}

__device__ __forceinline__ void p5_route(const Frame& F, const Params& P) {
    const float* x1 = (const float*)(P.ws + WS_X1); const float* mod = (const float*)(P.ws + WS_MOD); bf16_t* H = (bf16_t*)(P.ws + WS_H);
    const float* WR = (const float*)(P.ws + WS_WR); float* gates = (float*)(P.ws + WS_GATE); unsigned* list = (unsigned*)(P.ws + WS_LIST); unsigned* gcount = (unsigned*)(P.ws + WS_CTL) + CW_GCOUNT;
    const float* b_group = P.in[15]; const float* b_router = P.in[17];
    float* wl = (float*)F.lds;
    unsigned* lcount = (unsigned*)(F.lds + MISC_OFF);
    unsigned* lbase = lcount + 32;
    unsigned* tinfo = lcount + 64;
    float* twt = (float*)(tinfo + 256 * 4);
    for (int idx = F.tid; idx < 36 * 1024 / 4; idx += NTHREADS) ((f32x4*)wl)[idx] = ((const f32x4*)WR)[idx];
    float bg[4], br[32];
#pragma unroll
    for (int i = 0; i < 4; ++i) bg[i] = b_group[i];
#pragma unroll
    for (int i = 0; i < 32; ++i) br[i] = b_router[i];
    for (int rb = F.vcu; rb < T / 256; rb += F.G) {
        if (F.tid < 32) lcount[F.tid] = 0u;
        __syncthreads();
        for (int it = 0; it < 32; ++it) {
            const int rl = F.wave * 32 + it, row = rb * 256 + rl, b = row >> 11;
            const f32x4* xr = (const f32x4*)(x1 + (size_t)row * DM) + F.lane;
            f32x4 v[4]; float s = 0.f;
#pragma unroll
            for (int j = 0; j < 4; ++j) { v[j] = xr[64 * j]; s += (v[j][0] * v[j][0] + v[j][1] * v[j][1]) + (v[j][2] * v[j][2] + v[j][3] * v[j][3]); }
            const float rstd = rsqrtf(wave_sum(s) * (1.f / DM) + EPS);
            const f32x4* sh = (const f32x4*)(mod + (size_t)b * 6144 + 3 * 1024) + F.lane; const f32x4* sc = (const f32x4*)(mod + (size_t)b * 6144 + 4 * 1024) + F.lane;
            u32x2* o = (u32x2*)(H + (size_t)row * DM) + F.lane;
#pragma unroll
            for (int j = 0; j < 4; ++j) { const f32x4 a = sh[64 * j], m = sc[64 * j]; v[j] = v[j] * rstd * (m + 1.0f) + a; u32x2 w; w.x = cvt_pk_bf16(v[j][0], v[j][1]); w.y = cvt_pk_bf16(v[j][2], v[j][3]); o[64 * j] = w; }
            float lg[36];
#pragma unroll
            for (int q = 0; q < 36; ++q) { float pa = 0.f;
#pragma unroll
                for (int j = 0; j < 4; ++j) { const f32x4 w4 = *(const f32x4*)(wl + q * 1024 + 256 * j + 4 * F.lane); pa += (w4[0] * v[j][0] + w4[1] * v[j][1]) + (w4[2] * v[j][2] + w4[3] * v[j][3]); }
                lg[q] = wave_sum(pa); }
            float gl[4];
#pragma unroll
            for (int i = 0; i < 4; ++i) gl[i] = lg[i] + bg[i];
            int gi = 0; float gm = gl[0];
#pragma unroll
            for (int i = 1; i < 4; ++i) if (gl[i] > gm) { gm = gl[i]; gi = i; }
            float den = 0.f;
#pragma unroll
            for (int i = 0; i < 4; ++i) den += __expf(gl[i] - gm);
            const float pg = 1.0f / den;
            float el[8];
#pragma unroll
            for (int i = 0; i < 8; ++i) { const float e0 = lg[4 + i] + br[i], e1 = lg[12 + i] + br[8 + i], e2 = lg[20 + i] + br[16 + i], e3 = lg[28 + i] + br[24 + i]; el[i] = gi == 0 ? e0 : (gi == 1 ? e1 : (gi == 2 ? e2 : e3)); }
            int i0 = 0; float v0 = el[0];
#pragma unroll
            for (int i = 1; i < 8; ++i) if (el[i] > v0) { v0 = el[i]; i0 = i; }
            int i1 = -1; float v1 = -3.0e38f;
#pragma unroll
            for (int i = 0; i < 8; ++i) if (i != i0 && el[i] > v1) { v1 = el[i]; i1 = i; }
            const float ex = __expf(v1 - v0); const float w0 = pg / (1.0f + ex), w1 = pg * ex / (1.0f + ex);
            if (F.lane == 0) { const int e0 = gi * 8 + i0, e1 = gi * 8 + i1; const unsigned r0 = atomicAdd(&lcount[e0], 1u), r1 = atomicAdd(&lcount[e1], 1u);
                tinfo[rl * 4 + 0] = (unsigned)e0 | ((unsigned)e1 << 8); tinfo[rl * 4 + 1] = r0; tinfo[rl * 4 + 2] = r1; twt[rl * 2] = w0; twt[rl * 2 + 1] = w1; }
        }
        __syncthreads();
        if (F.tid < 32) lbase[F.tid] = atomicAdd(&gcount[64 * F.tid], lcount[F.tid]);
        __syncthreads();
        if (F.tid < 256) { const int rl = F.tid, row = rb * 256 + rl; const unsigned ee = tinfo[rl * 4], e0 = ee & 255u, e1 = ee >> 8;
            list[(size_t)e0 * ECAP + lbase[e0] + tinfo[rl * 4 + 1]] = (unsigned)row * 2u; list[(size_t)e1 * ECAP + lbase[e1] + tinfo[rl * 4 + 2]] = (unsigned)row * 2u + 1u;
            gates[row * 2] = twt[rl * 2]; gates[row * 2 + 1] = twt[rl * 2 + 1]; }
        __syncthreads();
    }
}

__device__ __forceinline__ void p8_final(const Frame& F, const Params& P) {
    const float* x1 = (const float*)(P.ws + WS_X1); const bf16_t* Y0 = (const bf16_t*)(P.ws + WS_Y0); const bf16_t* Y1 = (const bf16_t*)(P.ws + WS_Y1); const float* fw = P.in[20];
    f32x4 wv[4];
#pragma unroll
    for (int j = 0; j < 4; ++j) wv[j] = ((const f32x4*)fw)[F.lane + 64 * j];
    for (int row = F.gw; row < T; row += F.NGW) {
        const f32x4* xr = (const f32x4*)(x1 + (size_t)row * DM) + F.lane; const u32x2* y0 = (const u32x2*)(Y0 + (size_t)row * DM) + F.lane; const u32x2* y1 = (const u32x2*)(Y1 + (size_t)row * DM) + F.lane;
        f32x4 v[4]; float s = 0.f;
#pragma unroll
        for (int j = 0; j < 4; ++j) { const u32x2 a = y0[64 * j], c = y1[64 * j]; v[j] = xr[64 * j];
            v[j][0] += bf_lo(a.x) + bf_lo(c.x); v[j][1] += bf_hi(a.x) + bf_hi(c.x); v[j][2] += bf_lo(a.y) + bf_lo(c.y); v[j][3] += bf_hi(a.y) + bf_hi(c.y);
            s += (v[j][0] * v[j][0] + v[j][1] * v[j][1]) + (v[j][2] * v[j][2] + v[j][3] * v[j][3]); }
        const float rstd = rsqrtf(wave_sum(s) * (1.f / DM) + EPS);
        f32x4* o = (f32x4*)(P.out + (size_t)row * DM) + F.lane;
#pragma unroll
        for (int j = 0; j < 4; ++j) o[64 * j] = v[j] * rstd * wv[j];
    }
}

__device__ __forceinline__ void moe_prefix(const Frame& F, const Params& P, int* pref) {
    const unsigned* gcount = (const unsigned*)(P.ws + WS_CTL) + CW_GCOUNT;
    __syncthreads();
    if (F.tid == 0) { int acc = 0; for (int e = 0; e < 32; ++e) { const int c = (int)__hip_atomic_load(gcount + 64 * e, __ATOMIC_RELAXED, __HIP_MEMORY_SCOPE_AGENT); pref[e] = acc; pref[33 + e] = c; acc += (c + 255) >> 8; } pref[32] = acc; }
    __syncthreads();
}

__global__ void __launch_bounds__(NTHREADS, 2) fwd_kernel(Params P) {
    extern __shared__ __attribute__((aligned(16))) unsigned char lds[];
    Frame F; F.lds = lds; F.tid = threadIdx.x; F.lane = F.tid & 63; F.wave = __builtin_amdgcn_readfirstlane(F.tid >> 6);
    F.G = gridDim.x; { const int bx = blockIdx.x; F.vcu = (F.G % 8 == 0) ? (bx % 8) * (F.G / 8) + bx / 8 : bx; }
    F.gw = F.vcu * NWAVES + F.wave; F.NGW = F.G * NWAVES;
    unsigned char* ws = P.ws;
    const int lo = P.ph_lo, hi = P.ph_hi;
#define IN(k) (lo <= (k) && (k) < hi)
#define GRID_BAR() do { __syncthreads(); cooperative_groups::this_grid().sync(); } while (0)
    if (IN(0)) p0_prep(F, P);
    if (IN(0) && IN(1)) GRID_BAR();
    if (IN(1)) p1_modulate(F, P);
    if (IN(1) && IN(2)) GRID_BAR();
    if (IN(2)) { pg8::DenseSched S; S.init(ws + WS_H, ws + WS_WIN, T, NPROJ, 1024, F.G, (int)blockIdx.x); pg8::EpiProj E{(bf16_t*)(ws + WS_PROJ), (float*)(ws + WS_DTRAW)}; pg8::gemm_phase(( LAS unsigned char*)lds, S, E); }
    if (IN(2) && IN(3)) GRID_BAR();
    if (IN(3)) p3a_ssd_naive(F, P);
    if (IN(3) && IN(4)) GRID_BAR();
    if (IN(4)) p3b_gate_pool(F, P);
    if (IN(4) && IN(5)) GRID_BAR();
    if (IN(5)) { pg8::DenseSched S; S.init(ws + WS_MIX, ws + WS_WOUT, T, 1024, 1024, F.G, (int)blockIdx.x); pg8::EpiX1 E{P.in[0], (const float*)(ws + WS_MOD), (float*)(ws + WS_X1)}; pg8::gemm_phase((LAS unsigned char*)lds, S, E); }
    if (IN(5) && IN(6)) GRID_BAR();
    if (IN(6)) p5_route(F, P);
    if (IN(6) && IN(7)) GRID_BAR();
    if (IN(7)) { int* pref = (int*)(lds + MISC_OFF); moe_prefix(F, P, pref);
        pg8::MoeSched<true> S; S.A = (const char*)(ws + WS_H); S.Bt = (const char*)(ws + WS_W13); S.K = 1024; S.nN = 4; S.G = F.G; S.c = F.vcu; S.pref = (const LAS int*)pref; S.list = (const unsigned*)(ws + WS_LIST);
        pg8::EpiAct E{(bf16_t*)(ws + WS_ACT)}; pg8::gemm_phase((LAS unsigned char*)lds, S, E); }
    if (IN(7) && IN(8)) GRID_BAR();
    if (IN(8)) { int* pref = (int*)(lds + MISC_OFF); moe_prefix(F, P, pref);
        pg8::MoeSched<false> S; S.A = (const char*)(ws + WS_ACT); S.Bt = (const char*)(ws + WS_W2); S.K = 512; S.nN = 4; S.G = F.G; S.c = F.vcu; S.pref = (const LAS int*)pref; S.list = (const unsigned*)(ws + WS_LIST);
        pg8::EpiY E{(const unsigned*)(ws + WS_LIST), (const float*)(ws + WS_GATE), (const float*)(ws + WS_MOD), (bf16_t*)(ws + WS_Y0), (bf16_t*)(ws + WS_Y1)}; pg8::gemm_phase((LAS unsigned char*)lds, S, E); }
    if (IN(8) && IN(9)) GRID_BAR();
    if (IN(9)) p8_final(F, P);
#undef IN
#undef GRID_BAR
}

extern "C" void kernel_launch(void* const* d_in, const int* in_sizes, int n_in, void* d_out, int out_size, void* d_ws, size_t ws_size, hipStream_t stream) {
    static int grid = 0;
    if (grid == 0) {
        if (n_in != 21 || out_size != T * DM || ws_size < WS_END) { fprintf(stderr, "kernel_launch: unexpected sizes n_in %d out %d ws %zu\n", n_in, out_size, ws_size); grid = -1; return; }
        int dev = 0, cus = 0;
        if (hipGetDevice(&dev) != hipSuccess || hipDeviceGetAttribute(&cus, hipDeviceAttributeMultiprocessorCount, dev) != hipSuccess) { grid = -1; return; }
        if (hipFuncSetAttribute((const void*)fwd_kernel, hipFuncAttributeMaxDynamicSharedMemorySize, LDS_BYTES) != hipSuccess) { fprintf(stderr, "kernel_launch: hipFuncSetAttribute failed\n"); grid = -1; return; }
        int per_cu = 0;
        if (hipOccupancyMaxActiveBlocksPerMultiprocessor(&per_cu, (const void*)fwd_kernel, NTHREADS, LDS_BYTES) != hipSuccess || per_cu < 1) { fprintf(stderr, "kernel_launch: occupancy query says %d blocks per CU\n", per_cu); (void)hipGetLastError(); per_cu = 1; }
        grid = cus;
    }
    if (grid < 0) return;
    (void)hipMemsetAsync((char*)d_ws + WS_CTL, 0, CTL_BYTES, stream);
    Params p{};
    for (int i = 0; i < 21; ++i) p.in[i] = (const float*)d_in[i];
    p.out = (float*)d_out; p.ws = (unsigned char*)d_ws;
    p.ph_lo = 0; p.ph_hi = 10;
    void* args[] = {&p};
    hipError_t e = hipLaunchCooperativeKernel((const void*)fwd_kernel, dim3(grid), dim3(NTHREADS), args, LDS_BYTES, stream);
    if (e != hipSuccess) fprintf(stderr, "kernel_launch: cooperative launch failed: %s (grid %d)\n", hipGetErrorString(e), grid);
}
```

```cpp
#include <hip/hip_runtime.h>
#include <hip/hip_cooperative_groups.h>
#include <cstdio>
#include <cstdint>

#ifndef MK_ONE_LAUNCH
#define MK_ONE_LAUNCH 0
#endif

#define LAS __attribute__((address_space(3)))
typedef unsigned short bf16_t;
typedef short bf16x8 __attribute__((ext_vector_type(8)));
typedef float f32x4 __attribute__((ext_vector_type(4)));
typedef float f32x2 __attribute__((ext_vector_type(2)));
typedef unsigned u32x4 __attribute__((ext_vector_type(4)));
typedef unsigned u32x2 __attribute__((ext_vector_type(2)));

constexpr int BATCH = 32, SEQ = 2048, DM = 1024, T = BATCH * SEQ;
constexpr int NPROJ = 3072, NPROJ_REAL = 2828;
constexpr int COL_Z = 256, COL_XS = 1024, COL_B = 1792, COL_C = 2304, COL_DT = 2816;
constexpr int NEXP = 32, FF = 512, ECAP = 65536;
constexpr int NWAVES = 8, NTHREADS = 512;
constexpr float EPS = 1e-6f;

constexpr size_t MiB = 1u << 20;
constexpr size_t WS_CTL = 0, CTL_BYTES = 1 * MiB;
constexpr size_t WS_MOD = 1 * MiB;
constexpr size_t WS_WR = 2 * MiB;
constexpr size_t WS_GATE = 3 * MiB;
constexpr size_t WS_DTRAW = 4 * MiB;
constexpr size_t WS_LIST = 8 * MiB;
constexpr size_t WS_WIN = 16 * MiB;
constexpr size_t WS_WOUT = 22 * MiB;
constexpr size_t WS_W13 = 24 * MiB;
constexpr size_t WS_W2 = 88 * MiB;
constexpr size_t WS_H = 128 * MiB;
constexpr size_t WS_PROJ = 256 * MiB;
constexpr size_t WS_MIX = 640 * MiB;
constexpr size_t WS_X1 = 768 * MiB;
constexpr size_t WS_END = 1024 * MiB;
constexpr size_t WS_XA = WS_X1;
constexpr size_t WS_DTV = 8 * MiB, WS_ACS = 12 * MiB;
constexpr size_t WS_Y0 = 256 * MiB, WS_Y1 = 384 * MiB;
constexpr size_t WS_ACT = 512 * MiB;
constexpr int CW_GCOUNT = 256;
constexpr int CW_BAR = 4096;

constexpr int LDS_BYTES = 163840;
constexpr int MISC_OFF = 147456;

struct Params {
    const float* in[21];
    float* out;
    unsigned char* ws;
    int ph_lo, ph_hi;
};

__device__ __forceinline__ unsigned cvt_pk_bf16(float lo, float hi) { unsigned r; asm volatile("v_cvt_pk_bf16_f32 %0, %1, %2" : "=v"(r) : "v"(lo), "v"(hi)); return r; }
__device__ __forceinline__ float bf_lo(unsigned u) { return __uint_as_float(u << 16); }
__device__ __forceinline__ float bf_hi(unsigned u) { return __uint_as_float(u & 0xffff0000u); }
__device__ __forceinline__ float wave_sum(float v) {
#pragma unroll
    for (int o = 1; o < 64; o <<= 1) v += __shfl_xor(v, o);
    return v;
}
__device__ __forceinline__ float sigmoidf_(float v) { return __builtin_amdgcn_rcpf(1.0f + __expf(-v)); }
__device__ __forceinline__ float siluf_(float v) { return v * sigmoidf_(v); }

namespace pg8 {
constexpr int BM = 256, BK = 64, HALF = 128, HTB = HALF * BK * 2, STAGE_BYTES = 8 * HTB, NXCD = 8, WGM = 8;
__host__ __device__ __forceinline__ int lds_byte(int r, int c) { const int st = (r >> 4) * 2 + (c >> 5), rr = r & 15, cc = c & 31, ob = rr * 64 + cc * 2; return st * 1024 + (ob ^ (((ob >> 9) & 1) << 5)); }
__host__ __device__ __forceinline__ void stage_rc(int b, int& R, int& C) { const int st = b / 1024, sb = b % 1024, swz = sb ^ (((sb >> 9) & 1) << 5); R = (st >> 1) * 16 + swz / 64; C = (st & 1) * 32 + (swz % 64) / 2; }
__host__ __device__ __forceinline__ int perm32(int rho) { const int n = rho >> 4, i = rho & 15; return 8 * (i >> 2) + 4 * n + (i & 3); }

struct Unit { int pm, pn, e, cnt, slot0; };

struct DenseSched {
    const char* A; const char* Bt; int K;
    int nM, nN, nwg, G, c;
    __device__ void init(const void* A_, const void* Bt_, int M, int N, int K_, int G_, int c_) { A = (const char*)A_; Bt = (const char*)Bt_; K = K_; nM = M / BM; nN = N / BM; nwg = nM * nN; G = G_; c = c_; }
    __device__ __forceinline__ bool next(int i, Unit& u) const {
        const long L = (long)i * G + c; if (L >= nwg) return false;
        int wgid = (int)L; { const int q = nwg / NXCD, r = nwg % NXCD, xcd = wgid % NXCD, off = wgid / NXCD; wgid = (xcd < r ? xcd * (q + 1) : r * (q + 1) + (xcd - r) * q) + off; }
        const int nig = WGM * nN, gid = wgid / nig, fm = gid * WGM, gsz = (nM - fm) < WGM ? (nM - fm) : WGM;
        u.pm = fm + ((wgid % nig) % gsz); u.pn = (wgid % nig) / gsz; u.e = 0; u.cnt = 256; u.slot0 = 0; return true;
    }
    __device__ __forceinline__ const char* a_base() const { return A; }
    __device__ __forceinline__ void a_off(const Unit& u, const int (&R)[2], const int (&C)[2], unsigned (&o)[2][2]) const {
#pragma unroll
        for (int h = 0; h < 2; ++h)
#pragma unroll
            for (int i = 0; i < 2; ++i) o[h][i] = (unsigned)((u.pm * BM + h * HALF + R[i]) * K + C[i]) * 2u;
    }
    __device__ __forceinline__ const char* b_ptr(const Unit& u) const { return Bt + (size_t)u.pn * BM * K * 2; }
};

template <bool GATHER>
struct MoeSched {
    const char* A; const char* Bt; int K, nN, G, c;
    const LAS int* pref;
    const unsigned* list;
    __device__ __forceinline__ bool next(int i, Unit& u) const {
        const long L = (long)i * G + c; const int tot = pref[32] * nN; if (L >= tot) return false;
        const int ti = (int)L / nN; u.pn = (int)L % nN;
        int e = 0;
#pragma unroll 1
        for (int j = 1; j < 32; ++j) if (pref[j] <= ti) e = j;
        const int mt = ti - pref[e]; u.pm = ti; u.e = e; u.slot0 = mt * 256; const int rem = pref[33 + e] - mt * 256; u.cnt = rem < 256 ? rem : 256; return true;
    }
    __device__ __forceinline__ const char* a_base() const { return A; }
    __device__ __forceinline__ void a_off(const Unit& u, const int (&R)[2], const int (&C)[2], unsigned (&o)[2][2]) const {
#pragma unroll
        for (int h = 0; h < 2; ++h)
#pragma unroll
            for (int i = 0; i < 2; ++i) {
                const int r = h * HALF + R[i];
                if (GATHER) { unsigned tok = 0; if (r < u.cnt) tok = list[(size_t)u.e * ECAP + u.slot0 + r] >> 1; o[h][i] = (unsigned)(tok * K + C[i]) * 2u; }
                else o[h][i] = (unsigned)((u.pm * BM + r) * K + C[i]) * 2u;
            }
    }
    __device__ __forceinline__ const char* b_ptr(const Unit& u) const { return Bt + ((size_t)u.e * (nN * BM) + (size_t)u.pn * BM) * K * 2; }
};

template <class Epi, class Sched>
__device__ __forceinline__ void gemm_phase(LAS unsigned char* lds, const Sched& S, const Epi& E) {
    const int tid = threadIdx.x, wid = __builtin_amdgcn_readfirstlane(tid >> 6), lane = tid & 63, wr = wid >> 2, wc = wid & 3, fr = lane & 15, fq = lane >> 4;
    const int K = S.K, nt = K / BK;
    int sR[2], sC[2]; unsigned voffB[2];
#pragma unroll
    for (int i = 0; i < 2; ++i) { int R, C; stage_rc(tid * 16 + i * 8192, R, C); sR[i] = R; sC[i] = C; const int Rb = Epi::PERM ? ((R & ~31) + perm32(R & 31)) : R; voffB[i] = (unsigned)(Rb * K + C) * 2u; }
    const size_t kstep = (size_t)(BK * 2);
    const size_t hstep = (size_t)HALF * K * 2;
    const unsigned ldsw = (unsigned)wid * 1024u;
    const int aoff = lds_byte(wr * 64 + fr, fq * 8), boff = lds_byte(wc * 32 + fr, fq * 8);
#define PG8_SA(b, h) (((b) * 2 + (h)) * HTB)
#define PG8_SB(b, h) ((4 + (b) * 2 + (h)) * HTB)
#define PG8_STAGE(bufoff, gbase, voff) do { _Pragma("unroll") for (int _i = 0; _i < 2; ++_i) \
        __builtin_amdgcn_global_load_lds((const unsigned*)((const char*)(gbase) + (voff)[_i]), (LAS unsigned*)(lds + (bufoff) + ldsw + _i * 8192), 16, 0, 0); } while (0)
#define PG8_LDA(dst, b, h) do { _Pragma("unroll") for (int m = 0; m < 4; ++m) _Pragma("unroll") for (int k = 0; k < 2; ++k) dst[m][k] = *(const LAS bf16x8*)(lds + PG8_SA(b, h) + aoff + m * 2048 + k * 1024); } while (0)
#define PG8_LDB(dst, b, h) do { _Pragma("unroll") for (int n = 0; n < 2; ++n) _Pragma("unroll") for (int k = 0; k < 2; ++k) dst[n][k] = *(const LAS bf16x8*)(lds + PG8_SB(b, h) + boff + n * 2048 + k * 1024); } while (0)
#define PG8_MMA(ai, bj, At, Bt) do { __builtin_amdgcn_s_setprio(1); _Pragma("unroll") for (int m = 0; m < 4; ++m) _Pragma("unroll") for (int n = 0; n < 2; ++n) _Pragma("unroll") for (int k = 0; k < 2; ++k) \
        acc[ai][bj][m][n] = __builtin_amdgcn_mfma_f32_16x16x32_bf16(Bt[n][k], At[m][k], acc[ai][bj][m][n], 0, 0, 0); __builtin_amdgcn_s_setprio(0); } while (0)
#define PG8_WAIT_V(n) asm volatile("s_waitcnt vmcnt(" #n ")" ::: "memory")
#define PG8_WAIT_L(n) asm volatile("s_waitcnt lgkmcnt(" #n ")" ::: "memory")
#define PG8_BAR __builtin_amdgcn_s_barrier()
#define PG8_SCHED __builtin_amdgcn_sched_barrier(0)
    Unit cur, nxt; int ui = 0;
    if (!S.next(0, cur)) return;
    f32x4 acc[2][2][4][2];
#pragma unroll
    for (int a = 0; a < 2; ++a)
#pragma unroll
        for (int b = 0; b < 2; ++b)
#pragma unroll
            for (int m = 0; m < 4; ++m)
#pragma unroll
                for (int n = 0; n < 2; ++n) acc[a][b][m][n] = (f32x4){0.f, 0.f, 0.f, 0.f};
    bf16x8 At[4][2], B0[2][2], B1[2][2];
    unsigned aoC[2][2], aoN[2][2];
    S.a_off(cur, sR, sC, aoC);
    const char* const Ab = S.a_base();
    const char* cB = S.b_ptr(cur);
    PG8_STAGE(PG8_SB(0, 0), cB, voffB); PG8_STAGE(PG8_SB(0, 1), cB + hstep, voffB); PG8_STAGE(PG8_SA(0, 0), Ab, aoC[0]); PG8_STAGE(PG8_SA(0, 1), Ab, aoC[1]);
    if (wr == 1) PG8_BAR;
    PG8_WAIT_V(2); PG8_BAR;
    PG8_STAGE(PG8_SB(1, 0), cB + kstep, voffB); PG8_STAGE(PG8_SA(1, 0), Ab + kstep, aoC[0]); PG8_STAGE(PG8_SB(1, 1), cB + hstep + kstep, voffB);
    PG8_WAIT_V(6); PG8_BAR;
    for (;;) {
        const bool has_next = S.next(ui + 1, nxt);
        const char* nB = cB;
        if (has_next) { S.a_off(nxt, sR, sC, aoN); nB = S.b_ptr(nxt); }
        else {
#pragma unroll
            for (int h = 0; h < 2; ++h)
#pragma unroll
                for (int i = 0; i < 2; ++i) aoN[h][i] = aoC[h][i];
        }
        for (int t = 0; t < nt; t += 2) {
            const bool last = (t == nt - 2);
            const char* a1 = Ab + (size_t)(t + 1) * kstep;
            const char* a2 = last ? Ab : Ab + (size_t)(t + 2) * kstep; const char* b2 = last ? nB : cB + (size_t)(t + 2) * kstep;
            const char* a3 = a2 + kstep; const char* b3 = b2 + kstep;
            unsigned o2[2][2];
#pragma unroll
            for (int h = 0; h < 2; ++h)
#pragma unroll
                for (int i = 0; i < 2; ++i) o2[h][i] = last ? aoN[h][i] : aoC[h][i];
            PG8_LDB(B0, 0, 0); PG8_LDB(B1, 0, 1); PG8_SCHED; PG8_LDA(At, 0, 0); PG8_STAGE(PG8_SA(1, 1), a1, aoC[1]);
            PG8_WAIT_V(8); PG8_WAIT_L(0); PG8_BAR; PG8_MMA(0, 0, At, B0); PG8_MMA(0, 1, At, B1); PG8_BAR; PG8_SCHED;
            PG8_LDA(At, 0, 1); PG8_STAGE(PG8_SB(0, 0), b2, voffB); PG8_STAGE(PG8_SB(0, 1), b2 + hstep, voffB); PG8_STAGE(PG8_SA(0, 0), a2, o2[0]);
            PG8_WAIT_V(8); PG8_WAIT_L(0); PG8_BAR; PG8_MMA(1, 0, At, B0); PG8_MMA(1, 1, At, B1); PG8_BAR; PG8_SCHED;
            PG8_LDB(B0, 1, 0); PG8_LDB(B1, 1, 1); PG8_SCHED; PG8_LDA(At, 1, 0); PG8_STAGE(PG8_SA(0, 1), a2, o2[1]);
            PG8_WAIT_V(8); PG8_WAIT_L(0); PG8_BAR; PG8_MMA(0, 0, At, B0); PG8_MMA(0, 1, At, B1); PG8_BAR; PG8_SCHED;
            PG8_LDA(At, 1, 1); PG8_STAGE(PG8_SB(1, 0), b3, voffB); PG8_STAGE(PG8_SB(1, 1), b3 + hstep, voffB); PG8_STAGE(PG8_SA(1, 0), a3, o2[0]);
            PG8_WAIT_V(8); PG8_WAIT_L(0); PG8_BAR; PG8_MMA(1, 0, At, B0); PG8_MMA(1, 1, At, B1); PG8_BAR; PG8_SCHED;
        }
        if (wr == 0) PG8_BAR;
        E(acc, cur, wr, wc, fr, fq);
        if (!has_next) break;
#pragma unroll
        for (int a = 0; a < 2; ++a)
#pragma unroll
            for (int b = 0; b < 2; ++b)
#pragma unroll
                for (int m = 0; m < 4; ++m)
#pragma unroll
                    for (int n = 0; n < 2; ++n) acc[a][b][m][n] = (f32x4){0.f, 0.f, 0.f, 0.f};
        cur = nxt; cB = nB; ++ui;
#pragma unroll
        for (int h = 0; h < 2; ++h)
#pragma unroll
            for (int i = 0; i < 2; ++i) aoC[h][i] = aoN[h][i];
        if (wr == 1) PG8_BAR;
    }
    PG8_WAIT_V(0);
    PG8_BAR;
#undef PG8_SA
#undef PG8_SB
#undef PG8_STAGE
#undef PG8_LDA
#undef PG8_LDB
#undef PG8_MMA
#undef PG8_WAIT_V
#undef PG8_WAIT_L
#undef PG8_BAR
#undef PG8_SCHED
}

struct EpiProj {
    static constexpr bool PERM = true;
    bf16_t* O; float* dtraw;
    __device__ __forceinline__ void operator()(const f32x4 (&acc)[2][2][4][2], const Unit& u, int wr, int wc, int fr, int fq) const {
        const int row0 = u.pm * BM + wr * 64 + fr, col0 = u.pn * BM + wc * 32 + 8 * fq;
#pragma unroll
        for (int ai = 0; ai < 2; ++ai)
#pragma unroll
            for (int m = 0; m < 4; ++m) { const int row = row0 + ai * HALF + m * 16; bf16_t* rowp = O + (size_t)row * NPROJ + col0;
#pragma unroll
                for (int bj = 0; bj < 2; ++bj) { const f32x4 v0 = acc[ai][bj][m][0], v1 = acc[ai][bj][m][1];
                    u32x4 w; w.x = cvt_pk_bf16(v0[0], v0[1]); w.y = cvt_pk_bf16(v0[2], v0[3]); w.z = cvt_pk_bf16(v1[0], v1[1]); w.w = cvt_pk_bf16(v1[2], v1[3]);
                    *(u32x4*)(rowp + bj * HALF) = w; }
                if (u.pn == 11 && wc == 0 && fq < 2) { float* d = dtraw + (size_t)row * 16 + 8 * fq; *(f32x4*)d = acc[ai][0][m][0]; *(f32x4*)(d + 4) = acc[ai][0][m][1]; }
            }
    }
};
struct EpiX1 {
    static constexpr bool PERM = false;
    const float* x; const float* mod; float* x1;
    __device__ __forceinline__ void operator()(const f32x4 (&acc)[2][2][4][2], const Unit& u, int wr, int wc, int fr, int fq) const {
        const int row0 = u.pm * BM + wr * 64 + fr, col0 = u.pn * BM + wc * 32 + 4 * fq; const int b = (u.pm * BM) >> 11;
        f32x4 gv[2][2];
#pragma unroll
        for (int bj = 0; bj < 2; ++bj)
#pragma unroll
            for (int n = 0; n < 2; ++n) gv[bj][n] = *(const f32x4*)(mod + (size_t)b * 6144 + 2 * 1024 + col0 + bj * HALF + n * 16);
#pragma unroll
        for (int ai = 0; ai < 2; ++ai)
#pragma unroll
            for (int m = 0; m < 4; ++m) { const size_t off = (size_t)(row0 + ai * HALF + m * 16) * DM + col0;
#pragma unroll
                for (int bj = 0; bj < 2; ++bj)
#pragma unroll
                    for (int n = 0; n < 2; ++n) { const f32x4 xv = *(const f32x4*)(x + off + bj * HALF + n * 16); *(f32x4*)(x1 + off + bj * HALF + n * 16) = xv + gv[bj][n] * acc[ai][bj][m][n]; } }
    }
};
struct EpiAct {
    static constexpr bool PERM = true;
    bf16_t* act;
    __device__ __forceinline__ void operator()(const f32x4 (&acc)[2][2][4][2], const Unit& u, int wr, int wc, int fr, int fq) const {
        const int row0 = u.pm * BM + wr * 64 + fr, col0 = u.pn * HALF + wc * 32 + 8 * fq;
#pragma unroll
        for (int ai = 0; ai < 2; ++ai)
#pragma unroll
            for (int m = 0; m < 4; ++m) { bf16_t* p = act + (size_t)(row0 + ai * HALF + m * 16) * FF + col0; float o[8];
#pragma unroll
                for (int n = 0; n < 2; ++n)
#pragma unroll
                    for (int i = 0; i < 4; ++i) { const float a = acc[ai][0][m][n][i], b = acc[ai][1][m][n][i]; o[n * 4 + i] = siluf_(a) * b; }
                u32x4 w; w.x = cvt_pk_bf16(o[0], o[1]); w.y = cvt_pk_bf16(o[2], o[3]); w.z = cvt_pk_bf16(o[4], o[5]); w.w = cvt_pk_bf16(o[6], o[7]);
                *(u32x4*)p = w; }
    }
};
struct EpiY {
    static constexpr bool PERM = true;
    const unsigned* list; const float* gates; const float* mod; bf16_t* Y0; bf16_t* Y1;
    __device__ __forceinline__ void operator()(const f32x4 (&acc)[2][2][4][2], const Unit& u, int wr, int wc, int fr, int fq) const {
        const int col0 = u.pn * BM + wc * 32 + 8 * fq;
#pragma unroll
        for (int ai = 0; ai < 2; ++ai)
#pragma unroll
            for (int m = 0; m < 4; ++m) { const int r = ai * HALF + wr * 64 + m * 16 + fr;
                if (r < u.cnt) {
                    const unsigned ent = list[(size_t)u.e * ECAP + u.slot0 + r]; const unsigned tok = ent >> 1; const float gate = gates[ent];
                    bf16_t* yp = ((ent & 1u) ? Y1 : Y0) + (size_t)tok * DM + col0; const float* gp = mod + (size_t)(tok >> 11) * 6144 + 5 * 1024 + col0;
#pragma unroll
                    for (int bj = 0; bj < 2; ++bj) { const f32x4 g0 = *(const f32x4*)(gp + bj * HALF), g1 = *(const f32x4*)(gp + bj * HALF + 4);
                        const f32x4 v0 = acc[ai][bj][m][0] * g0 * gate, v1 = acc[ai][bj][m][1] * g1 * gate;
                        u32x4 w; w.x = cvt_pk_bf16(v0[0], v0[1]); w.y = cvt_pk_bf16(v0[2], v0[3]); w.z = cvt_pk_bf16(v1[0], v1[1]); w.w = cvt_pk_bf16(v1[2], v1[3]);
                        *(u32x4*)(yp + bj * HALF) = w; } } }
    }
};
}

struct Frame {
    unsigned char* lds; int tid, lane, wave, vcu, G, gw, NGW;
};

__device__ __forceinline__ void transpose_item(const float* W, int ldw, int nvalid, int k0, int n0, bf16_t* WT, int K, int dst_row0, float* scr, int lane) {
#pragma unroll 8
    for (int i = 0; i < 32; ++i) { const int kk = 2 * i + (lane >> 5); const int n = n0 + (lane & 31); scr[kk * 33 + (lane & 31)] = (n < nvalid) ? W[(size_t)(k0 + kk) * ldw + n] : 0.f; }
    asm volatile("s_waitcnt lgkmcnt(0)" ::: "memory");
    const int c = lane & 7;
#pragma unroll
    for (int j = 0; j < 4; ++j) { const int n = (lane >> 3) + 8 * j; const float* s = scr + (8 * c) * 33 + n;
        u32x4 o; o.x = cvt_pk_bf16(s[0 * 33], s[1 * 33]); o.y = cvt_pk_bf16(s[2 * 33], s[3 * 33]); o.z = cvt_pk_bf16(s[4 * 33], s[5 * 33]); o.w = cvt_pk_bf16(s[6 * 33], s[7 * 33]);
        *(u32x4*)(WT + (size_t)(dst_row0 + n0 + n) * K + k0 + 8 * c) = o; }
    asm volatile("s_waitcnt lgkmcnt(0)" ::: "memory");
}

__device__ __forceinline__ void p0_prep(const Frame& F, const Params& P) {
    unsigned char* ws = P.ws;
    {
        float* sct = (float*)F.lds;
        const float* c = P.in[1];
        for (int idx = F.tid; idx < 32 * 1024; idx += NTHREADS) { const int b = idx >> 10, k = idx & 1023; sct[k * 32 + b] = siluf_(c[idx]); }
        __syncthreads();
        const float* w_ada = P.in[2]; const float* b_ada = P.in[3]; float* mod = (float*)(ws + WS_MOD);
        for (int cg = F.vcu; cg < 256; cg += F.G) {
            const int j = F.tid % 24, kg = F.tid / 24;
            float acc[32];
#pragma unroll
            for (int b = 0; b < 32; ++b) acc[b] = 0.f;
            if (kg < 16) {
                for (int kk = 0; kk < 64; ++kk) { const int k = kg * 64 + kk; const float w = w_ada[(size_t)k * 6144 + cg * 24 + j];
#pragma unroll
                    for (int q = 0; q < 8; ++q) { const f32x4 s = *(const f32x4*)(sct + k * 32 + 4 * q); acc[4 * q] += s[0] * w; acc[4 * q + 1] += s[1] * w; acc[4 * q + 2] += s[2] * w; acc[4 * q + 3] += s[3] * w; } }
            }
            float* px = (float*)(F.lds + 131072);
            float tot[2] = {0.f, 0.f};
#pragma unroll 1
            for (int half = 0; half < 2; ++half) {
                if (kg < 16 && (kg >> 3) == half) {
#pragma unroll
                    for (int b = 0; b < 32; ++b) px[((kg & 7) * 24 + j) * 32 + b] = acc[b];
                }
                __syncthreads();
#pragma unroll
                for (int r = 0; r < 2; ++r) { const int o = F.tid + r * 512; if (o < 768) { float s = 0.f;
#pragma unroll
                        for (int q = 0; q < 8; ++q) s += px[q * 768 + o]; tot[r] += s; } }
                __syncthreads();
            }
#pragma unroll
            for (int r = 0; r < 2; ++r) { const int o = F.tid + r * 512; if (o < 768) { const int jj = o >> 5, b = o & 31; mod[(size_t)b * 6144 + cg * 24 + jj] = tot[r] + b_ada[cg * 24 + jj]; } }
        }
        __syncthreads();
    }
    {
        float* scr = (float*)(F.lds + F.wave * 16384);
        const float* w_in = P.in[4]; const float* w_out = P.in[13]; const float* w13 = P.in[18]; const float* w2 = P.in[19];
        bf16_t* WIN = (bf16_t*)(ws + WS_WIN); bf16_t* WOUT = (bf16_t*)(ws + WS_WOUT); bf16_t* W13 = (bf16_t*)(ws + WS_W13); bf16_t* W2 = (bf16_t*)(ws + WS_W2);
        constexpr int I0 = 16 * 88, I1 = 16 * 32, I2 = 32 * 16 * 32, I3 = 32 * 8 * 32, NIT = I0 + I1 + I2 + I3;
        for (int it = F.gw; it < NIT; it += F.NGW) {
            int r = it;
            if (r < I0) { const int kb = r / 88, nb = 8 + r % 88; transpose_item(w_in, NPROJ_REAL, NPROJ_REAL, kb * 64, nb * 32, WIN, 1024, 0, scr, F.lane); continue; } r -= I0;
            if (r < I1) { const int kb = r / 32, nb = r % 32; transpose_item(w_out, 1024, 1024, kb * 64, nb * 32, WOUT, 1024, 0, scr, F.lane); continue; } r -= I1;
            if (r < I2) { const int e = r / 512, q = r % 512, kb = q / 32, nb = q % 32; const int n0 = nb * 32, bj = n0 >> 9, rem = n0 & 511, pn = rem >> 7, j0 = rem & 127;
                transpose_item(w13 + (size_t)e * 1024 * 1024, 1024, 1024, kb * 64, n0, W13 + (size_t)e * 1024 * 1024, 1024, pn * 256 + bj * 128 + j0 - n0, scr, F.lane); continue; } r -= I2;
            { const int e = r / 256, q = r % 256, kb = q / 32, nb = q % 32;
                transpose_item(w2 + (size_t)e * 512 * 1024, 1024, 1024, kb * 64, nb * 32, W2 + (size_t)e * 1024 * 512, 512, 0, scr, F.lane); }
        }
    }
    {
        const float* w_in = P.in[4]; const float* w_pool = P.in[5]; const float* pscale = P.in[6]; bf16_t* WIN = (bf16_t*)(ws + WS_WIN);
        for (int idx = F.vcu * NTHREADS + F.tid; idx < 256 * 1024; idx += F.G * NTHREADS) {
            const int n = idx >> 10, k = idx & 1023, g = n >> 6, d = n & 63; const float* wi = w_in + (size_t)k * NPROJ_REAL + g * 64; const float* wp = w_pool + (size_t)g * 4096 + d;
            float s = 0.f;
#pragma unroll 8
            for (int cc = 0; cc < 64; ++cc) s += wi[cc] * wp[cc * 64];
            s *= pscale[n];
            WIN[(size_t)n * 1024 + k] = (bf16_t)(cvt_pk_bf16(s, 0.f) & 0xffffu);
        }
    }
    {
        const float* wg = P.in[14]; const float* wrt = P.in[16]; float* WR = (float*)(ws + WS_WR);
        for (int idx = F.vcu * NTHREADS + F.tid; idx < 36 * 1024; idx += F.G * NTHREADS) { const int j = idx >> 10, k = idx & 1023; WR[idx] = (j < 4) ? wg[k * 4 + j] : wrt[k * 32 + (j - 4)]; }
    }
}

__device__ __forceinline__ void p1_modulate(const Frame& F, const Params& P) {
    const float* x = P.in[0]; const float* mod = (const float*)(P.ws + WS_MOD); bf16_t* H = (bf16_t*)(P.ws + WS_H);
    for (int row = F.gw; row < T; row += F.NGW) {
        const int b = row >> 11; const f32x4* xr = (const f32x4*)(x + (size_t)row * DM) + F.lane;
        f32x4 v[4]; float s = 0.f;
#pragma unroll
        for (int j = 0; j < 4; ++j) { v[j] = xr[64 * j]; s += (v[j][0] * v[j][0] + v[j][1] * v[j][1]) + (v[j][2] * v[j][2] + v[j][3] * v[j][3]); }
        const float rstd = rsqrtf(wave_sum(s) * (1.f / DM) + EPS);
        const f32x4* sh = (const f32x4*)(mod + (size_t)b * 6144) + F.lane; const f32x4* sc = (const f32x4*)(mod + (size_t)b * 6144 + 1024) + F.lane;
        u32x2* o = (u32x2*)(H + (size_t)row * DM) + F.lane;
#pragma unroll
        for (int j = 0; j < 4; ++j) { const f32x4 a = sh[64 * j], m = sc[64 * j]; const f32x4 h = v[j] * rstd * (m + 1.0f) + a; u32x2 w; w.x = cvt_pk_bf16(h[0], h[1]); w.y = cvt_pk_bf16(h[2], h[3]); o[64 * j] = w; }
    }
}

__device__ __forceinline__ void p3_conv(const Frame& F, const Params& P) {
    const bf16_t* proj = (const bf16_t*)(P.ws + WS_PROJ); bf16_t* XA = (bf16_t*)(P.ws + WS_XA);
    const float* conv_w = P.in[7]; const float* conv_b = P.in[8];
    if (F.tid < 24) {
        const float* dtraw = (const float*)(P.ws + WS_DTRAW); float* DTV = (float*)(P.ws + WS_DTV); float* ACS = (float*)(P.ws + WS_ACS);
        const float* dt_bias = P.in[9]; const float* a_log = P.in[10];
        for (int idx = F.vcu * 24 + F.tid; idx < BATCH * 16 * 12; idx += F.G * 24) {
            const int h = idx % 12, bc = idx / 12; const float a = -__expf(a_log[h]), dtb = dt_bias[h]; float cs = 0.f;
            for (int l = 0; l < 128; ++l) { const size_t row = (size_t)bc * 128 + l; const float v = dtraw[row * 16 + h] + dtb; const float dt = v > 20.f ? v : log1pf(__expf(v)); cs += dt * a; DTV[row * 16 + h] = dt; ACS[row * 16 + h] = cs; }
        }
    }
    for (int item = F.vcu * NTHREADS + F.tid; item < (T / 16) * 224; item += F.G * NTHREADS) {
        const int cg = item % 224, rr = item / 224, ch = cg * 8, row0 = rr * 16, t0 = row0 & (SEQ - 1);
        float w[4][8], bs[8];
#pragma unroll
        for (int j = 0; j < 4; ++j) { const f32x4 a = *(const f32x4*)(conv_w + j * 1792 + ch), c = *(const f32x4*)(conv_w + j * 1792 + ch + 4);
#pragma unroll
            for (int k = 0; k < 4; ++k) { w[j][k] = a[k]; w[j][4 + k] = c[k]; } }
        { const f32x4 a = *(const f32x4*)(conv_b + ch), c = *(const f32x4*)(conv_b + ch + 4);
#pragma unroll
            for (int k = 0; k < 4; ++k) { bs[k] = a[k]; bs[4 + k] = c[k]; } }
        float r0[8], r1[8], r2[8];
        const bf16_t* src = proj + (size_t)row0 * NPROJ + COL_XS + ch;
#define LD8(dst, p) do { const u32x4 _v = *(const u32x4*)(p); dst[0] = bf_lo(_v.x); dst[1] = bf_hi(_v.x); dst[2] = bf_lo(_v.y); dst[3] = bf_hi(_v.y); dst[4] = bf_lo(_v.z); dst[5] = bf_hi(_v.z); dst[6] = bf_lo(_v.w); dst[7] = bf_hi(_v.w); } while (0)
        if (t0 >= 3) { LD8(r0, src - 3 * (size_t)NPROJ); LD8(r1, src - 2 * (size_t)NPROJ); LD8(r2, src - (size_t)NPROJ); }
        else {
#pragma unroll
            for (int k = 0; k < 8; ++k) { r0[k] = 0.f; r1[k] = 0.f; r2[k] = 0.f; } }
#pragma unroll 4
        for (int i = 0; i < 16; ++i) {
            float cur[8]; LD8(cur, src + (size_t)i * NPROJ); float o[8];
#pragma unroll
            for (int k = 0; k < 8; ++k) { const float v = bs[k] + w[0][k] * r0[k] + w[1][k] * r1[k] + w[2][k] * r2[k] + w[3][k] * cur[k]; o[k] = siluf_(v); r0[k] = r1[k]; r1[k] = r2[k]; r2[k] = cur[k]; }
            u32x4 pk; pk.x = cvt_pk_bf16(o[0], o[1]); pk.y = cvt_pk_bf16(o[2], o[3]); pk.z = cvt_pk_bf16(o[4], o[5]); pk.w = cvt_pk_bf16(o[6], o[7]);
            *(u32x4*)(XA + (size_t)(row0 + i) * 1792 + ch) = pk;
        }
#undef LD8
    }
}

constexpr int L_B = 0, L_C = 32768, L_X = 49152, L_S = 98304, L_DT = 147456, L_ACS = L_DT + 1536, L_W = L_ACS + 1536, L_EA = L_W + 1536;
typedef short v4i16 __attribute__((ext_vector_type(4)));
__device__ __forceinline__ int swz16(int r) { const int h = (r >> 3) & 1; return ((((r & 7) + 4 * h) & 7) << 1) | h; }
__device__ __forceinline__ int swz8(int row) { return ((row >> 1) & 3) << 1; }
__device__ __forceinline__ bf16x8 tr_pair(LAS unsigned char* a0, LAS unsigned char* a1) {
    const v4i16 lo = __builtin_amdgcn_ds_read_tr16_b64_v4i16((LAS v4i16*)a0), hi = __builtin_amdgcn_ds_read_tr16_b64_v4i16((LAS v4i16*)a1);
    return (bf16x8){lo[0], lo[1], lo[2], lo[3], hi[0], hi[1], hi[2], hi[3]};
}
__device__ __forceinline__ bf16x8 pack8(const float (&v)[8]) {
    u32x4 p; p.x = cvt_pk_bf16(v[0], v[1]); p.y = cvt_pk_bf16(v[2], v[3]); p.z = cvt_pk_bf16(v[4], v[5]); p.w = cvt_pk_bf16(v[6], v[7]);
    return __builtin_bit_cast(bf16x8, p);
}
#define MFMA16(a, b, c) __builtin_amdgcn_mfma_f32_16x16x32_bf16((a), (b), (c), 0, 0, 0)

#define OPAQUE(x) asm volatile("" : "+v"(x))
template <int CH>
__device__ __forceinline__ void ssd_compute(LAS unsigned char* L, int lt, int hl, int lane, f32x4 (&sacc)[2][6], f32x4 (&yacc)[6], float dsk0, float dsk1) {
    OPAQUE(lane);
    const int i = lane & 15, q = lane >> 4, qp = i >> 2, pp = lane & 3;
    const int lrow0 = 64 * hl + 16 * lt;
    int pr[4];
    { const int fsw = swz16(i);
#pragma unroll
      for (int ks = 0; ks < 4; ++ks) { pr[ks] = i * 256 + (((4 * ks + q) ^ fsw) << 4); OPAQUE(pr[ks]); } }
    int q16 = 16 * q; OPAQUE(q16);
    int i4 = 4 * i; OPAQUE(i4);
    const int r4 = 4 * q + qp;
    int tb[2], tx[4];
    { const int fr = swz16(r4), xr = swz8(r4);
#pragma unroll
      for (int nt2 = 0; nt2 < 2; ++nt2) { tb[nt2] = r4 * 256 + 8 * (pp & 1) + (((2 * (2 * lt + nt2) + (pp >> 1)) ^ fr) << 4); OPAQUE(tb[nt2]); }
#pragma unroll
      for (int pt = 0; pt < 4; ++pt) { tx[pt] = r4 * 128 + 8 * (pp & 1) + (((2 * pt + (pp >> 1)) ^ xr) << 4); OPAQUE(tx[pt]); } }
    int cbase = lt * 4096; OPAQUE(cbase);
    int lq = (lrow0 + 4 * q) * 4; OPAQUE(lq);
    int li = (lrow0 + i) * 4; OPAQUE(li);
    bf16x8 cfrag[4];
#pragma unroll
    for (int ks = 0; ks < 4; ++ks) cfrag[ks] = *(const LAS bf16x8*)(L + L_C + cbase + pr[ks]);
#pragma unroll
    for (int ct = 0; ct < 6; ++ct) { f32x4 a = (f32x4){0.f, 0.f, 0.f, 0.f};
#pragma unroll
        for (int ks = 0; ks < 4; ++ks) { const bf16x8 sf = *(const LAS bf16x8*)(L + L_S + (96 * CH + 16 * ct) * 256 + pr[ks]); a = MFMA16(cfrag[ks], sf, a); }
        yacc[ct] = a; }
#pragma unroll
    for (int hsel = 0; hsel < 2; ++hsel) { const f32x4 e = *(const LAS f32x4*)(L + L_EA + (CH + hsel) * 512 + lq);
#pragma unroll
        for (int ct = 0; ct < 6; ++ct) if ((((6 * CH + ct) >> 2) - CH) == hsel) yacc[ct] = yacc[ct] * e; }
    __builtin_amdgcn_sched_barrier(0);
    f32x4 cbt[8];
#pragma unroll
    for (int ts = 0; ts < 8; ++ts) { f32x4 a = (f32x4){0.f, 0.f, 0.f, 0.f};
#pragma unroll
        for (int ks = 0; ks < 4; ++ks) { const bf16x8 bf = *(const LAS bf16x8*)(L + L_B + ts * 4096 + pr[ks]); a = MFMA16(bf, cfrag[ks], a); }
        cbt[ts] = a; }
    __builtin_amdgcn_sched_barrier(0);
    bf16x8 mfrag[2][4];
    int dq = lrow0 + i - 4 * q; OPAQUE(dq);
#pragma unroll
    for (int hsel = 0; hsel < 2; ++hsel) { const int r = CH + hsel; const float acl = *(const LAS float*)(L + L_ACS + r * 512 + li); const float dsk = hsel ? dsk1 : dsk0;
#pragma unroll
        for (int kk = 0; kk < 4; ++kk) { float v[8];
#pragma unroll
            for (int hf = 0; hf < 2; ++hf) { const int ts = 2 * kk + hf; const f32x4 as = *(const LAS f32x4*)(L + L_ACS + r * 512 + ts * 64 + q16), ds = *(const LAS f32x4*)(L + L_DT + r * 512 + ts * 64 + q16);
#pragma unroll
                for (int j = 0; j < 4; ++j) { const int sc = 16 * ts + j; const float arg = fminf(acl - as[j], 0.f); const float cd = cbt[ts][j] * ds[j]; const float m = cd * __expf(arg);
                    v[4 * hf + j] = (sc < dq) ? m : ((sc == dq) ? (cd + dsk) : 0.f); } }
            mfrag[hsel][kk] = pack8(v); } }
    __builtin_amdgcn_sched_barrier(0);
#pragma unroll
    for (int hsel = 0; hsel < 2; ++hsel) { const float cd = *(const LAS float*)(L + L_EA + (CH + hsel) * 512 + 127 * 4);
#pragma unroll
        for (int ct = 0; ct < 6; ++ct) if ((((6 * CH + ct) >> 2) - CH) == hsel) { sacc[0][ct] = sacc[0][ct] * cd; sacc[1][ct] = sacc[1][ct] * cd; } }
#pragma unroll
    for (int kk = 0; kk < 4; ++kk) {
        bf16x8 btf[2];
#pragma unroll
        for (int nt2 = 0; nt2 < 2; ++nt2) btf[nt2] = tr_pair(L + L_B + kk * 8192 + tb[nt2], L + L_B + kk * 8192 + 4096 + tb[nt2]);
        f32x4 wl[2], wh[2];
#pragma unroll
        for (int hsel = 0; hsel < 2; ++hsel) { wl[hsel] = *(const LAS f32x4*)(L + L_W + (CH + hsel) * 512 + kk * 128 + q16); wh[hsel] = *(const LAS f32x4*)(L + L_W + (CH + hsel) * 512 + kk * 128 + 64 + q16); }
#pragma unroll
        for (int ct = 0; ct < 6; ++ct) { const int ctg = 6 * CH + ct, r = ctg >> 2, pt = ctg & 3, hsel = r - CH;
            const bf16x8 xf = tr_pair(L + L_X + r * 16384 + kk * 4096 + tx[pt], L + L_X + r * 16384 + kk * 4096 + 2048 + tx[pt]);
            yacc[ct] = MFMA16(mfrag[hsel][kk], xf, yacc[ct]);
            float xs[8];
#pragma unroll
            for (int e = 0; e < 4; ++e) { xs[e] = __uint_as_float((unsigned)(unsigned short)xf[e] << 16) * wl[hsel][e]; xs[4 + e] = __uint_as_float((unsigned)(unsigned short)xf[4 + e] << 16) * wh[hsel][e]; }
            const bf16x8 xsf = pack8(xs);
            sacc[0][ct] = MFMA16(btf[0], xsf, sacc[0][ct]); sacc[1][ct] = MFMA16(btf[1], xsf, sacc[1][ct]); }
        __builtin_amdgcn_sched_barrier(0);
    }
}

__device__ __forceinline__ void p4_ssd(const Frame& F, const Params& P) {
    LAS unsigned char* L = (LAS unsigned char*)F.lds;
    const bf16_t* XA = (const bf16_t*)(P.ws + WS_XA); const float* DTV = (const float*)(P.ws + WS_DTV); const float* ACS = (const float*)(P.ws + WS_ACS);
    const bf16_t* proj = (const bf16_t*)(P.ws + WS_PROJ); bf16_t* mix = (bf16_t*)(P.ws + WS_MIX); const float* norm_w = P.in[12]; const float* d_skip = P.in[11];
    const int lane = F.lane, lt = F.wave >> 1, ch = F.wave & 1;
    for (int u = F.vcu; u < 256; u += F.G) {
        const int b = u >> 3, g = (u >> 1) & 3, hl = u & 1;
        for (int idx = F.tid; idx < 49152 / 16; idx += NTHREADS) *(LAS u32x4*)(L + L_S + idx * 16) = (u32x4){0u, 0u, 0u, 0u};
        f32x4 sacc[2][6];
#pragma unroll
        for (int a = 0; a < 2; ++a)
#pragma unroll
            for (int c = 0; c < 6; ++c) sacc[a][c] = (f32x4){0.f, 0.f, 0.f, 0.f};
        const float dsk0 = d_skip[3 * g + ch], dsk1 = d_skip[3 * g + ch + 1];
        for (int ck = 0; ck < 16; ++ck) {
            const size_t tok0 = (size_t)b * SEQ + ck * 128;
            int tt = F.tid; OPAQUE(tt);
            { const bf16_t* xrow = XA + tok0 * 1792;
#pragma unroll
            for (int k = 0; k < 4; ++k) { const int idx = tt + NTHREADS * k, row = idx >> 4, chk = idx & 15; const u32x4 v = *(const u32x4*)(xrow + (unsigned)(row * 1792 + 768 + g * 128 + chk * 8));
                *(LAS u32x4*)(L + L_B + row * 256 + ((chk ^ swz16(row & 15)) << 4)) = v; }
#pragma unroll
            for (int k = 0; k < 2; ++k) { const int idx = tt + NTHREADS * k, row = idx >> 4, chk = idx & 15; const u32x4 v = *(const u32x4*)(xrow + (unsigned)((64 * hl + row) * 1792 + 1280 + g * 128 + chk * 8));
                *(LAS u32x4*)(L + L_C + row * 256 + ((chk ^ swz16(row & 15)) << 4)) = v; }
#pragma unroll
            for (int k = 0; k < 6; ++k) { const int idx = tt + NTHREADS * k, row = idx / 24, c24 = idx % 24, r = c24 >> 3, chk = c24 & 7; const u32x4 v = *(const u32x4*)(xrow + (unsigned)(row * 1792 + g * 192 + c24 * 8));
                *(LAS u32x4*)(L + L_X + r * 16384 + row * 128 + ((chk ^ swz8(row)) << 4)) = v; }
            if (tt < 384) { const int r = tt >> 7, l = tt & 127, hh = 3 * g + r; const float* dp = DTV + tok0 * 16; const float* ap = ACS + tok0 * 16; const float dt = dp[l * 16 + hh], ac = ap[l * 16 + hh], a127 = ap[127 * 16 + hh];
                *(LAS float*)(L + L_DT + (r * 128 + l) * 4) = dt; *(LAS float*)(L + L_ACS + (r * 128 + l) * 4) = ac; *(LAS float*)(L + L_W + (r * 128 + l) * 4) = dt * __expf(a127 - ac); *(LAS float*)(L + L_EA + (r * 128 + l) * 4) = __expf(ac); } }
            __syncthreads();
            f32x4 yacc[6];
            if (ch == 0) ssd_compute<0>(L, lt, hl, lane, sacc, yacc, dsk0, dsk1); else ssd_compute<1>(L, lt, hl, lane, sacc, yacc, dsk0, dsk1);
            __syncthreads();
            { int l2 = lane; OPAQUE(l2); const int i = l2 & 15, q = l2 >> 4;
#pragma unroll
            for (int nt2 = 0; nt2 < 2; ++nt2)
#pragma unroll
                for (int ct = 0; ct < 6; ++ct) { const f32x4 s = sacc[nt2][ct]; u32x2 pk; pk.x = cvt_pk_bf16(s[0], s[1]); pk.y = cvt_pk_bf16(s[2], s[3]);
                    const int row = 96 * ch + 16 * ct + i, n0 = 16 * (2 * lt + nt2) + 4 * q; *(LAS u32x2*)(L + L_S + row * 256 + (((n0 >> 3) ^ swz16(i)) << 4) + 8 * ((n0 >> 2) & 1)) = pk; }
#pragma unroll
            for (int ct = 0; ct < 6; ++ct)
#pragma unroll
                for (int j = 0; j < 4; ++j) *(LAS float*)(L + L_X + (16 * lt + 4 * q + j) * 768 + (96 * ch + 16 * ct + i) * 4) = yacc[ct][j]; }
            __syncthreads();
            { int t2 = F.tid; OPAQUE(t2); const int row = t2 >> 3, seg = t2 & 7; const int c0 = g * 192 + seg * 24;
                const bf16_t* zp = proj + (tok0 + 64 * hl) * NPROJ + (unsigned)(row * NPROJ + COL_Z + c0); float v[24]; float ss = 0.f;
#pragma unroll
                for (int k = 0; k < 3; ++k) { const u32x4 z = *(const u32x4*)(zp + 8 * k); const f32x4 y0 = *(const LAS f32x4*)(L + L_X + row * 768 + seg * 96 + k * 32), y1 = *(const LAS f32x4*)(L + L_X + row * 768 + seg * 96 + k * 32 + 16);
                    v[8 * k + 0] = y0[0] * siluf_(bf_lo(z.x)); v[8 * k + 1] = y0[1] * siluf_(bf_hi(z.x)); v[8 * k + 2] = y0[2] * siluf_(bf_lo(z.y)); v[8 * k + 3] = y0[3] * siluf_(bf_hi(z.y));
                    v[8 * k + 4] = y1[0] * siluf_(bf_lo(z.z)); v[8 * k + 5] = y1[1] * siluf_(bf_hi(z.z)); v[8 * k + 6] = y1[2] * siluf_(bf_lo(z.w)); v[8 * k + 7] = y1[3] * siluf_(bf_hi(z.w)); }
#pragma unroll
                for (int k = 0; k < 24; ++k) ss += v[k] * v[k];
                ss += __shfl_xor(ss, 1); ss += __shfl_xor(ss, 2); ss += __shfl_xor(ss, 4);
                const float rstd = rsqrtf(ss * (1.f / 192.f) + EPS);
                bf16_t* op = mix + (tok0 + 64 * hl) * DM + (unsigned)(row * DM + 256 + c0);
#pragma unroll
                for (int k = 0; k < 3; ++k) { const f32x4 n0 = *(const f32x4*)(norm_w + c0 + 8 * k), n1 = *(const f32x4*)(norm_w + c0 + 8 * k + 4); u32x4 pk;
                    pk.x = cvt_pk_bf16(v[8 * k] * rstd * n0[0], v[8 * k + 1] * rstd * n0[1]); pk.y = cvt_pk_bf16(v[8 * k + 2] * rstd * n0[2], v[8 * k + 3] * rstd * n0[3]);
                    pk.z = cvt_pk_bf16(v[8 * k + 4] * rstd * n1[0], v[8 * k + 5] * rstd * n1[1]); pk.w = cvt_pk_bf16(v[8 * k + 6] * rstd * n1[2], v[8 * k + 7] * rstd * n1[3]);
                    *(u32x4*)(op + 8 * k) = pk; } }
            __syncthreads();
        }
    }
    for (int row = F.gw; row < T; row += F.NGW) {
        const int win = 2 << (F.lane >> 4), pos = row & (SEQ - 1); const int cnt = (pos + 1) < win ? (pos + 1) : win;
        const bf16_t* up = proj + (size_t)row * NPROJ + 4 * F.lane;
        float s0 = 0.f, s1 = 0.f, s2 = 0.f, s3 = 0.f, c0 = 0.f, c1 = 0.f, c2 = 0.f, c3 = 0.f;
        for (int j = 0; j < cnt; ++j) { const u32x2 w = *(const u32x2*)(up - (size_t)j * NPROJ); const float e0 = bf_lo(w.x), e1 = bf_hi(w.x), e2 = bf_lo(w.y), e3 = bf_hi(w.y);
            if (j == 0) { c0 = e0; c1 = e1; c2 = e2; c3 = e3; } s0 += e0; s1 += e1; s2 += e2; s3 += e3; }
        const float inv = 1.0f / (float)cnt; u32x2 w; w.x = cvt_pk_bf16(s0 * inv - c0, s1 * inv - c1); w.y = cvt_pk_bf16(s2 * inv - c2, s3 * inv - c3);
        *(u32x2*)(mix + (size_t)row * DM + 4 * F.lane) = w;
    }
}

__device__ __forceinline__ void p5_route(const Frame& F, const Params& P) {
    const float* x1 = (const float*)(P.ws + WS_X1); const float* mod = (const float*)(P.ws + WS_MOD); bf16_t* H = (bf16_t*)(P.ws + WS_H);
    const float* WR = (const float*)(P.ws + WS_WR); float* gates = (float*)(P.ws + WS_GATE); unsigned* list = (unsigned*)(P.ws + WS_LIST); unsigned* gcount = (unsigned*)(P.ws + WS_CTL) + CW_GCOUNT;
    const float* b_group = P.in[15]; const float* b_router = P.in[17];
    float* wl = (float*)F.lds;
    unsigned* lcount = (unsigned*)(F.lds + MISC_OFF);
    unsigned* lbase = lcount + 32;
    unsigned* tinfo = lcount + 64;
    float* twt = (float*)(tinfo + 256 * 4);
    for (int idx = F.tid; idx < 36 * 1024 / 4; idx += NTHREADS) ((f32x4*)wl)[idx] = ((const f32x4*)WR)[idx];
    float bg[4], br[32];
#pragma unroll
    for (int i = 0; i < 4; ++i) bg[i] = b_group[i];
#pragma unroll
    for (int i = 0; i < 32; ++i) br[i] = b_router[i];
    for (int rb = F.vcu; rb < T / 256; rb += F.G) {
        if (F.tid < 32) lcount[F.tid] = 0u;
        __syncthreads();
        for (int it = 0; it < 32; ++it) {
            const int rl = F.wave * 32 + it, row = rb * 256 + rl, b = row >> 11;
            const f32x4* xr = (const f32x4*)(x1 + (size_t)row * DM) + F.lane;
            f32x4 v[4]; float s = 0.f;
#pragma unroll
            for (int j = 0; j < 4; ++j) { v[j] = xr[64 * j]; s += (v[j][0] * v[j][0] + v[j][1] * v[j][1]) + (v[j][2] * v[j][2] + v[j][3] * v[j][3]); }
            const float rstd = rsqrtf(wave_sum(s) * (1.f / DM) + EPS);
            const f32x4* sh = (const f32x4*)(mod + (size_t)b * 6144 + 3 * 1024) + F.lane; const f32x4* sc = (const f32x4*)(mod + (size_t)b * 6144 + 4 * 1024) + F.lane;
            u32x2* o = (u32x2*)(H + (size_t)row * DM) + F.lane;
#pragma unroll
            for (int j = 0; j < 4; ++j) { const f32x4 a = sh[64 * j], m = sc[64 * j]; v[j] = v[j] * rstd * (m + 1.0f) + a; u32x2 w; w.x = cvt_pk_bf16(v[j][0], v[j][1]); w.y = cvt_pk_bf16(v[j][2], v[j][3]); o[64 * j] = w; }
            float lg[36];
#pragma unroll
            for (int q = 0; q < 36; ++q) { float pa = 0.f;
#pragma unroll
                for (int j = 0; j < 4; ++j) { const f32x4 w4 = *(const f32x4*)(wl + q * 1024 + 256 * j + 4 * F.lane); pa += (w4[0] * v[j][0] + w4[1] * v[j][1]) + (w4[2] * v[j][2] + w4[3] * v[j][3]); }
                lg[q] = wave_sum(pa); }
            float gl[4];
#pragma unroll
            for (int i = 0; i < 4; ++i) gl[i] = lg[i] + bg[i];
            int gi = 0; float gm = gl[0];
#pragma unroll
            for (int i = 1; i < 4; ++i) if (gl[i] > gm) { gm = gl[i]; gi = i; }
            float den = 0.f;
#pragma unroll
            for (int i = 0; i < 4; ++i) den += __expf(gl[i] - gm);
            const float pg = 1.0f / den;
            float el[8];
#pragma unroll
            for (int i = 0; i < 8; ++i) { const float e0 = lg[4 + i] + br[i], e1 = lg[12 + i] + br[8 + i], e2 = lg[20 + i] + br[16 + i], e3 = lg[28 + i] + br[24 + i]; el[i] = gi == 0 ? e0 : (gi == 1 ? e1 : (gi == 2 ? e2 : e3)); }
            int i0 = 0; float v0 = el[0];
#pragma unroll
            for (int i = 1; i < 8; ++i) if (el[i] > v0) { v0 = el[i]; i0 = i; }
            int i1 = -1; float v1 = -3.0e38f;
#pragma unroll
            for (int i = 0; i < 8; ++i) if (i != i0 && el[i] > v1) { v1 = el[i]; i1 = i; }
            const float ex = __expf(v1 - v0); const float w0 = pg / (1.0f + ex), w1 = pg * ex / (1.0f + ex);
            if (F.lane == 0) { const int e0 = gi * 8 + i0, e1 = gi * 8 + i1; const unsigned r0 = atomicAdd(&lcount[e0], 1u), r1 = atomicAdd(&lcount[e1], 1u);
                tinfo[rl * 4 + 0] = (unsigned)e0 | ((unsigned)e1 << 8); tinfo[rl * 4 + 1] = r0; tinfo[rl * 4 + 2] = r1; twt[rl * 2] = w0; twt[rl * 2 + 1] = w1; }
        }
        __syncthreads();
        if (F.tid < 32) lbase[F.tid] = atomicAdd(&gcount[64 * F.tid], lcount[F.tid]);
        __syncthreads();
        if (F.tid < 256) { const int rl = F.tid, row = rb * 256 + rl; const unsigned ee = tinfo[rl * 4], e0 = ee & 255u, e1 = ee >> 8;
            list[(size_t)e0 * ECAP + lbase[e0] + tinfo[rl * 4 + 1]] = (unsigned)row * 2u; list[(size_t)e1 * ECAP + lbase[e1] + tinfo[rl * 4 + 2]] = (unsigned)row * 2u + 1u;
            gates[row * 2] = twt[rl * 2]; gates[row * 2 + 1] = twt[rl * 2 + 1]; }
        __syncthreads();
    }
}

__device__ __forceinline__ void p8_final(const Frame& F, const Params& P) {
    const float* x1 = (const float*)(P.ws + WS_X1); const bf16_t* Y0 = (const bf16_t*)(P.ws + WS_Y0); const bf16_t* Y1 = (const bf16_t*)(P.ws + WS_Y1); const float* fw = P.in[20];
    f32x4 wv[4];
#pragma unroll
    for (int j = 0; j < 4; ++j) wv[j] = ((const f32x4*)fw)[F.lane + 64 * j];
    for (int row = F.gw; row < T; row += F.NGW) {
        const f32x4* xr = (const f32x4*)(x1 + (size_t)row * DM) + F.lane; const u32x2* y0 = (const u32x2*)(Y0 + (size_t)row * DM) + F.lane; const u32x2* y1 = (const u32x2*)(Y1 + (size_t)row * DM) + F.lane;
        f32x4 v[4]; float s = 0.f;
#pragma unroll
        for (int j = 0; j < 4; ++j) { const u32x2 a = y0[64 * j], c = y1[64 * j]; v[j] = xr[64 * j];
            v[j][0] += bf_lo(a.x) + bf_lo(c.x); v[j][1] += bf_hi(a.x) + bf_hi(c.x); v[j][2] += bf_lo(a.y) + bf_lo(c.y); v[j][3] += bf_hi(a.y) + bf_hi(c.y);
            s += (v[j][0] * v[j][0] + v[j][1] * v[j][1]) + (v[j][2] * v[j][2] + v[j][3] * v[j][3]); }
        const float rstd = rsqrtf(wave_sum(s) * (1.f / DM) + EPS);
        f32x4* o = (f32x4*)(P.out + (size_t)row * DM) + F.lane;
#pragma unroll
        for (int j = 0; j < 4; ++j) o[64 * j] = v[j] * rstd * wv[j];
    }
}

__device__ __forceinline__ void moe_prefix(const Frame& F, const Params& P, int* pref) {
    const unsigned* gcount = (const unsigned*)(P.ws + WS_CTL) + CW_GCOUNT;
    __syncthreads();
    if (F.tid == 0) { int acc = 0; for (int e = 0; e < 32; ++e) { const int c = (int)__hip_atomic_load(gcount + 64 * e, __ATOMIC_RELAXED, __HIP_MEMORY_SCOPE_AGENT); pref[e] = acc; pref[33 + e] = c; acc += (c + 255) >> 8; } pref[32] = acc; }
    __syncthreads();
}

__global__ void __launch_bounds__(NTHREADS, 2) fwd_kernel(Params P) {
    extern __shared__ __attribute__((aligned(16))) unsigned char lds[];
    Frame F; F.lds = lds; F.tid = threadIdx.x; F.lane = F.tid & 63; F.wave = __builtin_amdgcn_readfirstlane(F.tid >> 6);
    F.G = gridDim.x; { const int bx = blockIdx.x; F.vcu = (F.G % 8 == 0) ? (bx % 8) * (F.G / 8) + bx / 8 : bx; }
    F.gw = F.vcu * NWAVES + F.wave; F.NGW = F.G * NWAVES;
    unsigned char* ws = P.ws;
    const int lo = P.ph_lo, hi = P.ph_hi;
#define IN(k) (lo <= (k) && (k) < hi)
#define GRID_BAR() do { __syncthreads(); cooperative_groups::this_grid().sync(); } while (0)
    if (IN(0)) p0_prep(F, P);
    if (IN(0) && IN(1)) GRID_BAR();
    if (IN(1)) p1_modulate(F, P);
    if (IN(1) && IN(2)) GRID_BAR();
    if (IN(2)) { pg8::DenseSched S; S.init(ws + WS_H, ws + WS_WIN, T, NPROJ, 1024, F.G, (int)blockIdx.x); pg8::EpiProj E{(bf16_t*)(ws + WS_PROJ), (float*)(ws + WS_DTRAW)}; pg8::gemm_phase(( LAS unsigned char*)lds, S, E); }
    if (IN(2) && IN(3)) GRID_BAR();
    if (IN(3)) p3_conv(F, P);
    if (IN(3) && IN(4)) GRID_BAR();
    if (IN(4)) p4_ssd(F, P);
    if (IN(4) && IN(5)) GRID_BAR();
    if (IN(5)) { pg8::DenseSched S; S.init(ws + WS_MIX, ws + WS_WOUT, T, 1024, 1024, F.G, (int)blockIdx.x); pg8::EpiX1 E{P.in[0], (const float*)(ws + WS_MOD), (float*)(ws + WS_X1)}; pg8::gemm_phase((LAS unsigned char*)lds, S, E); }
    if (IN(5) && IN(6)) GRID_BAR();
    if (IN(6)) p5_route(F, P);
    if (IN(6) && IN(7)) GRID_BAR();
    if (IN(7)) { int* pref = (int*)(lds + MISC_OFF); moe_prefix(F, P, pref);
        pg8::MoeSched<true> S; S.A = (const char*)(ws + WS_H); S.Bt = (const char*)(ws + WS_W13); S.K = 1024; S.nN = 4; S.G = F.G; S.c = F.vcu; S.pref = (const LAS int*)pref; S.list = (const unsigned*)(ws + WS_LIST);
        pg8::EpiAct E{(bf16_t*)(ws + WS_ACT)}; pg8::gemm_phase((LAS unsigned char*)lds, S, E); }
    if (IN(7) && IN(8)) GRID_BAR();
    if (IN(8)) { int* pref = (int*)(lds + MISC_OFF); moe_prefix(F, P, pref);
        pg8::MoeSched<false> S; S.A = (const char*)(ws + WS_ACT); S.Bt = (const char*)(ws + WS_W2); S.K = 512; S.nN = 4; S.G = F.G; S.c = F.vcu; S.pref = (const LAS int*)pref; S.list = (const unsigned*)(ws + WS_LIST);
        pg8::EpiY E{(const unsigned*)(ws + WS_LIST), (const float*)(ws + WS_GATE), (const float*)(ws + WS_MOD), (bf16_t*)(ws + WS_Y0), (bf16_t*)(ws + WS_Y1)}; pg8::gemm_phase((LAS unsigned char*)lds, S, E); }
    if (IN(8) && IN(9)) GRID_BAR();
    if (IN(9)) p8_final(F, P);
#undef IN
#undef GRID_BAR
}

extern "C" void kernel_launch(void* const* d_in, const int* in_sizes, int n_in, void* d_out, int out_size, void* d_ws, size_t ws_size, hipStream_t stream) {
    static int grid = 0;
    if (grid == 0) {
        if (n_in != 21 || out_size != T * DM || ws_size < WS_END) { fprintf(stderr, "kernel_launch: unexpected sizes n_in %d out %d ws %zu\n", n_in, out_size, ws_size); grid = -1; return; }
        int dev = 0, cus = 0;
        if (hipGetDevice(&dev) != hipSuccess || hipDeviceGetAttribute(&cus, hipDeviceAttributeMultiprocessorCount, dev) != hipSuccess) { grid = -1; return; }
        if (hipFuncSetAttribute((const void*)fwd_kernel, hipFuncAttributeMaxDynamicSharedMemorySize, LDS_BYTES) != hipSuccess) { fprintf(stderr, "kernel_launch: hipFuncSetAttribute failed\n"); grid = -1; return; }
        int per_cu = 0;
        if (hipOccupancyMaxActiveBlocksPerMultiprocessor(&per_cu, (const void*)fwd_kernel, NTHREADS, LDS_BYTES) != hipSuccess || per_cu < 1) { fprintf(stderr, "kernel_launch: occupancy query says %d blocks per CU\n", per_cu); (void)hipGetLastError(); per_cu = 1; }
        grid = cus;
    }
    if (grid < 0) return;
    (void)hipMemsetAsync((char*)d_ws + WS_CTL, 0, CTL_BYTES, stream);
    Params p{};
    for (int i = 0; i < 21; ++i) p.in[i] = (const float*)d_in[i];
    p.out = (float*)d_out; p.ws = (unsigned char*)d_ws;
    p.ph_lo = 0; p.ph_hi = 10;
    void* args[] = {&p};
    hipError_t e = hipLaunchCooperativeKernel((const void*)fwd_kernel, dim3(grid), dim3(NTHREADS), args, LDS_BYTES, stream);
    if (e != hipSuccess) fprintf(stderr, "kernel_launch: cooperative launch failed: %s (grid %d)\n", hipGetErrorString(e), grid);
}
```

```cpp
#include <hip/hip_runtime.h>
#include <hip/hip_cooperative_groups.h>
#include <cstdio>
#include <cstdint>

#ifndef MK_ONE_LAUNCH
#define MK_ONE_LAUNCH 0
#endif

#define LAS __attribute__((address_space(3)))
typedef unsigned short bf16_t;
typedef short bf16x8 __attribute__((ext_vector_type(8)));
typedef float f32x4 __attribute__((ext_vector_type(4)));
typedef float f32x2 __attribute__((ext_vector_type(2)));
typedef unsigned u32x4 __attribute__((ext_vector_type(4)));
typedef unsigned u32x2 __attribute__((ext_vector_type(2)));

constexpr int BATCH = 32, SEQ = 2048, DM = 1024, T = BATCH * SEQ;
constexpr int NPROJ = 3072, NPROJ_REAL = 2828;
constexpr int COL_Z = 256, COL_XS = 1024, COL_B = 1792, COL_C = 2304, COL_DT = 2816;
constexpr int NEXP = 32, FF = 512, ECAP = 65536;
constexpr int NWAVES = 8, NTHREADS = 512;
constexpr float EPS = 1e-6f;

constexpr size_t MiB = 1u << 20;
constexpr size_t WS_CTL = 0, CTL_BYTES = 1 * MiB;
constexpr size_t WS_MOD = 1 * MiB;
constexpr size_t WS_WR = 2 * MiB;
constexpr size_t WS_SS16 = 4 * MiB;
constexpr size_t WS_GATE = 3 * MiB;
constexpr size_t WS_DTRAW = 4 * MiB;
constexpr size_t WS_LIST = 8 * MiB;
constexpr size_t WS_WIN = 16 * MiB;
constexpr size_t WS_WOUT = 22 * MiB;
constexpr size_t WS_W13 = 24 * MiB;
constexpr size_t WS_W2 = 88 * MiB;
constexpr size_t WS_H = 128 * MiB;
constexpr size_t WS_PROJ = 256 * MiB;
constexpr size_t WS_MIX = 640 * MiB;
constexpr size_t WS_X1 = 768 * MiB;
constexpr size_t WS_END = 1024 * MiB;
constexpr size_t WS_XA = WS_X1;
constexpr size_t WS_DTV = 8 * MiB, WS_ACS = 12 * MiB;
constexpr size_t WS_Y0 = 256 * MiB, WS_Y1 = 384 * MiB;
constexpr size_t WS_ACT = 512 * MiB;
constexpr int CW_GCOUNT = 256;
constexpr int CW_BAR = 4096;

constexpr int LDS_BYTES = 163840;
constexpr int MISC_OFF = 147456;

struct Params {
    const float* in[21];
    float* out;
    unsigned char* ws;
    int ph_lo, ph_hi;
};

__device__ __forceinline__ unsigned cvt_pk_bf16(float lo, float hi) { unsigned r; asm volatile("v_cvt_pk_bf16_f32 %0, %1, %2" : "=v"(r) : "v"(lo), "v"(hi)); return r; }
__device__ __forceinline__ float bf_lo(unsigned u) { return __uint_as_float(u << 16); }
__device__ __forceinline__ float bf_hi(unsigned u) { return __uint_as_float(u & 0xffff0000u); }
__device__ __forceinline__ float wave_sum(float v) {
#pragma unroll
    for (int o = 1; o < 64; o <<= 1) v += __shfl_xor(v, o);
    return v;
}
__device__ __forceinline__ float sigmoidf_(float v) { return __builtin_amdgcn_rcpf(1.0f + __expf(-v)); }
__device__ __forceinline__ float siluf_(float v) { return v * sigmoidf_(v); }

namespace pg8 {
constexpr int BM = 256, BK = 64, HALF = 128, HTB = HALF * BK * 2, STAGE_BYTES = 8 * HTB, NXCD = 8, WGM = 8;
__host__ __device__ __forceinline__ int lds_byte(int r, int c) { const int st = (r >> 4) * 2 + (c >> 5), rr = r & 15, cc = c & 31, ob = rr * 64 + cc * 2; return st * 1024 + (ob ^ (((ob >> 9) & 1) << 5)); }
__host__ __device__ __forceinline__ void stage_rc(int b, int& R, int& C) { const int st = b / 1024, sb = b % 1024, swz = sb ^ (((sb >> 9) & 1) << 5); R = (st >> 1) * 16 + swz / 64; C = (st & 1) * 32 + (swz % 64) / 2; }
__host__ __device__ __forceinline__ int perm32(int rho) { const int n = rho >> 4, i = rho & 15; return 8 * (i >> 2) + 4 * n + (i & 3); }

struct Unit { int pm, pn, e, cnt, slot0; };

struct DenseSched {
    const char* A; const char* Bt; int K;
    int nM, nN, nwg, G, c;
    __device__ void init(const void* A_, const void* Bt_, int M, int N, int K_, int G_, int c_) { A = (const char*)A_; Bt = (const char*)Bt_; K = K_; nM = M / BM; nN = N / BM; nwg = nM * nN; G = G_; c = c_; }
    __device__ __forceinline__ bool next(int i, Unit& u) const {
        const long L = (long)i * G + c; if (L >= nwg) return false;
        int wgid = (int)L; { const int q = nwg / NXCD, r = nwg % NXCD, xcd = wgid % NXCD, off = wgid / NXCD; wgid = (xcd < r ? xcd * (q + 1) : r * (q + 1) + (xcd - r) * q) + off; }
        const int nig = WGM * nN, gid = wgid / nig, fm = gid * WGM, gsz = (nM - fm) < WGM ? (nM - fm) : WGM;
        u.pm = fm + ((wgid % nig) % gsz); u.pn = (wgid % nig) / gsz; u.e = 0; u.cnt = 256; u.slot0 = 0; return true;
    }
    __device__ __forceinline__ const char* a_base() const { return A; }
    __device__ __forceinline__ void a_off(const Unit& u, const int (&R)[2], const int (&C)[2], unsigned (&o)[2][2]) const {
#pragma unroll
        for (int h = 0; h < 2; ++h)
#pragma unroll
            for (int i = 0; i < 2; ++i) o[h][i] = (unsigned)((u.pm * BM + h * HALF + R[i]) * K + C[i]) * 2u;
    }
    __device__ __forceinline__ const char* b_ptr(const Unit& u) const { return Bt + (size_t)u.pn * BM * K * 2; }
};

template <bool GATHER>
struct MoeSched {
    const char* A; const char* Bt; int K, nN, G, c;
    const LAS int* pref;
    const unsigned* list;
    __device__ __forceinline__ bool next(int i, Unit& u) const {
        const long L = (long)i * G + c; const int tot = pref[32] * nN; if (L >= tot) return false;
        const int ti = (int)L / nN; u.pn = (int)L % nN;
        int e = 0;
#pragma unroll 1
        for (int j = 1; j < 32; ++j) if (pref[j] <= ti) e = j;
        const int mt = ti - pref[e]; u.pm = ti; u.e = e; u.slot0 = mt * 256; const int rem = pref[33 + e] - mt * 256; u.cnt = rem < 256 ? rem : 256; return true;
    }
    __device__ __forceinline__ const char* a_base() const { return A; }
    __device__ __forceinline__ void a_off(const Unit& u, const int (&R)[2], const int (&C)[2], unsigned (&o)[2][2]) const {
#pragma unroll
        for (int h = 0; h < 2; ++h)
#pragma unroll
            for (int i = 0; i < 2; ++i) {
                const int r = h * HALF + R[i];
                if (GATHER) { unsigned tok = 0; if (r < u.cnt) tok = list[(size_t)u.e * ECAP + u.slot0 + r] >> 1; o[h][i] = (unsigned)(tok * K + C[i]) * 2u; }
                else o[h][i] = (unsigned)((u.pm * BM + r) * K + C[i]) * 2u;
            }
    }
    __device__ __forceinline__ const char* b_ptr(const Unit& u) const { return Bt + ((size_t)u.e * (nN * BM) + (size_t)u.pn * BM) * K * 2; }
};

template <class Epi, class Sched>
__device__ __forceinline__ void gemm_phase(LAS unsigned char* lds, const Sched& S, const Epi& E) {
    const int tid = threadIdx.x, wid = __builtin_amdgcn_readfirstlane(tid >> 6), lane = tid & 63, wr = wid >> 2, wc = wid & 3, fr = lane & 15, fq = lane >> 4;
    const int K = S.K, nt = K / BK;
    int sR[2], sC[2]; unsigned voffB[2];
#pragma unroll
    for (int i = 0; i < 2; ++i) { int R, C; stage_rc(tid * 16 + i * 8192, R, C); sR[i] = R; sC[i] = C; const int Rb = Epi::PERM ? ((R & ~31) + perm32(R & 31)) : R; voffB[i] = (unsigned)(Rb * K + C) * 2u; }
    const size_t kstep = (size_t)(BK * 2);
    const size_t hstep = (size_t)HALF * K * 2;
    const unsigned ldsw = (unsigned)wid * 1024u;
    const int aoff = lds_byte(wr * 64 + fr, fq * 8), boff = lds_byte(wc * 32 + fr, fq * 8);
#define PG8_SA(b, h) (((b) * 2 + (h)) * HTB)
#define PG8_SB(b, h) ((4 + (b) * 2 + (h)) * HTB)
#define PG8_STAGE(bufoff, gbase, voff) do { _Pragma("unroll") for (int _i = 0; _i < 2; ++_i) \
        __builtin_amdgcn_global_load_lds((const unsigned*)((const char*)(gbase) + (voff)[_i]), (LAS unsigned*)(lds + (bufoff) + ldsw + _i * 8192), 16, 0, 0); } while (0)
#define PG8_LDA(dst, b, h) do { _Pragma("unroll") for (int m = 0; m < 4; ++m) _Pragma("unroll") for (int k = 0; k < 2; ++k) dst[m][k] = *(const LAS bf16x8*)(lds + PG8_SA(b, h) + aoff + m * 2048 + k * 1024); } while (0)
#define PG8_LDB(dst, b, h) do { _Pragma("unroll") for (int n = 0; n < 2; ++n) _Pragma("unroll") for (int k = 0; k < 2; ++k) dst[n][k] = *(const LAS bf16x8*)(lds + PG8_SB(b, h) + boff + n * 2048 + k * 1024); } while (0)
#define PG8_MMA(ai, bj, At, Bt) do { __builtin_amdgcn_s_setprio(1); _Pragma("unroll") for (int m = 0; m < 4; ++m) _Pragma("unroll") for (int n = 0; n < 2; ++n) _Pragma("unroll") for (int k = 0; k < 2; ++k) \
        acc[ai][bj][m][n] = __builtin_amdgcn_mfma_f32_16x16x32_bf16(Bt[n][k], At[m][k], acc[ai][bj][m][n], 0, 0, 0); __builtin_amdgcn_s_setprio(0); } while (0)
#define PG8_WAIT_V(n) asm volatile("s_waitcnt vmcnt(" #n ")" ::: "memory")
#define PG8_WAIT_L(n) asm volatile("s_waitcnt lgkmcnt(" #n ")" ::: "memory")
#define PG8_BAR __builtin_amdgcn_s_barrier()
#define PG8_SCHED __builtin_amdgcn_sched_barrier(0)
    Unit cur, nxt; int ui = 0;
    if (!S.next(0, cur)) return;
    f32x4 acc[2][2][4][2];
#pragma unroll
    for (int a = 0; a < 2; ++a)
#pragma unroll
        for (int b = 0; b < 2; ++b)
#pragma unroll
            for (int m = 0; m < 4; ++m)
#pragma unroll
                for (int n = 0; n < 2; ++n) acc[a][b][m][n] = (f32x4){0.f, 0.f, 0.f, 0.f};
    bf16x8 At[4][2], B0[2][2], B1[2][2];
    unsigned aoC[2][2], aoN[2][2];
    S.a_off(cur, sR, sC, aoC);
    const char* const Ab = S.a_base();
    const char* cB = S.b_ptr(cur);
    PG8_STAGE(PG8_SB(0, 0), cB, voffB); PG8_STAGE(PG8_SB(0, 1), cB + hstep, voffB); PG8_STAGE(PG8_SA(0, 0), Ab, aoC[0]); PG8_STAGE(PG8_SA(0, 1), Ab, aoC[1]);
    if (wr == 1) PG8_BAR;
    PG8_WAIT_V(2); PG8_BAR;
    PG8_STAGE(PG8_SB(1, 0), cB + kstep, voffB); PG8_STAGE(PG8_SA(1, 0), Ab + kstep, aoC[0]); PG8_STAGE(PG8_SB(1, 1), cB + hstep + kstep, voffB);
    PG8_WAIT_V(6); PG8_BAR;
    for (;;) {
        const bool has_next = S.next(ui + 1, nxt);
        const char* nB = cB;
        if (has_next) { S.a_off(nxt, sR, sC, aoN); nB = S.b_ptr(nxt); }
        else {
#pragma unroll
            for (int h = 0; h < 2; ++h)
#pragma unroll
                for (int i = 0; i < 2; ++i) aoN[h][i] = aoC[h][i];
        }
        for (int t = 0; t < nt; t += 2) {
            const bool last = (t == nt - 2);
            const char* a1 = Ab + (size_t)(t + 1) * kstep;
            const char* a2 = last ? Ab : Ab + (size_t)(t + 2) * kstep; const char* b2 = last ? nB : cB + (size_t)(t + 2) * kstep;
            const char* a3 = a2 + kstep; const char* b3 = b2 + kstep;
            unsigned o2[2][2];
#pragma unroll
            for (int h = 0; h < 2; ++h)
#pragma unroll
                for (int i = 0; i < 2; ++i) o2[h][i] = last ? aoN[h][i] : aoC[h][i];
            PG8_LDB(B0, 0, 0); PG8_LDB(B1, 0, 1); PG8_SCHED; PG8_LDA(At, 0, 0); PG8_STAGE(PG8_SA(1, 1), a1, aoC[1]);
            PG8_WAIT_V(8); PG8_WAIT_L(0); PG8_BAR; PG8_MMA(0, 0, At, B0); PG8_MMA(0, 1, At, B1); PG8_BAR; PG8_SCHED;
            PG8_LDA(At, 0, 1); PG8_STAGE(PG8_SB(0, 0), b2, voffB); PG8_STAGE(PG8_SB(0, 1), b2 + hstep, voffB); PG8_STAGE(PG8_SA(0, 0), a2, o2[0]);
            PG8_WAIT_V(8); PG8_WAIT_L(0); PG8_BAR; PG8_MMA(1, 0, At, B0); PG8_MMA(1, 1, At, B1); PG8_BAR; PG8_SCHED;
            PG8_LDB(B0, 1, 0); PG8_LDB(B1, 1, 1); PG8_SCHED; PG8_LDA(At, 1, 0); PG8_STAGE(PG8_SA(0, 1), a2, o2[1]);
            PG8_WAIT_V(8); PG8_WAIT_L(0); PG8_BAR; PG8_MMA(0, 0, At, B0); PG8_MMA(0, 1, At, B1); PG8_BAR; PG8_SCHED;
            PG8_LDA(At, 1, 1); PG8_STAGE(PG8_SB(1, 0), b3, voffB); PG8_STAGE(PG8_SB(1, 1), b3 + hstep, voffB); PG8_STAGE(PG8_SA(1, 0), a3, o2[0]);
            PG8_WAIT_V(8); PG8_WAIT_L(0); PG8_BAR; PG8_MMA(1, 0, At, B0); PG8_MMA(1, 1, At, B1); PG8_BAR; PG8_SCHED;
        }
        if (wr == 0) PG8_BAR;
        E(acc, cur, wr, wc, fr, fq);
        if (!has_next) break;
#pragma unroll
        for (int a = 0; a < 2; ++a)
#pragma unroll
            for (int b = 0; b < 2; ++b)
#pragma unroll
                for (int m = 0; m < 4; ++m)
#pragma unroll
                    for (int n = 0; n < 2; ++n) acc[a][b][m][n] = (f32x4){0.f, 0.f, 0.f, 0.f};
        cur = nxt; cB = nB; ++ui;
#pragma unroll
        for (int h = 0; h < 2; ++h)
#pragma unroll
            for (int i = 0; i < 2; ++i) aoC[h][i] = aoN[h][i];
        if (wr == 1) PG8_BAR;
    }
    PG8_WAIT_V(0);
    PG8_BAR;
#undef PG8_SA
#undef PG8_SB
#undef PG8_STAGE
#undef PG8_LDA
#undef PG8_LDB
#undef PG8_MMA
#undef PG8_WAIT_V
#undef PG8_WAIT_L
#undef PG8_BAR
#undef PG8_SCHED
}

struct EpiProj {
    static constexpr bool PERM = true;
    bf16_t* O; float* dtraw;
    __device__ __forceinline__ void operator()(const f32x4 (&acc)[2][2][4][2], const Unit& u, int wr, int wc, int fr, int fq) const {
        const int row0 = u.pm * BM + wr * 64 + fr, col0 = u.pn * BM + wc * 32 + 8 * fq;
#pragma unroll
        for (int ai = 0; ai < 2; ++ai)
#pragma unroll
            for (int m = 0; m < 4; ++m) { const int row = row0 + ai * HALF + m * 16; bf16_t* rowp = O + (size_t)row * NPROJ + col0;
#pragma unroll
                for (int bj = 0; bj < 2; ++bj) { const f32x4 v0 = acc[ai][bj][m][0], v1 = acc[ai][bj][m][1];
                    u32x4 w; w.x = cvt_pk_bf16(v0[0], v0[1]); w.y = cvt_pk_bf16(v0[2], v0[3]); w.z = cvt_pk_bf16(v1[0], v1[1]); w.w = cvt_pk_bf16(v1[2], v1[3]);
                    *(u32x4*)(rowp + bj * HALF) = w; }
                if (u.pn == 11 && wc == 0 && fq < 2) { float* d = dtraw + (size_t)row * 16 + 8 * fq; *(f32x4*)d = acc[ai][0][m][0]; *(f32x4*)(d + 4) = acc[ai][0][m][1]; }
            }
    }
};
struct EpiX1 {
    static constexpr bool PERM = false;
    const float* x; const float* mod; float* x1; float* ss16;
    __device__ __forceinline__ void operator()(const f32x4 (&acc)[2][2][4][2], const Unit& u, int wr, int wc, int fr, int fq) const {
        const int row0 = u.pm * BM + wr * 64 + fr, col0 = u.pn * BM + wc * 32 + 4 * fq; const int b = (u.pm * BM) >> 11;
        f32x4 gv[2][2];
#pragma unroll
        for (int bj = 0; bj < 2; ++bj)
#pragma unroll
            for (int n = 0; n < 2; ++n) gv[bj][n] = *(const f32x4*)(mod + (size_t)b * 6144 + 2 * 1024 + col0 + bj * HALF + n * 16);
#pragma unroll
        for (int ai = 0; ai < 2; ++ai)
#pragma unroll
            for (int m = 0; m < 4; ++m) { const int row = row0 + ai * HALF + m * 16; const size_t off = (size_t)row * DM + col0; float ss = 0.f;
#pragma unroll
                for (int bj = 0; bj < 2; ++bj)
#pragma unroll
                    for (int n = 0; n < 2; ++n) { const f32x4 xv = *(const f32x4*)(x + off + bj * HALF + n * 16); const f32x4 o = xv + gv[bj][n] * acc[ai][bj][m][n]; *(f32x4*)(x1 + off + bj * HALF + n * 16) = o;
                        ss += (o[0] * o[0] + o[1] * o[1]) + (o[2] * o[2] + o[3] * o[3]); }
                ss += __shfl_xor(ss, 16); ss += __shfl_xor(ss, 32);
                if (fq == 0) ss16[(size_t)row * 16 + u.pn * 4 + wc] = ss; }
    }
};
struct EpiAct {
    static constexpr bool PERM = true;
    bf16_t* act;
    __device__ __forceinline__ void operator()(const f32x4 (&acc)[2][2][4][2], const Unit& u, int wr, int wc, int fr, int fq) const {
        const int row0 = u.pm * BM + wr * 64 + fr, col0 = u.pn * HALF + wc * 32 + 8 * fq;
#pragma unroll
        for (int ai = 0; ai < 2; ++ai)
#pragma unroll
            for (int m = 0; m < 4; ++m) { bf16_t* p = act + (size_t)(row0 + ai * HALF + m * 16) * FF + col0; float o[8];
#pragma unroll
                for (int n = 0; n < 2; ++n)
#pragma unroll
                    for (int i = 0; i < 4; ++i) { const float a = acc[ai][0][m][n][i], b = acc[ai][1][m][n][i]; o[n * 4 + i] = siluf_(a) * b; }
                u32x4 w; w.x = cvt_pk_bf16(o[0], o[1]); w.y = cvt_pk_bf16(o[2], o[3]); w.z = cvt_pk_bf16(o[4], o[5]); w.w = cvt_pk_bf16(o[6], o[7]);
                *(u32x4*)p = w; }
    }
};
struct EpiY {
    static constexpr bool PERM = true;
    const unsigned* list; const float* gates; const float* mod; bf16_t* Y0; bf16_t* Y1;
    __device__ __forceinline__ void operator()(const f32x4 (&acc)[2][2][4][2], const Unit& u, int wr, int wc, int fr, int fq) const {
        const int col0 = u.pn * BM + wc * 32 + 8 * fq;
#pragma unroll
        for (int ai = 0; ai < 2; ++ai)
#pragma unroll
            for (int m = 0; m < 4; ++m) { const int r = ai * HALF + wr * 64 + m * 16 + fr;
                if (r < u.cnt) {
                    const unsigned ent = list[(size_t)u.e * ECAP + u.slot0 + r]; const unsigned tok = ent >> 1; const float gate = gates[ent];
                    bf16_t* yp = ((ent & 1u) ? Y1 : Y0) + (size_t)tok * DM + col0; const float* gp = mod + (size_t)(tok >> 11) * 6144 + 5 * 1024 + col0;
#pragma unroll
                    for (int bj = 0; bj < 2; ++bj) { const f32x4 g0 = *(const f32x4*)(gp + bj * HALF), g1 = *(const f32x4*)(gp + bj * HALF + 4);
                        const f32x4 v0 = acc[ai][bj][m][0] * g0 * gate, v1 = acc[ai][bj][m][1] * g1 * gate;
                        u32x4 w; w.x = cvt_pk_bf16(v0[0], v0[1]); w.y = cvt_pk_bf16(v0[2], v0[3]); w.z = cvt_pk_bf16(v1[0], v1[1]); w.w = cvt_pk_bf16(v1[2], v1[3]);
                        *(u32x4*)(yp + bj * HALF) = w; } } }
    }
};
}

struct Frame {
    unsigned char* lds; int tid, lane, wave, vcu, G, gw, NGW;
};

__device__ __forceinline__ void transpose_item(const float* W, int ldw, int nvalid, int k0, int n0, bf16_t* WT, int K, int dst_row0, float* scr, int lane) {
#pragma unroll 8
    for (int i = 0; i < 32; ++i) { const int kk = 2 * i + (lane >> 5); const int n = n0 + (lane & 31); scr[kk * 33 + (lane & 31)] = (n < nvalid) ? W[(size_t)(k0 + kk) * ldw + n] : 0.f; }
    asm volatile("s_waitcnt lgkmcnt(0)" ::: "memory");
    const int c = lane & 7;
#pragma unroll
    for (int j = 0; j < 4; ++j) { const int n = (lane >> 3) + 8 * j; const float* s = scr + (8 * c) * 33 + n;
        u32x4 o; o.x = cvt_pk_bf16(s[0 * 33], s[1 * 33]); o.y = cvt_pk_bf16(s[2 * 33], s[3 * 33]); o.z = cvt_pk_bf16(s[4 * 33], s[5 * 33]); o.w = cvt_pk_bf16(s[6 * 33], s[7 * 33]);
        *(u32x4*)(WT + (size_t)(dst_row0 + n0 + n) * K + k0 + 8 * c) = o; }
    asm volatile("s_waitcnt lgkmcnt(0)" ::: "memory");
}

__device__ __forceinline__ void p0_prep(const Frame& F, const Params& P) {
    unsigned char* ws = P.ws;
    {
        float* sct = (float*)F.lds;
        const float* c = P.in[1];
        for (int idx = F.tid; idx < 32 * 1024; idx += NTHREADS) { const int b = idx >> 10, k = idx & 1023; sct[k * 32 + b] = siluf_(c[idx]); }
        __syncthreads();
        const float* w_ada = P.in[2]; const float* b_ada = P.in[3]; float* mod = (float*)(ws + WS_MOD);
        for (int cg = F.vcu; cg < 256; cg += F.G) {
            const int j = F.tid % 24, kg = F.tid / 24;
            float acc[32];
#pragma unroll
            for (int b = 0; b < 32; ++b) acc[b] = 0.f;
            if (kg < 16) {
                for (int kk = 0; kk < 64; ++kk) { const int k = kg * 64 + kk; const float w = w_ada[(size_t)k * 6144 + cg * 24 + j];
#pragma unroll
                    for (int q = 0; q < 8; ++q) { const f32x4 s = *(const f32x4*)(sct + k * 32 + 4 * q); acc[4 * q] += s[0] * w; acc[4 * q + 1] += s[1] * w; acc[4 * q + 2] += s[2] * w; acc[4 * q + 3] += s[3] * w; } }
            }
            float* px = (float*)(F.lds + 131072);
            float tot[2] = {0.f, 0.f};
#pragma unroll 1
            for (int half = 0; half < 2; ++half) {
                if (kg < 16 && (kg >> 3) == half) {
#pragma unroll
                    for (int b = 0; b < 32; ++b) px[((kg & 7) * 24 + j) * 32 + b] = acc[b];
                }
                __syncthreads();
#pragma unroll
                for (int r = 0; r < 2; ++r) { const int o = F.tid + r * 512; if (o < 768) { float s = 0.f;
#pragma unroll
                        for (int q = 0; q < 8; ++q) s += px[q * 768 + o]; tot[r] += s; } }
                __syncthreads();
            }
#pragma unroll
            for (int r = 0; r < 2; ++r) { const int o = F.tid + r * 512; if (o < 768) { const int jj = o >> 5, b = o & 31; mod[(size_t)b * 6144 + cg * 24 + jj] = tot[r] + b_ada[cg * 24 + jj]; } }
        }
        __syncthreads();
    }
    {
        float* scr = (float*)(F.lds + F.wave * 16384);
        const float* w_in = P.in[4]; const float* w_out = P.in[13]; const float* w13 = P.in[18]; const float* w2 = P.in[19];
        bf16_t* WIN = (bf16_t*)(ws + WS_WIN); bf16_t* WOUT = (bf16_t*)(ws + WS_WOUT); bf16_t* W13 = (bf16_t*)(ws + WS_W13); bf16_t* W2 = (bf16_t*)(ws + WS_W2);
        constexpr int I0 = 16 * 88, I1 = 16 * 32, I2 = 32 * 16 * 32, I3 = 32 * 8 * 32, NIT = I0 + I1 + I2 + I3;
        for (int it = F.gw; it < NIT; it += F.NGW) {
            int r = it;
            if (r < I0) { const int kb = r / 88, nb = 8 + r % 88; transpose_item(w_in, NPROJ_REAL, NPROJ_REAL, kb * 64, nb * 32, WIN, 1024, 0, scr, F.lane); continue; } r -= I0;
            if (r < I1) { const int kb = r / 32, nb = r % 32; transpose_item(w_out, 1024, 1024, kb * 64, nb * 32, WOUT, 1024, 0, scr, F.lane); continue; } r -= I1;
            if (r < I2) { const int e = r / 512, q = r % 512, kb = q / 32, nb = q % 32; const int n0 = nb * 32, bj = n0 >> 9, rem = n0 & 511, pn = rem >> 7, j0 = rem & 127;
                transpose_item(w13 + (size_t)e * 1024 * 1024, 1024, 1024, kb * 64, n0, W13 + (size_t)e * 1024 * 1024, 1024, pn * 256 + bj * 128 + j0 - n0, scr, F.lane); continue; } r -= I2;
            { const int e = r / 256, q = r % 256, kb = q / 32, nb = q % 32;
                transpose_item(w2 + (size_t)e * 512 * 1024, 1024, 1024, kb * 64, nb * 32, W2 + (size_t)e * 1024 * 512, 512, 0, scr, F.lane); }
        }
    }
    {
        const float* w_in = P.in[4]; const float* w_pool = P.in[5]; const float* pscale = P.in[6]; bf16_t* WIN = (bf16_t*)(ws + WS_WIN);
        for (int idx = F.vcu * NTHREADS + F.tid; idx < 256 * 1024; idx += F.G * NTHREADS) {
            const int n = idx >> 10, k = idx & 1023, g = n >> 6, d = n & 63; const float* wi = w_in + (size_t)k * NPROJ_REAL + g * 64; const float* wp = w_pool + (size_t)g * 4096 + d;
            float s = 0.f;
#pragma unroll 8
            for (int cc = 0; cc < 64; ++cc) s += wi[cc] * wp[cc * 64];
            s *= pscale[n];
            WIN[(size_t)n * 1024 + k] = (bf16_t)(cvt_pk_bf16(s, 0.f) & 0xffffu);
        }
    }
    {
        const float* wg = P.in[14]; const float* wrt = P.in[16]; bf16_t* WRH = (bf16_t*)(ws + WS_WR); bf16_t* WRL = (bf16_t*)(ws + WS_WR + 131072);
        for (int idx = F.vcu * NTHREADS + F.tid; idx < 36 * 1024; idx += F.G * NTHREADS) { const int j = idx >> 10, k = idx & 1023; const float w = (j < 4) ? wg[k * 4 + j] : wrt[k * 32 + (j - 4)];
            const unsigned hi = cvt_pk_bf16(w, 0.f) & 0xffffu; const float lo = w - __uint_as_float(hi << 16); WRH[idx] = (bf16_t)hi; WRL[idx] = (bf16_t)(cvt_pk_bf16(lo, 0.f) & 0xffffu); }
    }
}

__device__ __forceinline__ void p1_modulate(const Frame& F, const Params& P) {
    const float* x = P.in[0]; const float* mod = (const float*)(P.ws + WS_MOD); bf16_t* H = (bf16_t*)(P.ws + WS_H);
    for (int row = F.gw; row < T; row += F.NGW) {
        const int b = row >> 11; const f32x4* xr = (const f32x4*)(x + (size_t)row * DM) + F.lane;
        f32x4 v[4]; float s = 0.f;
#pragma unroll
        for (int j = 0; j < 4; ++j) { v[j] = xr[64 * j]; s += (v[j][0] * v[j][0] + v[j][1] * v[j][1]) + (v[j][2] * v[j][2] + v[j][3] * v[j][3]); }
        const float rstd = rsqrtf(wave_sum(s) * (1.f / DM) + EPS);
        const f32x4* sh = (const f32x4*)(mod + (size_t)b * 6144) + F.lane; const f32x4* sc = (const f32x4*)(mod + (size_t)b * 6144 + 1024) + F.lane;
        u32x2* o = (u32x2*)(H + (size_t)row * DM) + F.lane;
#pragma unroll
        for (int j = 0; j < 4; ++j) { const f32x4 a = sh[64 * j], m = sc[64 * j]; const f32x4 h = v[j] * rstd * (m + 1.0f) + a; u32x2 w; w.x = cvt_pk_bf16(h[0], h[1]); w.y = cvt_pk_bf16(h[2], h[3]); o[64 * j] = w; }
    }
}

__device__ __forceinline__ void p3_conv(const Frame& F, const Params& P) {
    const bf16_t* proj = (const bf16_t*)(P.ws + WS_PROJ); bf16_t* XA = (bf16_t*)(P.ws + WS_XA);
    const float* conv_w = P.in[7]; const float* conv_b = P.in[8];
    if (F.tid < 24) {
        const float* dtraw = (const float*)(P.ws + WS_DTRAW); float* DTV = (float*)(P.ws + WS_DTV); float* ACS = (float*)(P.ws + WS_ACS);
        const float* dt_bias = P.in[9]; const float* a_log = P.in[10];
        for (int idx = F.vcu * 24 + F.tid; idx < BATCH * 16 * 12; idx += F.G * 24) {
            const int h = idx % 12, bc = idx / 12; const float a = -__expf(a_log[h]), dtb = dt_bias[h]; float cs = 0.f;
            for (int l = 0; l < 128; ++l) { const size_t row = (size_t)bc * 128 + l; const float v = dtraw[row * 16 + h] + dtb; const float dt = v > 20.f ? v : log1pf(__expf(v)); cs += dt * a; DTV[row * 16 + h] = dt; ACS[row * 16 + h] = cs; }
        }
    }
    for (int item = F.vcu * NTHREADS + F.tid; item < (T / 16) * 224; item += F.G * NTHREADS) {
        const int cg = item % 224, rr = item / 224, ch = cg * 8, row0 = rr * 16, t0 = row0 & (SEQ - 1);
        float w[4][8], bs[8];
#pragma unroll
        for (int j = 0; j < 4; ++j) { const f32x4 a = *(const f32x4*)(conv_w + j * 1792 + ch), c = *(const f32x4*)(conv_w + j * 1792 + ch + 4);
#pragma unroll
            for (int k = 0; k < 4; ++k) { w[j][k] = a[k]; w[j][4 + k] = c[k]; } }
        { const f32x4 a = *(const f32x4*)(conv_b + ch), c = *(const f32x4*)(conv_b + ch + 4);
#pragma unroll
            for (int k = 0; k < 4; ++k) { bs[k] = a[k]; bs[4 + k] = c[k]; } }
        float r0[8], r1[8], r2[8];
        const bf16_t* src = proj + (size_t)row0 * NPROJ + COL_XS + ch;
#define LD8(dst, p) do { const u32x4 _v = *(const u32x4*)(p); dst[0] = bf_lo(_v.x); dst[1] = bf_hi(_v.x); dst[2] = bf_lo(_v.y); dst[3] = bf_hi(_v.y); dst[4] = bf_lo(_v.z); dst[5] = bf_hi(_v.z); dst[6] = bf_lo(_v.w); dst[7] = bf_hi(_v.w); } while (0)
        if (t0 >= 3) { LD8(r0, src - 3 * (size_t)NPROJ); LD8(r1, src - 2 * (size_t)NPROJ); LD8(r2, src - (size_t)NPROJ); }
        else {
#pragma unroll
            for (int k = 0; k < 8; ++k) { r0[k] = 0.f; r1[k] = 0.f; r2[k] = 0.f; } }
#pragma unroll 4
        for (int i = 0; i < 16; ++i) {
            float cur[8]; LD8(cur, src + (size_t)i * NPROJ); float o[8];
#pragma unroll
            for (int k = 0; k < 8; ++k) { const float v = bs[k] + w[0][k] * r0[k] + w[1][k] * r1[k] + w[2][k] * r2[k] + w[3][k] * cur[k]; o[k] = siluf_(v); r0[k] = r1[k]; r1[k] = r2[k]; r2[k] = cur[k]; }
            u32x4 pk; pk.x = cvt_pk_bf16(o[0], o[1]); pk.y = cvt_pk_bf16(o[2], o[3]); pk.z = cvt_pk_bf16(o[4], o[5]); pk.w = cvt_pk_bf16(o[6], o[7]);
            *(u32x4*)(XA + (size_t)(row0 + i) * 1792 + ch) = pk;
        }
#undef LD8
    }
}

constexpr int L_B = 0, L_C = 32768, L_X = 49152, L_S = 98304, L_DT = 147456, L_ACS = L_DT + 1536, L_W = L_ACS + 1536, L_EA = L_W + 1536;
typedef short v4i16 __attribute__((ext_vector_type(4)));
__device__ __forceinline__ int swz16(int r) { const int h = (r >> 3) & 1; return ((((r & 7) + 4 * h) & 7) << 1) | h; }
__device__ __forceinline__ int swz8(int row) { return ((row >> 1) & 3) << 1; }
__device__ __forceinline__ bf16x8 tr_pair(LAS unsigned char* a0, LAS unsigned char* a1) {
    const v4i16 lo = __builtin_amdgcn_ds_read_tr16_b64_v4i16((LAS v4i16*)a0), hi = __builtin_amdgcn_ds_read_tr16_b64_v4i16((LAS v4i16*)a1);
    return (bf16x8){lo[0], lo[1], lo[2], lo[3], hi[0], hi[1], hi[2], hi[3]};
}
__device__ __forceinline__ bf16x8 pack8(const float (&v)[8]) {
    u32x4 p; p.x = cvt_pk_bf16(v[0], v[1]); p.y = cvt_pk_bf16(v[2], v[3]); p.z = cvt_pk_bf16(v[4], v[5]); p.w = cvt_pk_bf16(v[6], v[7]);
    return __builtin_bit_cast(bf16x8, p);
}
#define MFMA16(a, b, c) __builtin_amdgcn_mfma_f32_16x16x32_bf16((a), (b), (c), 0, 0, 0)

#define OPAQUE(x) asm volatile("" : "+v"(x))
template <int CH>
__device__ __forceinline__ void ssd_compute(LAS unsigned char* L, int lt, int hl, int lane, f32x4 (&sacc)[2][6], f32x4 (&yacc)[6], float dsk0, float dsk1) {
    OPAQUE(lane);
    const int i = lane & 15, q = lane >> 4, qp = i >> 2, pp = lane & 3;
    const int lrow0 = 64 * hl + 16 * lt;
    int pr[4];
    { const int fsw = swz16(i);
#pragma unroll
      for (int ks = 0; ks < 4; ++ks) { pr[ks] = i * 256 + (((4 * ks + q) ^ fsw) << 4); OPAQUE(pr[ks]); } }
    int q16 = 16 * q; OPAQUE(q16);
    int i4 = 4 * i; OPAQUE(i4);
    const int r4 = 4 * q + qp;
    int tb[2], tx[4];
    { const int fr = swz16(r4), xr = swz8(r4);
#pragma unroll
      for (int nt2 = 0; nt2 < 2; ++nt2) { tb[nt2] = r4 * 256 + 8 * (pp & 1) + (((2 * (2 * lt + nt2) + (pp >> 1)) ^ fr) << 4); OPAQUE(tb[nt2]); }
#pragma unroll
      for (int pt = 0; pt < 4; ++pt) { tx[pt] = r4 * 128 + 8 * (pp & 1) + (((2 * pt + (pp >> 1)) ^ xr) << 4); OPAQUE(tx[pt]); } }
    int cbase = lt * 4096; OPAQUE(cbase);
    int lq = (lrow0 + 4 * q) * 4; OPAQUE(lq);
    int li = (lrow0 + i) * 4; OPAQUE(li);
    bf16x8 cfrag[4];
#pragma unroll
    for (int ks = 0; ks < 4; ++ks) cfrag[ks] = *(const LAS bf16x8*)(L + L_C + cbase + pr[ks]);
#pragma unroll
    for (int ct = 0; ct < 6; ++ct) { f32x4 a = (f32x4){0.f, 0.f, 0.f, 0.f};
#pragma unroll
        for (int ks = 0; ks < 4; ++ks) { const bf16x8 sf = *(const LAS bf16x8*)(L + L_S + (96 * CH + 16 * ct) * 256 + pr[ks]); a = MFMA16(cfrag[ks], sf, a); }
        yacc[ct] = a; }
#pragma unroll
    for (int hsel = 0; hsel < 2; ++hsel) { const f32x4 e = *(const LAS f32x4*)(L + L_EA + (CH + hsel) * 512 + lq);
#pragma unroll
        for (int ct = 0; ct < 6; ++ct) if ((((6 * CH + ct) >> 2) - CH) == hsel) yacc[ct] = yacc[ct] * e; }
    __builtin_amdgcn_sched_barrier(0);
    f32x4 cbt[8];
#pragma unroll
    for (int ts = 0; ts < 8; ++ts) { f32x4 a = (f32x4){0.f, 0.f, 0.f, 0.f};
#pragma unroll
        for (int ks = 0; ks < 4; ++ks) { const bf16x8 bf = *(const LAS bf16x8*)(L + L_B + ts * 4096 + pr[ks]); a = MFMA16(bf, cfrag[ks], a); }
        cbt[ts] = a; }
    __builtin_amdgcn_sched_barrier(0);
    bf16x8 mfrag[2][4];
    int dq = lrow0 + i - 4 * q; OPAQUE(dq);
#pragma unroll
    for (int hsel = 0; hsel < 2; ++hsel) { const int r = CH + hsel; const float acl = *(const LAS float*)(L + L_ACS + r * 512 + li); const float dsk = hsel ? dsk1 : dsk0;
#pragma unroll
        for (int kk = 0; kk < 4; ++kk) { float v[8];
#pragma unroll
            for (int hf = 0; hf < 2; ++hf) { const int ts = 2 * kk + hf; const f32x4 as = *(const LAS f32x4*)(L + L_ACS + r * 512 + ts * 64 + q16), ds = *(const LAS f32x4*)(L + L_DT + r * 512 + ts * 64 + q16);
#pragma unroll
                for (int j = 0; j < 4; ++j) { const int sc = 16 * ts + j; const float arg = fminf(acl - as[j], 0.f); const float cd = cbt[ts][j] * ds[j]; const float m = cd * __expf(arg);
                    v[4 * hf + j] = (sc < dq) ? m : ((sc == dq) ? (cd + dsk) : 0.f); } }
            mfrag[hsel][kk] = pack8(v); } }
    __builtin_amdgcn_sched_barrier(0);
#pragma unroll
    for (int hsel = 0; hsel < 2; ++hsel) { const float cd = *(const LAS float*)(L + L_EA + (CH + hsel) * 512 + 127 * 4);
#pragma unroll
        for (int ct = 0; ct < 6; ++ct) if ((((6 * CH + ct) >> 2) - CH) == hsel) { sacc[0][ct] = sacc[0][ct] * cd; sacc[1][ct] = sacc[1][ct] * cd; } }
#pragma unroll
    for (int kk = 0; kk < 4; ++kk) {
        bf16x8 btf[2];
#pragma unroll
        for (int nt2 = 0; nt2 < 2; ++nt2) btf[nt2] = tr_pair(L + L_B + kk * 8192 + tb[nt2], L + L_B + kk * 8192 + 4096 + tb[nt2]);
        f32x4 wl[2], wh[2];
#pragma unroll
        for (int hsel = 0; hsel < 2; ++hsel) { wl[hsel] = *(const LAS f32x4*)(L + L_W + (CH + hsel) * 512 + kk * 128 + q16); wh[hsel] = *(const LAS f32x4*)(L + L_W + (CH + hsel) * 512 + kk * 128 + 64 + q16); }
#pragma unroll
        for (int ct = 0; ct < 6; ++ct) { const int ctg = 6 * CH + ct, r = ctg >> 2, pt = ctg & 3, hsel = r - CH;
            const bf16x8 xf = tr_pair(L + L_X + r * 16384 + kk * 4096 + tx[pt], L + L_X + r * 16384 + kk * 4096 + 2048 + tx[pt]);
            yacc[ct] = MFMA16(mfrag[hsel][kk], xf, yacc[ct]);
            float xs[8];
#pragma unroll
            for (int e = 0; e < 4; ++e) { xs[e] = __uint_as_float((unsigned)(unsigned short)xf[e] << 16) * wl[hsel][e]; xs[4 + e] = __uint_as_float((unsigned)(unsigned short)xf[4 + e] << 16) * wh[hsel][e]; }
            const bf16x8 xsf = pack8(xs);
            sacc[0][ct] = MFMA16(btf[0], xsf, sacc[0][ct]); sacc[1][ct] = MFMA16(btf[1], xsf, sacc[1][ct]); }
        __builtin_amdgcn_sched_barrier(0);
    }
}

__device__ __forceinline__ void p4_ssd(const Frame& F, const Params& P) {
    LAS unsigned char* L = (LAS unsigned char*)F.lds;
    const bf16_t* XA = (const bf16_t*)(P.ws + WS_XA); const float* DTV = (const float*)(P.ws + WS_DTV); const float* ACS = (const float*)(P.ws + WS_ACS);
    const bf16_t* proj = (const bf16_t*)(P.ws + WS_PROJ); bf16_t* mix = (bf16_t*)(P.ws + WS_MIX); const float* norm_w = P.in[12]; const float* d_skip = P.in[11];
    const int lane = F.lane, lt = F.wave >> 1, ch = F.wave & 1;
    for (int u = F.vcu; u < 256; u += F.G) {
        const int b = u >> 3, g = (u >> 1) & 3, hl = u & 1;
        for (int idx = F.tid; idx < 49152 / 16; idx += NTHREADS) *(LAS u32x4*)(L + L_S + idx * 16) = (u32x4){0u, 0u, 0u, 0u};
        f32x4 sacc[2][6];
#pragma unroll
        for (int a = 0; a < 2; ++a)
#pragma unroll
            for (int c = 0; c < 6; ++c) sacc[a][c] = (f32x4){0.f, 0.f, 0.f, 0.f};
        const float dsk0 = d_skip[3 * g + ch], dsk1 = d_skip[3 * g + ch + 1];
        for (int ck = 0; ck < 16; ++ck) {
            const size_t tok0 = (size_t)b * SEQ + ck * 128;
            int tt = F.tid; OPAQUE(tt);
            { const bf16_t* xrow = XA + tok0 * 1792;
#pragma unroll
            for (int k = 0; k < 4; ++k) { const int idx = tt + NTHREADS * k, row = idx >> 4, chk = idx & 15; const u32x4 v = *(const u32x4*)(xrow + (unsigned)(row * 1792 + 768 + g * 128 + chk * 8));
                *(LAS u32x4*)(L + L_B + row * 256 + ((chk ^ swz16(row & 15)) << 4)) = v; }
#pragma unroll
            for (int k = 0; k < 2; ++k) { const int idx = tt + NTHREADS * k, row = idx >> 4, chk = idx & 15; const u32x4 v = *(const u32x4*)(xrow + (unsigned)((64 * hl + row) * 1792 + 1280 + g * 128 + chk * 8));
                *(LAS u32x4*)(L + L_C + row * 256 + ((chk ^ swz16(row & 15)) << 4)) = v; }
#pragma unroll
            for (int k = 0; k < 6; ++k) { const int idx = tt + NTHREADS * k, row = idx / 24, c24 = idx % 24, r = c24 >> 3, chk = c24 & 7; const u32x4 v = *(const u32x4*)(xrow + (unsigned)(row * 1792 + g * 192 + c24 * 8));
                *(LAS u32x4*)(L + L_X + r * 16384 + row * 128 + ((chk ^ swz8(row)) << 4)) = v; }
            if (tt < 384) { const int r = tt >> 7, l = tt & 127, hh = 3 * g + r; const float* dp = DTV + tok0 * 16; const float* ap = ACS + tok0 * 16; const float dt = dp[l * 16 + hh], ac = ap[l * 16 + hh], a127 = ap[127 * 16 + hh];
                *(LAS float*)(L + L_DT + (r * 128 + l) * 4) = dt; *(LAS float*)(L + L_ACS + (r * 128 + l) * 4) = ac; *(LAS float*)(L + L_W + (r * 128 + l) * 4) = dt * __expf(a127 - ac); *(LAS float*)(L + L_EA + (r * 128 + l) * 4) = __expf(ac); } }
            __syncthreads();
            f32x4 yacc[6];
            if (ch == 0) ssd_compute<0>(L, lt, hl, lane, sacc, yacc, dsk0, dsk1); else ssd_compute<1>(L, lt, hl, lane, sacc, yacc, dsk0, dsk1);
            __syncthreads();
            { int l2 = lane; OPAQUE(l2); const int i = l2 & 15, q = l2 >> 4;
#pragma unroll
            for (int nt2 = 0; nt2 < 2; ++nt2)
#pragma unroll
                for (int ct = 0; ct < 6; ++ct) { const f32x4 s = sacc[nt2][ct]; u32x2 pk; pk.x = cvt_pk_bf16(s[0], s[1]); pk.y = cvt_pk_bf16(s[2], s[3]);
                    const int row = 96 * ch + 16 * ct + i, n0 = 16 * (2 * lt + nt2) + 4 * q; *(LAS u32x2*)(L + L_S + row * 256 + (((n0 >> 3) ^ swz16(i)) << 4) + 8 * ((n0 >> 2) & 1)) = pk; }
#pragma unroll
            for (int ct = 0; ct < 6; ++ct)
#pragma unroll
                for (int j = 0; j < 4; ++j) *(LAS float*)(L + L_X + (16 * lt + 4 * q + j) * 768 + (96 * ch + 16 * ct + i) * 4) = yacc[ct][j]; }
            __syncthreads();
            { int t2 = F.tid; OPAQUE(t2); const int row = t2 >> 3, seg = t2 & 7; const int c0 = g * 192 + seg * 24;
                const bf16_t* zp = proj + (tok0 + 64 * hl) * NPROJ + (unsigned)(row * NPROJ + COL_Z + c0); float v[24]; float ss = 0.f;
#pragma unroll
                for (int k = 0; k < 3; ++k) { const u32x4 z = *(const u32x4*)(zp + 8 * k); const f32x4 y0 = *(const LAS f32x4*)(L + L_X + row * 768 + seg * 96 + k * 32), y1 = *(const LAS f32x4*)(L + L_X + row * 768 + seg * 96 + k * 32 + 16);
                    v[8 * k + 0] = y0[0] * siluf_(bf_lo(z.x)); v[8 * k + 1] = y0[1] * siluf_(bf_hi(z.x)); v[8 * k + 2] = y0[2] * siluf_(bf_lo(z.y)); v[8 * k + 3] = y0[3] * siluf_(bf_hi(z.y));
                    v[8 * k + 4] = y1[0] * siluf_(bf_lo(z.z)); v[8 * k + 5] = y1[1] * siluf_(bf_hi(z.z)); v[8 * k + 6] = y1[2] * siluf_(bf_lo(z.w)); v[8 * k + 7] = y1[3] * siluf_(bf_hi(z.w)); }
#pragma unroll
                for (int k = 0; k < 24; ++k) ss += v[k] * v[k];
                ss += __shfl_xor(ss, 1); ss += __shfl_xor(ss, 2); ss += __shfl_xor(ss, 4);
                const float rstd = rsqrtf(ss * (1.f / 192.f) + EPS);
                bf16_t* op = mix + (tok0 + 64 * hl) * DM + (unsigned)(row * DM + 256 + c0);
#pragma unroll
                for (int k = 0; k < 3; ++k) { const f32x4 n0 = *(const f32x4*)(norm_w + c0 + 8 * k), n1 = *(const f32x4*)(norm_w + c0 + 8 * k + 4); u32x4 pk;
                    pk.x = cvt_pk_bf16(v[8 * k] * rstd * n0[0], v[8 * k + 1] * rstd * n0[1]); pk.y = cvt_pk_bf16(v[8 * k + 2] * rstd * n0[2], v[8 * k + 3] * rstd * n0[3]);
                    pk.z = cvt_pk_bf16(v[8 * k + 4] * rstd * n1[0], v[8 * k + 5] * rstd * n1[1]); pk.w = cvt_pk_bf16(v[8 * k + 6] * rstd * n1[2], v[8 * k + 7] * rstd * n1[3]);
                    *(u32x4*)(op + 8 * k) = pk; } }
            __syncthreads();
        }
    }
    for (int row = F.gw; row < T; row += F.NGW) {
        const int win = 2 << (F.lane >> 4), pos = row & (SEQ - 1); const int cnt = (pos + 1) < win ? (pos + 1) : win;
        const bf16_t* up = proj + (size_t)row * NPROJ + 4 * F.lane;
        float s0 = 0.f, s1 = 0.f, s2 = 0.f, s3 = 0.f, c0 = 0.f, c1 = 0.f, c2 = 0.f, c3 = 0.f;
        for (int j = 0; j < cnt; ++j) { const u32x2 w = *(const u32x2*)(up - (size_t)j * NPROJ); const float e0 = bf_lo(w.x), e1 = bf_hi(w.x), e2 = bf_lo(w.y), e3 = bf_hi(w.y);
            if (j == 0) { c0 = e0; c1 = e1; c2 = e2; c3 = e3; } s0 += e0; s1 += e1; s2 += e2; s3 += e3; }
        const float inv = 1.0f / (float)cnt; u32x2 w; w.x = cvt_pk_bf16(s0 * inv - c0, s1 * inv - c1); w.y = cvt_pk_bf16(s2 * inv - c2, s3 * inv - c3);
        *(u32x2*)(mix + (size_t)row * DM + 4 * F.lane) = w;
    }
}

constexpr int R_WH = 0, R_WL = 73728, R_SC = 147456, R_SH = R_SC + 4096, R_CNT = R_SH + 4096, R_LG = 0;
__device__ __forceinline__ void p5_route(const Frame& F, const Params& P) {
    LAS unsigned char* L = (LAS unsigned char*)F.lds;
    const float* x1 = (const float*)(P.ws + WS_X1); const float* mod = (const float*)(P.ws + WS_MOD); bf16_t* H = (bf16_t*)(P.ws + WS_H); const float* ss16 = (const float*)(P.ws + WS_SS16);
    const bf16_t* WRH = (const bf16_t*)(P.ws + WS_WR); const bf16_t* WRL = (const bf16_t*)(P.ws + WS_WR + 131072);
    float* gates = (float*)(P.ws + WS_GATE); unsigned* list = (unsigned*)(P.ws + WS_LIST); unsigned* gcount = (unsigned*)(P.ws + WS_CTL) + CW_GCOUNT;
    const float* b_group = P.in[15]; const float* b_router = P.in[17];
    LAS unsigned* lcount = (LAS unsigned*)(L + R_CNT);
    LAS unsigned* lbase = lcount + 32;
    LAS unsigned* tinfo = lcount + 64;
    LAS float* twt = (LAS float*)(tinfo + 256 * 4);
    const int lane = F.lane, i = lane & 15, q = lane >> 4;
    for (int rb = F.vcu; rb < T / 256; rb += F.G) {
        const int b = rb >> 3;
        for (int idx = F.tid; idx < 36 * 128; idx += NTHREADS) { const int j = idx >> 7, c = idx & 127; const int dst = j * 2048 + ((c ^ swz16(j & 15)) << 4);
            *(LAS u32x4*)(L + R_WH + dst) = *(const u32x4*)(WRH + (size_t)j * 1024 + c * 8); *(LAS u32x4*)(L + R_WL + dst) = *(const u32x4*)(WRL + (size_t)j * 1024 + c * 8); }
        for (int idx = F.tid; idx < 256; idx += NTHREADS) { const f32x4 sc = *(const f32x4*)(mod + (size_t)b * 6144 + 4 * 1024 + idx * 4), sh = *(const f32x4*)(mod + (size_t)b * 6144 + 3 * 1024 + idx * 4);
            *(LAS f32x4*)(L + R_SC + idx * 16) = sc + 1.0f; *(LAS f32x4*)(L + R_SH + idx * 16) = sh; }
        if (F.tid < 32) lcount[F.tid] = 0u;
        __syncthreads();
        const int rowA = rb * 256 + F.wave * 32 + i;
        float rstd[2];
#pragma unroll
        for (int rt = 0; rt < 2; ++rt) { const f32x4* sp = (const f32x4*)(ss16 + (size_t)(rowA + 16 * rt) * 16); const f32x4 a = sp[0], c = sp[1], d = sp[2], e = sp[3];
            const float ss = ((a[0] + a[1]) + (a[2] + a[3])) + ((c[0] + c[1]) + (c[2] + c[3])) + ((d[0] + d[1]) + (d[2] + d[3])) + ((e[0] + e[1]) + (e[2] + e[3])); rstd[rt] = rsqrtf(ss * (1.f / DM) + EPS); }
        f32x4 acc[2][3];
#pragma unroll
        for (int rt = 0; rt < 2; ++rt)
#pragma unroll
            for (int ct = 0; ct < 3; ++ct) acc[rt][ct] = (f32x4){0.f, 0.f, 0.f, 0.f};
        int wrow[3];
#pragma unroll
        for (int ct = 0; ct < 3; ++ct) { const int j = (16 * ct + i) < 36 ? (16 * ct + i) : 35; wrow[ct] = j * 2048; }
        const int fsw = swz16(i);
        const int fswc = swz16(35 & 15);
#pragma unroll 2
        for (int s = 0; s < 32; ++s) {
            bf16x8 wh[3], wl[3];
#pragma unroll
            for (int ct = 0; ct < 3; ++ct) { const int sw = ((16 * ct + i) < 36) ? fsw : fswc; const int o = wrow[ct] + ((((4 * s + q) & ~15) | (((4 * s + q) & 15) ^ sw)) << 4);
                wh[ct] = *(const LAS bf16x8*)(L + R_WH + o); wl[ct] = *(const LAS bf16x8*)(L + R_WL + o); }
            const f32x4 sc0 = *(const LAS f32x4*)(L + R_SC + (32 * s + 8 * q) * 4), sc1 = *(const LAS f32x4*)(L + R_SC + (32 * s + 8 * q + 4) * 4);
            const f32x4 sh0 = *(const LAS f32x4*)(L + R_SH + (32 * s + 8 * q) * 4), sh1 = *(const LAS f32x4*)(L + R_SH + (32 * s + 8 * q + 4) * 4);
#pragma unroll
            for (int rt = 0; rt < 2; ++rt) { const size_t off = (size_t)(rowA + 16 * rt) * DM + 32 * s + 8 * q;
                const f32x4 x0 = *(const f32x4*)(x1 + off), x1v = *(const f32x4*)(x1 + off + 4);
                const f32x4 h0 = x0 * rstd[rt] * sc0 + sh0, h1 = x1v * rstd[rt] * sc1 + sh1;
                u32x4 hi; hi.x = cvt_pk_bf16(h0[0], h0[1]); hi.y = cvt_pk_bf16(h0[2], h0[3]); hi.z = cvt_pk_bf16(h1[0], h1[1]); hi.w = cvt_pk_bf16(h1[2], h1[3]);
                *(u32x4*)(H + off) = hi;
                u32x4 lo; lo.x = cvt_pk_bf16(h0[0] - bf_lo(hi.x), h0[1] - bf_hi(hi.x)); lo.y = cvt_pk_bf16(h0[2] - bf_lo(hi.y), h0[3] - bf_hi(hi.y));
                lo.z = cvt_pk_bf16(h1[0] - bf_lo(hi.z), h1[1] - bf_hi(hi.z)); lo.w = cvt_pk_bf16(h1[2] - bf_lo(hi.w), h1[3] - bf_hi(hi.w));
                const bf16x8 ah = __builtin_bit_cast(bf16x8, hi), al = __builtin_bit_cast(bf16x8, lo);
#pragma unroll
                for (int ct = 0; ct < 3; ++ct) { acc[rt][ct] = MFMA16(ah, wh[ct], acc[rt][ct]); acc[rt][ct] = MFMA16(al, wh[ct], acc[rt][ct]); acc[rt][ct] = MFMA16(ah, wl[ct], acc[rt][ct]); } }
        }
        __syncthreads();
        LAS float* lg = (LAS float*)(L + R_LG);
#pragma unroll
        for (int rt = 0; rt < 2; ++rt)
#pragma unroll
            for (int ct = 0; ct < 3; ++ct)
#pragma unroll
                for (int j = 0; j < 4; ++j) { const int col = 16 * ct + i; if (col < 36) lg[(F.wave * 32 + 16 * rt + 4 * q + j) * 37 + col] = acc[rt][ct][j]; }
        __syncthreads();
        if (F.tid < 256) {
            const int rl = F.tid; const LAS float* lr = lg + rl * 37;
            float gl[4];
#pragma unroll
            for (int k = 0; k < 4; ++k) gl[k] = lr[k] + b_group[k];
            int gi = 0; float gm = gl[0];
#pragma unroll
            for (int k = 1; k < 4; ++k) if (gl[k] > gm) { gm = gl[k]; gi = k; }
            float den = 0.f;
#pragma unroll
            for (int k = 0; k < 4; ++k) den += __expf(gl[k] - gm);
            const float pg = 1.0f / den;
            float el[8];
#pragma unroll
            for (int k = 0; k < 8; ++k) el[k] = lr[4 + gi * 8 + k] + b_router[gi * 8 + k];
            int i0 = 0; float v0 = el[0];
#pragma unroll
            for (int k = 1; k < 8; ++k) if (el[k] > v0) { v0 = el[k]; i0 = k; }
            int i1 = -1; float v1 = -3.0e38f;
#pragma unroll
            for (int k = 0; k < 8; ++k) if (k != i0 && el[k] > v1) { v1 = el[k]; i1 = k; }
            const float ex = __expf(v1 - v0); const float w0 = pg / (1.0f + ex), w1 = pg * ex / (1.0f + ex);
            const int e0 = gi * 8 + i0, e1 = gi * 8 + i1; const unsigned r0 = atomicAdd((unsigned*)&lcount[e0], 1u), r1 = atomicAdd((unsigned*)&lcount[e1], 1u);
            tinfo[rl * 4 + 0] = (unsigned)e0 | ((unsigned)e1 << 8); tinfo[rl * 4 + 1] = r0; tinfo[rl * 4 + 2] = r1; twt[rl * 2] = w0; twt[rl * 2 + 1] = w1;
        }
        __syncthreads();
        if (F.tid < 32) lbase[F.tid] = atomicAdd(&gcount[64 * F.tid], lcount[F.tid]);
        __syncthreads();
        if (F.tid < 256) { const int rl = F.tid, row = rb * 256 + rl; const unsigned ee = tinfo[rl * 4], e0 = ee & 255u, e1 = ee >> 8;
            list[(size_t)e0 * ECAP + lbase[e0] + tinfo[rl * 4 + 1]] = (unsigned)row * 2u; list[(size_t)e1 * ECAP + lbase[e1] + tinfo[rl * 4 + 2]] = (unsigned)row * 2u + 1u;
            gates[row * 2] = twt[rl * 2]; gates[row * 2 + 1] = twt[rl * 2 + 1]; }
        __syncthreads();
    }
}

__device__ __forceinline__ void p8_final(const Frame& F, const Params& P) {
    const float* x1 = (const float*)(P.ws + WS_X1); const bf16_t* Y0 = (const bf16_t*)(P.ws + WS_Y0); const bf16_t* Y1 = (const bf16_t*)(P.ws + WS_Y1); const float* fw = P.in[20];
    f32x4 wv[4];
#pragma unroll
    for (int j = 0; j < 4; ++j) wv[j] = ((const f32x4*)fw)[F.lane + 64 * j];
    for (int row = F.gw; row < T; row += F.NGW) {
        const f32x4* xr = (const f32x4*)(x1 + (size_t)row * DM) + F.lane; const u32x2* y0 = (const u32x2*)(Y0 + (size_t)row * DM) + F.lane; const u32x2* y1 = (const u32x2*)(Y1 + (size_t)row * DM) + F.lane;
        f32x4 v[4]; float s = 0.f;
#pragma unroll
        for (int j = 0; j < 4; ++j) { const u32x2 a = y0[64 * j], c = y1[64 * j]; v[j] = xr[64 * j];
            v[j][0] += bf_lo(a.x) + bf_lo(c.x); v[j][1] += bf_hi(a.x) + bf_hi(c.x); v[j][2] += bf_lo(a.y) + bf_lo(c.y); v[j][3] += bf_hi(a.y) + bf_hi(c.y);
            s += (v[j][0] * v[j][0] + v[j][1] * v[j][1]) + (v[j][2] * v[j][2] + v[j][3] * v[j][3]); }
        const float rstd = rsqrtf(wave_sum(s) * (1.f / DM) + EPS);
        f32x4* o = (f32x4*)(P.out + (size_t)row * DM) + F.lane;
#pragma unroll
        for (int j = 0; j < 4; ++j) o[64 * j] = v[j] * rstd * wv[j];
    }
}

__device__ __forceinline__ void moe_prefix(const Frame& F, const Params& P, int* pref) {
    const unsigned* gcount = (const unsigned*)(P.ws + WS_CTL) + CW_GCOUNT;
    __syncthreads();
    if (F.tid == 0) { int acc = 0; for (int e = 0; e < 32; ++e) { const int c = (int)__hip_atomic_load(gcount + 64 * e, __ATOMIC_RELAXED, __HIP_MEMORY_SCOPE_AGENT); pref[e] = acc; pref[33 + e] = c; acc += (c + 255) >> 8; } pref[32] = acc; }
    __syncthreads();
}

#define XB_TMO      128
#define XB_XCNT(j)  (256  + 64 * (j))
#define XB_XSUB(j)  (1280 + 64 * (j))
#define XB_XGEN(j)  (2304 + 64 * (j))
#define XB_TOP      3328
#define XB_TOPGEN   3392
#define XCD_BAR_WORDS 3456
#define XB_SPIN_CAP (1u << 22)
__device__ __forceinline__ unsigned xb_ld(unsigned* p)              { return __hip_atomic_load(p, __ATOMIC_RELAXED, __HIP_MEMORY_SCOPE_AGENT); }
__device__ __forceinline__ unsigned xb_add(unsigned* p, unsigned v) { return __hip_atomic_fetch_add(p, v, __ATOMIC_RELAXED, __HIP_MEMORY_SCOPE_AGENT); }
__device__ __forceinline__ unsigned xb_xcc_id() { return (unsigned)__builtin_amdgcn_s_getreg((3 << 11) | 20) & 0xFu; }
#define XB_SPIN(cond, bar) do { unsigned _sp = 0; while (cond) { __builtin_amdgcn_s_sleep(1); \
    if ((++_sp & 255u) == 0u) { if (xb_ld(&(bar)[XB_TMO])) break; if (_sp > XB_SPIN_CAP) { atomicAdd(&(bar)[XB_TMO], 1u); break; } } } } while (0)
struct XcdBarrier { unsigned* bar; unsigned x; volatile LAS unsigned* st; };
__device__ __forceinline__ XcdBarrier xcd_barrier_post(unsigned* bar, volatile LAS unsigned* st) {
    XcdBarrier b; b.bar = bar; b.x = xb_xcc_id(); b.st = st;
    if (threadIdx.x == 0) (void)xb_add(&bar[XB_XCNT(b.x)], 1u);
    return b;
}
__device__ __forceinline__ void xcd_barrier_complete(unsigned* bar, unsigned x, unsigned& nloc, unsigned& nx) {
    const unsigned G = gridDim.x * gridDim.y * gridDim.z;
    unsigned sum, cnt, mine, sp = 0u;
    for (;;) {
        sum = 0u; cnt = 0u; mine = 0u;
#pragma unroll
        for (unsigned j = 0; j < 16; ++j) { const unsigned c = xb_ld(&bar[XB_XCNT(j)]); sum += c; cnt += (c > 0u) ? 1u : 0u; mine = (j == x) ? c : mine; }
        if (sum == G) break;
        __builtin_amdgcn_s_sleep(1);
        if ((++sp & 255u) == 0u) { if (xb_ld(&bar[XB_TMO])) break; if (sp > XB_SPIN_CAP) { atomicAdd(&bar[XB_TMO], 1u); break; } }
    }
    nloc = mine > 0u ? mine : 1u; nx = cnt > 0u ? cnt : 1u;
}
__device__ __forceinline__ void xcd_barrier(const XcdBarrier& b) {
    asm volatile("s_waitcnt vmcnt(0)" ::: "memory");
    __syncthreads();
    if (threadIdx.x == 0) {
        unsigned* bar = b.bar;
        __builtin_amdgcn_s_waitcnt(0);
        unsigned nloc = b.st[0], nx = b.st[1];
        if (nloc == 0u) { xcd_barrier_complete(bar, b.x, nloc, nx); b.st[0] = nloc; b.st[1] = nx; }
        const unsigned old = xb_add(&bar[XB_XSUB(b.x)], 1u);
        const unsigned gen = old / nloc;
        if (old + 1u == (gen + 1u) * nloc) {
            __builtin_amdgcn_fence(__ATOMIC_RELEASE, "agent");
            asm volatile("s_waitcnt vmcnt(0)" ::: "memory");
            const unsigned og = xb_add(&bar[XB_TOP], 1u);
            const unsigned tg = og / nx;
            if (og + 1u == (tg + 1u) * nx) xb_add(&bar[XB_TOPGEN], 1u);
            else XB_SPIN(xb_ld(&bar[XB_TOPGEN]) == tg, bar);
            __builtin_amdgcn_fence(__ATOMIC_ACQUIRE, "agent");
            xb_add(&bar[XB_XGEN(b.x)], 1u);
            asm volatile("s_waitcnt vmcnt(0)" ::: "memory");
        } else {
            XB_SPIN(xb_ld(&bar[XB_XGEN(b.x)]) == gen, bar);
            __builtin_amdgcn_fence(__ATOMIC_ACQUIRE, "agent");
            asm volatile("s_waitcnt vmcnt(0)" ::: "memory");
        }
    }
    __syncthreads();
}

__global__ void __launch_bounds__(NTHREADS, 2) fwd_kernel(Params P) {
    extern __shared__ __attribute__((aligned(16))) unsigned char lds[];
    Frame F; F.lds = lds; F.tid = threadIdx.x; F.lane = F.tid & 63; F.wave = __builtin_amdgcn_readfirstlane(F.tid >> 6);
    F.G = gridDim.x; { const int bx = blockIdx.x; F.vcu = (F.G % 8 == 0) ? (bx % 8) * (F.G / 8) + bx / 8 : bx; }
    F.gw = F.vcu * NWAVES + F.wave; F.NGW = F.G * NWAVES;
    unsigned char* ws = P.ws;
    const int lo = P.ph_lo, hi = P.ph_hi;
    volatile LAS unsigned* bst = (volatile LAS unsigned*)((LAS unsigned char*)lds + (LDS_BYTES - 64));
    if (F.tid < 2) bst[F.tid] = 0u;
    __syncthreads();
    const XcdBarrier xbar = xcd_barrier_post((unsigned*)(ws + WS_CTL) + CW_BAR, bst);
#define IN(k) (lo <= (k) && (k) < hi)
#define GRID_BAR() xcd_barrier(xbar)
#define GRID_BAR_CG() do { __syncthreads(); cooperative_groups::this_grid().sync(); } while (0)
    if (IN(0)) p0_prep(F, P);
    if (IN(0) && IN(1)) GRID_BAR_CG();
    if (IN(1)) p1_modulate(F, P);
    if (IN(1) && IN(2)) GRID_BAR();
    if (IN(2)) { pg8::DenseSched S; S.init(ws + WS_H, ws + WS_WIN, T, NPROJ, 1024, F.G, (int)blockIdx.x); pg8::EpiProj E{(bf16_t*)(ws + WS_PROJ), (float*)(ws + WS_DTRAW)}; pg8::gemm_phase(( LAS unsigned char*)lds, S, E); }
    if (IN(2) && IN(3)) GRID_BAR();
    if (IN(3)) p3_conv(F, P);
    if (IN(3) && IN(4)) GRID_BAR();
    if (IN(4)) p4_ssd(F, P);
    if (IN(4) && IN(5)) GRID_BAR();
    if (IN(5)) { pg8::DenseSched S; S.init(ws + WS_MIX, ws + WS_WOUT, T, 1024, 1024, F.G, (int)blockIdx.x); pg8::EpiX1 E{P.in[0], (const float*)(ws + WS_MOD), (float*)(ws + WS_X1), (float*)(ws + WS_SS16)}; pg8::gemm_phase((LAS unsigned char*)lds, S, E); }
    if (IN(5) && IN(6)) GRID_BAR();
    if (IN(6)) p5_route(F, P);
    if (IN(6) && IN(7)) GRID_BAR();
    if (IN(7)) { int* pref = (int*)(lds + MISC_OFF); moe_prefix(F, P, pref);
        pg8::MoeSched<true> S; S.A = (const char*)(ws + WS_H); S.Bt = (const char*)(ws + WS_W13); S.K = 1024; S.nN = 4; S.G = F.G; S.c = F.vcu; S.pref = (const LAS int*)pref; S.list = (const unsigned*)(ws + WS_LIST);
        pg8::EpiAct E{(bf16_t*)(ws + WS_ACT)}; pg8::gemm_phase((LAS unsigned char*)lds, S, E); }
    if (IN(7) && IN(8)) GRID_BAR();
    if (IN(8)) { int* pref = (int*)(lds + MISC_OFF); moe_prefix(F, P, pref);
        pg8::MoeSched<false> S; S.A = (const char*)(ws + WS_ACT); S.Bt = (const char*)(ws + WS_W2); S.K = 512; S.nN = 4; S.G = F.G; S.c = F.vcu; S.pref = (const LAS int*)pref; S.list = (const unsigned*)(ws + WS_LIST);
        pg8::EpiY E{(const unsigned*)(ws + WS_LIST), (const float*)(ws + WS_GATE), (const float*)(ws + WS_MOD), (bf16_t*)(ws + WS_Y0), (bf16_t*)(ws + WS_Y1)}; pg8::gemm_phase((LAS unsigned char*)lds, S, E); }
    if (IN(8) && IN(9)) GRID_BAR();
    if (IN(9)) p8_final(F, P);
#undef IN
#undef GRID_BAR
#undef GRID_BAR_CG
}

extern "C" void kernel_launch(void* const* d_in, const int* in_sizes, int n_in, void* d_out, int out_size, void* d_ws, size_t ws_size, hipStream_t stream) {
    static int grid = 0;
    if (grid == 0) {
        if (n_in != 21 || out_size != T * DM || ws_size < WS_END) { fprintf(stderr, "kernel_launch: unexpected sizes n_in %d out %d ws %zu\n", n_in, out_size, ws_size); grid = -1; return; }
        int dev = 0, cus = 0;
        if (hipGetDevice(&dev) != hipSuccess || hipDeviceGetAttribute(&cus, hipDeviceAttributeMultiprocessorCount, dev) != hipSuccess) { grid = -1; return; }
        if (hipFuncSetAttribute((const void*)fwd_kernel, hipFuncAttributeMaxDynamicSharedMemorySize, LDS_BYTES) != hipSuccess) { fprintf(stderr, "kernel_launch: hipFuncSetAttribute failed\n"); grid = -1; return; }
        int per_cu = 0;
        if (hipOccupancyMaxActiveBlocksPerMultiprocessor(&per_cu, (const void*)fwd_kernel, NTHREADS, LDS_BYTES) != hipSuccess || per_cu < 1) { fprintf(stderr, "kernel_launch: occupancy query says %d blocks per CU\n", per_cu); (void)hipGetLastError(); per_cu = 1; }
        grid = cus;
    }
    if (grid < 0) return;
    (void)hipMemsetAsync((char*)d_ws + WS_CTL, 0, CTL_BYTES, stream);
    Params p{};
    for (int i = 0; i < 21; ++i) p.in[i] = (const float*)d_in[i];
    p.out = (float*)d_out; p.ws = (unsigned char*)d_ws;
    p.ph_lo = 0; p.ph_hi = 10;
    void* args[] = {&p};
    hipError_t e = hipLaunchCooperativeKernel((const void*)fwd_kernel, dim3(grid), dim3(NTHREADS), args, LDS_BYTES, stream);
    if (e != hipSuccess) fprintf(stderr, "kernel_launch: cooperative launch failed: %s (grid %d)\n", hipGetErrorString(e), grid);
}
```

```cpp
#include <hip/hip_runtime.h>
#include <hip/hip_cooperative_groups.h>
#include <cstdio>
#include <cstdint>

#ifndef MK_ONE_LAUNCH
#define MK_ONE_LAUNCH 0
#endif

#define LAS __attribute__((address_space(3)))
typedef unsigned short bf16_t;
typedef short bf16x8 __attribute__((ext_vector_type(8)));
typedef float f32x4 __attribute__((ext_vector_type(4)));
typedef float f32x2 __attribute__((ext_vector_type(2)));
typedef unsigned u32x4 __attribute__((ext_vector_type(4)));
typedef unsigned u32x2 __attribute__((ext_vector_type(2)));

constexpr int BATCH = 32, SEQ = 2048, DM = 1024, T = BATCH * SEQ;
constexpr int NPROJ = 3072, NPROJ_REAL = 2828;
constexpr int COL_Z = 256, COL_XS = 1024, COL_B = 1792, COL_C = 2304, COL_DT = 2816;
constexpr int NEXP = 32, FF = 512, ECAP = 65536;
constexpr int NWAVES = 8, NTHREADS = 512;
constexpr float EPS = 1e-6f;

constexpr size_t MiB = 1u << 20;
constexpr size_t WS_CTL = 0, CTL_BYTES = 1 * MiB;
constexpr size_t WS_MOD = 1 * MiB;
constexpr size_t WS_WR = 2 * MiB;
constexpr size_t WS_SS16 = 4 * MiB;
constexpr size_t WS_SGATE = 120 * MiB;
constexpr size_t WS_DTRAW = 4 * MiB;
constexpr size_t WS_LIST = 8 * MiB;
constexpr size_t WS_WIN = 16 * MiB;
constexpr size_t WS_WOUT = 22 * MiB;
constexpr size_t WS_W13 = 24 * MiB;
constexpr size_t WS_W2 = 88 * MiB;
constexpr size_t WS_H = 128 * MiB;
constexpr size_t WS_PROJ = 256 * MiB;
constexpr size_t WS_MIX = 640 * MiB;
constexpr size_t WS_X1 = 768 * MiB;
constexpr size_t WS_END = 1024 * MiB;
constexpr size_t WS_XA = WS_X1;
constexpr size_t WS_DTV = 8 * MiB, WS_ACS = 12 * MiB;
constexpr size_t WS_Y0 = 256 * MiB, WS_Y1 = 384 * MiB;
constexpr size_t WS_ACT = 512 * MiB;
constexpr int CW_GCOUNT = 256;
constexpr int CW_BAR = 4096;

constexpr int LDS_BYTES = 163840;
constexpr int MISC_OFF = 147456;

struct Params {
    const float* in[21];
    float* out;
    unsigned char* ws;
    int ph_lo, ph_hi;
};

__device__ __forceinline__ unsigned cvt_pk_bf16(float lo, float hi) { unsigned r; asm volatile("v_cvt_pk_bf16_f32 %0, %1, %2" : "=v"(r) : "v"(lo), "v"(hi)); return r; }
__device__ __forceinline__ float bf_lo(unsigned u) { return __uint_as_float(u << 16); }
__device__ __forceinline__ float bf_hi(unsigned u) { return __uint_as_float(u & 0xffff0000u); }
__device__ __forceinline__ float wave_sum(float v) {
#pragma unroll
    for (int o = 1; o < 64; o <<= 1) v += __shfl_xor(v, o);
    return v;
}
__device__ __forceinline__ float sigmoidf_(float v) { return __builtin_amdgcn_rcpf(1.0f + __expf(-v)); }
__device__ __forceinline__ float siluf_(float v) { return v * sigmoidf_(v); }

namespace pg8 {
constexpr int BM = 256, BK = 64, HALF = 128, HTB = HALF * BK * 2, STAGE_BYTES = 8 * HTB, NXCD = 8, WGM = 8;
__host__ __device__ __forceinline__ int lds_byte(int r, int c) { const int st = (r >> 4) * 2 + (c >> 5), rr = r & 15, cc = c & 31, ob = rr * 64 + cc * 2; return st * 1024 + (ob ^ (((ob >> 9) & 1) << 5)); }
__host__ __device__ __forceinline__ void stage_rc(int b, int& R, int& C) { const int st = b / 1024, sb = b % 1024, swz = sb ^ (((sb >> 9) & 1) << 5); R = (st >> 1) * 16 + swz / 64; C = (st & 1) * 32 + (swz % 64) / 2; }
__host__ __device__ __forceinline__ int perm32(int rho) { const int n = rho >> 4, i = rho & 15; return 8 * (i >> 2) + 4 * n + (i & 3); }

struct Unit { int pm, pn, e, cnt, slot0; };

struct DenseSched {
    const char* A; const char* Bt; int K;
    int nM, nN, nwg, G, c;
    __device__ void init(const void* A_, const void* Bt_, int M, int N, int K_, int G_, int c_) { A = (const char*)A_; Bt = (const char*)Bt_; K = K_; nM = M / BM; nN = N / BM; nwg = nM * nN; G = G_; c = c_; }
    __device__ __forceinline__ bool next(int i, Unit& u) const {
        const long L = (long)i * G + c; if (L >= nwg) return false;
        int wgid = (int)L; { const int q = nwg / NXCD, r = nwg % NXCD, xcd = wgid % NXCD, off = wgid / NXCD; wgid = (xcd < r ? xcd * (q + 1) : r * (q + 1) + (xcd - r) * q) + off; }
        const int nig = WGM * nN, gid = wgid / nig, fm = gid * WGM, gsz = (nM - fm) < WGM ? (nM - fm) : WGM;
        u.pm = fm + ((wgid % nig) % gsz); u.pn = (wgid % nig) / gsz; u.e = 0; u.cnt = 256; u.slot0 = 0; return true;
    }
    __device__ __forceinline__ const char* a_base() const { return A; }
    __device__ __forceinline__ void a_raw(const Unit& u, const int (&R)[2], unsigned (&raw)[2][2]) const {
#pragma unroll
        for (int h = 0; h < 2; ++h)
#pragma unroll
            for (int i = 0; i < 2; ++i) raw[h][i] = (unsigned)(u.pm * BM + h * HALF + R[i]);
    }
    __device__ __forceinline__ void a_fin(const int (&C)[2], const unsigned (&raw)[2][2], unsigned (&o)[2][2]) const {
#pragma unroll
        for (int h = 0; h < 2; ++h)
#pragma unroll
            for (int i = 0; i < 2; ++i) o[h][i] = (raw[h][i] * (unsigned)K + (unsigned)C[i]) * 2u;
    }
    __device__ __forceinline__ const char* b_ptr(const Unit& u) const { return Bt + (size_t)u.pn * BM * K * 2; }
};

template <bool GATHER>
struct MoeSched {
    const char* A; const char* Bt; int K, nN, G, c;
    const LAS int* pref;
    const unsigned* list;
    __device__ __forceinline__ bool next(int i, Unit& u) const {
        const long L = (long)i * G + c; const int tot = pref[32] * nN; if (L >= tot) return false;
        const int ti = (int)L / nN; u.pn = (int)L % nN;
        int e = 0;
#pragma unroll 1
        for (int j = 1; j < 32; ++j) if (pref[j] <= ti) e = j;
        const int mt = ti - pref[e]; u.pm = ti; u.e = e; u.slot0 = mt * 256; const int rem = pref[33 + e] - mt * 256; u.cnt = rem < 256 ? rem : 256; return true;
    }
    __device__ __forceinline__ const char* a_base() const { return A; }
    __device__ __forceinline__ void a_raw(const Unit& u, const int (&R)[2], unsigned (&raw)[2][2]) const {
#pragma unroll
        for (int h = 0; h < 2; ++h)
#pragma unroll
            for (int i = 0; i < 2; ++i) {
                const int r = h * HALF + R[i];
                if (GATHER) { unsigned ent = 0; if (r < u.cnt) ent = list[(size_t)u.e * ECAP + u.slot0 + r]; raw[h][i] = ent >> 1; }
                else raw[h][i] = (unsigned)(u.pm * BM + r);
            }
    }
    __device__ __forceinline__ void a_fin(const int (&C)[2], const unsigned (&raw)[2][2], unsigned (&o)[2][2]) const {
#pragma unroll
        for (int h = 0; h < 2; ++h)
#pragma unroll
            for (int i = 0; i < 2; ++i) o[h][i] = (raw[h][i] * (unsigned)K + (unsigned)C[i]) * 2u;
    }
    __device__ __forceinline__ const char* b_ptr(const Unit& u) const { return Bt + ((size_t)u.e * (nN * BM) + (size_t)u.pn * BM) * K * 2; }
};

template <class Epi, class Sched>
__device__ __forceinline__ void gemm_phase(LAS unsigned char* lds, const Sched& S, const Epi& E) {
    const int tid = threadIdx.x, wid = __builtin_amdgcn_readfirstlane(tid >> 6), lane = tid & 63, wr = wid >> 2, wc = wid & 3, fr = lane & 15, fq = lane >> 4;
    const int K = S.K, nt = K / BK;
    int sR[2], sC[2]; unsigned voffB[2];
#pragma unroll
    for (int i = 0; i < 2; ++i) { int R, C; stage_rc(tid * 16 + i * 8192, R, C); sR[i] = R; sC[i] = C; const int Rb = Epi::PERM ? ((R & ~31) + perm32(R & 31)) : R; voffB[i] = (unsigned)(Rb * K + C) * 2u; }
    const size_t kstep = (size_t)(BK * 2);
    const size_t hstep = (size_t)HALF * K * 2;
    const unsigned ldsw = (unsigned)wid * 1024u;
    const int aoff = lds_byte(wr * 64 + fr, fq * 8), boff = lds_byte(wc * 32 + fr, fq * 8);
#define PG8_SA(b, h) (((b) * 2 + (h)) * HTB)
#define PG8_SB(b, h) ((4 + (b) * 2 + (h)) * HTB)
#define PG8_STAGE(bufoff, gbase, voff) do { _Pragma("unroll") for (int _i = 0; _i < 2; ++_i) \
        __builtin_amdgcn_global_load_lds((const unsigned*)((const char*)(gbase) + (voff)[_i]), (LAS unsigned*)(lds + (bufoff) + ldsw + _i * 8192), 16, 0, 0); } while (0)
#define PG8_LDA(dst, b, h) do { _Pragma("unroll") for (int m = 0; m < 4; ++m) _Pragma("unroll") for (int k = 0; k < 2; ++k) dst[m][k] = *(const LAS bf16x8*)(lds + PG8_SA(b, h) + aoff + m * 2048 + k * 1024); } while (0)
#define PG8_LDB(dst, b, h) do { _Pragma("unroll") for (int n = 0; n < 2; ++n) _Pragma("unroll") for (int k = 0; k < 2; ++k) dst[n][k] = *(const LAS bf16x8*)(lds + PG8_SB(b, h) + boff + n * 2048 + k * 1024); } while (0)
#define PG8_MMA(ai, bj, At, Bt) do { __builtin_amdgcn_s_setprio(1); _Pragma("unroll") for (int m = 0; m < 4; ++m) _Pragma("unroll") for (int n = 0; n < 2; ++n) _Pragma("unroll") for (int k = 0; k < 2; ++k) \
        acc[ai][bj][m][n] = __builtin_amdgcn_mfma_f32_16x16x32_bf16(Bt[n][k], At[m][k], acc[ai][bj][m][n], 0, 0, 0); __builtin_amdgcn_s_setprio(0); } while (0)
#define PG8_WAIT_V(n) asm volatile("s_waitcnt vmcnt(" #n ")" ::: "memory")
#define PG8_WAIT_L(n) asm volatile("s_waitcnt lgkmcnt(" #n ")" ::: "memory")
#define PG8_BAR __builtin_amdgcn_s_barrier()
#define PG8_SCHED __builtin_amdgcn_sched_barrier(0)
    Unit cur, nxt; int ui = 0;
    if (!S.next(0, cur)) return;
    f32x4 acc[2][2][4][2];
#pragma unroll
    for (int a = 0; a < 2; ++a)
#pragma unroll
        for (int b = 0; b < 2; ++b)
#pragma unroll
            for (int m = 0; m < 4; ++m)
#pragma unroll
                for (int n = 0; n < 2; ++n) acc[a][b][m][n] = (f32x4){0.f, 0.f, 0.f, 0.f};
    bf16x8 At[4][2], B0[2][2], B1[2][2];
    unsigned aoC[2][2], aoN[2][2], rawN[2][2];
    S.a_raw(cur, sR, rawN); S.a_fin(sC, rawN, aoC);
    const char* const Ab = S.a_base();
    const char* cB = S.b_ptr(cur);
    PG8_STAGE(PG8_SB(0, 0), cB, voffB); PG8_STAGE(PG8_SB(0, 1), cB + hstep, voffB); PG8_STAGE(PG8_SA(0, 0), Ab, aoC[0]); PG8_STAGE(PG8_SA(0, 1), Ab, aoC[1]);
    if (wr == 1) PG8_BAR;
    PG8_WAIT_V(2); PG8_BAR;
    PG8_STAGE(PG8_SB(1, 0), cB + kstep, voffB); PG8_STAGE(PG8_SA(1, 0), Ab + kstep, aoC[0]); PG8_STAGE(PG8_SB(1, 1), cB + hstep + kstep, voffB);
    PG8_WAIT_V(6); PG8_BAR;
    for (;;) {
        const bool has_next = S.next(ui + 1, nxt);
        const char* nB = cB;
        if (has_next) { S.a_raw(nxt, sR, rawN); nB = S.b_ptr(nxt); }
#pragma unroll
        for (int h = 0; h < 2; ++h)
#pragma unroll
            for (int i = 0; i < 2; ++i) aoN[h][i] = aoC[h][i];
        for (int t = 0; t < nt; t += 2) {
            const bool last = (t == nt - 2);
            const char* a1 = Ab + (size_t)(t + 1) * kstep;
            const char* a2 = last ? Ab : Ab + (size_t)(t + 2) * kstep; const char* b2 = last ? nB : cB + (size_t)(t + 2) * kstep;
            const char* a3 = a2 + kstep; const char* b3 = b2 + kstep;
            if (last && has_next) {
#pragma unroll
                for (int h = 0; h < 2; ++h)
#pragma unroll
                    for (int i = 0; i < 2; ++i) asm volatile("" : "+v"(rawN[h][i]));
                S.a_fin(sC, rawN, aoN); }
            unsigned o2[2][2];
#pragma unroll
            for (int h = 0; h < 2; ++h)
#pragma unroll
                for (int i = 0; i < 2; ++i) o2[h][i] = last ? aoN[h][i] : aoC[h][i];
            PG8_LDB(B0, 0, 0); PG8_LDB(B1, 0, 1); PG8_SCHED; PG8_LDA(At, 0, 0); PG8_STAGE(PG8_SA(1, 1), a1, aoC[1]);
            PG8_WAIT_V(8); PG8_WAIT_L(0); PG8_BAR; PG8_MMA(0, 0, At, B0); PG8_MMA(0, 1, At, B1); PG8_BAR; PG8_SCHED;
            PG8_LDA(At, 0, 1); PG8_STAGE(PG8_SB(0, 0), b2, voffB); PG8_STAGE(PG8_SB(0, 1), b2 + hstep, voffB); PG8_STAGE(PG8_SA(0, 0), a2, o2[0]);
            PG8_WAIT_V(8); PG8_WAIT_L(0); PG8_BAR; PG8_MMA(1, 0, At, B0); PG8_MMA(1, 1, At, B1); PG8_BAR; PG8_SCHED;
            PG8_LDB(B0, 1, 0); PG8_LDB(B1, 1, 1); PG8_SCHED; PG8_LDA(At, 1, 0); PG8_STAGE(PG8_SA(0, 1), a2, o2[1]);
            PG8_WAIT_V(8); PG8_WAIT_L(0); PG8_BAR; PG8_MMA(0, 0, At, B0); PG8_MMA(0, 1, At, B1); PG8_BAR; PG8_SCHED;
            PG8_LDA(At, 1, 1); PG8_STAGE(PG8_SB(1, 0), b3, voffB); PG8_STAGE(PG8_SB(1, 1), b3 + hstep, voffB); PG8_STAGE(PG8_SA(1, 0), a3, o2[0]);
            PG8_WAIT_V(8); PG8_WAIT_L(0); PG8_BAR; PG8_MMA(1, 0, At, B0); PG8_MMA(1, 1, At, B1); PG8_BAR; PG8_SCHED;
        }
        if (wr == 0) PG8_BAR;
        E(acc, cur, wr, wc, fr, fq);
        if (!has_next) break;
#pragma unroll
        for (int a = 0; a < 2; ++a)
#pragma unroll
            for (int b = 0; b < 2; ++b)
#pragma unroll
                for (int m = 0; m < 4; ++m)
#pragma unroll
                    for (int n = 0; n < 2; ++n) acc[a][b][m][n] = (f32x4){0.f, 0.f, 0.f, 0.f};
        cur = nxt; cB = nB; ++ui;
#pragma unroll
        for (int h = 0; h < 2; ++h)
#pragma unroll
            for (int i = 0; i < 2; ++i) aoC[h][i] = aoN[h][i];
        if (wr == 1) PG8_BAR;
    }
    PG8_WAIT_V(0);
    PG8_BAR;
#undef PG8_SA
#undef PG8_SB
#undef PG8_STAGE
#undef PG8_LDA
#undef PG8_LDB
#undef PG8_MMA
#undef PG8_WAIT_V
#undef PG8_WAIT_L
#undef PG8_BAR
#undef PG8_SCHED
}

struct EpiProj {
    static constexpr bool PERM = true;
    bf16_t* O; float* dtraw;
    __device__ __forceinline__ void operator()(const f32x4 (&acc)[2][2][4][2], const Unit& u, int wr, int wc, int fr, int fq) const {
        const int row0 = u.pm * BM + wr * 64 + fr, col0 = u.pn * BM + wc * 32 + 8 * fq;
#pragma unroll
        for (int ai = 0; ai < 2; ++ai)
#pragma unroll
            for (int m = 0; m < 4; ++m) { const int row = row0 + ai * HALF + m * 16; bf16_t* rowp = O + (size_t)row * NPROJ + col0;
#pragma unroll
                for (int bj = 0; bj < 2; ++bj) { const f32x4 v0 = acc[ai][bj][m][0], v1 = acc[ai][bj][m][1];
                    u32x4 w; w.x = cvt_pk_bf16(v0[0], v0[1]); w.y = cvt_pk_bf16(v0[2], v0[3]); w.z = cvt_pk_bf16(v1[0], v1[1]); w.w = cvt_pk_bf16(v1[2], v1[3]);
                    *(u32x4*)(rowp + bj * HALF) = w; }
                if (u.pn == 11 && wc == 0 && fq < 2) { float* d = dtraw + (size_t)row * 16 + 8 * fq; *(f32x4*)d = acc[ai][0][m][0]; *(f32x4*)(d + 4) = acc[ai][0][m][1]; }
            }
    }
};
struct EpiX1 {
    static constexpr bool PERM = false;
    const float* x; const float* mod; float* x1; float* ss16;
    __device__ __forceinline__ void operator()(const f32x4 (&acc)[2][2][4][2], const Unit& u, int wr, int wc, int fr, int fq) const {
        const int row0 = u.pm * BM + wr * 64 + fr, col0 = u.pn * BM + wc * 32 + 4 * fq; const int b = (u.pm * BM) >> 11;
        f32x4 gv[2][2];
#pragma unroll
        for (int bj = 0; bj < 2; ++bj)
#pragma unroll
            for (int n = 0; n < 2; ++n) gv[bj][n] = *(const f32x4*)(mod + (size_t)b * 6144 + 2 * 1024 + col0 + bj * HALF + n * 16);
#pragma unroll
        for (int ai = 0; ai < 2; ++ai)
#pragma unroll
            for (int m = 0; m < 4; ++m) { const int row = row0 + ai * HALF + m * 16; const size_t off = (size_t)row * DM + col0; float ss = 0.f;
#pragma unroll
                for (int bj = 0; bj < 2; ++bj)
#pragma unroll
                    for (int n = 0; n < 2; ++n) { const f32x4 xv = *(const f32x4*)(x + off + bj * HALF + n * 16); const f32x4 o = xv + gv[bj][n] * acc[ai][bj][m][n]; *(f32x4*)(x1 + off + bj * HALF + n * 16) = o;
                        ss += (o[0] * o[0] + o[1] * o[1]) + (o[2] * o[2] + o[3] * o[3]); }
                ss += __shfl_xor(ss, 16); ss += __shfl_xor(ss, 32);
                if (fq == 0) ss16[(size_t)row * 16 + u.pn * 4 + wc] = ss; }
    }
};
struct EpiAct {
    static constexpr bool PERM = true;
    bf16_t* act;
    __device__ __forceinline__ void operator()(const f32x4 (&acc)[2][2][4][2], const Unit& u, int wr, int wc, int fr, int fq) const {
        const int row0 = u.pm * BM + wr * 64 + fr, col0 = u.pn * HALF + wc * 32 + 8 * fq;
#pragma unroll
        for (int ai = 0; ai < 2; ++ai)
#pragma unroll
            for (int m = 0; m < 4; ++m) { bf16_t* p = act + (size_t)(row0 + ai * HALF + m * 16) * FF + col0; float o[8];
#pragma unroll
                for (int n = 0; n < 2; ++n)
#pragma unroll
                    for (int i = 0; i < 4; ++i) { const float a = acc[ai][0][m][n][i], b = acc[ai][1][m][n][i]; o[n * 4 + i] = siluf_(a) * b; }
                u32x4 w; w.x = cvt_pk_bf16(o[0], o[1]); w.y = cvt_pk_bf16(o[2], o[3]); w.z = cvt_pk_bf16(o[4], o[5]); w.w = cvt_pk_bf16(o[6], o[7]);
                *(u32x4*)p = w; }
    }
};
struct EpiY {
    static constexpr bool PERM = true;
    const unsigned* list; const float* gates; bf16_t* Y0; bf16_t* Y1;
    __device__ __forceinline__ void operator()(const f32x4 (&acc)[2][2][4][2], const Unit& u, int wr, int wc, int fr, int fq) const {
        const int col0 = u.pn * BM + wc * 32 + 8 * fq; const size_t sb = (size_t)u.e * ECAP + u.slot0;
        unsigned ent[2][4]; float gt[2][4];
#pragma unroll
        for (int ai = 0; ai < 2; ++ai)
#pragma unroll
            for (int m = 0; m < 4; ++m) { const int r = ai * HALF + wr * 64 + m * 16 + fr; const int rc = r < u.cnt ? r : 0; ent[ai][m] = list[sb + rc]; gt[ai][m] = gates[sb + rc]; }
#pragma unroll
        for (int ai = 0; ai < 2; ++ai)
#pragma unroll
            for (int m = 0; m < 4; ++m) { const int r = ai * HALF + wr * 64 + m * 16 + fr;
                if (r < u.cnt) {
                    const unsigned tok = ent[ai][m] >> 1; const float gate = gt[ai][m];
                    bf16_t* yp = ((ent[ai][m] & 1u) ? Y1 : Y0) + (size_t)tok * DM + col0;
#pragma unroll
                    for (int bj = 0; bj < 2; ++bj) { const f32x4 v0 = acc[ai][bj][m][0] * gate, v1 = acc[ai][bj][m][1] * gate;
                        u32x4 w; w.x = cvt_pk_bf16(v0[0], v0[1]); w.y = cvt_pk_bf16(v0[2], v0[3]); w.z = cvt_pk_bf16(v1[0], v1[1]); w.w = cvt_pk_bf16(v1[2], v1[3]);
                        *(u32x4*)(yp + bj * HALF) = w; } } }
    }
};
}

struct Frame {
    unsigned char* lds; int tid, lane, wave, vcu, G, gw, NGW;
};

__device__ __forceinline__ void transpose_item(const float* W, int ldw, int nvalid, int k0, int n0, bf16_t* WT, int K, int dst_row0, float* scr, int lane) {
#pragma unroll 8
    for (int i = 0; i < 32; ++i) { const int kk = 2 * i + (lane >> 5); const int n = n0 + (lane & 31); scr[kk * 33 + (lane & 31)] = (n < nvalid) ? W[(size_t)(k0 + kk) * ldw + n] : 0.f; }
    asm volatile("s_waitcnt lgkmcnt(0)" ::: "memory");
    const int c = lane & 7;
#pragma unroll
    for (int j = 0; j < 4; ++j) { const int n = (lane >> 3) + 8 * j; const float* s = scr + (8 * c) * 33 + n;
        u32x4 o; o.x = cvt_pk_bf16(s[0 * 33], s[1 * 33]); o.y = cvt_pk_bf16(s[2 * 33], s[3 * 33]); o.z = cvt_pk_bf16(s[4 * 33], s[5 * 33]); o.w = cvt_pk_bf16(s[6 * 33], s[7 * 33]);
        *(u32x4*)(WT + (size_t)(dst_row0 + n0 + n) * K + k0 + 8 * c) = o; }
    asm volatile("s_waitcnt lgkmcnt(0)" ::: "memory");
}

__device__ __forceinline__ void p0_prep(const Frame& F, const Params& P) {
    unsigned char* ws = P.ws;
    {
        float* sct = (float*)F.lds;
        const float* c = P.in[1];
        for (int idx = F.tid; idx < 32 * 1024; idx += NTHREADS) { const int b = idx >> 10, k = idx & 1023; sct[k * 32 + b] = siluf_(c[idx]); }
        __syncthreads();
        const float* w_ada = P.in[2]; const float* b_ada = P.in[3]; float* mod = (float*)(ws + WS_MOD);
        for (int cg = F.vcu; cg < 256; cg += F.G) {
            const int j = F.tid % 24, kg = F.tid / 24;
            float acc[32];
#pragma unroll
            for (int b = 0; b < 32; ++b) acc[b] = 0.f;
            if (kg < 16) {
                for (int kk = 0; kk < 64; ++kk) { const int k = kg * 64 + kk; const float w = w_ada[(size_t)k * 6144 + cg * 24 + j];
#pragma unroll
                    for (int q = 0; q < 8; ++q) { const f32x4 s = *(const f32x4*)(sct + k * 32 + 4 * q); acc[4 * q] += s[0] * w; acc[4 * q + 1] += s[1] * w; acc[4 * q + 2] += s[2] * w; acc[4 * q + 3] += s[3] * w; } }
            }
            float* px = (float*)(F.lds + 131072);
            float tot[2] = {0.f, 0.f};
#pragma unroll 1
            for (int half = 0; half < 2; ++half) {
                if (kg < 16 && (kg >> 3) == half) {
#pragma unroll
                    for (int b = 0; b < 32; ++b) px[((kg & 7) * 24 + j) * 32 + b] = acc[b];
                }
                __syncthreads();
#pragma unroll
                for (int r = 0; r < 2; ++r) { const int o = F.tid + r * 512; if (o < 768) { float s = 0.f;
#pragma unroll
                        for (int q = 0; q < 8; ++q) s += px[q * 768 + o]; tot[r] += s; } }
                __syncthreads();
            }
#pragma unroll
            for (int r = 0; r < 2; ++r) { const int o = F.tid + r * 512; if (o < 768) { const int jj = o >> 5, b = o & 31; mod[(size_t)b * 6144 + cg * 24 + jj] = tot[r] + b_ada[cg * 24 + jj]; } }
        }
        __syncthreads();
    }
    {
        float* scr = (float*)(F.lds + F.wave * 16384);
        const float* w_in = P.in[4]; const float* w_out = P.in[13]; const float* w13 = P.in[18]; const float* w2 = P.in[19];
        bf16_t* WIN = (bf16_t*)(ws + WS_WIN); bf16_t* WOUT = (bf16_t*)(ws + WS_WOUT); bf16_t* W13 = (bf16_t*)(ws + WS_W13); bf16_t* W2 = (bf16_t*)(ws + WS_W2);
        constexpr int I0 = 16 * 88, I1 = 16 * 32, I2 = 32 * 16 * 32, I3 = 32 * 8 * 32, NIT = I0 + I1 + I2 + I3;
        for (int it = F.gw; it < NIT; it += F.NGW) {
            int r = it;
            if (r < I0) { const int kb = r / 88, nb = 8 + r % 88; transpose_item(w_in, NPROJ_REAL, NPROJ_REAL, kb * 64, nb * 32, WIN, 1024, 0, scr, F.lane); continue; } r -= I0;
            if (r < I1) { const int kb = r / 32, nb = r % 32; transpose_item(w_out, 1024, 1024, kb * 64, nb * 32, WOUT, 1024, 0, scr, F.lane); continue; } r -= I1;
            if (r < I2) { const int e = r / 512, q = r % 512, kb = q / 32, nb = q % 32; const int n0 = nb * 32, bj = n0 >> 9, rem = n0 & 511, pn = rem >> 7, j0 = rem & 127;
                transpose_item(w13 + (size_t)e * 1024 * 1024, 1024, 1024, kb * 64, n0, W13 + (size_t)e * 1024 * 1024, 1024, pn * 256 + bj * 128 + j0 - n0, scr, F.lane); continue; } r -= I2;
            { const int e = r / 256, q = r % 256, kb = q / 32, nb = q % 32;
                transpose_item(w2 + (size_t)e * 512 * 1024, 1024, 1024, kb * 64, nb * 32, W2 + (size_t)e * 1024 * 512, 512, 0, scr, F.lane); }
        }
    }
    {
        const float* w_in = P.in[4]; const float* w_pool = P.in[5]; const float* pscale = P.in[6]; bf16_t* WIN = (bf16_t*)(ws + WS_WIN);
        for (int idx = F.vcu * NTHREADS + F.tid; idx < 256 * 1024; idx += F.G * NTHREADS) {
            const int n = idx >> 10, k = idx & 1023, g = n >> 6, d = n & 63; const float* wi = w_in + (size_t)k * NPROJ_REAL + g * 64; const float* wp = w_pool + (size_t)g * 4096 + d;
            float s = 0.f;
#pragma unroll 8
            for (int cc = 0; cc < 64; ++cc) s += wi[cc] * wp[cc * 64];
            s *= pscale[n];
            WIN[(size_t)n * 1024 + k] = (bf16_t)(cvt_pk_bf16(s, 0.f) & 0xffffu);
        }
    }
    {
        const float* wg = P.in[14]; const float* wrt = P.in[16]; bf16_t* WRH = (bf16_t*)(ws + WS_WR); bf16_t* WRL = (bf16_t*)(ws + WS_WR + 131072);
        for (int idx = F.vcu * NTHREADS + F.tid; idx < 36 * 1024; idx += F.G * NTHREADS) { const int j = idx >> 10, k = idx & 1023; const float w = (j < 4) ? wg[k * 4 + j] : wrt[k * 32 + (j - 4)];
            const unsigned hi = cvt_pk_bf16(w, 0.f) & 0xffffu; const float lo = w - __uint_as_float(hi << 16); WRH[idx] = (bf16_t)hi; WRL[idx] = (bf16_t)(cvt_pk_bf16(lo, 0.f) & 0xffffu); }
    }
}

__device__ __forceinline__ void p1_modulate(const Frame& F, const Params& P) {
    const float* x = P.in[0]; const float* mod = (const float*)(P.ws + WS_MOD); bf16_t* H = (bf16_t*)(P.ws + WS_H);
    for (int row = F.gw; row < T; row += F.NGW) {
        const int b = row >> 11; const f32x4* xr = (const f32x4*)(x + (size_t)row * DM) + F.lane;
        f32x4 v[4]; float s = 0.f;
#pragma unroll
        for (int j = 0; j < 4; ++j) { v[j] = xr[64 * j]; s += (v[j][0] * v[j][0] + v[j][1] * v[j][1]) + (v[j][2] * v[j][2] + v[j][3] * v[j][3]); }
        const float rstd = rsqrtf(wave_sum(s) * (1.f / DM) + EPS);
        const f32x4* sh = (const f32x4*)(mod + (size_t)b * 6144) + F.lane; const f32x4* sc = (const f32x4*)(mod + (size_t)b * 6144 + 1024) + F.lane;
        u32x2* o = (u32x2*)(H + (size_t)row * DM) + F.lane;
#pragma unroll
        for (int j = 0; j < 4; ++j) { const f32x4 a = sh[64 * j], m = sc[64 * j]; const f32x4 h = v[j] * rstd * (m + 1.0f) + a; u32x2 w; w.x = cvt_pk_bf16(h[0], h[1]); w.y = cvt_pk_bf16(h[2], h[3]); o[64 * j] = w; }
    }
}

template <int W>
__device__ __forceinline__ void pool_item(const bf16_t* src, bf16_t* dst, int t0) {
    u32x4 hist[W - 1], cur[16];
#pragma unroll
    for (int i = 0; i < 16; ++i) cur[i] = *(const u32x4*)(src + (size_t)i * NPROJ);
    if (t0 > 0) {
#pragma unroll
        for (int h = 0; h < W - 1; ++h) hist[h] = *(const u32x4*)(src - (size_t)(W - 1 - h) * NPROJ); }
    else {
#pragma unroll
        for (int h = 0; h < W - 1; ++h) hist[h] = (u32x4){0u, 0u, 0u, 0u}; }
#define UNP8P(dst, v) do { dst[0] = bf_lo(v.x); dst[1] = bf_hi(v.x); dst[2] = bf_lo(v.y); dst[3] = bf_hi(v.y); dst[4] = bf_lo(v.z); dst[5] = bf_hi(v.z); dst[6] = bf_lo(v.w); dst[7] = bf_hi(v.w); } while (0)
    float sum[8];
#pragma unroll
    for (int k = 0; k < 8; ++k) sum[k] = 0.f;
#pragma unroll
    for (int h = 0; h < W - 1; ++h) { float e[8]; UNP8P(e, hist[h]);
#pragma unroll
        for (int k = 0; k < 8; ++k) sum[k] += e[k]; }
#pragma unroll
    for (int i = 0; i < 16; ++i) {
        float c[8]; UNP8P(c, cur[i]);
#pragma unroll
        for (int k = 0; k < 8; ++k) sum[k] += c[k];
        if (i >= 1) { float o[8]; if (i <= W - 1) UNP8P(o, hist[i - 1 < W - 1 ? i - 1 : 0]); else UNP8P(o, cur[i - W >= 0 ? i - W : 0]);
#pragma unroll
            for (int k = 0; k < 8; ++k) sum[k] -= o[k]; }
        const int cnt = (t0 > 0) ? W : ((i + 1) < W ? (i + 1) : W); const float inv = 1.0f / (float)cnt;
        u32x4 pk; pk.x = cvt_pk_bf16(sum[0] * inv - c[0], sum[1] * inv - c[1]); pk.y = cvt_pk_bf16(sum[2] * inv - c[2], sum[3] * inv - c[3]);
        pk.z = cvt_pk_bf16(sum[4] * inv - c[4], sum[5] * inv - c[5]); pk.w = cvt_pk_bf16(sum[6] * inv - c[6], sum[7] * inv - c[7]);
        *(u32x4*)(dst + (size_t)i * DM) = pk;
    }
#undef UNP8P
}

__device__ __forceinline__ void p3_conv(const Frame& F, const Params& P) {
    const bf16_t* proj = (const bf16_t*)(P.ws + WS_PROJ); bf16_t* XA = (bf16_t*)(P.ws + WS_XA);
    const float* conv_w = P.in[7]; const float* conv_b = P.in[8];
    if (F.tid < 24) {
        const float* dtraw = (const float*)(P.ws + WS_DTRAW); float* DTV = (float*)(P.ws + WS_DTV); float* ACS = (float*)(P.ws + WS_ACS);
        const float* dt_bias = P.in[9]; const float* a_log = P.in[10];
        for (int idx = F.vcu * 24 + F.tid; idx < BATCH * 16 * 12; idx += F.G * 24) {
            const int h = idx % 12, bc = idx / 12; const float a = -__expf(a_log[h]), dtb = dt_bias[h]; float cs = 0.f;
            for (int l = 0; l < 128; ++l) { const size_t row = (size_t)bc * 128 + l; const float v = dtraw[row * 16 + h] + dtb; const float dt = v > 20.f ? v : log1pf(__expf(v)); cs += dt * a; DTV[row * 16 + h] = dt; ACS[row * 16 + h] = cs; }
        }
    }
    for (int item = F.vcu * NTHREADS + F.tid; item < (T / 16) * 224; item += F.G * NTHREADS) {
        const int cg = item % 224, rr = item / 224, ch = cg * 8, row0 = rr * 16, t0 = row0 & (SEQ - 1);
        const bf16_t* src = proj + (size_t)row0 * NPROJ + COL_XS + ch;
        u32x4 raw[19];
#pragma unroll
        for (int i = 0; i < 16; ++i) raw[3 + i] = *(const u32x4*)(src + (size_t)i * NPROJ);
        if (t0 >= 3) {
#pragma unroll
            for (int i = 0; i < 3; ++i) raw[i] = *(const u32x4*)(src - (size_t)(3 - i) * NPROJ); }
        else { raw[0] = (u32x4){0u, 0u, 0u, 0u}; raw[1] = raw[0]; raw[2] = raw[0]; }
        float w[4][8], bs[8];
#pragma unroll
        for (int j = 0; j < 4; ++j) { const f32x4 a = *(const f32x4*)(conv_w + j * 1792 + ch), c = *(const f32x4*)(conv_w + j * 1792 + ch + 4);
#pragma unroll
            for (int k = 0; k < 4; ++k) { w[j][k] = a[k]; w[j][4 + k] = c[k]; } }
        { const f32x4 a = *(const f32x4*)(conv_b + ch), c = *(const f32x4*)(conv_b + ch + 4);
#pragma unroll
            for (int k = 0; k < 4; ++k) { bs[k] = a[k]; bs[4 + k] = c[k]; } }
#define UNP8(dst, v) do { dst[0] = bf_lo(v.x); dst[1] = bf_hi(v.x); dst[2] = bf_lo(v.y); dst[3] = bf_hi(v.y); dst[4] = bf_lo(v.z); dst[5] = bf_hi(v.z); dst[6] = bf_lo(v.w); dst[7] = bf_hi(v.w); } while (0)
        float r0[8], r1[8], r2[8];
        UNP8(r0, raw[0]); UNP8(r1, raw[1]); UNP8(r2, raw[2]);
#pragma unroll
        for (int i = 0; i < 16; ++i) {
            float cur[8]; UNP8(cur, raw[3 + i]); float o[8];
#pragma unroll
            for (int k = 0; k < 8; ++k) { const float v = bs[k] + w[0][k] * r0[k] + w[1][k] * r1[k] + w[2][k] * r2[k] + w[3][k] * cur[k]; o[k] = siluf_(v); r0[k] = r1[k]; r1[k] = r2[k]; r2[k] = cur[k]; }
            u32x4 pk; pk.x = cvt_pk_bf16(o[0], o[1]); pk.y = cvt_pk_bf16(o[2], o[3]); pk.z = cvt_pk_bf16(o[4], o[5]); pk.w = cvt_pk_bf16(o[6], o[7]);
            *(u32x4*)(XA + (size_t)(row0 + i) * 1792 + ch) = pk;
        }
    }
    { bf16_t* mix = (bf16_t*)(P.ws + WS_MIX);
      for (int p = F.vcu * NTHREADS + F.tid; p < (T / 16) * 32; p += F.G * NTHREADS) {
        const int c8 = p & 7, rr8 = (p >> 3) & 7, grp = (p >> 6) & 3, rrblk = p >> 8; const int rr = rrblk * 8 + rr8, row0 = rr * 16, t0 = row0 & (SEQ - 1), col = grp * 64 + c8 * 8;
        const bf16_t* src = proj + (size_t)row0 * NPROJ + col; bf16_t* dst = mix + (size_t)row0 * DM + col;
        if (grp == 0) pool_item<2>(src, dst, t0); else if (grp == 1) pool_item<4>(src, dst, t0); else if (grp == 2) pool_item<8>(src, dst, t0); else pool_item<16>(src, dst, t0);
      } }
#undef UNP8
}

constexpr int L_B = 0, L_C = 32768, L_X = 49152, L_S = 98304, L_DT = 147456, L_ACS = L_DT + 1536, L_W = L_ACS + 1536, L_EA = L_W + 1536;
typedef short v4i16 __attribute__((ext_vector_type(4)));
__device__ __forceinline__ int swz16(int r) { const int h = (r >> 3) & 1; return ((((r & 7) + 4 * h) & 7) << 1) | h; }
__device__ __forceinline__ int swz8(int row) { return ((row >> 1) & 3) << 1; }
__device__ __forceinline__ bf16x8 tr_pair(LAS unsigned char* a0, LAS unsigned char* a1) {
    const v4i16 lo = __builtin_amdgcn_ds_read_tr16_b64_v4i16((LAS v4i16*)a0), hi = __builtin_amdgcn_ds_read_tr16_b64_v4i16((LAS v4i16*)a1);
    return (bf16x8){lo[0], lo[1], lo[2], lo[3], hi[0], hi[1], hi[2], hi[3]};
}
__device__ __forceinline__ bf16x8 pack8(const float (&v)[8]) {
    u32x4 p; p.x = cvt_pk_bf16(v[0], v[1]); p.y = cvt_pk_bf16(v[2], v[3]); p.z = cvt_pk_bf16(v[4], v[5]); p.w = cvt_pk_bf16(v[6], v[7]);
    return __builtin_bit_cast(bf16x8, p);
}
#define MFMA16(a, b, c) __builtin_amdgcn_mfma_f32_16x16x32_bf16((a), (b), (c), 0, 0, 0)

#define OPAQUE(x) asm volatile("" : "+v"(x))
template <int CH>
__device__ __forceinline__ void ssd_compute(LAS unsigned char* L, int lt, int hl, int lane, f32x4 (&sacc)[2][6], f32x4 (&yacc)[6], float dsk0, float dsk1) {
    OPAQUE(lane);
    const int i = lane & 15, q = lane >> 4, qp = i >> 2, pp = lane & 3;
    const int lrow0 = 64 * hl + 16 * lt;
    int pr[4];
    { const int fsw = swz16(i);
#pragma unroll
      for (int ks = 0; ks < 4; ++ks) { pr[ks] = i * 256 + (((4 * ks + q) ^ fsw) << 4); OPAQUE(pr[ks]); } }
    int q16 = 16 * q; OPAQUE(q16);
    int i4 = 4 * i; OPAQUE(i4);
    const int r4 = 4 * q + qp;
    int tb[2], tx[4];
    { const int fr = swz16(r4), xr = swz8(r4);
#pragma unroll
      for (int nt2 = 0; nt2 < 2; ++nt2) { tb[nt2] = r4 * 256 + 8 * (pp & 1) + (((2 * (2 * lt + nt2) + (pp >> 1)) ^ fr) << 4); OPAQUE(tb[nt2]); }
#pragma unroll
      for (int pt = 0; pt < 4; ++pt) { tx[pt] = r4 * 128 + 8 * (pp & 1) + (((2 * pt + (pp >> 1)) ^ xr) << 4); OPAQUE(tx[pt]); } }
    int cbase = lt * 4096; OPAQUE(cbase);
    int lq = (lrow0 + 4 * q) * 4; OPAQUE(lq);
    int li = (lrow0 + i) * 4; OPAQUE(li);
    bf16x8 cfrag[4];
#pragma unroll
    for (int ks = 0; ks < 4; ++ks) cfrag[ks] = *(const LAS bf16x8*)(L + L_C + cbase + pr[ks]);
#pragma unroll
    for (int ct = 0; ct < 6; ++ct) { f32x4 a = (f32x4){0.f, 0.f, 0.f, 0.f};
#pragma unroll
        for (int ks = 0; ks < 4; ++ks) { const bf16x8 sf = *(const LAS bf16x8*)(L + L_S + (96 * CH + 16 * ct) * 256 + pr[ks]); a = MFMA16(cfrag[ks], sf, a); }
        yacc[ct] = a; }
#pragma unroll
    for (int hsel = 0; hsel < 2; ++hsel) { const f32x4 e = *(const LAS f32x4*)(L + L_EA + (CH + hsel) * 512 + lq);
#pragma unroll
        for (int ct = 0; ct < 6; ++ct) if ((((6 * CH + ct) >> 2) - CH) == hsel) yacc[ct] = yacc[ct] * e; }
    __builtin_amdgcn_sched_barrier(0);
    f32x4 cbt[8];
#pragma unroll
    for (int ts = 0; ts < 8; ++ts) { f32x4 a = (f32x4){0.f, 0.f, 0.f, 0.f};
#pragma unroll
        for (int ks = 0; ks < 4; ++ks) { const bf16x8 bf = *(const LAS bf16x8*)(L + L_B + ts * 4096 + pr[ks]); a = MFMA16(bf, cfrag[ks], a); }
        cbt[ts] = a; }
    __builtin_amdgcn_sched_barrier(0);
    bf16x8 mfrag[2][4];
    int dq = lrow0 + i - 4 * q; OPAQUE(dq);
#pragma unroll
    for (int hsel = 0; hsel < 2; ++hsel) { const int r = CH + hsel; const float acl = *(const LAS float*)(L + L_ACS + r * 512 + li); const float dsk = hsel ? dsk1 : dsk0;
#pragma unroll
        for (int kk = 0; kk < 4; ++kk) { float v[8];
#pragma unroll
            for (int hf = 0; hf < 2; ++hf) { const int ts = 2 * kk + hf; const f32x4 as = *(const LAS f32x4*)(L + L_ACS + r * 512 + ts * 64 + q16), ds = *(const LAS f32x4*)(L + L_DT + r * 512 + ts * 64 + q16);
#pragma unroll
                for (int j = 0; j < 4; ++j) { const int sc = 16 * ts + j; const float arg = fminf(acl - as[j], 0.f); const float cd = cbt[ts][j] * ds[j]; const float m = cd * __expf(arg);
                    v[4 * hf + j] = (sc < dq) ? m : ((sc == dq) ? (cd + dsk) : 0.f); } }
            mfrag[hsel][kk] = pack8(v); } }
    __builtin_amdgcn_sched_barrier(0);
#pragma unroll
    for (int hsel = 0; hsel < 2; ++hsel) { const float cd = *(const LAS float*)(L + L_EA + (CH + hsel) * 512 + 127 * 4);
#pragma unroll
        for (int ct = 0; ct < 6; ++ct) if ((((6 * CH + ct) >> 2) - CH) == hsel) { sacc[0][ct] = sacc[0][ct] * cd; sacc[1][ct] = sacc[1][ct] * cd; } }
#pragma unroll
    for (int kk = 0; kk < 4; ++kk) {
        bf16x8 btf[2];
#pragma unroll
        for (int nt2 = 0; nt2 < 2; ++nt2) btf[nt2] = tr_pair(L + L_B + kk * 8192 + tb[nt2], L + L_B + kk * 8192 + 4096 + tb[nt2]);
        f32x4 wl[2], wh[2];
#pragma unroll
        for (int hsel = 0; hsel < 2; ++hsel) { wl[hsel] = *(const LAS f32x4*)(L + L_W + (CH + hsel) * 512 + kk * 128 + q16); wh[hsel] = *(const LAS f32x4*)(L + L_W + (CH + hsel) * 512 + kk * 128 + 64 + q16); }
#pragma unroll
        for (int ct = 0; ct < 6; ++ct) { const int ctg = 6 * CH + ct, r = ctg >> 2, pt = ctg & 3, hsel = r - CH;
            const bf16x8 xf = tr_pair(L + L_X + r * 16384 + kk * 4096 + tx[pt], L + L_X + r * 16384 + kk * 4096 + 2048 + tx[pt]);
            yacc[ct] = MFMA16(mfrag[hsel][kk], xf, yacc[ct]);
            float xs[8];
#pragma unroll
            for (int e = 0; e < 4; ++e) { xs[e] = __uint_as_float((unsigned)(unsigned short)xf[e] << 16) * wl[hsel][e]; xs[4 + e] = __uint_as_float((unsigned)(unsigned short)xf[4 + e] << 16) * wh[hsel][e]; }
            const bf16x8 xsf = pack8(xs);
            sacc[0][ct] = MFMA16(btf[0], xsf, sacc[0][ct]); sacc[1][ct] = MFMA16(btf[1], xsf, sacc[1][ct]); }
        __builtin_amdgcn_sched_barrier(0);
    }
}

__device__ __forceinline__ void p4_ssd(const Frame& F, const Params& P) {
    LAS unsigned char* L = (LAS unsigned char*)F.lds;
    const bf16_t* XA = (const bf16_t*)(P.ws + WS_XA); const float* DTV = (const float*)(P.ws + WS_DTV); const float* ACS = (const float*)(P.ws + WS_ACS);
    const bf16_t* proj = (const bf16_t*)(P.ws + WS_PROJ); bf16_t* mix = (bf16_t*)(P.ws + WS_MIX); const float* norm_w = P.in[12]; const float* d_skip = P.in[11];
    const int lane = F.lane, lt = F.wave >> 1, ch = F.wave & 1;
    for (int u = F.vcu; u < 256; u += F.G) {
        const int b = u >> 3, g = (u >> 1) & 3, hl = u & 1;
        for (int idx = F.tid; idx < 49152 / 16; idx += NTHREADS) *(LAS u32x4*)(L + L_S + idx * 16) = (u32x4){0u, 0u, 0u, 0u};
        f32x4 sacc[2][6];
#pragma unroll
        for (int a = 0; a < 2; ++a)
#pragma unroll
            for (int c = 0; c < 6; ++c) sacc[a][c] = (f32x4){0.f, 0.f, 0.f, 0.f};
        const float dsk0 = d_skip[3 * g + ch], dsk1 = d_skip[3 * g + ch + 1];
        for (int ck = 0; ck < 16; ++ck) {
            const size_t tok0 = (size_t)b * SEQ + ck * 128;
            int tt = F.tid; OPAQUE(tt);
            { const bf16_t* xrow = XA + tok0 * 1792;
#pragma unroll
            for (int k = 0; k < 4; ++k) { const int idx = tt + NTHREADS * k, row = idx >> 4, chk = idx & 15; const u32x4 v = *(const u32x4*)(xrow + (unsigned)(row * 1792 + 768 + g * 128 + chk * 8));
                *(LAS u32x4*)(L + L_B + row * 256 + ((chk ^ swz16(row & 15)) << 4)) = v; }
#pragma unroll
            for (int k = 0; k < 2; ++k) { const int idx = tt + NTHREADS * k, row = idx >> 4, chk = idx & 15; const u32x4 v = *(const u32x4*)(xrow + (unsigned)((64 * hl + row) * 1792 + 1280 + g * 128 + chk * 8));
                *(LAS u32x4*)(L + L_C + row * 256 + ((chk ^ swz16(row & 15)) << 4)) = v; }
#pragma unroll
            for (int k = 0; k < 6; ++k) { const int idx = tt + NTHREADS * k, row = idx / 24, c24 = idx % 24, r = c24 >> 3, chk = c24 & 7; const u32x4 v = *(const u32x4*)(xrow + (unsigned)(row * 1792 + g * 192 + c24 * 8));
                *(LAS u32x4*)(L + L_X + r * 16384 + row * 128 + ((chk ^ swz8(row)) << 4)) = v; }
            if (tt < 384) { const int r = tt >> 7, l = tt & 127, hh = 3 * g + r; const float* dp = DTV + tok0 * 16; const float* ap = ACS + tok0 * 16; const float dt = dp[l * 16 + hh], ac = ap[l * 16 + hh], a127 = ap[127 * 16 + hh];
                *(LAS float*)(L + L_DT + (r * 128 + l) * 4) = dt; *(LAS float*)(L + L_ACS + (r * 128 + l) * 4) = ac; *(LAS float*)(L + L_W + (r * 128 + l) * 4) = dt * __expf(a127 - ac); *(LAS float*)(L + L_EA + (r * 128 + l) * 4) = __expf(ac); } }
            __syncthreads();
            f32x4 yacc[6];
            if (ch == 0) ssd_compute<0>(L, lt, hl, lane, sacc, yacc, dsk0, dsk1); else ssd_compute<1>(L, lt, hl, lane, sacc, yacc, dsk0, dsk1);
            __syncthreads();
            { int l2 = lane; OPAQUE(l2); const int i = l2 & 15, q = l2 >> 4;
#pragma unroll
            for (int nt2 = 0; nt2 < 2; ++nt2)
#pragma unroll
                for (int ct = 0; ct < 6; ++ct) { const f32x4 s = sacc[nt2][ct]; u32x2 pk; pk.x = cvt_pk_bf16(s[0], s[1]); pk.y = cvt_pk_bf16(s[2], s[3]);
                    const int row = 96 * ch + 16 * ct + i, n0 = 16 * (2 * lt + nt2) + 4 * q; *(LAS u32x2*)(L + L_S + row * 256 + (((n0 >> 3) ^ swz16(i)) << 4) + 8 * ((n0 >> 2) & 1)) = pk; }
#pragma unroll
            for (int ct = 0; ct < 6; ++ct)
#pragma unroll
                for (int j = 0; j < 4; ++j) *(LAS float*)(L + L_X + (16 * lt + 4 * q + j) * 768 + (96 * ch + 16 * ct + i) * 4) = yacc[ct][j]; }
            __syncthreads();
            { int t2 = F.tid; OPAQUE(t2); const int row = t2 >> 3, seg = t2 & 7; const int c0 = g * 192 + seg * 24;
                const bf16_t* zp = proj + (tok0 + 64 * hl) * NPROJ + (unsigned)(row * NPROJ + COL_Z + c0); float v[24]; float ss = 0.f;
#pragma unroll
                for (int k = 0; k < 3; ++k) { const u32x4 z = *(const u32x4*)(zp + 8 * k); const f32x4 y0 = *(const LAS f32x4*)(L + L_X + row * 768 + seg * 96 + k * 32), y1 = *(const LAS f32x4*)(L + L_X + row * 768 + seg * 96 + k * 32 + 16);
                    v[8 * k + 0] = y0[0] * siluf_(bf_lo(z.x)); v[8 * k + 1] = y0[1] * siluf_(bf_hi(z.x)); v[8 * k + 2] = y0[2] * siluf_(bf_lo(z.y)); v[8 * k + 3] = y0[3] * siluf_(bf_hi(z.y));
                    v[8 * k + 4] = y1[0] * siluf_(bf_lo(z.z)); v[8 * k + 5] = y1[1] * siluf_(bf_hi(z.z)); v[8 * k + 6] = y1[2] * siluf_(bf_lo(z.w)); v[8 * k + 7] = y1[3] * siluf_(bf_hi(z.w)); }
#pragma unroll
                for (int k = 0; k < 24; ++k) ss += v[k] * v[k];
                ss += __shfl_xor(ss, 1); ss += __shfl_xor(ss, 2); ss += __shfl_xor(ss, 4);
                const float rstd = rsqrtf(ss * (1.f / 192.f) + EPS);
                bf16_t* op = mix + (tok0 + 64 * hl) * DM + (unsigned)(row * DM + 256 + c0);
#pragma unroll
                for (int k = 0; k < 3; ++k) { const f32x4 n0 = *(const f32x4*)(norm_w + c0 + 8 * k), n1 = *(const f32x4*)(norm_w + c0 + 8 * k + 4); u32x4 pk;
                    pk.x = cvt_pk_bf16(v[8 * k] * rstd * n0[0], v[8 * k + 1] * rstd * n0[1]); pk.y = cvt_pk_bf16(v[8 * k + 2] * rstd * n0[2], v[8 * k + 3] * rstd * n0[3]);
                    pk.z = cvt_pk_bf16(v[8 * k + 4] * rstd * n1[0], v[8 * k + 5] * rstd * n1[1]); pk.w = cvt_pk_bf16(v[8 * k + 6] * rstd * n1[2], v[8 * k + 7] * rstd * n1[3]);
                    *(u32x4*)(op + 8 * k) = pk; } }
            __syncthreads();
        }
    }
}
constexpr int R_WH = 0, R_WL = 73728, R_SC = 147456, R_SH = R_SC + 4096, R_CNT = R_SH + 4096, R_LG = 0;
__device__ __forceinline__ void p5_route(const Frame& F, const Params& P) {
    LAS unsigned char* L = (LAS unsigned char*)F.lds;
    const float* x1 = (const float*)(P.ws + WS_X1); const float* mod = (const float*)(P.ws + WS_MOD); bf16_t* H = (bf16_t*)(P.ws + WS_H); const float* ss16 = (const float*)(P.ws + WS_SS16);
    const bf16_t* WRH = (const bf16_t*)(P.ws + WS_WR); const bf16_t* WRL = (const bf16_t*)(P.ws + WS_WR + 131072);
    float* gates = (float*)(P.ws + WS_SGATE); unsigned* list = (unsigned*)(P.ws + WS_LIST); unsigned* gcount = (unsigned*)(P.ws + WS_CTL) + CW_GCOUNT;
    const float* b_group = P.in[15]; const float* b_router = P.in[17];
    LAS unsigned* lcount = (LAS unsigned*)(L + R_CNT);
    LAS unsigned* lbase = lcount + 32;
    LAS unsigned* tinfo = lcount + 64;
    LAS float* twt = (LAS float*)(tinfo + 256 * 4);
    const int lane = F.lane, i = lane & 15, q = lane >> 4;
    for (int rb = F.vcu; rb < T / 256; rb += F.G) {
        const int b = rb >> 3;
        for (int idx = F.tid; idx < 36 * 128; idx += NTHREADS) { const int j = idx >> 7, c = idx & 127; const int dst = j * 2048 + ((c ^ swz16(j & 15)) << 4);
            *(LAS u32x4*)(L + R_WH + dst) = *(const u32x4*)(WRH + (size_t)j * 1024 + c * 8); *(LAS u32x4*)(L + R_WL + dst) = *(const u32x4*)(WRL + (size_t)j * 1024 + c * 8); }
        for (int idx = F.tid; idx < 256; idx += NTHREADS) { const f32x4 sc = *(const f32x4*)(mod + (size_t)b * 6144 + 4 * 1024 + idx * 4), sh = *(const f32x4*)(mod + (size_t)b * 6144 + 3 * 1024 + idx * 4);
            *(LAS f32x4*)(L + R_SC + idx * 16) = sc + 1.0f; *(LAS f32x4*)(L + R_SH + idx * 16) = sh; }
        if (F.tid < 32) lcount[F.tid] = 0u;
        __syncthreads();
        const int rowA = rb * 256 + F.wave * 32 + i;
        float rstd[2];
#pragma unroll
        for (int rt = 0; rt < 2; ++rt) { const f32x4* sp = (const f32x4*)(ss16 + (size_t)(rowA + 16 * rt) * 16); const f32x4 a = sp[0], c = sp[1], d = sp[2], e = sp[3];
            const float ss = ((a[0] + a[1]) + (a[2] + a[3])) + ((c[0] + c[1]) + (c[2] + c[3])) + ((d[0] + d[1]) + (d[2] + d[3])) + ((e[0] + e[1]) + (e[2] + e[3])); rstd[rt] = rsqrtf(ss * (1.f / DM) + EPS); }
        f32x4 acc[2][3];
#pragma unroll
        for (int rt = 0; rt < 2; ++rt)
#pragma unroll
            for (int ct = 0; ct < 3; ++ct) acc[rt][ct] = (f32x4){0.f, 0.f, 0.f, 0.f};
        int wrow[3];
#pragma unroll
        for (int ct = 0; ct < 3; ++ct) { const int j = (16 * ct + i) < 36 ? (16 * ct + i) : 35; wrow[ct] = j * 2048; }
        const int fsw = swz16(i);
        const int fswc = swz16(35 & 15);
#pragma unroll 2
        for (int s = 0; s < 32; ++s) {
            bf16x8 wh[3], wl[3];
#pragma unroll
            for (int ct = 0; ct < 3; ++ct) { const int sw = ((16 * ct + i) < 36) ? fsw : fswc; const int o = wrow[ct] + ((((4 * s + q) & ~15) | (((4 * s + q) & 15) ^ sw)) << 4);
                wh[ct] = *(const LAS bf16x8*)(L + R_WH + o); wl[ct] = *(const LAS bf16x8*)(L + R_WL + o); }
            const f32x4 sc0 = *(const LAS f32x4*)(L + R_SC + (32 * s + 8 * q) * 4), sc1 = *(const LAS f32x4*)(L + R_SC + (32 * s + 8 * q + 4) * 4);
            const f32x4 sh0 = *(const LAS f32x4*)(L + R_SH + (32 * s + 8 * q) * 4), sh1 = *(const LAS f32x4*)(L + R_SH + (32 * s + 8 * q + 4) * 4);
#pragma unroll
            for (int rt = 0; rt < 2; ++rt) { const size_t off = (size_t)(rowA + 16 * rt) * DM + 32 * s + 8 * q;
                const f32x4 x0 = *(const f32x4*)(x1 + off), x1v = *(const f32x4*)(x1 + off + 4);
                const f32x4 h0 = x0 * rstd[rt] * sc0 + sh0, h1 = x1v * rstd[rt] * sc1 + sh1;
                u32x4 hi; hi.x = cvt_pk_bf16(h0[0], h0[1]); hi.y = cvt_pk_bf16(h0[2], h0[3]); hi.z = cvt_pk_bf16(h1[0], h1[1]); hi.w = cvt_pk_bf16(h1[2], h1[3]);
                *(u32x4*)(H + off) = hi;
                u32x4 lo; lo.x = cvt_pk_bf16(h0[0] - bf_lo(hi.x), h0[1] - bf_hi(hi.x)); lo.y = cvt_pk_bf16(h0[2] - bf_lo(hi.y), h0[3] - bf_hi(hi.y));
                lo.z = cvt_pk_bf16(h1[0] - bf_lo(hi.z), h1[1] - bf_hi(hi.z)); lo.w = cvt_pk_bf16(h1[2] - bf_lo(hi.w), h1[3] - bf_hi(hi.w));
                const bf16x8 ah = __builtin_bit_cast(bf16x8, hi), al = __builtin_bit_cast(bf16x8, lo);
#pragma unroll
                for (int ct = 0; ct < 3; ++ct) { acc[rt][ct] = MFMA16(ah, wh[ct], acc[rt][ct]); acc[rt][ct] = MFMA16(al, wh[ct], acc[rt][ct]); acc[rt][ct] = MFMA16(ah, wl[ct], acc[rt][ct]); } }
        }
        __syncthreads();
        LAS float* lg = (LAS float*)(L + R_LG);
#pragma unroll
        for (int rt = 0; rt < 2; ++rt)
#pragma unroll
            for (int ct = 0; ct < 3; ++ct)
#pragma unroll
                for (int j = 0; j < 4; ++j) { const int col = 16 * ct + i; if (col < 36) lg[(F.wave * 32 + 16 * rt + 4 * q + j) * 37 + col] = acc[rt][ct][j]; }
        __syncthreads();
        if (F.tid < 256) {
            const int rl = F.tid; const LAS float* lr = lg + rl * 37;
            float gl[4];
#pragma unroll
            for (int k = 0; k < 4; ++k) gl[k] = lr[k] + b_group[k];
            int gi = 0; float gm = gl[0];
#pragma unroll
            for (int k = 1; k < 4; ++k) if (gl[k] > gm) { gm = gl[k]; gi = k; }
            float den = 0.f;
#pragma unroll
            for (int k = 0; k < 4; ++k) den += __expf(gl[k] - gm);
            const float pg = 1.0f / den;
            float el[8];
#pragma unroll
            for (int k = 0; k < 8; ++k) el[k] = lr[4 + gi * 8 + k] + b_router[gi * 8 + k];
            int i0 = 0; float v0 = el[0];
#pragma unroll
            for (int k = 1; k < 8; ++k) if (el[k] > v0) { v0 = el[k]; i0 = k; }
            int i1 = -1; float v1 = -3.0e38f;
#pragma unroll
            for (int k = 0; k < 8; ++k) if (k != i0 && el[k] > v1) { v1 = el[k]; i1 = k; }
            const float ex = __expf(v1 - v0); const float w0 = pg / (1.0f + ex), w1 = pg * ex / (1.0f + ex);
            const int e0 = gi * 8 + i0, e1 = gi * 8 + i1; const unsigned r0 = atomicAdd((unsigned*)&lcount[e0], 1u), r1 = atomicAdd((unsigned*)&lcount[e1], 1u);
            tinfo[rl * 4 + 0] = (unsigned)e0 | ((unsigned)e1 << 8); tinfo[rl * 4 + 1] = r0; tinfo[rl * 4 + 2] = r1; twt[rl * 2] = w0; twt[rl * 2 + 1] = w1;
        }
        __syncthreads();
        if (F.tid < 32) lbase[F.tid] = atomicAdd(&gcount[64 * F.tid], lcount[F.tid]);
        __syncthreads();
        if (F.tid < 256) { const int rl = F.tid, row = rb * 256 + rl; const unsigned ee = tinfo[rl * 4], e0 = ee & 255u, e1 = ee >> 8;
            const size_t s0 = (size_t)e0 * ECAP + lbase[e0] + tinfo[rl * 4 + 1], s1 = (size_t)e1 * ECAP + lbase[e1] + tinfo[rl * 4 + 2];
            list[s0] = (unsigned)row * 2u; list[s1] = (unsigned)row * 2u + 1u; gates[s0] = twt[rl * 2]; gates[s1] = twt[rl * 2 + 1]; }
        __syncthreads();
    }
}

__device__ __forceinline__ void p8_final(const Frame& F, const Params& P) {
    const float* x1 = (const float*)(P.ws + WS_X1); const bf16_t* Y0 = (const bf16_t*)(P.ws + WS_Y0); const bf16_t* Y1 = (const bf16_t*)(P.ws + WS_Y1); const float* fw = P.in[20]; const float* mod = (const float*)(P.ws + WS_MOD);
    f32x4 wv[4];
#pragma unroll
    for (int j = 0; j < 4; ++j) wv[j] = ((const f32x4*)fw)[F.lane + 64 * j];
    for (int row = F.gw; row < T; row += F.NGW) {
        const f32x4* xr = (const f32x4*)(x1 + (size_t)row * DM) + F.lane; const u32x2* y0 = (const u32x2*)(Y0 + (size_t)row * DM) + F.lane; const u32x2* y1 = (const u32x2*)(Y1 + (size_t)row * DM) + F.lane;
        const f32x4* g2 = (const f32x4*)(mod + (size_t)(row >> 11) * 6144 + 5 * 1024) + F.lane;
        f32x4 v[4]; float s = 0.f;
#pragma unroll
        for (int j = 0; j < 4; ++j) { const u32x2 a = y0[64 * j], c = y1[64 * j]; const f32x4 g = g2[64 * j]; v[j] = xr[64 * j];
            v[j][0] += g[0] * (bf_lo(a.x) + bf_lo(c.x)); v[j][1] += g[1] * (bf_hi(a.x) + bf_hi(c.x)); v[j][2] += g[2] * (bf_lo(a.y) + bf_lo(c.y)); v[j][3] += g[3] * (bf_hi(a.y) + bf_hi(c.y));
            s += (v[j][0] * v[j][0] + v[j][1] * v[j][1]) + (v[j][2] * v[j][2] + v[j][3] * v[j][3]); }
        const float rstd = rsqrtf(wave_sum(s) * (1.f / DM) + EPS);
        f32x4* o = (f32x4*)(P.out + (size_t)row * DM) + F.lane;
#pragma unroll
        for (int j = 0; j < 4; ++j) o[64 * j] = v[j] * rstd * wv[j];
    }
}

__device__ __forceinline__ void moe_prefix(const Frame& F, const Params& P, int* pref) {
    const unsigned* gcount = (const unsigned*)(P.ws + WS_CTL) + CW_GCOUNT;
    __syncthreads();
    if (F.tid == 0) { int acc = 0; for (int e = 0; e < 32; ++e) { const int c = (int)__hip_atomic_load(gcount + 64 * e, __ATOMIC_RELAXED, __HIP_MEMORY_SCOPE_AGENT); pref[e] = acc; pref[33 + e] = c; acc += (c + 255) >> 8; } pref[32] = acc; }
    __syncthreads();
}

#define XB_TMO      128
#define XB_XCNT(j)  (256  + 64 * (j))
#define XB_XSUB(j)  (1280 + 64 * (j))
#define XB_XGEN(j)  (2304 + 64 * (j))
#define XB_TOP      3328
#define XB_TOPGEN   3392
#define XCD_BAR_WORDS 3456
#define XB_SPIN_CAP (1u << 22)
__device__ __forceinline__ unsigned xb_ld(unsigned* p)              { return __hip_atomic_load(p, __ATOMIC_RELAXED, __HIP_MEMORY_SCOPE_AGENT); }
__device__ __forceinline__ unsigned xb_add(unsigned* p, unsigned v) { return __hip_atomic_fetch_add(p, v, __ATOMIC_RELAXED, __HIP_MEMORY_SCOPE_AGENT); }
__device__ __forceinline__ unsigned xb_xcc_id() { return (unsigned)__builtin_amdgcn_s_getreg((3 << 11) | 20) & 0xFu; }
#define XB_SPIN(cond, bar) do { unsigned _sp = 0; while (cond) { __builtin_amdgcn_s_sleep(1); \
    if ((++_sp & 255u) == 0u) { if (xb_ld(&(bar)[XB_TMO])) break; if (_sp > XB_SPIN_CAP) { atomicAdd(&(bar)[XB_TMO], 1u); break; } } } } while (0)
struct XcdBarrier { unsigned* bar; unsigned x; volatile LAS unsigned* st; };
__device__ __forceinline__ XcdBarrier xcd_barrier_post(unsigned* bar, volatile LAS unsigned* st) {
    XcdBarrier b; b.bar = bar; b.x = xb_xcc_id(); b.st = st;
    if (threadIdx.x == 0) (void)xb_add(&bar[XB_XCNT(b.x)], 1u);
    return b;
}
__device__ __forceinline__ void xcd_barrier_complete(unsigned* bar, unsigned x, unsigned& nloc, unsigned& nx) {
    const unsigned G = gridDim.x * gridDim.y * gridDim.z;
    unsigned sum, cnt, mine, sp = 0u;
    for (;;) {
        sum = 0u; cnt = 0u; mine = 0u;
#pragma unroll
        for (unsigned j = 0; j < 16; ++j) { const unsigned c = xb_ld(&bar[XB_XCNT(j)]); sum += c; cnt += (c > 0u) ? 1u : 0u; mine = (j == x) ? c : mine; }
        if (sum == G) break;
        __builtin_amdgcn_s_sleep(1);
        if ((++sp & 255u) == 0u) { if (xb_ld(&bar[XB_TMO])) break; if (sp > XB_SPIN_CAP) { atomicAdd(&bar[XB_TMO], 1u); break; } }
    }
    nloc = mine > 0u ? mine : 1u; nx = cnt > 0u ? cnt : 1u;
}
__device__ __forceinline__ void xcd_barrier(const XcdBarrier& b) {
    asm volatile("s_waitcnt vmcnt(0)" ::: "memory");
    __syncthreads();
    if (threadIdx.x == 0) {
        unsigned* bar = b.bar;
        __builtin_amdgcn_s_waitcnt(0);
        unsigned nloc = b.st[0], nx = b.st[1];
        if (nloc == 0u) { xcd_barrier_complete(bar, b.x, nloc, nx); b.st[0] = nloc; b.st[1] = nx; }
        const unsigned old = xb_add(&bar[XB_XSUB(b.x)], 1u);
        const unsigned gen = old / nloc;
        if (old + 1u == (gen + 1u) * nloc) {
            __builtin_amdgcn_fence(__ATOMIC_RELEASE, "agent");
            asm volatile("s_waitcnt vmcnt(0)" ::: "memory");
            const unsigned og = xb_add(&bar[XB_TOP], 1u);
            const unsigned tg = og / nx;
            if (og + 1u == (tg + 1u) * nx) xb_add(&bar[XB_TOPGEN], 1u);
            else XB_SPIN(xb_ld(&bar[XB_TOPGEN]) == tg, bar);
            __builtin_amdgcn_fence(__ATOMIC_ACQUIRE, "agent");
            xb_add(&bar[XB_XGEN(b.x)], 1u);
            asm volatile("s_waitcnt vmcnt(0)" ::: "memory");
        } else {
            XB_SPIN(xb_ld(&bar[XB_XGEN(b.x)]) == gen, bar);
            __builtin_amdgcn_fence(__ATOMIC_ACQUIRE, "agent");
            asm volatile("s_waitcnt vmcnt(0)" ::: "memory");
        }
    }
    __syncthreads();
}

__global__ void __launch_bounds__(NTHREADS, 2) fwd_kernel(Params P) {
    extern __shared__ __attribute__((aligned(16))) unsigned char lds[];
    Frame F; F.lds = lds; F.tid = threadIdx.x; F.lane = F.tid & 63; F.wave = __builtin_amdgcn_readfirstlane(F.tid >> 6);
    F.G = gridDim.x; { const int bx = blockIdx.x; F.vcu = (F.G % 8 == 0) ? (bx % 8) * (F.G / 8) + bx / 8 : bx; }
    F.gw = F.vcu * NWAVES + F.wave; F.NGW = F.G * NWAVES;
    unsigned char* ws = P.ws;
    const int lo = P.ph_lo, hi = P.ph_hi;
    volatile LAS unsigned* bst = (volatile LAS unsigned*)((LAS unsigned char*)lds + (LDS_BYTES - 64));
    if (F.tid < 2) bst[F.tid] = 0u;
    __syncthreads();
    const XcdBarrier xbar = xcd_barrier_post((unsigned*)(ws + WS_CTL) + CW_BAR, bst);
#define IN(k) (lo <= (k) && (k) < hi)
#define GRID_BAR() xcd_barrier(xbar)
#define GRID_BAR_CG() do { __syncthreads(); cooperative_groups::this_grid().sync(); } while (0)
    if (IN(0)) p0_prep(F, P);
    if (IN(0) && IN(1)) GRID_BAR_CG();
    if (IN(1)) p1_modulate(F, P);
    if (IN(1) && IN(2)) GRID_BAR();
    if (IN(2)) { pg8::DenseSched S; S.init(ws + WS_H, ws + WS_WIN, T, NPROJ, 1024, F.G, (int)blockIdx.x); pg8::EpiProj E{(bf16_t*)(ws + WS_PROJ), (float*)(ws + WS_DTRAW)}; pg8::gemm_phase(( LAS unsigned char*)lds, S, E); }
    if (IN(2) && IN(3)) GRID_BAR();
    if (IN(3)) p3_conv(F, P);
    if (IN(3) && IN(4)) GRID_BAR();
    if (IN(4)) p4_ssd(F, P);
    if (IN(4) && IN(5)) GRID_BAR();
    if (IN(5)) { pg8::DenseSched S; S.init(ws + WS_MIX, ws + WS_WOUT, T, 1024, 1024, F.G, (int)blockIdx.x); pg8::EpiX1 E{P.in[0], (const float*)(ws + WS_MOD), (float*)(ws + WS_X1), (float*)(ws + WS_SS16)}; pg8::gemm_phase((LAS unsigned char*)lds, S, E); }
    if (IN(5) && IN(6)) GRID_BAR();
    if (IN(6)) p5_route(F, P);
    if (IN(6) && IN(7)) GRID_BAR();
    if (IN(7)) { int* pref = (int*)(lds + MISC_OFF); moe_prefix(F, P, pref);
        pg8::MoeSched<true> S; S.A = (const char*)(ws + WS_H); S.Bt = (const char*)(ws + WS_W13); S.K = 1024; S.nN = 4; S.G = F.G; S.c = F.vcu; S.pref = (const LAS int*)pref; S.list = (const unsigned*)(ws + WS_LIST);
        pg8::EpiAct E{(bf16_t*)(ws + WS_ACT)}; pg8::gemm_phase((LAS unsigned char*)lds, S, E); }
    if (IN(7) && IN(8)) GRID_BAR();
    if (IN(8)) { int* pref = (int*)(lds + MISC_OFF); moe_prefix(F, P, pref);
        pg8::MoeSched<false> S; S.A = (const char*)(ws + WS_ACT); S.Bt = (const char*)(ws + WS_W2); S.K = 512; S.nN = 4; S.G = F.G; S.c = F.vcu; S.pref = (const LAS int*)pref; S.list = (const unsigned*)(ws + WS_LIST);
        pg8::EpiY E{(const unsigned*)(ws + WS_LIST), (const float*)(ws + WS_SGATE), (bf16_t*)(ws + WS_Y0), (bf16_t*)(ws + WS_Y1)}; pg8::gemm_phase((LAS unsigned char*)lds, S, E); }
    if (IN(8) && IN(9)) GRID_BAR();
    if (IN(9)) p8_final(F, P);
#undef IN
#undef GRID_BAR
#undef GRID_BAR_CG
}

extern "C" void kernel_launch(void* const* d_in, const int* in_sizes, int n_in, void* d_out, int out_size, void* d_ws, size_t ws_size, hipStream_t stream) {
    static int grid = 0;
    if (grid == 0) {
        if (n_in != 21 || out_size != T * DM || ws_size < WS_END) { fprintf(stderr, "kernel_launch: unexpected sizes n_in %d out %d ws %zu\n", n_in, out_size, ws_size); grid = -1; return; }
        int dev = 0, cus = 0;
        if (hipGetDevice(&dev) != hipSuccess || hipDeviceGetAttribute(&cus, hipDeviceAttributeMultiprocessorCount, dev) != hipSuccess) { grid = -1; return; }
        if (hipFuncSetAttribute((const void*)fwd_kernel, hipFuncAttributeMaxDynamicSharedMemorySize, LDS_BYTES) != hipSuccess) { fprintf(stderr, "kernel_launch: hipFuncSetAttribute failed\n"); grid = -1; return; }
        int per_cu = 0;
        if (hipOccupancyMaxActiveBlocksPerMultiprocessor(&per_cu, (const void*)fwd_kernel, NTHREADS, LDS_BYTES) != hipSuccess || per_cu < 1) { fprintf(stderr, "kernel_launch: occupancy query says %d blocks per CU\n", per_cu); (void)hipGetLastError(); per_cu = 1; }
        grid = cus;
    }
    if (grid < 0) return;
    (void)hipMemsetAsync((char*)d_ws + WS_CTL, 0, CTL_BYTES, stream);
    Params p{};
    for (int i = 0; i < 21; ++i) p.in[i] = (const float*)d_in[i];
    p.out = (float*)d_out; p.ws = (unsigned char*)d_ws;
    p.ph_lo = 0; p.ph_hi = 10;
    void* args[] = {&p};
    hipError_t e = hipLaunchCooperativeKernel((const void*)fwd_kernel, dim3(grid), dim3(NTHREADS), args, LDS_BYTES, stream);
    if (e != hipSuccess) fprintf(stderr, "kernel_launch: cooperative launch failed: %s (grid %d)\n", hipGetErrorString(e), grid);
}
```

```cpp
#include <hip/hip_runtime.h>
#include <hip/hip_cooperative_groups.h>
#include <cstdio>
#include <cstdint>

#ifndef MK_ONE_LAUNCH
#define MK_ONE_LAUNCH 0
#endif

#define LAS __attribute__((address_space(3)))
typedef unsigned short bf16_t;
typedef short bf16x8 __attribute__((ext_vector_type(8)));
typedef float f32x4 __attribute__((ext_vector_type(4)));
typedef float f32x2 __attribute__((ext_vector_type(2)));
typedef unsigned u32x4 __attribute__((ext_vector_type(4)));
typedef unsigned u32x2 __attribute__((ext_vector_type(2)));

constexpr int BATCH = 32, SEQ = 2048, DM = 1024, T = BATCH * SEQ;
constexpr int NPROJ = 3072, NPROJ_REAL = 2828;
constexpr int COL_Z = 256, COL_XS = 1024, COL_B = 1792, COL_C = 2304, COL_DT = 2816;
constexpr int NEXP = 32, FF = 512, ECAP = 65536;
constexpr int NWAVES = 8, NTHREADS = 512;
constexpr float EPS = 1e-6f;

constexpr size_t MiB = 1u << 20;
constexpr size_t WS_CTL = 0, CTL_BYTES = 1 * MiB;
constexpr size_t WS_MOD = 1 * MiB;
constexpr size_t WS_WR = 2 * MiB;
constexpr size_t WS_SS16 = 4 * MiB;
constexpr size_t WS_SGATE = 120 * MiB;
constexpr size_t WS_DTRAW = 4 * MiB;
constexpr size_t WS_LIST = 8 * MiB;
constexpr size_t WS_WIN = 16 * MiB;
constexpr size_t WS_WOUT = 22 * MiB;
constexpr size_t WS_W13 = 24 * MiB;
constexpr size_t WS_W2 = 88 * MiB;
constexpr size_t WS_H = 128 * MiB;
constexpr size_t WS_PROJ = 256 * MiB;
constexpr size_t WS_MIX = 640 * MiB;
constexpr size_t WS_X1 = 768 * MiB;
constexpr size_t WS_END = 1024 * MiB;
constexpr size_t WS_XA = WS_X1;
constexpr size_t WS_SA = WS_H;
constexpr size_t WS_Y0 = 256 * MiB, WS_Y1 = 384 * MiB;
constexpr size_t WS_ACT = 512 * MiB;
constexpr int CW_GCOUNT = 256;
constexpr int CW_BAR = 4096;

constexpr int LDS_BYTES = 163840;
constexpr int MISC_OFF = 147456;

struct Params {
    const float* in[21];
    float* out;
    unsigned char* ws;
    int ph_lo, ph_hi;
};

__device__ __forceinline__ unsigned cvt_pk_bf16(float lo, float hi) { unsigned r; asm volatile("v_cvt_pk_bf16_f32 %0, %1, %2" : "=v"(r) : "v"(lo), "v"(hi)); return r; }
__device__ __forceinline__ float bf_lo(unsigned u) { return __uint_as_float(u << 16); }
__device__ __forceinline__ float bf_hi(unsigned u) { return __uint_as_float(u & 0xffff0000u); }
__device__ __forceinline__ float wave_sum(float v) {
#pragma unroll
    for (int o = 1; o < 64; o <<= 1) v += __shfl_xor(v, o);
    return v;
}
__device__ __forceinline__ float sigmoidf_(float v) { return __builtin_amdgcn_rcpf(1.0f + __expf(-v)); }
__device__ __forceinline__ float siluf_(float v) { return v * sigmoidf_(v); }

namespace pg8 {
constexpr int BM = 256, BK = 64, HALF = 128, HTB = HALF * BK * 2, STAGE_BYTES = 8 * HTB, NXCD = 8, WGM = 8;
__host__ __device__ __forceinline__ int lds_byte(int r, int c) { const int st = (r >> 4) * 2 + (c >> 5), rr = r & 15, cc = c & 31, ob = rr * 64 + cc * 2; return st * 1024 + (ob ^ (((ob >> 9) & 1) << 5)); }
__host__ __device__ __forceinline__ void stage_rc(int b, int& R, int& C) { const int st = b / 1024, sb = b % 1024, swz = sb ^ (((sb >> 9) & 1) << 5); R = (st >> 1) * 16 + swz / 64; C = (st & 1) * 32 + (swz % 64) / 2; }
__host__ __device__ __forceinline__ int perm32(int rho) { const int n = rho >> 4, i = rho & 15; return 8 * (i >> 2) + 4 * n + (i & 3); }

struct Unit { int pm, pn, e, cnt, slot0; };

struct DenseSched {
    const char* A; const char* Bt; int K;
    int nM, nN, nwg, G, c;
    __device__ void init(const void* A_, const void* Bt_, int M, int N, int K_, int G_, int c_) { A = (const char*)A_; Bt = (const char*)Bt_; K = K_; nM = M / BM; nN = N / BM; nwg = nM * nN; G = G_; c = c_; }
    __device__ __forceinline__ bool next(int i, Unit& u) const {
        const long L = (long)i * G + c; if (L >= nwg) return false;
        int wgid = (int)L; { const int q = nwg / NXCD, r = nwg % NXCD, xcd = wgid % NXCD, off = wgid / NXCD; wgid = (xcd < r ? xcd * (q + 1) : r * (q + 1) + (xcd - r) * q) + off; }
        const int nig = WGM * nN, gid = wgid / nig, fm = gid * WGM, gsz = (nM - fm) < WGM ? (nM - fm) : WGM;
        u.pm = fm + ((wgid % nig) % gsz); u.pn = (wgid % nig) / gsz; u.e = 0; u.cnt = 256; u.slot0 = 0; return true;
    }
    __device__ __forceinline__ const char* a_base() const { return A; }
    __device__ __forceinline__ void a_raw(const Unit& u, const int (&R)[2], unsigned (&raw)[2][2]) const {
#pragma unroll
        for (int h = 0; h < 2; ++h)
#pragma unroll
            for (int i = 0; i < 2; ++i) raw[h][i] = (unsigned)(u.pm * BM + h * HALF + R[i]);
    }
    __device__ __forceinline__ void a_fin(const int (&C)[2], const unsigned (&raw)[2][2], unsigned (&o)[2][2]) const {
#pragma unroll
        for (int h = 0; h < 2; ++h)
#pragma unroll
            for (int i = 0; i < 2; ++i) o[h][i] = (raw[h][i] * (unsigned)K + (unsigned)C[i]) * 2u;
    }
    __device__ __forceinline__ const char* b_ptr(const Unit& u) const { return Bt + (size_t)u.pn * BM * K * 2; }
};

template <bool GATHER>
struct MoeSched {
    const char* A; const char* Bt; int K, nN, G, c;
    const LAS int* pref;
    const unsigned* list;
    __device__ __forceinline__ bool next(int i, Unit& u) const {
        const long L = (long)i * G + c; const int tot = pref[32] * nN; if (L >= tot) return false;
        const int ti = (int)L / nN; u.pn = (int)L % nN;
        int e = 0;
#pragma unroll 1
        for (int j = 1; j < 32; ++j) if (pref[j] <= ti) e = j;
        const int mt = ti - pref[e]; u.pm = ti; u.e = e; u.slot0 = mt * 256; const int rem = pref[33 + e] - mt * 256; u.cnt = rem < 256 ? rem : 256; return true;
    }
    __device__ __forceinline__ const char* a_base() const { return A; }
    __device__ __forceinline__ void a_raw(const Unit& u, const int (&R)[2], unsigned (&raw)[2][2]) const {
#pragma unroll
        for (int h = 0; h < 2; ++h)
#pragma unroll
            for (int i = 0; i < 2; ++i) {
                const int r = h * HALF + R[i];
                if (GATHER) { unsigned ent = 0; if (r < u.cnt) ent = list[(size_t)u.e * ECAP + u.slot0 + r]; raw[h][i] = ent >> 1; }
                else raw[h][i] = (unsigned)(u.pm * BM + r);
            }
    }
    __device__ __forceinline__ void a_fin(const int (&C)[2], const unsigned (&raw)[2][2], unsigned (&o)[2][2]) const {
#pragma unroll
        for (int h = 0; h < 2; ++h)
#pragma unroll
            for (int i = 0; i < 2; ++i) o[h][i] = (raw[h][i] * (unsigned)K + (unsigned)C[i]) * 2u;
    }
    __device__ __forceinline__ const char* b_ptr(const Unit& u) const { return Bt + ((size_t)u.e * (nN * BM) + (size_t)u.pn * BM) * K * 2; }
};

template <class Epi, class Sched>
__device__ __forceinline__ void gemm_phase(LAS unsigned char* lds, const Sched& S, const Epi& E) {
    const int tid = threadIdx.x, wid = __builtin_amdgcn_readfirstlane(tid >> 6), lane = tid & 63, wr = wid >> 2, wc = wid & 3, fr = lane & 15, fq = lane >> 4;
    const int K = S.K, nt = K / BK;
    int sR[2], sC[2]; unsigned voffB[2];
#pragma unroll
    for (int i = 0; i < 2; ++i) { int R, C; stage_rc(tid * 16 + i * 8192, R, C); sR[i] = R; sC[i] = C; const int Rb = Epi::PERM ? ((R & ~31) + perm32(R & 31)) : R; voffB[i] = (unsigned)(Rb * K + C) * 2u; }
    const size_t kstep = (size_t)(BK * 2);
    const size_t hstep = (size_t)HALF * K * 2;
    const unsigned ldsw = (unsigned)wid * 1024u;
    const int aoff = lds_byte(wr * 64 + fr, fq * 8), boff = lds_byte(wc * 32 + fr, fq * 8);
#define PG8_SA(b, h) (((b) * 2 + (h)) * HTB)
#define PG8_SB(b, h) ((4 + (b) * 2 + (h)) * HTB)
#define PG8_STAGE(bufoff, gbase, voff) do { _Pragma("unroll") for (int _i = 0; _i < 2; ++_i) \
        __builtin_amdgcn_global_load_lds((const unsigned*)((const char*)(gbase) + (voff)[_i]), (LAS unsigned*)(lds + (bufoff) + ldsw + _i * 8192), 16, 0, 0); } while (0)
#define PG8_LDA(dst, b, h) do { _Pragma("unroll") for (int m = 0; m < 4; ++m) _Pragma("unroll") for (int k = 0; k < 2; ++k) dst[m][k] = *(const LAS bf16x8*)(lds + PG8_SA(b, h) + aoff + m * 2048 + k * 1024); } while (0)
#define PG8_LDB(dst, b, h) do { _Pragma("unroll") for (int n = 0; n < 2; ++n) _Pragma("unroll") for (int k = 0; k < 2; ++k) dst[n][k] = *(const LAS bf16x8*)(lds + PG8_SB(b, h) + boff + n * 2048 + k * 1024); } while (0)
#define PG8_MMA(ai, bj, At, Bt) do { __builtin_amdgcn_s_setprio(1); _Pragma("unroll") for (int m = 0; m < 4; ++m) _Pragma("unroll") for (int n = 0; n < 2; ++n) _Pragma("unroll") for (int k = 0; k < 2; ++k) \
        acc[ai][bj][m][n] = __builtin_amdgcn_mfma_f32_16x16x32_bf16(Bt[n][k], At[m][k], acc[ai][bj][m][n], 0, 0, 0); __builtin_amdgcn_s_setprio(0); } while (0)
#define PG8_WAIT_V(n) asm volatile("s_waitcnt vmcnt(" #n ")" ::: "memory")
#define PG8_WAIT_L(n) asm volatile("s_waitcnt lgkmcnt(" #n ")" ::: "memory")
#define PG8_BAR __builtin_amdgcn_s_barrier()
#define PG8_SCHED __builtin_amdgcn_sched_barrier(0)
    Unit cur, nxt; int ui = 0;
    if (!S.next(0, cur)) return;
    f32x4 acc[2][2][4][2];
#pragma unroll
    for (int a = 0; a < 2; ++a)
#pragma unroll
        for (int b = 0; b < 2; ++b)
#pragma unroll
            for (int m = 0; m < 4; ++m)
#pragma unroll
                for (int n = 0; n < 2; ++n) acc[a][b][m][n] = (f32x4){0.f, 0.f, 0.f, 0.f};
    bf16x8 At[4][2], B0[2][2], B1[2][2];
    unsigned aoC[2][2], aoN[2][2], rawN[2][2];
    S.a_raw(cur, sR, rawN); S.a_fin(sC, rawN, aoC);
    const char* const Ab = S.a_base();
    const char* cB = S.b_ptr(cur);
    PG8_STAGE(PG8_SB(0, 0), cB, voffB); PG8_STAGE(PG8_SB(0, 1), cB + hstep, voffB); PG8_STAGE(PG8_SA(0, 0), Ab, aoC[0]); PG8_STAGE(PG8_SA(0, 1), Ab, aoC[1]);
    if (wr == 1) PG8_BAR;
    PG8_WAIT_V(2); PG8_BAR;
    PG8_STAGE(PG8_SB(1, 0), cB + kstep, voffB); PG8_STAGE(PG8_SA(1, 0), Ab + kstep, aoC[0]); PG8_STAGE(PG8_SB(1, 1), cB + hstep + kstep, voffB);
    PG8_WAIT_V(6); PG8_BAR;
    for (;;) {
        const bool has_next = S.next(ui + 1, nxt);
        const char* nB = cB;
        if (has_next) { S.a_raw(nxt, sR, rawN); nB = S.b_ptr(nxt); }
#pragma unroll
        for (int h = 0; h < 2; ++h)
#pragma unroll
            for (int i = 0; i < 2; ++i) aoN[h][i] = aoC[h][i];
        for (int t = 0; t < nt; t += 2) {
            const bool last = (t == nt - 2);
            const char* a1 = Ab + (size_t)(t + 1) * kstep;
            const char* a2 = last ? Ab : Ab + (size_t)(t + 2) * kstep; const char* b2 = last ? nB : cB + (size_t)(t + 2) * kstep;
            const char* a3 = a2 + kstep; const char* b3 = b2 + kstep;
            if (last && has_next) {
#pragma unroll
                for (int h = 0; h < 2; ++h)
#pragma unroll
                    for (int i = 0; i < 2; ++i) asm volatile("" : "+v"(rawN[h][i]));
                S.a_fin(sC, rawN, aoN); }
            unsigned o2[2][2];
#pragma unroll
            for (int h = 0; h < 2; ++h)
#pragma unroll
                for (int i = 0; i < 2; ++i) o2[h][i] = last ? aoN[h][i] : aoC[h][i];
            PG8_LDB(B0, 0, 0); PG8_LDB(B1, 0, 1); PG8_SCHED; PG8_LDA(At, 0, 0); PG8_STAGE(PG8_SA(1, 1), a1, aoC[1]);
            PG8_WAIT_V(8); PG8_WAIT_L(0); PG8_BAR; PG8_MMA(0, 0, At, B0); PG8_MMA(0, 1, At, B1); PG8_BAR; PG8_SCHED;
            PG8_LDA(At, 0, 1); PG8_STAGE(PG8_SB(0, 0), b2, voffB); PG8_STAGE(PG8_SB(0, 1), b2 + hstep, voffB); PG8_STAGE(PG8_SA(0, 0), a2, o2[0]);
            PG8_WAIT_V(8); PG8_WAIT_L(0); PG8_BAR; PG8_MMA(1, 0, At, B0); PG8_MMA(1, 1, At, B1); PG8_BAR; PG8_SCHED;
            PG8_LDB(B0, 1, 0); PG8_LDB(B1, 1, 1); PG8_SCHED; PG8_LDA(At, 1, 0); PG8_STAGE(PG8_SA(0, 1), a2, o2[1]);
            PG8_WAIT_V(8); PG8_WAIT_L(0); PG8_BAR; PG8_MMA(0, 0, At, B0); PG8_MMA(0, 1, At, B1); PG8_BAR; PG8_SCHED;
            PG8_LDA(At, 1, 1); PG8_STAGE(PG8_SB(1, 0), b3, voffB); PG8_STAGE(PG8_SB(1, 1), b3 + hstep, voffB); PG8_STAGE(PG8_SA(1, 0), a3, o2[0]);
            PG8_WAIT_V(8); PG8_WAIT_L(0); PG8_BAR; PG8_MMA(1, 0, At, B0); PG8_MMA(1, 1, At, B1); PG8_BAR; PG8_SCHED;
        }
        if (wr == 0) PG8_BAR;
        E(acc, cur, wr, wc, fr, fq);
        if (!has_next) break;
#pragma unroll
        for (int a = 0; a < 2; ++a)
#pragma unroll
            for (int b = 0; b < 2; ++b)
#pragma unroll
                for (int m = 0; m < 4; ++m)
#pragma unroll
                    for (int n = 0; n < 2; ++n) acc[a][b][m][n] = (f32x4){0.f, 0.f, 0.f, 0.f};
        cur = nxt; cB = nB; ++ui;
#pragma unroll
        for (int h = 0; h < 2; ++h)
#pragma unroll
            for (int i = 0; i < 2; ++i) aoC[h][i] = aoN[h][i];
        if (wr == 1) PG8_BAR;
    }
    PG8_WAIT_V(0);
    PG8_BAR;
#undef PG8_SA
#undef PG8_SB
#undef PG8_STAGE
#undef PG8_LDA
#undef PG8_LDB
#undef PG8_MMA
#undef PG8_WAIT_V
#undef PG8_WAIT_L
#undef PG8_BAR
#undef PG8_SCHED
}

struct EpiProj {
    static constexpr bool PERM = true;
    bf16_t* O; float* dtraw;
    __device__ __forceinline__ void operator()(const f32x4 (&acc)[2][2][4][2], const Unit& u, int wr, int wc, int fr, int fq) const {
        const int row0 = u.pm * BM + wr * 64 + fr, col0 = u.pn * BM + wc * 32 + 8 * fq;
#pragma unroll
        for (int ai = 0; ai < 2; ++ai)
#pragma unroll
            for (int m = 0; m < 4; ++m) { const int row = row0 + ai * HALF + m * 16; bf16_t* rowp = O + (size_t)row * NPROJ + col0;
#pragma unroll
                for (int bj = 0; bj < 2; ++bj) { const f32x4 v0 = acc[ai][bj][m][0], v1 = acc[ai][bj][m][1];
                    u32x4 w; w.x = cvt_pk_bf16(v0[0], v0[1]); w.y = cvt_pk_bf16(v0[2], v0[3]); w.z = cvt_pk_bf16(v1[0], v1[1]); w.w = cvt_pk_bf16(v1[2], v1[3]);
                    *(u32x4*)(rowp + bj * HALF) = w; }
                if (u.pn == 11 && wc == 0 && fq < 2) { float* d = dtraw + (size_t)row * 16 + 8 * fq; *(f32x4*)d = acc[ai][0][m][0]; *(f32x4*)(d + 4) = acc[ai][0][m][1]; }
            }
    }
};
struct EpiX1 {
    static constexpr bool PERM = false;
    const float* x; const float* mod; float* x1; float* ss16;
    __device__ __forceinline__ void operator()(const f32x4 (&acc)[2][2][4][2], const Unit& u, int wr, int wc, int fr, int fq) const {
        const int row0 = u.pm * BM + wr * 64 + fr, col0 = u.pn * BM + wc * 32 + 4 * fq; const int b = (u.pm * BM) >> 11;
        f32x4 gv[2][2];
#pragma unroll
        for (int bj = 0; bj < 2; ++bj)
#pragma unroll
            for (int n = 0; n < 2; ++n) gv[bj][n] = *(const f32x4*)(mod + (size_t)b * 6144 + 2 * 1024 + col0 + bj * HALF + n * 16);
#pragma unroll
        for (int ai = 0; ai < 2; ++ai)
#pragma unroll
            for (int m = 0; m < 4; ++m) { const int row = row0 + ai * HALF + m * 16; const size_t off = (size_t)row * DM + col0; float ss = 0.f;
#pragma unroll
                for (int bj = 0; bj < 2; ++bj)
#pragma unroll
                    for (int n = 0; n < 2; ++n) { const f32x4 xv = *(const f32x4*)(x + off + bj * HALF + n * 16); const f32x4 o = xv + gv[bj][n] * acc[ai][bj][m][n]; *(f32x4*)(x1 + off + bj * HALF + n * 16) = o;
                        ss += (o[0] * o[0] + o[1] * o[1]) + (o[2] * o[2] + o[3] * o[3]); }
                ss += __shfl_xor(ss, 16); ss += __shfl_xor(ss, 32);
                if (fq == 0) ss16[(size_t)row * 16 + u.pn * 4 + wc] = ss; }
    }
};
struct EpiAct {
    static constexpr bool PERM = true;
    bf16_t* act;
    __device__ __forceinline__ void operator()(const f32x4 (&acc)[2][2][4][2], const Unit& u, int wr, int wc, int fr, int fq) const {
        const int row0 = u.pm * BM + wr * 64 + fr, col0 = u.pn * HALF + wc * 32 + 8 * fq;
#pragma unroll
        for (int ai = 0; ai < 2; ++ai)
#pragma unroll
            for (int m = 0; m < 4; ++m) { bf16_t* p = act + (size_t)(row0 + ai * HALF + m * 16) * FF + col0; float o[8];
#pragma unroll
                for (int n = 0; n < 2; ++n)
#pragma unroll
                    for (int i = 0; i < 4; ++i) { const float a = acc[ai][0][m][n][i], b = acc[ai][1][m][n][i]; o[n * 4 + i] = siluf_(a) * b; }
                u32x4 w; w.x = cvt_pk_bf16(o[0], o[1]); w.y = cvt_pk_bf16(o[2], o[3]); w.z = cvt_pk_bf16(o[4], o[5]); w.w = cvt_pk_bf16(o[6], o[7]);
                *(u32x4*)p = w; }
    }
};
struct EpiY {
    static constexpr bool PERM = true;
    const unsigned* list; const float* gates; bf16_t* Y0; bf16_t* Y1;
    __device__ __forceinline__ void operator()(const f32x4 (&acc)[2][2][4][2], const Unit& u, int wr, int wc, int fr, int fq) const {
        const int col0 = u.pn * BM + wc * 32 + 8 * fq; const size_t sb = (size_t)u.e * ECAP + u.slot0;
        unsigned ent[2][4]; float gt[2][4];
#pragma unroll
        for (int ai = 0; ai < 2; ++ai)
#pragma unroll
            for (int m = 0; m < 4; ++m) { const int r = ai * HALF + wr * 64 + m * 16 + fr; const int rc = r < u.cnt ? r : 0; ent[ai][m] = list[sb + rc]; gt[ai][m] = gates[sb + rc]; }
#pragma unroll
        for (int ai = 0; ai < 2; ++ai)
#pragma unroll
            for (int m = 0; m < 4; ++m) { const int r = ai * HALF + wr * 64 + m * 16 + fr;
                if (r < u.cnt) {
                    const unsigned tok = ent[ai][m] >> 1; const float gate = gt[ai][m];
                    bf16_t* yp = ((ent[ai][m] & 1u) ? Y1 : Y0) + (size_t)tok * DM + col0;
#pragma unroll
                    for (int bj = 0; bj < 2; ++bj) { const f32x4 v0 = acc[ai][bj][m][0] * gate, v1 = acc[ai][bj][m][1] * gate;
                        u32x4 w; w.x = cvt_pk_bf16(v0[0], v0[1]); w.y = cvt_pk_bf16(v0[2], v0[3]); w.z = cvt_pk_bf16(v1[0], v1[1]); w.w = cvt_pk_bf16(v1[2], v1[3]);
                        *(u32x4*)(yp + bj * HALF) = w; } } }
    }
};
}

struct Frame {
    unsigned char* lds; int tid, lane, wave, vcu, G, gw, NGW;
};

struct TrItem { const float* src; bf16_t* dst; int ldw, nrel, K; };
__device__ __forceinline__ void tr_load(const TrItem& t, int lane, f32x4 (&v)[8]) {
    const int c4 = (lane & 7) * 4;
#pragma unroll
    for (int i = 0; i < 8; ++i) { const int kk = (lane >> 3) + 8 * i; v[i] = (c4 < t.nrel) ? *(const f32x4*)(t.src + (size_t)kk * t.ldw + c4) : (f32x4){0.f, 0.f, 0.f, 0.f}; }
}
__device__ __forceinline__ void tr_to_lds(const f32x4 (&v)[8], float* scr, int lane) {
    const int c4 = (lane & 7) * 4;
#pragma unroll
    for (int i = 0; i < 8; ++i) { const int kk = (lane >> 3) + 8 * i; float* p = scr + kk * 33 + c4; p[0] = v[i][0]; p[1] = v[i][1]; p[2] = v[i][2]; p[3] = v[i][3]; }
    asm volatile("s_waitcnt lgkmcnt(0)" ::: "memory");
}
__device__ __forceinline__ void tr_store(const TrItem& t, const float* scr, int lane) {
    const int c = lane & 7;
#pragma unroll
    for (int j = 0; j < 4; ++j) { const int n = (lane >> 3) + 8 * j; const float* s = scr + (8 * c) * 33 + n;
        u32x4 o; o.x = cvt_pk_bf16(s[0 * 33], s[1 * 33]); o.y = cvt_pk_bf16(s[2 * 33], s[3 * 33]); o.z = cvt_pk_bf16(s[4 * 33], s[5 * 33]); o.w = cvt_pk_bf16(s[6 * 33], s[7 * 33]);
        *(u32x4*)(t.dst + (size_t)n * t.K + 8 * c) = o; }
    asm volatile("s_waitcnt lgkmcnt(0)" ::: "memory");
}
__device__ __forceinline__ void p0_prep(const Frame& F, const Params& P) {
    unsigned char* ws = P.ws;
    {
        float* sct = (float*)F.lds;
        const float* c = P.in[1];
        for (int idx = F.tid; idx < 32 * 1024; idx += NTHREADS) { const int b = idx >> 10, k = idx & 1023; sct[k * 32 + b] = siluf_(c[idx]); }
        __syncthreads();
        const float* w_ada = P.in[2]; const float* b_ada = P.in[3]; float* mod = (float*)(ws + WS_MOD);
        for (int cg = F.vcu; cg < 256; cg += F.G) {
            const int j = F.tid % 24, kg = F.tid / 24;
            float acc[32];
#pragma unroll
            for (int b = 0; b < 32; ++b) acc[b] = 0.f;
            if (kg < 16) {
                for (int kb = 0; kb < 4; ++kb) { float wv[16];
#pragma unroll
                    for (int kk = 0; kk < 16; ++kk) wv[kk] = w_ada[(size_t)(kg * 64 + kb * 16 + kk) * 6144 + cg * 24 + j];
#pragma unroll
                    for (int kk = 0; kk < 16; ++kk) { const int k = kg * 64 + kb * 16 + kk; const float w = wv[kk];
#pragma unroll
                        for (int q = 0; q < 8; ++q) { const f32x4 s = *(const f32x4*)(sct + k * 32 + 4 * q); acc[4 * q] += s[0] * w; acc[4 * q + 1] += s[1] * w; acc[4 * q + 2] += s[2] * w; acc[4 * q + 3] += s[3] * w; } } }
            }
            float* px = (float*)(F.lds + 131072);
            float tot[2] = {0.f, 0.f};
#pragma unroll 1
            for (int half = 0; half < 2; ++half) {
                if (kg < 16 && (kg >> 3) == half) {
#pragma unroll
                    for (int b = 0; b < 32; ++b) px[((kg & 7) * 24 + j) * 32 + b] = acc[b];
                }
                __syncthreads();
#pragma unroll
                for (int r = 0; r < 2; ++r) { const int o = F.tid + r * 512; if (o < 768) { float s = 0.f;
#pragma unroll
                        for (int q = 0; q < 8; ++q) s += px[q * 768 + o]; tot[r] += s; } }
                __syncthreads();
            }
#pragma unroll
            for (int r = 0; r < 2; ++r) { const int o = F.tid + r * 512; if (o < 768) { const int jj = o >> 5, b = o & 31; mod[(size_t)b * 6144 + cg * 24 + jj] = tot[r] + b_ada[cg * 24 + jj]; } }
        }
        __syncthreads();
    }
    {
        float* scr = (float*)(F.lds + F.wave * 16384);
        const float* w_in = P.in[4]; const float* w_out = P.in[13]; const float* w13 = P.in[18]; const float* w2 = P.in[19];
        bf16_t* WIN = (bf16_t*)(ws + WS_WIN); bf16_t* WOUT = (bf16_t*)(ws + WS_WOUT); bf16_t* W13 = (bf16_t*)(ws + WS_W13); bf16_t* W2 = (bf16_t*)(ws + WS_W2);
        constexpr int I0 = 16 * 88, I1 = 16 * 32, I2 = 32 * 16 * 32, I3 = 32 * 8 * 32, NIT = I0 + I1 + I2 + I3;
        auto decode = [&](int it) -> TrItem {
            TrItem t; int r = it;
            if (r < I0) { const int kb = r / 88, nb = 8 + r % 88, n0 = nb * 32; t.src = w_in + (size_t)kb * 64 * NPROJ_REAL + n0; t.ldw = NPROJ_REAL; t.nrel = NPROJ_REAL - n0; t.dst = WIN + (size_t)n0 * 1024 + kb * 64; t.K = 1024; return t; } r -= I0;
            if (r < I1) { const int kb = r / 32, nb = r % 32, n0 = nb * 32; t.src = w_out + (size_t)kb * 64 * 1024 + n0; t.ldw = 1024; t.nrel = 32; t.dst = WOUT + (size_t)n0 * 1024 + kb * 64; t.K = 1024; return t; } r -= I1;
            if (r < I2) { const int e = r / 512, q = r % 512, kb = q / 32, nb = q % 32; const int n0 = nb * 32, bj = n0 >> 9, rem = n0 & 511, pn = rem >> 7, j0 = rem & 127;
                t.src = w13 + (size_t)e * 1024 * 1024 + (size_t)kb * 64 * 1024 + n0; t.ldw = 1024; t.nrel = 32; t.dst = W13 + (size_t)e * 1024 * 1024 + (size_t)(pn * 256 + bj * 128 + j0) * 1024 + kb * 64; t.K = 1024; return t; } r -= I2;
            { const int e = r / 256, q = r % 256, kb = q / 32, nb = q % 32, n0 = nb * 32;
                t.src = w2 + (size_t)e * 512 * 1024 + (size_t)kb * 64 * 1024 + n0; t.ldw = 1024; t.nrel = 32; t.dst = W2 + (size_t)e * 1024 * 512 + (size_t)n0 * 512 + kb * 64; t.K = 512; return t; }
        };
        int it = F.gw; f32x4 v[8]; TrItem cur;
        if (it < NIT) { cur = decode(it); tr_load(cur, F.lane, v); }
        while (it < NIT) {
            tr_to_lds(v, scr, F.lane);
            const int nx = it + F.NGW; TrItem nxt = cur;
            if (nx < NIT) { nxt = decode(nx); tr_load(nxt, F.lane, v); }
            tr_store(cur, scr, F.lane);
            cur = nxt; it = nx;
        }
    }
    {
        const float* w_in = P.in[4]; const float* w_pool = P.in[5]; const float* pscale = P.in[6]; bf16_t* WIN = (bf16_t*)(ws + WS_WIN);
        for (int idx = F.vcu * NTHREADS + F.tid; idx < 256 * 1024; idx += F.G * NTHREADS) {
            const int n = idx >> 10, k = idx & 1023, g = n >> 6, d = n & 63; const float* wi = w_in + (size_t)k * NPROJ_REAL + g * 64; const float* wp = w_pool + (size_t)g * 4096 + d;
            float s = 0.f;
#pragma unroll 8
            for (int cc = 0; cc < 64; ++cc) s += wi[cc] * wp[cc * 64];
            s *= pscale[n];
            WIN[(size_t)n * 1024 + k] = (bf16_t)(cvt_pk_bf16(s, 0.f) & 0xffffu);
        }
    }
    {
        const float* wg = P.in[14]; const float* wrt = P.in[16]; bf16_t* WRH = (bf16_t*)(ws + WS_WR); bf16_t* WRL = (bf16_t*)(ws + WS_WR + 131072);
        for (int idx = F.vcu * NTHREADS + F.tid; idx < 36 * 1024; idx += F.G * NTHREADS) { const int j = idx >> 10, k = idx & 1023; const float w = (j < 4) ? wg[k * 4 + j] : wrt[k * 32 + (j - 4)];
            const unsigned hi = cvt_pk_bf16(w, 0.f) & 0xffffu; const float lo = w - __uint_as_float(hi << 16); WRH[idx] = (bf16_t)hi; WRL[idx] = (bf16_t)(cvt_pk_bf16(lo, 0.f) & 0xffffu); }
    }
}

__device__ __forceinline__ void p1_modulate(const Frame& F, const Params& P) {
    const float* x = P.in[0]; const float* mod = (const float*)(P.ws + WS_MOD); bf16_t* H = (bf16_t*)(P.ws + WS_H);
    for (int row = F.gw; row < T; row += F.NGW) {
        const int b = row >> 11; const f32x4* xr = (const f32x4*)(x + (size_t)row * DM) + F.lane;
        f32x4 v[4]; float s = 0.f;
#pragma unroll
        for (int j = 0; j < 4; ++j) { v[j] = xr[64 * j]; s += (v[j][0] * v[j][0] + v[j][1] * v[j][1]) + (v[j][2] * v[j][2] + v[j][3] * v[j][3]); }
        const float rstd = rsqrtf(wave_sum(s) * (1.f / DM) + EPS);
        const f32x4* sh = (const f32x4*)(mod + (size_t)b * 6144) + F.lane; const f32x4* sc = (const f32x4*)(mod + (size_t)b * 6144 + 1024) + F.lane;
        u32x2* o = (u32x2*)(H + (size_t)row * DM) + F.lane;
#pragma unroll
        for (int j = 0; j < 4; ++j) { const f32x4 a = sh[64 * j], m = sc[64 * j]; const f32x4 h = v[j] * rstd * (m + 1.0f) + a; u32x2 w; w.x = cvt_pk_bf16(h[0], h[1]); w.y = cvt_pk_bf16(h[2], h[3]); o[64 * j] = w; }
    }
}

template <int W>
__device__ __forceinline__ void pool_item(const bf16_t* src, bf16_t* dst, int t0) {
    u32x4 hist[W - 1], cur[16];
#pragma unroll
    for (int i = 0; i < 16; ++i) cur[i] = *(const u32x4*)(src + (size_t)i * NPROJ);
    if (t0 > 0) {
#pragma unroll
        for (int h = 0; h < W - 1; ++h) hist[h] = *(const u32x4*)(src - (size_t)(W - 1 - h) * NPROJ); }
    else {
#pragma unroll
        for (int h = 0; h < W - 1; ++h) hist[h] = (u32x4){0u, 0u, 0u, 0u}; }
#define UNP8P(dst, v) do { dst[0] = bf_lo(v.x); dst[1] = bf_hi(v.x); dst[2] = bf_lo(v.y); dst[3] = bf_hi(v.y); dst[4] = bf_lo(v.z); dst[5] = bf_hi(v.z); dst[6] = bf_lo(v.w); dst[7] = bf_hi(v.w); } while (0)
    float sum[8];
#pragma unroll
    for (int k = 0; k < 8; ++k) sum[k] = 0.f;
#pragma unroll
    for (int h = 0; h < W - 1; ++h) { float e[8]; UNP8P(e, hist[h]);
#pragma unroll
        for (int k = 0; k < 8; ++k) sum[k] += e[k]; }
#pragma unroll
    for (int i = 0; i < 16; ++i) {
        float c[8]; UNP8P(c, cur[i]);
#pragma unroll
        for (int k = 0; k < 8; ++k) sum[k] += c[k];
        if (i >= 1) { float o[8]; if (i <= W - 1) UNP8P(o, hist[i - 1 < W - 1 ? i - 1 : 0]); else UNP8P(o, cur[i - W >= 0 ? i - W : 0]);
#pragma unroll
            for (int k = 0; k < 8; ++k) sum[k] -= o[k]; }
        const int cnt = (t0 > 0) ? W : ((i + 1) < W ? (i + 1) : W); const float inv = 1.0f / (float)cnt;
        u32x4 pk; pk.x = cvt_pk_bf16(sum[0] * inv - c[0], sum[1] * inv - c[1]); pk.y = cvt_pk_bf16(sum[2] * inv - c[2], sum[3] * inv - c[3]);
        pk.z = cvt_pk_bf16(sum[4] * inv - c[4], sum[5] * inv - c[5]); pk.w = cvt_pk_bf16(sum[6] * inv - c[6], sum[7] * inv - c[7]);
        *(u32x4*)(dst + (size_t)i * DM) = pk;
    }
#undef UNP8P
}

__device__ __forceinline__ void p3_conv(const Frame& F, const Params& P) {
    const bf16_t* proj = (const bf16_t*)(P.ws + WS_PROJ); bf16_t* XA = (bf16_t*)(P.ws + WS_XA);
    const float* conv_w = P.in[7]; const float* conv_b = P.in[8];
    if (F.wave < 2) {
        const float* dtraw = (const float*)(P.ws + WS_DTRAW); float* SA = (float*)(P.ws + WS_SA);
        const float* dt_bias = P.in[9]; const float* a_log = P.in[10];
        for (int bc = F.vcu * 2 + F.wave; bc < BATCH * 16; bc += F.G * 2) {
            const int h = F.lane < 48 ? (F.lane >> 2) : 11, seg = F.lane & 3; const float a = -__expf(a_log[h]), dtb = dt_bias[h];
            const float* src = dtraw + ((size_t)bc * 128 + 32 * seg) * 16 + h;
            float raw[32], dt[32], cs[32];
#pragma unroll
            for (int j = 0; j < 32; ++j) raw[j] = src[j * 16];
            float run = 0.f;
#pragma unroll
            for (int j = 0; j < 32; ++j) { const float v = raw[j] + dtb; dt[j] = v > 20.f ? v : log1pf(__expf(v)); run += dt[j] * a; cs[j] = run; }
            const float s0 = __shfl(run, (F.lane & ~3) + 0), s1 = __shfl(run, (F.lane & ~3) + 1), s2 = __shfl(run, (F.lane & ~3) + 2), s3 = __shfl(run, (F.lane & ~3) + 3);
            const float base = (seg > 0 ? s0 : 0.f) + (seg > 1 ? s1 : 0.f) + (seg > 2 ? s2 : 0.f); const float a127 = ((s0 + s1) + s2) + s3;
            if (F.lane < 48) {
                float* dst = SA + ((size_t)bc * 4 + h / 3) * 1536 + (h % 3) * 128 + 32 * seg;
#pragma unroll
                for (int j4 = 0; j4 < 8; ++j4) { f32x4 vd, va, vw, ve;
#pragma unroll
                    for (int e = 0; e < 4; ++e) { const int j = 4 * j4 + e; const float ac = base + cs[j], ae = base + cs[j | 15]; vd[e] = dt[j]; va[e] = ac; vw[e] = dt[j] * __expf(a127 - ac); ve[e] = dt[j] * __expf(ae - ac); }
                    *(f32x4*)(dst + 4 * j4) = vd; *(f32x4*)(dst + 384 + 4 * j4) = va; *(f32x4*)(dst + 768 + 4 * j4) = vw; *(f32x4*)(dst + 1152 + 4 * j4) = ve; }
            }
        }
    }
    for (int item = F.vcu * NTHREADS + F.tid; item < (T / 16) * 224; item += F.G * NTHREADS) {
        const int cg = item % 224, rr = item / 224, ch = cg * 8, row0 = rr * 16, t0 = row0 & (SEQ - 1);
        const bf16_t* src = proj + (size_t)row0 * NPROJ + COL_XS + ch;
        u32x4 raw[19];
#pragma unroll
        for (int i = 0; i < 16; ++i) raw[3 + i] = *(const u32x4*)(src + (size_t)i * NPROJ);
        if (t0 >= 3) {
#pragma unroll
            for (int i = 0; i < 3; ++i) raw[i] = *(const u32x4*)(src - (size_t)(3 - i) * NPROJ); }
        else { raw[0] = (u32x4){0u, 0u, 0u, 0u}; raw[1] = raw[0]; raw[2] = raw[0]; }
        float w[4][8], bs[8];
#pragma unroll
        for (int j = 0; j < 4; ++j) { const f32x4 a = *(const f32x4*)(conv_w + j * 1792 + ch), c = *(const f32x4*)(conv_w + j * 1792 + ch + 4);
#pragma unroll
            for (int k = 0; k < 4; ++k) { w[j][k] = a[k]; w[j][4 + k] = c[k]; } }
        { const f32x4 a = *(const f32x4*)(conv_b + ch), c = *(const f32x4*)(conv_b + ch + 4);
#pragma unroll
            for (int k = 0; k < 4; ++k) { bs[k] = a[k]; bs[4 + k] = c[k]; } }
#define UNP8(dst, v) do { dst[0] = bf_lo(v.x); dst[1] = bf_hi(v.x); dst[2] = bf_lo(v.y); dst[3] = bf_hi(v.y); dst[4] = bf_lo(v.z); dst[5] = bf_hi(v.z); dst[6] = bf_lo(v.w); dst[7] = bf_hi(v.w); } while (0)
        float r0[8], r1[8], r2[8];
        UNP8(r0, raw[0]); UNP8(r1, raw[1]); UNP8(r2, raw[2]);
#pragma unroll
        for (int i = 0; i < 16; ++i) {
            float cur[8]; UNP8(cur, raw[3 + i]); float o[8];
#pragma unroll
            for (int k = 0; k < 8; ++k) { const float v = bs[k] + w[0][k] * r0[k] + w[1][k] * r1[k] + w[2][k] * r2[k] + w[3][k] * cur[k]; o[k] = siluf_(v); r0[k] = r1[k]; r1[k] = r2[k]; r2[k] = cur[k]; }
            u32x4 pk; pk.x = cvt_pk_bf16(o[0], o[1]); pk.y = cvt_pk_bf16(o[2], o[3]); pk.z = cvt_pk_bf16(o[4], o[5]); pk.w = cvt_pk_bf16(o[6], o[7]);
            *(u32x4*)(XA + (size_t)(row0 + i) * 1792 + ch) = pk;
        }
    }
    { bf16_t* mix = (bf16_t*)(P.ws + WS_MIX);
      for (int p = F.vcu * NTHREADS + F.tid; p < (T / 16) * 32; p += F.G * NTHREADS) {
        const int c8 = p & 7, rr8 = (p >> 3) & 7, grp = (p >> 6) & 3, rrblk = p >> 8; const int rr = rrblk * 8 + rr8, row0 = rr * 16, t0 = row0 & (SEQ - 1), col = grp * 64 + c8 * 8;
        const bf16_t* src = proj + (size_t)row0 * NPROJ + col; bf16_t* dst = mix + (size_t)row0 * DM + col;
        if (grp == 0) pool_item<2>(src, dst, t0); else if (grp == 1) pool_item<4>(src, dst, t0); else if (grp == 2) pool_item<8>(src, dst, t0); else pool_item<16>(src, dst, t0);
      } }
#undef UNP8
}

constexpr int L_B = 0, L_C = 32768, L_X = 49152, L_S = 98304, L_DT = 147456, L_ACS = L_DT + 1536, L_W = L_ACS + 1536, L_ES = L_W + 1536, L_NW = L_ES + 1536, L_T = L_NW + 768;
static_assert(L_T + 22 * 384 <= LDS_BYTES - 64, "SSD LDS map");
typedef short v4i16 __attribute__((ext_vector_type(4)));
__device__ __forceinline__ int swz16(int r) { const int h = (r >> 3) & 1; return ((((r & 7) + 4 * h) & 7) << 1) | h; }
__device__ __forceinline__ int swz8(int row) { return ((row >> 1) & 3) << 1; }
__device__ __forceinline__ bf16x8 tr_pair(LAS unsigned char* a0, LAS unsigned char* a1) {
    const v4i16 lo = __builtin_amdgcn_ds_read_tr16_b64_v4i16((LAS v4i16*)a0), hi = __builtin_amdgcn_ds_read_tr16_b64_v4i16((LAS v4i16*)a1);
    return (bf16x8){lo[0], lo[1], lo[2], lo[3], hi[0], hi[1], hi[2], hi[3]};
}
__device__ __forceinline__ bf16x8 pack8(const float (&v)[8]) {
    u32x4 p; p.x = cvt_pk_bf16(v[0], v[1]); p.y = cvt_pk_bf16(v[2], v[3]); p.z = cvt_pk_bf16(v[4], v[5]); p.w = cvt_pk_bf16(v[6], v[7]);
    return __builtin_bit_cast(bf16x8, p);
}
#define MFMA16(a, b, c) __builtin_amdgcn_mfma_f32_16x16x32_bf16((a), (b), (c), 0, 0, 0)
#define OPAQUE(x) asm volatile("" : "+v"(x))
#define SBAR() do { asm volatile("s_waitcnt lgkmcnt(0)" ::: "memory"); __builtin_amdgcn_s_barrier(); asm volatile("" ::: "memory"); } while (0)

#define SSD_LANE() int ln_ = lane; OPAQUE(ln_); const int i = ln_ & 15, q = ln_ >> 4, qp = i >> 2, pp = ln_ & 3; (void)qp; (void)pp
#define SSD_PR() int pr[4]; { const int fsw = swz16(i); _Pragma("unroll") for (int ks = 0; ks < 4; ++ks) { pr[ks] = i * 256 + (((4 * ks + q) ^ fsw) << 4); OPAQUE(pr[ks]); } }
template <int CH>
__device__ __forceinline__ void ssd_compute(LAS unsigned char* L, int lt, int hl, int lane, f32x4 (&sacc)[2][6], f32x4 (&yacc)[6], float dsk0, float dsk1) {
    const int gl = 4 * hl + lt;
    const int lrow0 = 16 * gl;
    f32x4 cbt[8];
    {
        SSD_LANE(); SSD_PR();
        int cbase = lt * 4096; OPAQUE(cbase);
        bf16x8 cfrag[4];
#pragma unroll
        for (int ks = 0; ks < 4; ++ks) cfrag[ks] = *(const LAS bf16x8*)(L + L_C + cbase + pr[ks]);
#pragma unroll
        for (int tp = 0; tp < 4; ++tp) {
            f32x4 a0 = (f32x4){0.f, 0.f, 0.f, 0.f}, a1 = a0;
            if (2 * tp <= gl) {
                bf16x8 f0[4], f1[4];
#pragma unroll
                for (int ks = 0; ks < 4; ++ks) { f0[ks] = *(const LAS bf16x8*)(L + L_B + (2 * tp) * 4096 + pr[ks]); f1[ks] = *(const LAS bf16x8*)(L + L_B + (2 * tp + 1) * 4096 + pr[ks]); }
#pragma unroll
                for (int ks = 0; ks < 4; ++ks) { a0 = MFMA16(f0[ks], cfrag[ks], a0); a1 = MFMA16(f1[ks], cfrag[ks], a1); }
            }
            cbt[2 * tp] = a0; cbt[2 * tp + 1] = a1;
            __builtin_amdgcn_sched_barrier(0);
        }
    }
    bf16x8 mfrag[2][4];
    {
        SSD_LANE();
        int q16 = 16 * q; OPAQUE(q16);
        int lq = (lrow0 + 4 * q) * 4; OPAQUE(lq);
        int li = (lrow0 + i) * 4; OPAQUE(li);
        int dq = i - 4 * q; OPAQUE(dq);
        float acl[2];
#pragma unroll
        for (int hsel = 0; hsel < 2; ++hsel) acl[hsel] = *(const LAS float*)(L + L_ACS + (CH + hsel) * 512 + li);
#pragma unroll
        for (int kk = 0; kk < 4; ++kk) {
            f32x4 es[2][2]; float ae[2][2];
#pragma unroll
            for (int hsel = 0; hsel < 2; ++hsel)
#pragma unroll
                for (int hf = 0; hf < 2; ++hf) { const int ts = 2 * kk + hf, r = CH + hsel; es[hsel][hf] = *(const LAS f32x4*)(L + L_ES + r * 512 + ts * 64 + q16); ae[hsel][hf] = *(const LAS float*)(L + L_ACS + r * 512 + (16 * ts + 15) * 4); }
#pragma unroll
            for (int hsel = 0; hsel < 2; ++hsel) { const int r = CH + hsel; const float dsk = hsel ? dsk1 : dsk0; float v[8];
#pragma unroll
                for (int hf = 0; hf < 2; ++hf) { const int ts = 2 * kk + hf;
                    if (ts < gl) { const float el = __expf(acl[hsel] - ae[hsel][hf]);
#pragma unroll
                        for (int j = 0; j < 4; ++j) v[4 * hf + j] = cbt[ts][j] * el * es[hsel][hf][j]; }
                    else if (ts == gl) { const f32x4 asd = *(const LAS f32x4*)(L + L_ACS + r * 512 + lq), dsd = *(const LAS f32x4*)(L + L_DT + r * 512 + lq);
#pragma unroll
                        for (int j = 0; j < 4; ++j) { const float arg = fminf(acl[hsel] - asd[j], 0.f); const float cd = cbt[ts][j] * dsd[j]; const float m = cd * __expf(arg);
                            v[4 * hf + j] = (j < dq) ? m : ((j == dq) ? (cd + dsk) : 0.f); } }
                    else {
#pragma unroll
                        for (int j = 0; j < 4; ++j) v[4 * hf + j] = 0.f; } }
                mfrag[hsel][kk] = pack8(v); }
            __builtin_amdgcn_sched_barrier(0);
        }
    }
    {
        SSD_LANE(); SSD_PR();
        int cbase = lt * 4096; OPAQUE(cbase);
        int lq = (lrow0 + 4 * q) * 4; OPAQUE(lq);
        bf16x8 cfrag[4];
#pragma unroll
        for (int ks = 0; ks < 4; ++ks) cfrag[ks] = *(const LAS bf16x8*)(L + L_C + cbase + pr[ks]);
#pragma unroll
        for (int cp = 0; cp < 3; ++cp) { bf16x8 f0[4], f1[4];
#pragma unroll
            for (int ks = 0; ks < 4; ++ks) { f0[ks] = *(const LAS bf16x8*)(L + L_S + (96 * CH + 32 * cp) * 256 + pr[ks]); f1[ks] = *(const LAS bf16x8*)(L + L_S + (96 * CH + 32 * cp + 16) * 256 + pr[ks]); }
            f32x4 a0 = (f32x4){0.f, 0.f, 0.f, 0.f}, a1 = a0;
#pragma unroll
            for (int ks = 0; ks < 4; ++ks) { a0 = MFMA16(cfrag[ks], f0[ks], a0); a1 = MFMA16(cfrag[ks], f1[ks], a1); }
            yacc[2 * cp] = a0; yacc[2 * cp + 1] = a1; }
#pragma unroll
        for (int hsel = 0; hsel < 2; ++hsel) { const f32x4 ac4 = *(const LAS f32x4*)(L + L_ACS + (CH + hsel) * 512 + lq); const f32x4 e = (f32x4){__expf(ac4[0]), __expf(ac4[1]), __expf(ac4[2]), __expf(ac4[3])};
#pragma unroll
            for (int ct = 0; ct < 6; ++ct) if ((((6 * CH + ct) >> 2) - CH) == hsel) yacc[ct] = yacc[ct] * e; }
    }
#pragma unroll
    for (int hsel = 0; hsel < 2; ++hsel) { const float cd = __expf(*(const LAS float*)(L + L_ACS + (CH + hsel) * 512 + 127 * 4));
#pragma unroll
        for (int ct = 0; ct < 6; ++ct) if ((((6 * CH + ct) >> 2) - CH) == hsel) { sacc[0][ct] = sacc[0][ct] * cd; sacc[1][ct] = sacc[1][ct] * cd; } }
    __builtin_amdgcn_sched_barrier(0);
    SSD_LANE();
    int q16 = 16 * q; OPAQUE(q16);
    const int r4 = 4 * q + qp;
    int tb[2], tx[4];
    { const int fr = swz16(r4), xr = swz8(r4);
#pragma unroll
      for (int nt2 = 0; nt2 < 2; ++nt2) { tb[nt2] = r4 * 256 + 8 * (pp & 1) + (((2 * (2 * lt + nt2) + (pp >> 1)) ^ fr) << 4); OPAQUE(tb[nt2]); }
#pragma unroll
      for (int pt = 0; pt < 4; ++pt) { tx[pt] = r4 * 128 + 8 * (pp & 1) + (((2 * pt + (pp >> 1)) ^ xr) << 4); OPAQUE(tx[pt]); } }
#pragma unroll
    for (int kk = 0; kk < 4; ++kk) {
        bf16x8 btf[2], xf[6];
#pragma unroll
        for (int nt2 = 0; nt2 < 2; ++nt2) btf[nt2] = tr_pair(L + L_B + kk * 8192 + tb[nt2], L + L_B + kk * 8192 + 4096 + tb[nt2]);
#pragma unroll
        for (int ct = 0; ct < 6; ++ct) { const int ctg = 6 * CH + ct, r = ctg >> 2, pt = ctg & 3; xf[ct] = tr_pair(L + L_X + r * 16384 + kk * 4096 + tx[pt], L + L_X + r * 16384 + kk * 4096 + 2048 + tx[pt]); }
        f32x4 wl[2], wh[2];
#pragma unroll
        for (int hsel = 0; hsel < 2; ++hsel) { wl[hsel] = *(const LAS f32x4*)(L + L_W + (CH + hsel) * 512 + kk * 128 + q16); wh[hsel] = *(const LAS f32x4*)(L + L_W + (CH + hsel) * 512 + kk * 128 + 64 + q16); }
        const bool ydo = (2 * kk <= gl);
#pragma unroll
        for (int ct = 0; ct < 6; ++ct) { const int ctg = 6 * CH + ct, r = ctg >> 2, hsel = r - CH;
            if (ydo) yacc[ct] = MFMA16(mfrag[hsel][kk], xf[ct], yacc[ct]);
            float xs[8];
#pragma unroll
            for (int e = 0; e < 4; ++e) { xs[e] = __uint_as_float((unsigned)(unsigned short)xf[ct][e] << 16) * wl[hsel][e]; xs[4 + e] = __uint_as_float((unsigned)(unsigned short)xf[ct][4 + e] << 16) * wh[hsel][e]; }
            const bf16x8 xsf = pack8(xs);
            sacc[0][ct] = MFMA16(btf[0], xsf, sacc[0][ct]); sacc[1][ct] = MFMA16(btf[1], xsf, sacc[1][ct]); }
        __builtin_amdgcn_sched_barrier(0);
    }
}

__device__ __forceinline__ void ssd_dma_bx(LAS unsigned char* L, const bf16_t* xrow, int g, int wave, int lane) {
    OPAQUE(lane);
#pragma unroll
    for (int k = 0; k < 4; ++k) { const int m = wave * 4 + k, row = 4 * m + (lane >> 4), lc = (lane & 15) ^ swz16(row & 15);
        __builtin_amdgcn_global_load_lds((const unsigned*)(xrow + 768 + g * 128 + (unsigned)(row * 1792 + lc * 8)), (LAS unsigned*)(L + L_B + m * 1024), 16, 0, 0); }
#pragma unroll
    for (int k = 0; k < 6; ++k) { const int m = wave * 6 + k, r = m >> 4, blk = m & 15, row = 8 * blk + (lane >> 3), lc = (lane & 7) ^ swz8(row);
        __builtin_amdgcn_global_load_lds((const unsigned*)(xrow + g * 192 + r * 64 + (unsigned)(row * 1792 + lc * 8)), (LAS unsigned*)(L + L_X + r * 16384 + blk * 1024), 16, 0, 0); }
}
__device__ __forceinline__ void ssd_dma_c(LAS unsigned char* L, const bf16_t* xrow, int wave, int lane) {
    OPAQUE(lane);
#pragma unroll
    for (int k = 0; k < 2; ++k) { const int m = wave * 2 + k, row = 4 * m + (lane >> 4), lc = (lane & 15) ^ swz16(row & 15);
        __builtin_amdgcn_global_load_lds((const unsigned*)(xrow + (unsigned)(row * 1792 + lc * 8)), (LAS unsigned*)(L + L_C + m * 1024), 16, 0, 0); }
}

__device__ __forceinline__ void p4_ssd(const Frame& F, const Params& P) {
    LAS unsigned char* L = (LAS unsigned char*)F.lds;
    const bf16_t* XA = (const bf16_t*)(P.ws + WS_XA); const float* SA = (const float*)(P.ws + WS_SA);
    const bf16_t* proj = (const bf16_t*)(P.ws + WS_PROJ); bf16_t* mix = (bf16_t*)(P.ws + WS_MIX); const float* norm_w = P.in[12]; const float* d_skip = P.in[11];
    const int lane = F.lane, lt = F.wave >> 1, ch = F.wave & 1;
    for (int u = F.vcu; u < 256; u += F.G) {
        const int b = u >> 3, g = (u >> 1) & 3, hl = u & 1;
        __syncthreads();
        { int tz = F.tid; OPAQUE(tz); unsigned zz = 0u; OPAQUE(zz);
#pragma unroll
          for (int k = 0; k < 6; ++k) *(LAS u32x4*)(L + L_S + (tz + NTHREADS * k) * 16) = (u32x4){zz, zz, zz, zz};
          if (tz < 192) *(LAS float*)(L + L_NW + tz * 4) = norm_w[g * 192 + tz]; }
        f32x4 sacc[2][6];
#pragma unroll
        for (int a = 0; a < 2; ++a)
#pragma unroll
            for (int c = 0; c < 6; ++c) sacc[a][c] = (f32x4){0.f, 0.f, 0.f, 0.f};
        const float dsk0 = d_skip[3 * g + ch], dsk1 = d_skip[3 * g + ch + 1];
        const size_t tokb = (size_t)b * SEQ;
#define SSD_ROLES int t3_ = F.tid; OPAQUE(t3_); const int orow = t3_ >> 3, oseg = t3_ & 7, oc0 = g * 192 + oseg * 24; (void)orow; (void)oseg; (void)oc0
#define SSD_DMA_SMALL(bc_) do { if (F.wave < 6) { int ln2_ = lane; OPAQUE(ln2_); __builtin_amdgcn_global_load_lds((const unsigned*)(SA + ((size_t)(bc_) * 4 + g) * 1536 + F.wave * 256 + ln2_ * 4), (LAS unsigned*)(L + L_DT + F.wave * 1024), 16, 0, 0); } } while (0)
        ssd_dma_bx(L, XA + tokb * 1792, g, F.wave, lane); ssd_dma_c(L, XA + (tokb + 64 * hl) * 1792 + 1280 + g * 128, F.wave, lane);
        u32x4 zr[3];
        SSD_DMA_SMALL(b * 16);
        { SSD_ROLES;
          const bf16_t* zp = proj + (tokb + 64 * hl) * NPROJ + (unsigned)(orow * NPROJ + COL_Z + oc0);
#pragma unroll
          for (int k = 0; k < 3; ++k) zr[k] = *(const u32x4*)(zp + 8 * k); }
        for (int ck = 0; ck < 16; ++ck) {
            const size_t tok0 = tokb + ck * 128;
            SSD_ROLES;
            asm volatile("s_waitcnt vmcnt(0)" ::: "memory");
            SBAR();
            f32x4 yacc[6];
            if (ch == 0) ssd_compute<0>(L, lt, hl, lane, sacc, yacc, dsk0, dsk1); else ssd_compute<1>(L, lt, hl, lane, sacc, yacc, dsk0, dsk1);
            SBAR();
            float gz[24];
#pragma unroll
            for (int k = 0; k < 3; ++k) { gz[8 * k + 0] = siluf_(bf_lo(zr[k].x)); gz[8 * k + 1] = siluf_(bf_hi(zr[k].x)); gz[8 * k + 2] = siluf_(bf_lo(zr[k].y)); gz[8 * k + 3] = siluf_(bf_hi(zr[k].y));
                gz[8 * k + 4] = siluf_(bf_lo(zr[k].z)); gz[8 * k + 5] = siluf_(bf_hi(zr[k].z)); gz[8 * k + 6] = siluf_(bf_lo(zr[k].w)); gz[8 * k + 7] = siluf_(bf_hi(zr[k].w)); }
            if (ck < 15) {
                SSD_DMA_SMALL(b * 16 + ck + 1);
                ssd_dma_bx(L, XA + (tok0 + 128) * 1792, g, F.wave, lane);
            }
            { int l2 = lane; OPAQUE(l2); const int i = l2 & 15, q = l2 >> 4;
#pragma unroll
            for (int nt2 = 0; nt2 < 2; ++nt2)
#pragma unroll
                for (int ct = 0; ct < 6; ++ct) { const f32x4 s = sacc[nt2][ct]; u32x2 pk; pk.x = cvt_pk_bf16(s[0], s[1]); pk.y = cvt_pk_bf16(s[2], s[3]);
                    const int row = 96 * ch + 16 * ct + i, n0 = 16 * (2 * lt + nt2) + 4 * q; *(LAS u32x2*)(L + L_S + row * 256 + (((n0 >> 3) ^ swz16(i)) << 4) + 8 * ((n0 >> 2) & 1)) = pk; }
#pragma unroll
            for (int j = 0; j < 4; ++j) { const int row = 16 * lt + 4 * q + j; const int rb = row < 42 ? (L_C + row * 384) : (L_T + (row - 42) * 384);
#pragma unroll
                for (int ct = 0; ct < 6; ++ct) *(LAS bf16_t*)(L + rb + (96 * ch + 16 * ct + i) * 2) = (bf16_t)(cvt_pk_bf16(yacc[ct][j], 0.f) & 0xffffu); } }
            SBAR();
            u32x4 yr[3];
            { const int row = orow, seg = oseg; const int rb = row < 42 ? (L_C + row * 384) : (L_T + (row - 42) * 384);
#pragma unroll
              for (int k = 0; k < 3; ++k) yr[k] = *(const LAS u32x4*)(L + rb + seg * 48 + k * 16); }
            SBAR();
            if (ck < 15) ssd_dma_c(L, XA + (tok0 + 128 + 64 * hl) * 1792 + 1280 + g * 128, F.wave, lane);
            { float v[24]; float ss = 0.f;
#pragma unroll
              for (int k = 0; k < 3; ++k) { v[8 * k + 0] = bf_lo(yr[k].x) * gz[8 * k + 0]; v[8 * k + 1] = bf_hi(yr[k].x) * gz[8 * k + 1]; v[8 * k + 2] = bf_lo(yr[k].y) * gz[8 * k + 2]; v[8 * k + 3] = bf_hi(yr[k].y) * gz[8 * k + 3];
                  v[8 * k + 4] = bf_lo(yr[k].z) * gz[8 * k + 4]; v[8 * k + 5] = bf_hi(yr[k].z) * gz[8 * k + 5]; v[8 * k + 6] = bf_lo(yr[k].w) * gz[8 * k + 6]; v[8 * k + 7] = bf_hi(yr[k].w) * gz[8 * k + 7]; }
#pragma unroll
              for (int k = 0; k < 24; ++k) ss += v[k] * v[k];
              ss += __shfl_xor(ss, 1); ss += __shfl_xor(ss, 2); ss += __shfl_xor(ss, 4);
              const float rstd = rsqrtf(ss * (1.f / 192.f) + EPS);
              bf16_t* op = mix + (tok0 + 64 * hl) * DM + (unsigned)(orow * DM + 256 + oc0);
#pragma unroll
              for (int k = 0; k < 3; ++k) { const f32x4 n0 = *(const LAS f32x4*)(L + L_NW + (oseg * 24 + 8 * k) * 4), n1 = *(const LAS f32x4*)(L + L_NW + (oseg * 24 + 8 * k + 4) * 4); u32x4 pk;
                  pk.x = cvt_pk_bf16(v[8 * k] * rstd * n0[0], v[8 * k + 1] * rstd * n0[1]); pk.y = cvt_pk_bf16(v[8 * k + 2] * rstd * n0[2], v[8 * k + 3] * rstd * n0[3]);
                  pk.z = cvt_pk_bf16(v[8 * k + 4] * rstd * n1[0], v[8 * k + 5] * rstd * n1[1]); pk.w = cvt_pk_bf16(v[8 * k + 6] * rstd * n1[2], v[8 * k + 7] * rstd * n1[3]);
                  *(u32x4*)(op + 8 * k) = pk; } }
            if (ck < 15) { const bf16_t* zp = proj + (tok0 + 128 + 64 * hl) * NPROJ + (unsigned)(orow * NPROJ + COL_Z + oc0);
#pragma unroll
                for (int k = 0; k < 3; ++k) zr[k] = *(const u32x4*)(zp + 8 * k); }
        }
    }
}

constexpr int R_WH = 0, R_WL = 73728, R_SC = 147456, R_SH = R_SC + 4096, R_CNT = R_SH + 4096, R_LG = 0;
__device__ __forceinline__ void p5_route(const Frame& F, const Params& P) {
    LAS unsigned char* L = (LAS unsigned char*)F.lds;
    const float* x1 = (const float*)(P.ws + WS_X1); const float* mod = (const float*)(P.ws + WS_MOD); bf16_t* H = (bf16_t*)(P.ws + WS_H); const float* ss16 = (const float*)(P.ws + WS_SS16);
    const bf16_t* WRH = (const bf16_t*)(P.ws + WS_WR); const bf16_t* WRL = (const bf16_t*)(P.ws + WS_WR + 131072);
    float* gates = (float*)(P.ws + WS_SGATE); unsigned* list = (unsigned*)(P.ws + WS_LIST); unsigned* gcount = (unsigned*)(P.ws + WS_CTL) + CW_GCOUNT;
    const float* b_group = P.in[15]; const float* b_router = P.in[17];
    LAS unsigned* lcount = (LAS unsigned*)(L + R_CNT);
    LAS unsigned* lbase = lcount + 32;
    LAS unsigned* tinfo = lcount + 64;
    LAS float* twt = (LAS float*)(tinfo + 256 * 4);
    const int lane = F.lane, i = lane & 15, q = lane >> 4;
    for (int rb = F.vcu; rb < T / 256; rb += F.G) {
        const int b = rb >> 3;
        for (int idx = F.tid; idx < 36 * 128; idx += NTHREADS) { const int j = idx >> 7, c = idx & 127; const int dst = j * 2048 + ((c ^ swz16(j & 15)) << 4);
            *(LAS u32x4*)(L + R_WH + dst) = *(const u32x4*)(WRH + (size_t)j * 1024 + c * 8); *(LAS u32x4*)(L + R_WL + dst) = *(const u32x4*)(WRL + (size_t)j * 1024 + c * 8); }
        for (int idx = F.tid; idx < 256; idx += NTHREADS) { const f32x4 sc = *(const f32x4*)(mod + (size_t)b * 6144 + 4 * 1024 + idx * 4), sh = *(const f32x4*)(mod + (size_t)b * 6144 + 3 * 1024 + idx * 4);
            *(LAS f32x4*)(L + R_SC + idx * 16) = sc + 1.0f; *(LAS f32x4*)(L + R_SH + idx * 16) = sh; }
        if (F.tid < 32) lcount[F.tid] = 0u;
        __syncthreads();
        const int rowA = rb * 256 + F.wave * 32 + i;
        float rstd[2];
#pragma unroll
        for (int rt = 0; rt < 2; ++rt) { const f32x4* sp = (const f32x4*)(ss16 + (size_t)(rowA + 16 * rt) * 16); const f32x4 a = sp[0], c = sp[1], d = sp[2], e = sp[3];
            const float ss = ((a[0] + a[1]) + (a[2] + a[3])) + ((c[0] + c[1]) + (c[2] + c[3])) + ((d[0] + d[1]) + (d[2] + d[3])) + ((e[0] + e[1]) + (e[2] + e[3])); rstd[rt] = rsqrtf(ss * (1.f / DM) + EPS); }
        f32x4 acc[2][3];
#pragma unroll
        for (int rt = 0; rt < 2; ++rt)
#pragma unroll
            for (int ct = 0; ct < 3; ++ct) acc[rt][ct] = (f32x4){0.f, 0.f, 0.f, 0.f};
        int wrow[3];
#pragma unroll
        for (int ct = 0; ct < 3; ++ct) { const int j = (16 * ct + i) < 36 ? (16 * ct + i) : 35; wrow[ct] = j * 2048; }
        const int fsw = swz16(i);
        const int fswc = swz16(35 & 15);
#pragma unroll 2
        for (int s = 0; s < 32; ++s) {
            bf16x8 wh[3], wl[3];
#pragma unroll
            for (int ct = 0; ct < 3; ++ct) { const int sw = ((16 * ct + i) < 36) ? fsw : fswc; const int o = wrow[ct] + ((((4 * s + q) & ~15) | (((4 * s + q) & 15) ^ sw)) << 4);
                wh[ct] = *(const LAS bf16x8*)(L + R_WH + o); wl[ct] = *(const LAS bf16x8*)(L + R_WL + o); }
            const f32x4 sc0 = *(const LAS f32x4*)(L + R_SC + (32 * s + 8 * q) * 4), sc1 = *(const LAS f32x4*)(L + R_SC + (32 * s + 8 * q + 4) * 4);
            const f32x4 sh0 = *(const LAS f32x4*)(L + R_SH + (32 * s + 8 * q) * 4), sh1 = *(const LAS f32x4*)(L + R_SH + (32 * s + 8 * q + 4) * 4);
#pragma unroll
            for (int rt = 0; rt < 2; ++rt) { const size_t off = (size_t)(rowA + 16 * rt) * DM + 32 * s + 8 * q;
                const f32x4 x0 = *(const f32x4*)(x1 + off), x1v = *(const f32x4*)(x1 + off + 4);
                const f32x4 h0 = x0 * rstd[rt] * sc0 + sh0, h1 = x1v * rstd[rt] * sc1 + sh1;
                u32x4 hi; hi.x = cvt_pk_bf16(h0[0], h0[1]); hi.y = cvt_pk_bf16(h0[2], h0[3]); hi.z = cvt_pk_bf16(h1[0], h1[1]); hi.w = cvt_pk_bf16(h1[2], h1[3]);
                *(u32x4*)(H + off) = hi;
                u32x4 lo; lo.x = cvt_pk_bf16(h0[0] - bf_lo(hi.x), h0[1] - bf_hi(hi.x)); lo.y = cvt_pk_bf16(h0[2] - bf_lo(hi.y), h0[3] - bf_hi(hi.y));
                lo.z = cvt_pk_bf16(h1[0] - bf_lo(hi.z), h1[1] - bf_hi(hi.z)); lo.w = cvt_pk_bf16(h1[2] - bf_lo(hi.w), h1[3] - bf_hi(hi.w));
                const bf16x8 ah = __builtin_bit_cast(bf16x8, hi), al = __builtin_bit_cast(bf16x8, lo);
#pragma unroll
                for (int ct = 0; ct < 3; ++ct) { acc[rt][ct] = MFMA16(ah, wh[ct], acc[rt][ct]); acc[rt][ct] = MFMA16(al, wh[ct], acc[rt][ct]); acc[rt][ct] = MFMA16(ah, wl[ct], acc[rt][ct]); } }
        }
        __syncthreads();
        LAS float* lg = (LAS float*)(L + R_LG);
#pragma unroll
        for (int rt = 0; rt < 2; ++rt)
#pragma unroll
            for (int ct = 0; ct < 3; ++ct)
#pragma unroll
                for (int j = 0; j < 4; ++j) { const int col = 16 * ct + i; if (col < 36) lg[(F.wave * 32 + 16 * rt + 4 * q + j) * 37 + col] = acc[rt][ct][j]; }
        __syncthreads();
        if (F.tid < 256) {
            const int rl = F.tid; const LAS float* lr = lg + rl * 37;
            float gl[4];
#pragma unroll
            for (int k = 0; k < 4; ++k) gl[k] = lr[k] + b_group[k];
            int gi = 0; float gm = gl[0];
#pragma unroll
            for (int k = 1; k < 4; ++k) if (gl[k] > gm) { gm = gl[k]; gi = k; }
            float den = 0.f;
#pragma unroll
            for (int k = 0; k < 4; ++k) den += __expf(gl[k] - gm);
            const float pg = 1.0f / den;
            float el[8];
#pragma unroll
            for (int k = 0; k < 8; ++k) el[k] = lr[4 + gi * 8 + k] + b_router[gi * 8 + k];
            int i0 = 0; float v0 = el[0];
#pragma unroll
            for (int k = 1; k < 8; ++k) if (el[k] > v0) { v0 = el[k]; i0 = k; }
            int i1 = -1; float v1 = -3.0e38f;
#pragma unroll
            for (int k = 0; k < 8; ++k) if (k != i0 && el[k] > v1) { v1 = el[k]; i1 = k; }
            const float ex = __expf(v1 - v0); const float w0 = pg / (1.0f + ex), w1 = pg * ex / (1.0f + ex);
            const int e0 = gi * 8 + i0, e1 = gi * 8 + i1; const unsigned r0 = atomicAdd((unsigned*)&lcount[e0], 1u), r1 = atomicAdd((unsigned*)&lcount[e1], 1u);
            tinfo[rl * 4 + 0] = (unsigned)e0 | ((unsigned)e1 << 8); tinfo[rl * 4 + 1] = r0; tinfo[rl * 4 + 2] = r1; twt[rl * 2] = w0; twt[rl * 2 + 1] = w1;
        }
        __syncthreads();
        if (F.tid < 32) lbase[F.tid] = atomicAdd(&gcount[64 * F.tid], lcount[F.tid]);
        __syncthreads();
        if (F.tid < 256) { const int rl = F.tid, row = rb * 256 + rl; const unsigned ee = tinfo[rl * 4], e0 = ee & 255u, e1 = ee >> 8;
            const size_t s0 = (size_t)e0 * ECAP + lbase[e0] + tinfo[rl * 4 + 1], s1 = (size_t)e1 * ECAP + lbase[e1] + tinfo[rl * 4 + 2];
            list[s0] = (unsigned)row * 2u; list[s1] = (unsigned)row * 2u + 1u; gates[s0] = twt[rl * 2]; gates[s1] = twt[rl * 2 + 1]; }
        __syncthreads();
    }
}

__device__ __forceinline__ void p8_final(const Frame& F, const Params& P) {
    const float* x1 = (const float*)(P.ws + WS_X1); const bf16_t* Y0 = (const bf16_t*)(P.ws + WS_Y0); const bf16_t* Y1 = (const bf16_t*)(P.ws + WS_Y1); const float* fw = P.in[20]; const float* mod = (const float*)(P.ws + WS_MOD);
    f32x4 wv[4];
#pragma unroll
    for (int j = 0; j < 4; ++j) wv[j] = ((const f32x4*)fw)[F.lane + 64 * j];
    for (int row = F.gw; row < T; row += F.NGW) {
        const f32x4* xr = (const f32x4*)(x1 + (size_t)row * DM) + F.lane; const u32x2* y0 = (const u32x2*)(Y0 + (size_t)row * DM) + F.lane; const u32x2* y1 = (const u32x2*)(Y1 + (size_t)row * DM) + F.lane;
        const f32x4* g2 = (const f32x4*)(mod + (size_t)(row >> 11) * 6144 + 5 * 1024) + F.lane;
        f32x4 v[4]; float s = 0.f;
#pragma unroll
        for (int j = 0; j < 4; ++j) { const u32x2 a = y0[64 * j], c = y1[64 * j]; const f32x4 g = g2[64 * j]; v[j] = xr[64 * j];
            v[j][0] += g[0] * (bf_lo(a.x) + bf_lo(c.x)); v[j][1] += g[1] * (bf_hi(a.x) + bf_hi(c.x)); v[j][2] += g[2] * (bf_lo(a.y) + bf_lo(c.y)); v[j][3] += g[3] * (bf_hi(a.y) + bf_hi(c.y));
            s += (v[j][0] * v[j][0] + v[j][1] * v[j][1]) + (v[j][2] * v[j][2] + v[j][3] * v[j][3]); }
        const float rstd = rsqrtf(wave_sum(s) * (1.f / DM) + EPS);
        f32x4* o = (f32x4*)(P.out + (size_t)row * DM) + F.lane;
#pragma unroll
        for (int j = 0; j < 4; ++j) o[64 * j] = v[j] * rstd * wv[j];
    }
}

__device__ __forceinline__ void moe_prefix(const Frame& F, const Params& P, int* pref) {
    const unsigned* gcount = (const unsigned*)(P.ws + WS_CTL) + CW_GCOUNT;
    __syncthreads();
    if (F.tid == 0) { int acc = 0; for (int e = 0; e < 32; ++e) { const int c = (int)__hip_atomic_load(gcount + 64 * e, __ATOMIC_RELAXED, __HIP_MEMORY_SCOPE_AGENT); pref[e] = acc; pref[33 + e] = c; acc += (c + 255) >> 8; } pref[32] = acc; }
    __syncthreads();
}

#define XB_TMO      128
#define XB_XCNT(j)  (256  + 64 * (j))
#define XB_XSUB(j)  (1280 + 64 * (j))
#define XB_XGEN(j)  (2304 + 64 * (j))
#define XB_TOP      3328
#define XB_TOPGEN   3392
#define XCD_BAR_WORDS 3456
#define XB_SPIN_CAP (1u << 22)
__device__ __forceinline__ unsigned xb_ld(unsigned* p)              { return __hip_atomic_load(p, __ATOMIC_RELAXED, __HIP_MEMORY_SCOPE_AGENT); }
__device__ __forceinline__ unsigned xb_add(unsigned* p, unsigned v) { return __hip_atomic_fetch_add(p, v, __ATOMIC_RELAXED, __HIP_MEMORY_SCOPE_AGENT); }
__device__ __forceinline__ unsigned xb_xcc_id() { return (unsigned)__builtin_amdgcn_s_getreg((3 << 11) | 20) & 0xFu; }
#define XB_SPIN(cond, bar) do { unsigned _sp = 0; while (cond) { __builtin_amdgcn_s_sleep(1); \
    if ((++_sp & 255u) == 0u) { if (xb_ld(&(bar)[XB_TMO])) break; if (_sp > XB_SPIN_CAP) { atomicAdd(&(bar)[XB_TMO], 1u); break; } } } } while (0)
struct XcdBarrier { unsigned* bar; unsigned x; volatile LAS unsigned* st; };
__device__ __forceinline__ XcdBarrier xcd_barrier_post(unsigned* bar, volatile LAS unsigned* st) {
    XcdBarrier b; b.bar = bar; b.x = xb_xcc_id(); b.st = st;
    if (threadIdx.x == 0) (void)xb_add(&bar[XB_XCNT(b.x)], 1u);
    return b;
}
__device__ __forceinline__ void xcd_barrier_complete(unsigned* bar, unsigned x, unsigned& nloc, unsigned& nx) {
    const unsigned G = gridDim.x * gridDim.y * gridDim.z;
    unsigned sum, cnt, mine, sp = 0u;
    for (;;) {
        sum = 0u; cnt = 0u; mine = 0u;
#pragma unroll
        for (unsigned j = 0; j < 16; ++j) { const unsigned c = xb_ld(&bar[XB_XCNT(j)]); sum += c; cnt += (c > 0u) ? 1u : 0u; mine = (j == x) ? c : mine; }
        if (sum == G) break;
        __builtin_amdgcn_s_sleep(1);
        if ((++sp & 255u) == 0u) { if (xb_ld(&bar[XB_TMO])) break; if (sp > XB_SPIN_CAP) { atomicAdd(&bar[XB_TMO], 1u); break; } }
    }
    nloc = mine > 0u ? mine : 1u; nx = cnt > 0u ? cnt : 1u;
}
__device__ __forceinline__ void xcd_barrier(const XcdBarrier& b) {
    asm volatile("s_waitcnt vmcnt(0)" ::: "memory");
    __syncthreads();
    if (threadIdx.x == 0) {
        unsigned* bar = b.bar;
        __builtin_amdgcn_s_waitcnt(0);
        unsigned nloc = b.st[0], nx = b.st[1];
        if (nloc == 0u) { xcd_barrier_complete(bar, b.x, nloc, nx); b.st[0] = nloc; b.st[1] = nx; }
        const unsigned old = xb_add(&bar[XB_XSUB(b.x)], 1u);
        const unsigned gen = old / nloc;
        if (old + 1u == (gen + 1u) * nloc) {
            __builtin_amdgcn_fence(__ATOMIC_RELEASE, "agent");
            asm volatile("s_waitcnt vmcnt(0)" ::: "memory");
            const unsigned og = xb_add(&bar[XB_TOP], 1u);
            const unsigned tg = og / nx;
            if (og + 1u == (tg + 1u) * nx) xb_add(&bar[XB_TOPGEN], 1u);
            else XB_SPIN(xb_ld(&bar[XB_TOPGEN]) == tg, bar);
            __builtin_amdgcn_fence(__ATOMIC_ACQUIRE, "agent");
            xb_add(&bar[XB_XGEN(b.x)], 1u);
            asm volatile("s_waitcnt vmcnt(0)" ::: "memory");
        } else {
            XB_SPIN(xb_ld(&bar[XB_XGEN(b.x)]) == gen, bar);
            __builtin_amdgcn_fence(__ATOMIC_ACQUIRE, "agent");
            asm volatile("s_waitcnt vmcnt(0)" ::: "memory");
        }
    }
    __syncthreads();
}

__global__ void __launch_bounds__(NTHREADS, 2) fwd_kernel(Params P) {
    extern __shared__ __attribute__((aligned(16))) unsigned char lds[];
    Frame F; F.lds = lds; F.tid = threadIdx.x; F.lane = F.tid & 63; F.wave = __builtin_amdgcn_readfirstlane(F.tid >> 6);
    F.G = gridDim.x; { const int bx = blockIdx.x; F.vcu = (F.G % 8 == 0) ? (bx % 8) * (F.G / 8) + bx / 8 : bx; }
    F.gw = F.vcu * NWAVES + F.wave; F.NGW = F.G * NWAVES;
    unsigned char* ws = P.ws;
    const int lo = P.ph_lo, hi = P.ph_hi;
    volatile LAS unsigned* bst = (volatile LAS unsigned*)((LAS unsigned char*)lds + (LDS_BYTES - 64));
    if (F.tid < 2) bst[F.tid] = 0u;
    __syncthreads();
    const XcdBarrier xbar = xcd_barrier_post((unsigned*)(ws + WS_CTL) + CW_BAR, bst);
#define IN(k) (lo <= (k) && (k) < hi)
#define GRID_BAR() xcd_barrier(xbar)
#define GRID_BAR_CG() do { __syncthreads(); cooperative_groups::this_grid().sync(); } while (0)
    if (IN(0)) p0_prep(F, P);
    if (IN(0) && IN(1)) GRID_BAR_CG();
    if (IN(1)) p1_modulate(F, P);
    if (IN(1) && IN(2)) GRID_BAR();
    if (IN(2)) { pg8::DenseSched S; S.init(ws + WS_H, ws + WS_WIN, T, NPROJ, 1024, F.G, (int)blockIdx.x); pg8::EpiProj E{(bf16_t*)(ws + WS_PROJ), (float*)(ws + WS_DTRAW)}; pg8::gemm_phase(( LAS unsigned char*)lds, S, E); }
    if (IN(2) && IN(3)) GRID_BAR();
    if (IN(3)) p3_conv(F, P);
    if (IN(3) && IN(4)) GRID_BAR();
    if (IN(4)) p4_ssd(F, P);
    if (IN(4) && IN(5)) GRID_BAR();
    if (IN(5)) { pg8::DenseSched S; S.init(ws + WS_MIX, ws + WS_WOUT, T, 1024, 1024, F.G, (int)blockIdx.x); pg8::EpiX1 E{P.in[0], (const float*)(ws + WS_MOD), (float*)(ws + WS_X1), (float*)(ws + WS_SS16)}; pg8::gemm_phase((LAS unsigned char*)lds, S, E); }
    if (IN(5) && IN(6)) GRID_BAR();
    if (IN(6)) p5_route(F, P);
    if (IN(6) && IN(7)) GRID_BAR();
    if (IN(7)) { int* pref = (int*)(lds + MISC_OFF); moe_prefix(F, P, pref);
        pg8::MoeSched<true> S; S.A = (const char*)(ws + WS_H); S.Bt = (const char*)(ws + WS_W13); S.K = 1024; S.nN = 4; S.G = F.G; S.c = F.vcu; S.pref = (const LAS int*)pref; S.list = (const unsigned*)(ws + WS_LIST);
        pg8::EpiAct E{(bf16_t*)(ws + WS_ACT)}; pg8::gemm_phase((LAS unsigned char*)lds, S, E); }
    if (IN(7) && IN(8)) GRID_BAR();
    if (IN(8)) { int* pref = (int*)(lds + MISC_OFF); moe_prefix(F, P, pref);
        pg8::MoeSched<false> S; S.A = (const char*)(ws + WS_ACT); S.Bt = (const char*)(ws + WS_W2); S.K = 512; S.nN = 4; S.G = F.G; S.c = F.vcu; S.pref = (const LAS int*)pref; S.list = (const unsigned*)(ws + WS_LIST);
        pg8::EpiY E{(const unsigned*)(ws + WS_LIST), (const float*)(ws + WS_SGATE), (bf16_t*)(ws + WS_Y0), (bf16_t*)(ws + WS_Y1)}; pg8::gemm_phase((LAS unsigned char*)lds, S, E); }
    if (IN(8) && IN(9)) GRID_BAR();
    if (IN(9)) p8_final(F, P);
#undef IN
#undef GRID_BAR
#undef GRID_BAR_CG
}

extern "C" void kernel_launch(void* const* d_in, const int* in_sizes, int n_in, void* d_out, int out_size, void* d_ws, size_t ws_size, hipStream_t stream) {
    static int grid = 0;
    if (grid == 0) {
        if (n_in != 21 || out_size != T * DM || ws_size < WS_END) { fprintf(stderr, "kernel_launch: unexpected sizes n_in %d out %d ws %zu\n", n_in, out_size, ws_size); grid = -1; return; }
        int dev = 0, cus = 0;
        if (hipGetDevice(&dev) != hipSuccess || hipDeviceGetAttribute(&cus, hipDeviceAttributeMultiprocessorCount, dev) != hipSuccess) { grid = -1; return; }
        if (hipFuncSetAttribute((const void*)fwd_kernel, hipFuncAttributeMaxDynamicSharedMemorySize, LDS_BYTES) != hipSuccess) { fprintf(stderr, "kernel_launch: hipFuncSetAttribute failed\n"); grid = -1; return; }
        int per_cu = 0;
        if (hipOccupancyMaxActiveBlocksPerMultiprocessor(&per_cu, (const void*)fwd_kernel, NTHREADS, LDS_BYTES) != hipSuccess || per_cu < 1) { fprintf(stderr, "kernel_launch: occupancy query says %d blocks per CU\n", per_cu); (void)hipGetLastError(); per_cu = 1; }
        grid = cus;
    }
    if (grid < 0) return;
    (void)hipMemsetAsync((char*)d_ws + WS_CTL, 0, CTL_BYTES, stream);
    Params p{};
    for (int i = 0; i < 21; ++i) p.in[i] = (const float*)d_in[i];
    p.out = (float*)d_out; p.ws = (unsigned char*)d_ws;
    p.ph_lo = 0; p.ph_hi = 10;
    void* args[] = {&p};
    hipError_t e = hipLaunchCooperativeKernel((const void*)fwd_kernel, dim3(grid), dim3(NTHREADS), args, LDS_BYTES, stream);
    if (e != hipSuccess) fprintf(stderr, "kernel_launch: cooperative launch failed: %s (grid %d)\n", hipGetErrorString(e), grid);
}
```

```cpp
#include <hip/hip_runtime.h>
#include <hip/hip_cooperative_groups.h>
#include <cstdio>
#include <cstdint>

#ifndef MK_ONE_LAUNCH
#define MK_ONE_LAUNCH 0
#endif

#define LAS __attribute__((address_space(3)))
typedef unsigned short bf16_t;
typedef short bf16x8 __attribute__((ext_vector_type(8)));
typedef float f32x4 __attribute__((ext_vector_type(4)));
typedef float f32x2 __attribute__((ext_vector_type(2)));
typedef unsigned u32x4 __attribute__((ext_vector_type(4)));
typedef unsigned u32x2 __attribute__((ext_vector_type(2)));
typedef int i32x4 __attribute__((ext_vector_type(4)));
typedef int i32x8 __attribute__((ext_vector_type(8)));

constexpr int BATCH = 32, SEQ = 2048, DM = 1024, T = BATCH * SEQ;
constexpr int NPROJ = 3072, NPROJ_REAL = 2828;
constexpr int COL_Z = 256, COL_XS = 1024, COL_B = 1792, COL_C = 2304, COL_DT = 2816;
constexpr int NEXP = 32, FF = 512, ECAP = 65536;
constexpr int NWAVES = 8, NTHREADS = 512;
constexpr float EPS = 1e-6f;

constexpr size_t MiB = 1u << 20;
constexpr size_t WS_CTL = 0, CTL_BYTES = 1 * MiB;
constexpr size_t WS_MOD = 1 * MiB;
constexpr size_t WS_WR = 2 * MiB;
constexpr size_t WS_WDT = 2 * MiB + 512 * 1024;
constexpr size_t WS_SS16 = 4 * MiB;
constexpr size_t WS_SGATE = 120 * MiB;
constexpr size_t WS_DTRAW = 4 * MiB;
constexpr size_t WS_LIST = 8 * MiB;
constexpr size_t WS_WIN = 16 * MiB;
constexpr size_t WS_WOUT = 22 * MiB;
constexpr size_t WS_W13 = 24 * MiB;
constexpr size_t WS_W2 = 88 * MiB;
constexpr size_t WS_H = 128 * MiB;
constexpr size_t WS_PROJ = 256 * MiB;
constexpr size_t WS_MIX = 640 * MiB;
constexpr size_t WS_X1 = 768 * MiB;
constexpr size_t WS_END = 1024 * MiB;
constexpr size_t WS_XA = WS_X1;
constexpr size_t WS_SA = WS_H;
constexpr size_t WS_Y0 = 256 * MiB, WS_Y1 = 384 * MiB;
constexpr size_t WS_ACT = 512 * MiB;
constexpr int CW_GCOUNT = 256;
constexpr int CW_BAR = 4096;

constexpr int LDS_BYTES = 163840;
constexpr int MISC_OFF = 147456;

struct Params {
    const float* in[21];
    float* out;
    unsigned char* ws;
    int ph_lo, ph_hi;
};

__device__ __forceinline__ unsigned cvt_pk_bf16(float lo, float hi) { unsigned r; asm volatile("v_cvt_pk_bf16_f32 %0, %1, %2" : "=v"(r) : "v"(lo), "v"(hi)); return r; }
__device__ __forceinline__ float clamp_f8(float v) { return __builtin_fminf(__builtin_fmaxf(v, -448.f), 448.f); }
__device__ __forceinline__ unsigned cvt_pk4_fp8(float a, float b, float c, float d) {
    int w = 0; w = __builtin_amdgcn_cvt_pk_fp8_f32(clamp_f8(a), clamp_f8(b), w, false); w = __builtin_amdgcn_cvt_pk_fp8_f32(clamp_f8(c), clamp_f8(d), w, true); return (unsigned)w; }
__device__ __forceinline__ float bf_lo(unsigned u) { return __uint_as_float(u << 16); }
__device__ __forceinline__ float bf_hi(unsigned u) { return __uint_as_float(u & 0xffff0000u); }
__device__ __forceinline__ float wave_sum(float v) {
#pragma unroll
    for (int o = 1; o < 64; o <<= 1) v += __shfl_xor(v, o);
    return v;
}
__device__ __forceinline__ float sigmoidf_(float v) { return __builtin_amdgcn_rcpf(1.0f + __expf(-v)); }
__device__ __forceinline__ float siluf_(float v) { return v * sigmoidf_(v); }

namespace pg8 {
constexpr float W_F8_SCALE = 32.f, W_F8_INV = 1.f / 32.f;
constexpr int BM = 256, BK = 64, HALF = 128, HTB = HALF * BK * 2, STAGE_BYTES = 8 * HTB, NXCD = 8, WGM = 4;
__host__ __device__ __forceinline__ int lds_byte(int r, int c) { const int st = (r >> 4) * 2 + (c >> 5), rr = r & 15, cc = c & 31, ob = rr * 64 + cc * 2; return st * 1024 + (ob ^ (((ob >> 9) & 1) << 5)); }
__host__ __device__ __forceinline__ void stage_rc(int b, int& R, int& C) { const int st = b / 1024, sb = b % 1024, swz = sb ^ (((sb >> 9) & 1) << 5); R = (st >> 1) * 16 + swz / 64; C = (st & 1) * 32 + (swz % 64) / 2; }
__host__ __device__ __forceinline__ int perm32(int rho) { const int n = rho >> 4, i = rho & 15; return 8 * (i >> 2) + 4 * n + (i & 3); }

struct Unit { int pm, pn, e, cnt, slot0; };

struct DenseSched {
    const char* A; const char* Bt; int K;
    int nM, nN, nwg, G, c;
    __device__ void init(const void* A_, const void* Bt_, int M, int N, int K_, int G_, int c_) { A = (const char*)A_; Bt = (const char*)Bt_; K = K_; nM = M / BM; nN = N / BM; nwg = nM * nN; G = G_; c = c_; }
    __device__ __forceinline__ bool next(int i, Unit& u) const {
        const long L = (long)i * G + c; if (L >= nwg) return false;
        int wgid = (int)L; { const int q = nwg / NXCD, r = nwg % NXCD, xcd = wgid % NXCD, off = wgid / NXCD; wgid = (xcd < r ? xcd * (q + 1) : r * (q + 1) + (xcd - r) * q) + off; }
        const int nig = WGM * nN, gid = wgid / nig, fm = gid * WGM, gsz = (nM - fm) < WGM ? (nM - fm) : WGM;
        u.pm = fm + ((wgid % nig) % gsz); u.pn = (wgid % nig) / gsz; u.e = 0; u.cnt = 256; u.slot0 = 0; return true;
    }
    static constexpr bool FP8 = false;
    __device__ __forceinline__ int kb() const { return K * 2; }
    __device__ __forceinline__ const char* a_base() const { return A; }
    __device__ __forceinline__ void a_raw(const Unit& u, const int (&R)[2], unsigned (&raw)[2][2]) const {
#pragma unroll
        for (int h = 0; h < 2; ++h)
#pragma unroll
            for (int i = 0; i < 2; ++i) raw[h][i] = (unsigned)(u.pm * BM + h * HALF + R[i]);
    }
    __device__ __forceinline__ void a_fin(const int (&C)[2], const unsigned (&raw)[2][2], unsigned (&o)[2][2]) const {
#pragma unroll
        for (int h = 0; h < 2; ++h)
#pragma unroll
            for (int i = 0; i < 2; ++i) o[h][i] = (raw[h][i] * (unsigned)K + (unsigned)C[i]) * 2u;
    }
    __device__ __forceinline__ const char* b_ptr(const Unit& u) const { return Bt + (size_t)u.pn * BM * K * 2; }
};

template <bool GATHER>
struct MoeSched {
    static constexpr bool FP8 = true;
    __device__ __forceinline__ int kb() const { return K; }
    const char* A; const char* Bt; int K, nN, G, c;
    const LAS int* pref;
    const unsigned* list;
    __device__ __forceinline__ bool next(int i, Unit& u) const {
        const long L = (long)i * G + c; const int tot = pref[32] * nN; if (L >= tot) return false;
        const int ti = (int)L / nN; u.pn = (int)L % nN;
        int e = 0;
#pragma unroll 1
        for (int step = 16; step >= 1; step >>= 1) if (pref[e + step] <= ti) e += step;
        const int mt = ti - pref[e]; u.pm = ti; u.e = e; u.slot0 = mt * 256; const int rem = pref[33 + e] - mt * 256; u.cnt = rem < 256 ? rem : 256; return true;
    }
    __device__ __forceinline__ const char* a_base() const { return A; }
    __device__ __forceinline__ void a_raw(const Unit& u, const int (&R)[2], unsigned (&raw)[2][2]) const {
#pragma unroll
        for (int h = 0; h < 2; ++h)
#pragma unroll
            for (int i = 0; i < 2; ++i) {
                const int r = h * HALF + R[i];
                if (GATHER) { unsigned ent = 0; if (r < u.cnt) ent = list[(size_t)u.e * ECAP + u.slot0 + r]; raw[h][i] = ent >> 1; }
                else raw[h][i] = (unsigned)(u.pm * BM + r);
            }
    }
    __device__ __forceinline__ void a_fin(const int (&C)[2], const unsigned (&raw)[2][2], unsigned (&o)[2][2]) const {
#pragma unroll
        for (int h = 0; h < 2; ++h)
#pragma unroll
            for (int i = 0; i < 2; ++i) o[h][i] = raw[h][i] * (unsigned)K + (unsigned)C[i] * 2u;
    }
    __device__ __forceinline__ const char* b_ptr(const Unit& u) const { return Bt + ((size_t)u.e * (nN * BM) + (size_t)u.pn * BM) * K; }
};

template <class Epi, class Sched>
__device__ __forceinline__ void gemm_phase(LAS unsigned char* lds, const Sched& S, const Epi& E, unsigned stagger_ticks = 0u) {
    if (stagger_ticks) { const unsigned long long t0 = __builtin_amdgcn_s_memrealtime(); while ((unsigned long long)(__builtin_amdgcn_s_memrealtime() - t0) < (unsigned long long)stagger_ticks) __builtin_amdgcn_s_sleep(16); }
    const int tid = threadIdx.x, wid = __builtin_amdgcn_readfirstlane(tid >> 6), lane = tid & 63, wr = wid >> 2, wc = wid & 3, fr = lane & 15, fq = lane >> 4;
    const int KB = S.kb(), nt = KB / (BK * 2);
    int sR[2], sC[2]; unsigned voffB[2];
#pragma unroll
    for (int i = 0; i < 2; ++i) { int R, C; stage_rc(tid * 16 + i * 8192, R, C); sR[i] = R; sC[i] = C; const int Rb = Epi::PERM ? ((R & ~31) + perm32(R & 31)) : R; voffB[i] = (unsigned)(Rb * KB + C * 2); }
    const size_t kstep = (size_t)(BK * 2);
    const size_t hstep = (size_t)HALF * KB;
    const unsigned ldsw = (unsigned)wid * 1024u;
    const int aoff = lds_byte(wr * 64 + fr, fq * 8), boff = lds_byte(wc * 32 + fr, fq * 8);
#define PG8_SA(b, h) (((b) * 2 + (h)) * HTB)
#define PG8_SB(b, h) ((4 + (b) * 2 + (h)) * HTB)
#define PG8_STAGE(bufoff, gbase, voff) do { _Pragma("unroll") for (int _i = 0; _i < 2; ++_i) \
        __builtin_amdgcn_global_load_lds((const unsigned*)((const char*)(gbase) + (voff)[_i]), (LAS unsigned*)(lds + (bufoff) + ldsw + _i * 8192), 16, 0, 0); } while (0)
#define PG8_LDA(dst, b, h) do { _Pragma("unroll") for (int m = 0; m < 4; ++m) _Pragma("unroll") for (int k = 0; k < 2; ++k) { const i32x4 v_ = *(const LAS i32x4*)(lds + PG8_SA(b, h) + aoff + m * 2048 + k * 1024); if (k == 0) dst[m].lo = v_; else dst[m].hi = v_; } } while (0)
#define PG8_LDB(dst, b, h) do { _Pragma("unroll") for (int n = 0; n < 2; ++n) _Pragma("unroll") for (int k = 0; k < 2; ++k) { const i32x4 v_ = *(const LAS i32x4*)(lds + PG8_SB(b, h) + boff + n * 2048 + k * 1024); if (k == 0) dst[n].lo = v_; else dst[n].hi = v_; } } while (0)
#define PG8_MMA(ai, bj, At, Bt) do { __builtin_amdgcn_s_setprio(1); _Pragma("unroll") for (int m = 0; m < 4; ++m) _Pragma("unroll") for (int n = 0; n < 2; ++n) _Pragma("unroll") for (int k = 0; k < 2; ++k) \
        acc[ai][bj][m][n] = __builtin_amdgcn_mfma_f32_16x16x32_bf16(__builtin_bit_cast(bf16x8, k ? (i32x4)Bt[n].hi : (i32x4)Bt[n].lo), __builtin_bit_cast(bf16x8, k ? (i32x4)At[m].hi : (i32x4)At[m].lo), acc[ai][bj][m][n], 0, 0, 0); __builtin_amdgcn_s_setprio(0); } while (0)
#define PG8_MMA8(ai, bj, At, Bt) do { __builtin_amdgcn_s_setprio(1); _Pragma("unroll") for (int m = 0; m < 4; ++m) _Pragma("unroll") for (int n = 0; n < 2; ++n) { \
        asm volatile("v_mfma_f32_16x16x128_f8f6f4 %0, %1, %2, %0" : "+v"(acc[ai][bj][m][n]) : "v"(Bt[n]), "v"(At[m])); } \
        __builtin_amdgcn_s_setprio(0); } while (0)
#define PG8_MM(ai, bj, At, Bt) do { if constexpr (Sched::FP8) PG8_MMA8(ai, bj, At, Bt); else PG8_MMA(ai, bj, At, Bt); } while (0)
#define PG8_WAIT_V(n) asm volatile("s_waitcnt vmcnt(" #n ")" ::: "memory")
#define PG8_WAIT_L(n) asm volatile("s_waitcnt lgkmcnt(" #n ")" ::: "memory")
#define PG8_BAR __builtin_amdgcn_s_barrier()
#define PG8_SCHED __builtin_amdgcn_sched_barrier(0)
    Unit cur, nxt; int ui = 0;
    if (!S.next(0, cur)) return;
    f32x4 acc[2][2][4][2];
#pragma unroll
    for (int a = 0; a < 2; ++a)
#pragma unroll
        for (int b = 0; b < 2; ++b)
#pragma unroll
            for (int m = 0; m < 4; ++m)
#pragma unroll
                for (int n = 0; n < 2; ++n) acc[a][b][m][n] = (f32x4){0.f, 0.f, 0.f, 0.f};
    i32x8 At[4], B0[2], B1[2];
    unsigned aoC[2][2], aoN[2][2], rawN[2][2];
    S.a_raw(cur, sR, rawN); S.a_fin(sC, rawN, aoC);
    const char* const Ab = S.a_base();
    const char* cB = S.b_ptr(cur);
    PG8_STAGE(PG8_SB(0, 0), cB, voffB); PG8_STAGE(PG8_SB(0, 1), cB + hstep, voffB); PG8_STAGE(PG8_SA(0, 0), Ab, aoC[0]); PG8_STAGE(PG8_SA(0, 1), Ab, aoC[1]);
    if (wr == 1) PG8_BAR;
    PG8_WAIT_V(2); PG8_BAR;
    PG8_STAGE(PG8_SB(1, 0), cB + kstep, voffB); PG8_STAGE(PG8_SA(1, 0), Ab + kstep, aoC[0]); PG8_STAGE(PG8_SB(1, 1), cB + hstep + kstep, voffB);
    PG8_WAIT_V(6); PG8_BAR;
    for (;;) {
        const bool has_next = S.next(ui + 1, nxt);
        const char* nB = cB;
        if (has_next) { S.a_raw(nxt, sR, rawN); nB = S.b_ptr(nxt); }
#pragma unroll
        for (int h = 0; h < 2; ++h)
#pragma unroll
            for (int i = 0; i < 2; ++i) aoN[h][i] = aoC[h][i];
        for (int t = 0; t < nt; t += 2) {
            const bool last = (t == nt - 2);
            const char* a1 = Ab + (size_t)(t + 1) * kstep;
            const char* a2 = last ? Ab : Ab + (size_t)(t + 2) * kstep; const char* b2 = last ? nB : cB + (size_t)(t + 2) * kstep;
            const char* a3 = a2 + kstep; const char* b3 = b2 + kstep;
            if (last && has_next) {
#pragma unroll
                for (int h = 0; h < 2; ++h)
#pragma unroll
                    for (int i = 0; i < 2; ++i) asm volatile("" : "+v"(rawN[h][i]));
                S.a_fin(sC, rawN, aoN); }
            unsigned o2[2][2];
#pragma unroll
            for (int h = 0; h < 2; ++h)
#pragma unroll
                for (int i = 0; i < 2; ++i) o2[h][i] = last ? aoN[h][i] : aoC[h][i];
            PG8_LDB(B0, 0, 0); PG8_LDB(B1, 0, 1); PG8_SCHED; PG8_LDA(At, 0, 0); PG8_STAGE(PG8_SA(1, 1), a1, aoC[1]);
            PG8_WAIT_V(8); PG8_WAIT_L(0); PG8_BAR; PG8_MM(0, 0, At, B0); PG8_MM(0, 1, At, B1); PG8_BAR; PG8_SCHED;
            PG8_LDA(At, 0, 1); PG8_STAGE(PG8_SB(0, 0), b2, voffB); PG8_STAGE(PG8_SB(0, 1), b2 + hstep, voffB); PG8_STAGE(PG8_SA(0, 0), a2, o2[0]);
            PG8_WAIT_V(8); PG8_WAIT_L(0); PG8_BAR; PG8_MM(1, 0, At, B0); PG8_MM(1, 1, At, B1); PG8_BAR; PG8_SCHED;
            PG8_LDB(B0, 1, 0); PG8_LDB(B1, 1, 1); PG8_SCHED; PG8_LDA(At, 1, 0); PG8_STAGE(PG8_SA(0, 1), a2, o2[1]);
            PG8_WAIT_V(8); PG8_WAIT_L(0); PG8_BAR; PG8_MM(0, 0, At, B0); PG8_MM(0, 1, At, B1); PG8_BAR; PG8_SCHED;
            PG8_LDA(At, 1, 1); PG8_STAGE(PG8_SB(1, 0), b3, voffB); PG8_STAGE(PG8_SB(1, 1), b3 + hstep, voffB); PG8_STAGE(PG8_SA(1, 0), a3, o2[0]);
            PG8_WAIT_V(8); PG8_WAIT_L(0); PG8_BAR; PG8_MM(1, 0, At, B0); PG8_MM(1, 1, At, B1); PG8_BAR; PG8_SCHED;
        }
        if constexpr (Sched::FP8) asm volatile("s_nop 15\n\ts_nop 7" ::: "memory");
        if (wr == 0) PG8_BAR;
        E(acc, cur, wr, wc, fr, fq);
        if (!has_next) break;
#pragma unroll
        for (int a = 0; a < 2; ++a)
#pragma unroll
            for (int b = 0; b < 2; ++b)
#pragma unroll
                for (int m = 0; m < 4; ++m)
#pragma unroll
                    for (int n = 0; n < 2; ++n) acc[a][b][m][n] = (f32x4){0.f, 0.f, 0.f, 0.f};
        cur = nxt; cB = nB; ++ui;
#pragma unroll
        for (int h = 0; h < 2; ++h)
#pragma unroll
            for (int i = 0; i < 2; ++i) aoC[h][i] = aoN[h][i];
        if (wr == 1) PG8_BAR;
    }
    PG8_WAIT_V(0);
    PG8_BAR;
#undef PG8_SA
#undef PG8_SB
#undef PG8_STAGE
#undef PG8_LDA
#undef PG8_LDB
#undef PG8_MMA
#undef PG8_MMA8
#undef PG8_MM
#undef PG8_WAIT_V
#undef PG8_WAIT_L
#undef PG8_BAR
#undef PG8_SCHED
}

struct EpiProj {
    static constexpr bool PERM = true;
    bf16_t* O; float* dtraw;
    __device__ __forceinline__ void operator()(const f32x4 (&acc)[2][2][4][2], const Unit& u, int wr, int wc, int fr, int fq) const {
        const int row0 = u.pm * BM + wr * 64 + fr, col0 = u.pn * BM + wc * 32 + 8 * fq;
#pragma unroll
        for (int ai = 0; ai < 2; ++ai)
#pragma unroll
            for (int m = 0; m < 4; ++m) { const int row = row0 + ai * HALF + m * 16; bf16_t* rowp = O + (size_t)row * NPROJ + col0;
#pragma unroll
                for (int bj = 0; bj < 2; ++bj) { const f32x4 v0 = acc[ai][bj][m][0], v1 = acc[ai][bj][m][1];
                    u32x4 w; w.x = cvt_pk_bf16(v0[0], v0[1]); w.y = cvt_pk_bf16(v0[2], v0[3]); w.z = cvt_pk_bf16(v1[0], v1[1]); w.w = cvt_pk_bf16(v1[2], v1[3]);
                    __builtin_nontemporal_store(w, (u32x4*)(rowp + bj * HALF)); } }
    }
};
struct EpiX1 {
    static constexpr bool PERM = true;
    const float* x; const float* mod; bf16_t* x1; float* ss16;
    __device__ __forceinline__ void operator()(const f32x4 (&acc)[2][2][4][2], const Unit& u, int wr, int wc, int fr, int fq) const {
        const int row0 = u.pm * BM + wr * 64 + fr, col0 = u.pn * BM + wc * 32 + 8 * fq; const int b = (u.pm * BM) >> 11;
        f32x4 gv[2][2];
#pragma unroll
        for (int bj = 0; bj < 2; ++bj)
#pragma unroll
            for (int n = 0; n < 2; ++n) gv[bj][n] = *(const f32x4*)(mod + (size_t)b * 6144 + 2 * 1024 + col0 + bj * HALF + n * 4);
#pragma unroll
        for (int ai = 0; ai < 2; ++ai) {
            f32x4 xa[4][2], xb[4][2];
#pragma unroll
            for (int m = 0; m < 4; ++m) { const size_t off = (size_t)(row0 + ai * HALF + m * 16) * DM + col0;
#pragma unroll
                for (int bj = 0; bj < 2; ++bj) { xa[m][bj] = *(const f32x4*)(x + off + bj * HALF); xb[m][bj] = *(const f32x4*)(x + off + bj * HALF + 4); } }
#pragma unroll
            for (int m = 0; m < 4; ++m) { const int row = row0 + ai * HALF + m * 16; const size_t off = (size_t)row * DM + col0; float ss = 0.f;
#pragma unroll
                for (int bj = 0; bj < 2; ++bj) {
                    const f32x4 o0 = xa[m][bj] + gv[bj][0] * acc[ai][bj][m][0], o1 = xb[m][bj] + gv[bj][1] * acc[ai][bj][m][1];
                    u32x4 w; w.x = cvt_pk_bf16(o0[0], o0[1]); w.y = cvt_pk_bf16(o0[2], o0[3]); w.z = cvt_pk_bf16(o1[0], o1[1]); w.w = cvt_pk_bf16(o1[2], o1[3]);
                    *(u32x4*)(x1 + off + bj * HALF) = w;
                    ss += ((o0[0] * o0[0] + o0[1] * o0[1]) + (o0[2] * o0[2] + o0[3] * o0[3])) + ((o1[0] * o1[0] + o1[1] * o1[1]) + (o1[2] * o1[2] + o1[3] * o1[3])); }
                ss += __shfl_xor(ss, 16); ss += __shfl_xor(ss, 32);
                if (fq == 0) ss16[(size_t)row * 16 + u.pn * 4 + wc] = ss; }
        }
    }
};
struct EpiAct {
    static constexpr bool PERM = true;
    unsigned char* act;
    __device__ __forceinline__ void operator()(const f32x4 (&acc)[2][2][4][2], const Unit& u, int wr, int wc, int fr, int fq) const {
        const int row0 = u.pm * BM + wr * 64 + fr, col0 = u.pn * HALF + wc * 32 + 8 * fq; const int odd = fq & 1;
#pragma unroll
        for (int ai = 0; ai < 2; ++ai)
#pragma unroll
            for (int mp = 0; mp < 2; ++mp) { u32x2 w[2];
#pragma unroll
                for (int mm = 0; mm < 2; ++mm) { const int m = 2 * mp + mm; float o[8];
#pragma unroll
                    for (int n = 0; n < 2; ++n)
#pragma unroll
                        for (int i = 0; i < 4; ++i) { const float a = acc[ai][0][m][n][i] * W_F8_INV, b = acc[ai][1][m][n][i] * W_F8_INV; o[n * 4 + i] = siluf_(a) * b; }
                    w[mm].x = cvt_pk4_fp8(o[0], o[1], o[2], o[3]); w[mm].y = cvt_pk4_fp8(o[4], o[5], o[6], o[7]); }
                const auto sx = __builtin_amdgcn_permlane16_swap(w[0].x, w[1].x, false, false), sy = __builtin_amdgcn_permlane16_swap(w[0].y, w[1].y, false, false);
                u32x4 v; v.x = sx[0]; v.y = sy[0]; v.z = sx[1]; v.w = sy[1];
                *(u32x4*)(act + (size_t)(row0 + ai * HALF + (2 * mp + odd) * 16) * FF + col0 - 8 * odd) = v; }
    }
};
struct EpiY {
    static constexpr bool PERM = true;
    const unsigned* list; const float* gates; unsigned char* Y0; unsigned char* Y1;
    __device__ __forceinline__ void operator()(const f32x4 (&acc)[2][2][4][2], const Unit& u, int wr, int wc, int fr, int fq) const {
        const int col0 = u.pn * BM + wc * 32 + 8 * fq; const size_t sb = (size_t)u.e * ECAP + u.slot0; const int odd = fq & 1;
        unsigned ent[2][4]; float gt[2][4];
#pragma unroll
        for (int ai = 0; ai < 2; ++ai)
#pragma unroll
            for (int m = 0; m < 4; ++m) { const int r = ai * HALF + wr * 64 + m * 16 + fr; const int rc = r < u.cnt ? r : 0; ent[ai][m] = list[sb + rc]; gt[ai][m] = gates[sb + rc]; }
#pragma unroll
        for (int ai = 0; ai < 2; ++ai)
#pragma unroll
            for (int m = 0; m < 4; ++m) { const int r = ai * HALF + wr * 64 + m * 16 + fr;
                const unsigned tok = ent[ai][m] >> 1; const float gate = gt[ai][m] * W_F8_INV; u32x2 w[2];
#pragma unroll
                for (int bj = 0; bj < 2; ++bj) { const f32x4 v0 = acc[ai][bj][m][0] * gate, v1 = acc[ai][bj][m][1] * gate;
                    w[bj].x = cvt_pk4_fp8(v0[0], v0[1], v0[2], v0[3]); w[bj].y = cvt_pk4_fp8(v1[0], v1[1], v1[2], v1[3]); }
                const auto sx = __builtin_amdgcn_permlane16_swap(w[0].x, w[1].x, false, false), sy = __builtin_amdgcn_permlane16_swap(w[0].y, w[1].y, false, false);
                u32x4 v; v.x = sx[0]; v.y = sy[0]; v.z = sx[1]; v.w = sy[1];
                if (r < u.cnt) *(u32x4*)(((ent[ai][m] & 1u) ? Y1 : Y0) + (size_t)tok * DM + col0 + (odd ? HALF - 8 : 0)) = v; }
    }
};
}

struct Frame {
    unsigned char* lds; int tid, lane, wave, vcu, G, gw, NGW;
};

struct TrItem { const float* src; bf16_t* dst; int ldw, nrel, K, f8; };
__device__ __forceinline__ void tr_load(const TrItem& t, int lane, f32x4 (&v)[8]) {
    const int c4 = (lane & 7) * 4;
#pragma unroll
    for (int i = 0; i < 8; ++i) { const int kk = (lane >> 3) + 8 * i; v[i] = (c4 < t.nrel) ? *(const f32x4*)(t.src + (size_t)kk * t.ldw + c4) : (f32x4){0.f, 0.f, 0.f, 0.f}; }
}
__device__ __forceinline__ void tr_to_lds(const f32x4 (&v)[8], float* scr, int lane) {
    const int c4 = (lane & 7) * 4;
#pragma unroll
    for (int i = 0; i < 8; ++i) { const int kk = (lane >> 3) + 8 * i; float* p = scr + kk * 33 + c4; p[0] = v[i][0]; p[1] = v[i][1]; p[2] = v[i][2]; p[3] = v[i][3]; }
    asm volatile("s_waitcnt lgkmcnt(0)" ::: "memory");
}
__device__ __forceinline__ void tr_store(const TrItem& t, const float* scr, int lane) {
    const int c = lane & 7;
#pragma unroll
    for (int j = 0; j < 4; ++j) { const int n = (lane >> 3) + 8 * j; const float* s = scr + (8 * c) * 33 + n;
        u32x4 o; o.x = cvt_pk_bf16(s[0 * 33], s[1 * 33]); o.y = cvt_pk_bf16(s[2 * 33], s[3 * 33]); o.z = cvt_pk_bf16(s[4 * 33], s[5 * 33]); o.w = cvt_pk_bf16(s[6 * 33], s[7 * 33]);
        if (t.f8) { u32x2 o8; o8.x = cvt_pk4_fp8(s[0 * 33] * pg8::W_F8_SCALE, s[1 * 33] * pg8::W_F8_SCALE, s[2 * 33] * pg8::W_F8_SCALE, s[3 * 33] * pg8::W_F8_SCALE);
            o8.y = cvt_pk4_fp8(s[4 * 33] * pg8::W_F8_SCALE, s[5 * 33] * pg8::W_F8_SCALE, s[6 * 33] * pg8::W_F8_SCALE, s[7 * 33] * pg8::W_F8_SCALE);
            *(u32x2*)((unsigned char*)t.dst + (size_t)n * t.K + 8 * c) = o8; }
        else *(u32x4*)(t.dst + (size_t)n * t.K + 8 * c) = o; }
    asm volatile("s_waitcnt lgkmcnt(0)" ::: "memory");
}
__device__ __forceinline__ void p0_prep(const Frame& F, const Params& P) {
    unsigned char* ws = P.ws;
    {
        float* sct = (float*)F.lds;
        const float* c = P.in[1];
        for (int idx = F.tid; idx < 32 * 1024; idx += NTHREADS) { const int b = idx >> 10, k = idx & 1023; sct[k * 32 + (((b & ~3) ^ ((k & 7) << 2)) | (b & 3))] = siluf_(c[idx]); }
        __syncthreads();
        const float* w_ada = P.in[2]; const float* b_ada = P.in[3]; float* mod = (float*)(ws + WS_MOD);
        for (int cg = F.vcu; cg < 256; cg += F.G) {
            const int j = F.tid % 24, kg = F.tid / 24;
            float acc[32];
#pragma unroll
            for (int b = 0; b < 32; ++b) acc[b] = 0.f;
            if (kg < 16) {
                for (int kb = 0; kb < 4; ++kb) { float wv[16];
#pragma unroll
                    for (int kk = 0; kk < 16; ++kk) wv[kk] = w_ada[(size_t)(kg * 64 + kb * 16 + kk) * 6144 + cg * 24 + j];
#pragma unroll
                    for (int kk = 0; kk < 16; ++kk) { const int k = kg * 64 + kb * 16 + kk; const float w = wv[kk];
#pragma unroll
                        for (int q = 0; q < 8; ++q) { const f32x4 s = *(const f32x4*)(sct + k * 32 + ((4 * q) ^ ((k & 7) << 2))); acc[4 * q] += s[0] * w; acc[4 * q + 1] += s[1] * w; acc[4 * q + 2] += s[2] * w; acc[4 * q + 3] += s[3] * w; } } }
            }
            float* px = (float*)(F.lds + 131072);
            float tot[2] = {0.f, 0.f};
#pragma unroll 1
            for (int half = 0; half < 2; ++half) {
                if (kg < 16 && (kg >> 3) == half) {
#pragma unroll
                    for (int b = 0; b < 32; ++b) px[b * 192 + (kg & 7) * 24 + j] = acc[b];
                }
                __syncthreads();
#pragma unroll
                for (int r = 0; r < 2; ++r) { const int o = F.tid + r * 512; if (o < 768) { float s = 0.f;
#pragma unroll
                        for (int q = 0; q < 8; ++q) s += px[(o / 24) * 192 + q * 24 + (o % 24)]; tot[r] += s; } }
                __syncthreads();
            }
#pragma unroll
            for (int r = 0; r < 2; ++r) { const int o = F.tid + r * 512; if (o < 768) { const int jj = o % 24, b = o / 24; mod[(size_t)b * 6144 + cg * 24 + jj] = tot[r] + b_ada[cg * 24 + jj]; } }
        }
        __syncthreads();
    }
    {
        float* scr = (float*)(F.lds + F.wave * 16384);
        const float* w_in = P.in[4]; const float* w_out = P.in[13]; const float* w13 = P.in[18]; const float* w2 = P.in[19];
        bf16_t* WIN = (bf16_t*)(ws + WS_WIN); bf16_t* WOUT = (bf16_t*)(ws + WS_WOUT); bf16_t* W13 = (bf16_t*)(ws + WS_W13); bf16_t* W2 = (bf16_t*)(ws + WS_W2);
        constexpr int I0 = 16 * 80, I1 = 16 * 32, I2 = 32 * 16 * 32, I3 = 32 * 8 * 32, NIT = I0 + I1 + I2 + I3;
        auto decode = [&](int it) -> TrItem {
            TrItem t; int r = it;
            if (r < I0) { const int kb = r / 80, nb = 8 + r % 80, n0 = nb * 32; t.src = w_in + (size_t)kb * 64 * NPROJ_REAL + n0; t.ldw = NPROJ_REAL; t.nrel = NPROJ_REAL - n0; t.dst = WIN + (size_t)n0 * 1024 + kb * 64; t.K = 1024; t.f8 = 0; return t; } r -= I0;
            if (r < I1) { const int kb = r / 32, nb = r % 32, n0 = nb * 32; t.src = w_out + (size_t)kb * 64 * 1024 + n0; t.ldw = 1024; t.nrel = 32; t.dst = WOUT + (size_t)n0 * 1024 + kb * 64; t.K = 1024; t.f8 = 0; return t; } r -= I1;
            if (r < I2) { const int e = r / 512, q = r % 512, kb = q / 32, nb = q % 32; const int n0 = nb * 32, bj = n0 >> 9, rem = n0 & 511, pn = rem >> 7, j0 = rem & 127;
                t.src = w13 + (size_t)e * 1024 * 1024 + (size_t)kb * 64 * 1024 + n0; t.ldw = 1024; t.nrel = 32; t.dst = (bf16_t*)((unsigned char*)W13 + (size_t)e * 1024 * 1024 + (size_t)(pn * 256 + bj * 128 + j0) * 1024 + kb * 64); t.K = 1024; t.f8 = 1; return t; } r -= I2;
            { const int e = r / 256, q = r % 256, kb = q / 32, nb = q % 32, n0 = nb * 32;
                t.src = w2 + (size_t)e * 512 * 1024 + (size_t)kb * 64 * 1024 + n0; t.ldw = 1024; t.nrel = 32; t.dst = (bf16_t*)((unsigned char*)W2 + (size_t)e * 1024 * 512 + (size_t)n0 * 512 + kb * 64); t.K = 512; t.f8 = 1; return t; }
        };
        int it = F.gw; f32x4 v[8]; TrItem cur;
        if (it < NIT) { cur = decode(it); tr_load(cur, F.lane, v); }
        while (it < NIT) {
            tr_to_lds(v, scr, F.lane);
            const int nx = it + F.NGW; TrItem nxt = cur;
            if (nx < NIT) { nxt = decode(nx); tr_load(nxt, F.lane, v); }
            tr_store(cur, scr, F.lane);
            cur = nxt; it = nx;
        }
    }
    {
        const float* w_in = P.in[4]; const float* w_pool = P.in[5]; const float* pscale = P.in[6]; bf16_t* WIN = (bf16_t*)(ws + WS_WIN);
        for (int idx = F.vcu * NTHREADS + F.tid; idx < 256 * 1024; idx += F.G * NTHREADS) {
            const int n = idx >> 10, k = idx & 1023, g = n >> 6, d = n & 63; const float* wi = w_in + (size_t)k * NPROJ_REAL + g * 64; const float* wp = w_pool + (size_t)g * 4096 + d;
            float s = 0.f;
#pragma unroll 8
            for (int cc = 0; cc < 64; ++cc) s += wi[cc] * wp[cc * 64];
            s *= pscale[n];
            WIN[(size_t)n * 1024 + k] = (bf16_t)(cvt_pk_bf16(s, 0.f) & 0xffffu);
        }
    }
    {
        const float* wg = P.in[14]; const float* wrt = P.in[16]; bf16_t* WRH = (bf16_t*)(ws + WS_WR); bf16_t* WRL = (bf16_t*)(ws + WS_WR + 131072);
        { const float* w_in = P.in[4]; float* WDT = (float*)(ws + WS_WDT); for (int idx = F.vcu * NTHREADS + F.tid; idx < 12 * 1024; idx += F.G * NTHREADS) { const int j = idx >> 10, k = idx & 1023; WDT[idx] = w_in[(size_t)k * NPROJ_REAL + COL_DT + j]; } }
        for (int idx = F.vcu * NTHREADS + F.tid; idx < 36 * 1024; idx += F.G * NTHREADS) { const int j = idx >> 10, k = idx & 1023; const float w = (j < 4) ? wg[k * 4 + j] : wrt[k * 32 + (j - 4)];
            const unsigned hi = cvt_pk_bf16(w, 0.f) & 0xffffu; const float lo = w - __uint_as_float(hi << 16); WRH[idx] = (bf16_t)hi; WRL[idx] = (bf16_t)(cvt_pk_bf16(lo, 0.f) & 0xffffu); }
    }
}

__device__ __forceinline__ void p1_modulate(const Frame& F, const Params& P) {
    const float* x = P.in[0]; const float* mod = (const float*)(P.ws + WS_MOD); bf16_t* H = (bf16_t*)(P.ws + WS_H); float* dtraw = (float*)(P.ws + WS_DTRAW);
    float* wdt = (float*)F.lds;
    for (int idx = F.tid; idx < 12 * 256; idx += NTHREADS) ((f32x4*)wdt)[idx] = ((const f32x4*)(P.ws + WS_WDT))[idx];
    __syncthreads();
    const int lane = F.lane;
    f32x4 v[2][4], vn[2][4], vnn[2][4];
#define P1_LOAD(dst, rw) do { if ((rw) < T) { _Pragma("unroll") for (int r = 0; r < 2; ++r) { const f32x4* xr = (const f32x4*)(x + (size_t)((rw) + r) * DM) + lane; \
        _Pragma("unroll") for (int j = 0; j < 4; ++j) dst[r][j] = __builtin_nontemporal_load(xr + 64 * j); } } } while (0)
    P1_LOAD(v, F.gw * 2); P1_LOAD(vn, F.gw * 2 + F.NGW * 2);
    for (int row0 = F.gw * 2; row0 < T; row0 += F.NGW * 2) {
        const int b = row0 >> 11; float s[2] = {0.f, 0.f};
        P1_LOAD(vnn, row0 + F.NGW * 4);
        const f32x4* sh = (const f32x4*)(mod + (size_t)b * 6144) + lane; const f32x4* sc = (const f32x4*)(mod + (size_t)b * 6144 + 1024) + lane;
        f32x4 a[4], m[4];
#pragma unroll
        for (int j = 0; j < 4; ++j) { a[j] = sh[64 * j]; m[j] = sc[64 * j] + 1.0f; }
#pragma unroll
        for (int r = 0; r < 2; ++r) {
#pragma unroll
            for (int j = 0; j < 4; ++j) s[r] += (v[r][j][0] * v[r][j][0] + v[r][j][1] * v[r][j][1]) + (v[r][j][2] * v[r][j][2] + v[r][j][3] * v[r][j][3]);
            const float rstd = rsqrtf(wave_sum(s[r]) * (1.f / DM) + EPS);
            u32x2* o = (u32x2*)(H + (size_t)(row0 + r) * DM) + lane;
#pragma unroll
            for (int j = 0; j < 4; ++j) { v[r][j] = v[r][j] * rstd * m[j] + a[j]; u32x2 w; w.x = cvt_pk_bf16(v[r][j][0], v[r][j][1]); w.y = cvt_pk_bf16(v[r][j][2], v[r][j][3]); o[64 * j] = w; } }
        float pv[32];
#pragma unroll
        for (int c = 0; c < 16; ++c) { float p0 = 0.f, p1 = 0.f;
            if (c < 12) {
#pragma unroll
                for (int j = 0; j < 4; ++j) { const f32x4 w4 = *(const f32x4*)(wdt + c * 1024 + 256 * j + 4 * lane);
                    p0 += (w4[0] * v[0][j][0] + w4[1] * v[0][j][1]) + (w4[2] * v[0][j][2] + w4[3] * v[0][j][3]); p1 += (w4[0] * v[1][j][0] + w4[1] * v[1][j][1]) + (w4[2] * v[1][j][2] + w4[3] * v[1][j][3]); } }
            pv[c] = p0; pv[16 + c] = p1; }
#pragma unroll
        for (int k = 0; k < 16; ++k) { const bool hi = (lane & 16) != 0; const float mine = hi ? pv[k + 16] : pv[k], send = hi ? pv[k] : pv[k + 16]; pv[k] = mine + __shfl_xor(send, 16); }
#pragma unroll
        for (int k = 0; k < 8; ++k) { const bool hi = (lane & 8) != 0; const float mine = hi ? pv[k + 8] : pv[k], send = hi ? pv[k] : pv[k + 8]; pv[k] = mine + __shfl_xor(send, 8); }
#pragma unroll
        for (int k = 0; k < 4; ++k) { const bool hi = (lane & 4) != 0; const float mine = hi ? pv[k + 4] : pv[k], send = hi ? pv[k] : pv[k + 4]; pv[k] = mine + __shfl_xor(send, 4); }
#pragma unroll
        for (int k = 0; k < 2; ++k) { const bool hi = (lane & 2) != 0; const float mine = hi ? pv[k + 2] : pv[k], send = hi ? pv[k] : pv[k + 2]; pv[k] = mine + __shfl_xor(send, 2); }
        { const bool hi = (lane & 1) != 0; const float mine = hi ? pv[1] : pv[0], send = hi ? pv[0] : pv[1]; pv[0] = mine + __shfl_xor(send, 1); }
        const float tot = pv[0] + __shfl_xor(pv[0], 32);
        if (lane < 32 && (lane & 15) < 12) dtraw[(size_t)(row0 + (lane >> 4)) * 16 + (lane & 15)] = tot;
#pragma unroll
        for (int r = 0; r < 2; ++r)
#pragma unroll
            for (int j = 0; j < 4; ++j) { v[r][j] = vn[r][j]; vn[r][j] = vnn[r][j]; }
    }
#undef P1_LOAD
}

template <int W>
__device__ __forceinline__ void pool_item(const bf16_t* src, bf16_t* dst, int t0) {
    u32x4 hist[W - 1], cur[16];
#pragma unroll
    for (int i = 0; i < 16; ++i) cur[i] = *(const u32x4*)(src + (size_t)i * NPROJ);
    if (t0 > 0) {
#pragma unroll
        for (int h = 0; h < W - 1; ++h) hist[h] = *(const u32x4*)(src - (size_t)(W - 1 - h) * NPROJ); }
    else {
#pragma unroll
        for (int h = 0; h < W - 1; ++h) hist[h] = (u32x4){0u, 0u, 0u, 0u}; }
#define UNP8P(dst, v) do { dst[0] = bf_lo(v.x); dst[1] = bf_hi(v.x); dst[2] = bf_lo(v.y); dst[3] = bf_hi(v.y); dst[4] = bf_lo(v.z); dst[5] = bf_hi(v.z); dst[6] = bf_lo(v.w); dst[7] = bf_hi(v.w); } while (0)
    float sum[8];
#pragma unroll
    for (int k = 0; k < 8; ++k) sum[k] = 0.f;
#pragma unroll
    for (int h = 0; h < W - 1; ++h) { float e[8]; UNP8P(e, hist[h]);
#pragma unroll
        for (int k = 0; k < 8; ++k) sum[k] += e[k]; }
#pragma unroll
    for (int i = 0; i < 16; ++i) {
        float c[8]; UNP8P(c, cur[i]);
#pragma unroll
        for (int k = 0; k < 8; ++k) sum[k] += c[k];
        if (i >= 1) { float o[8]; if (i <= W - 1) UNP8P(o, hist[i - 1 < W - 1 ? i - 1 : 0]); else UNP8P(o, cur[i - W >= 0 ? i - W : 0]);
#pragma unroll
            for (int k = 0; k < 8; ++k) sum[k] -= o[k]; }
        const int cnt = (t0 > 0) ? W : ((i + 1) < W ? (i + 1) : W); const float inv = 1.0f / (float)cnt;
        u32x4 pk; pk.x = cvt_pk_bf16(sum[0] * inv - c[0], sum[1] * inv - c[1]); pk.y = cvt_pk_bf16(sum[2] * inv - c[2], sum[3] * inv - c[3]);
        pk.z = cvt_pk_bf16(sum[4] * inv - c[4], sum[5] * inv - c[5]); pk.w = cvt_pk_bf16(sum[6] * inv - c[6], sum[7] * inv - c[7]);
        *(u32x4*)(dst + (size_t)i * DM) = pk;
    }
#undef UNP8P
}

__device__ __forceinline__ void p3_conv(const Frame& F, const Params& P) {
    const bf16_t* proj = (const bf16_t*)(P.ws + WS_PROJ); bf16_t* XA = (bf16_t*)(P.ws + WS_XA);
    const float* conv_w = P.in[7]; const float* conv_b = P.in[8];
    if (F.wave < 2) {
        const float* dtraw = (const float*)(P.ws + WS_DTRAW); float* SA = (float*)(P.ws + WS_SA);
        const float* dt_bias = P.in[9]; const float* a_log = P.in[10];
        for (int bc = F.vcu * 2 + F.wave; bc < BATCH * 16; bc += F.G * 2) {
            const int h = F.lane < 48 ? (F.lane >> 2) : 11, seg = F.lane & 3; const float a = -__expf(a_log[h]), dtb = dt_bias[h];
            const float* src = dtraw + ((size_t)bc * 128 + 32 * seg) * 16 + h;
            float raw[32], dt[32], cs[32];
#pragma unroll
            for (int j = 0; j < 32; ++j) raw[j] = src[j * 16];
            float run = 0.f;
#pragma unroll
            for (int j = 0; j < 32; ++j) { const float v = raw[j] + dtb; dt[j] = v > 20.f ? v : log1pf(__expf(v)); run += dt[j] * a; cs[j] = run; }
            const float s0 = __shfl(run, (F.lane & ~3) + 0), s1 = __shfl(run, (F.lane & ~3) + 1), s2 = __shfl(run, (F.lane & ~3) + 2), s3 = __shfl(run, (F.lane & ~3) + 3);
            const float base = (seg > 0 ? s0 : 0.f) + (seg > 1 ? s1 : 0.f) + (seg > 2 ? s2 : 0.f); const float a127 = ((s0 + s1) + s2) + s3;
            if (F.lane < 48) {
                float* dst = SA + ((size_t)bc * 4 + h / 3) * 1536 + (h % 3) * 128 + 32 * seg;
#pragma unroll
                for (int j4 = 0; j4 < 8; ++j4) { f32x4 vd, va, vw, ve;
#pragma unroll
                    for (int e = 0; e < 4; ++e) { const int j = 4 * j4 + e; const float ac = base + cs[j], ae = base + cs[j | 15]; vd[e] = dt[j]; va[e] = ac; vw[e] = dt[j] * __expf(a127 - ac); ve[e] = dt[j] * __expf(ae - ac); }
                    *(f32x4*)(dst + 4 * j4) = vd; *(f32x4*)(dst + 384 + 4 * j4) = va; *(f32x4*)(dst + 768 + 4 * j4) = vw; *(f32x4*)(dst + 1152 + 4 * j4) = ve; }
            }
        }
    }
    {
        constexpr int NITEM = (T / 16) * 224; const int stride = F.G * NTHREADS;
        int item = F.vcu * NTHREADS + F.tid;
        u32x4 raw[19];
        auto load_item = [&](int it, u32x4 (&r)[19]) {
            const int cg = it % 224, rr = it / 224, ch = cg * 8, row0 = rr * 16, t0 = row0 & (SEQ - 1);
            const bf16_t* src = proj + (size_t)row0 * NPROJ + COL_XS + ch;
#pragma unroll
            for (int i = 0; i < 16; ++i) r[3 + i] = __builtin_nontemporal_load((const u32x4*)(src + (size_t)i * NPROJ));
            if (t0 >= 3) {
#pragma unroll
                for (int i = 0; i < 3; ++i) r[i] = *(const u32x4*)(src - (size_t)(3 - i) * NPROJ); }
            else { r[0] = (u32x4){0u, 0u, 0u, 0u}; r[1] = r[0]; r[2] = r[0]; }
        };
        if (item < NITEM) load_item(item, raw);
        while (item < NITEM) {
            const int cg = item % 224, rr = item / 224, ch = cg * 8, row0 = rr * 16;
            const int nxt = item + stride;
            u32x4 raw2[19];
            if (nxt < NITEM) load_item(nxt, raw2);
            float w[4][8], bs[8];
#pragma unroll
            for (int j = 0; j < 4; ++j) { const f32x4 a = *(const f32x4*)(conv_w + j * 1792 + ch), c = *(const f32x4*)(conv_w + j * 1792 + ch + 4);
#pragma unroll
                for (int k = 0; k < 4; ++k) { w[j][k] = a[k]; w[j][4 + k] = c[k]; } }
            { const f32x4 a = *(const f32x4*)(conv_b + ch), c = *(const f32x4*)(conv_b + ch + 4);
#pragma unroll
                for (int k = 0; k < 4; ++k) { bs[k] = a[k]; bs[4 + k] = c[k]; } }
#define UNP8(dst, v) do { dst[0] = bf_lo(v.x); dst[1] = bf_hi(v.x); dst[2] = bf_lo(v.y); dst[3] = bf_hi(v.y); dst[4] = bf_lo(v.z); dst[5] = bf_hi(v.z); dst[6] = bf_lo(v.w); dst[7] = bf_hi(v.w); } while (0)
            float r0[8], r1[8], r2[8];
            UNP8(r0, raw[0]); UNP8(r1, raw[1]); UNP8(r2, raw[2]);
#pragma unroll
            for (int i = 0; i < 16; ++i) {
                float cur[8]; UNP8(cur, raw[3 + i]); float o[8];
#pragma unroll
                for (int k = 0; k < 8; ++k) { const float v = bs[k] + w[0][k] * r0[k] + w[1][k] * r1[k] + w[2][k] * r2[k] + w[3][k] * cur[k]; o[k] = siluf_(v); r0[k] = r1[k]; r1[k] = r2[k]; r2[k] = cur[k]; }
                u32x4 pk; pk.x = cvt_pk_bf16(o[0], o[1]); pk.y = cvt_pk_bf16(o[2], o[3]); pk.z = cvt_pk_bf16(o[4], o[5]); pk.w = cvt_pk_bf16(o[6], o[7]);
                *(u32x4*)(XA + (size_t)(row0 + i) * 1792 + ch) = pk;
            }
#pragma unroll
            for (int i = 0; i < 19; ++i) raw[i] = raw2[i];
            item = nxt;
        }
    }
    { bf16_t* mix = (bf16_t*)(P.ws + WS_MIX);
      for (int p = F.vcu * NTHREADS + F.tid; p < (T / 16) * 32; p += F.G * NTHREADS) {
        const int c8 = p & 7, rr8 = (p >> 3) & 7, grp = (p >> 6) & 3, rrblk = p >> 8; const int rr = rrblk * 8 + rr8, row0 = rr * 16, t0 = row0 & (SEQ - 1), col = grp * 64 + c8 * 8;
        const bf16_t* src = proj + (size_t)row0 * NPROJ + col; bf16_t* dst = mix + (size_t)row0 * DM + col;
        if (grp == 0) pool_item<2>(src, dst, t0); else if (grp == 1) pool_item<4>(src, dst, t0); else if (grp == 2) pool_item<8>(src, dst, t0); else pool_item<16>(src, dst, t0);
      } }
#undef UNP8
}

constexpr int L_B = 0, L_C = 32768, L_X = 49152, L_S = 98304, L_DT = 147456, L_ACS = L_DT + 1536, L_W = L_ACS + 1536, L_ES = L_W + 1536, L_NW = L_ES + 1536, L_T = L_NW + 768;
static_assert(L_T <= LDS_BYTES - 64, "SSD LDS map");
typedef short v4i16 __attribute__((ext_vector_type(4)));
__device__ __forceinline__ int swz16(int r) { const int h = (r >> 3) & 1; return ((((r & 7) + 4 * h) & 7) << 1) | h; }
__device__ __forceinline__ int swz8(int row) { return ((row >> 1) & 3) << 1; }
__device__ __forceinline__ bf16x8 tr_pair(LAS unsigned char* a0, LAS unsigned char* a1) {
    const v4i16 lo = __builtin_amdgcn_ds_read_tr16_b64_v4i16((LAS v4i16*)a0), hi = __builtin_amdgcn_ds_read_tr16_b64_v4i16((LAS v4i16*)a1);
    return (bf16x8){lo[0], lo[1], lo[2], lo[3], hi[0], hi[1], hi[2], hi[3]};
}
__device__ __forceinline__ bf16x8 pack8(const float (&v)[8]) {
    u32x4 p; p.x = cvt_pk_bf16(v[0], v[1]); p.y = cvt_pk_bf16(v[2], v[3]); p.z = cvt_pk_bf16(v[4], v[5]); p.w = cvt_pk_bf16(v[6], v[7]);
    return __builtin_bit_cast(bf16x8, p);
}
#define MFMA16(a, b, c) __builtin_amdgcn_mfma_f32_16x16x32_bf16((a), (b), (c), 0, 0, 0)
#define OPAQUE(x) asm volatile("" : "+v"(x))
#define SBAR() do { asm volatile("s_waitcnt lgkmcnt(0)" ::: "memory"); __builtin_amdgcn_s_barrier(); asm volatile("" ::: "memory"); } while (0)

__device__ __forceinline__ int ssd_glmap(int hl, int lt) { return hl ? (lt == 0 ? 2 : (lt == 1 ? 3 : (lt == 2 ? 5 : 4))) : (lt == 0 ? 0 : (lt == 1 ? 1 : (lt == 2 ? 7 : 6))); }
#define SSD_LANE() int ln_ = lane; OPAQUE(ln_); const int i = ln_ & 15, q = ln_ >> 4, qp = i >> 2, pp = ln_ & 3; (void)qp; (void)pp
#define SSD_PR() int pr[4]; { const int fsw = swz16(i); _Pragma("unroll") for (int ks = 0; ks < 4; ++ks) { pr[ks] = i * 256 + (((4 * ks + q) ^ fsw) << 4); OPAQUE(pr[ks]); } }
template <int CH>
__device__ __forceinline__ void ssd_compute(LAS unsigned char* L, int lt, int hl, int lane, f32x4 (&sacc)[2][6], f32x4 (&yacc)[6], float dsk0, float dsk1, bool xwait) {
    const int gl = ssd_glmap(hl, lt);
    const int lrow0 = 16 * gl;
    f32x4 cbt[8];
    {
        SSD_LANE(); SSD_PR();
        int cbase = lt * 4096; OPAQUE(cbase);
        bf16x8 cfrag[4];
#pragma unroll
        for (int ks = 0; ks < 4; ++ks) cfrag[ks] = *(const LAS bf16x8*)(L + L_C + cbase + pr[ks]);
#pragma unroll
        for (int tp = 0; tp < 4; ++tp) {
            f32x4 a0 = (f32x4){0.f, 0.f, 0.f, 0.f}, a1 = a0;
            if (2 * tp <= gl) {
                bf16x8 f0[4], f1[4];
#pragma unroll
                for (int ks = 0; ks < 4; ++ks) { f0[ks] = *(const LAS bf16x8*)(L + L_B + (2 * tp) * 4096 + pr[ks]); f1[ks] = *(const LAS bf16x8*)(L + L_B + (2 * tp + 1) * 4096 + pr[ks]); }
#pragma unroll
                for (int ks = 0; ks < 4; ++ks) { a0 = MFMA16(f0[ks], cfrag[ks], a0); a1 = MFMA16(f1[ks], cfrag[ks], a1); }
            }
            cbt[2 * tp] = a0; cbt[2 * tp + 1] = a1;
            __builtin_amdgcn_sched_barrier(0);
        }
    }
    bf16x8 mfrag[2][4];
    {
        SSD_LANE();
        int q16 = 16 * q; OPAQUE(q16);
        int lq = (lrow0 + 4 * q) * 4; OPAQUE(lq);
        int li = (lrow0 + i) * 4; OPAQUE(li);
        int dq = i - 4 * q; OPAQUE(dq);
        float acl[2];
#pragma unroll
        for (int hsel = 0; hsel < 2; ++hsel) acl[hsel] = *(const LAS float*)(L + L_ACS + (CH + hsel) * 512 + li);
#pragma unroll
        for (int kk = 0; kk < 4; ++kk) {
            f32x4 es[2][2]; float ae[2][2];
#pragma unroll
            for (int hsel = 0; hsel < 2; ++hsel)
#pragma unroll
                for (int hf = 0; hf < 2; ++hf) { const int ts = 2 * kk + hf, r = CH + hsel; es[hsel][hf] = *(const LAS f32x4*)(L + L_ES + r * 512 + ts * 64 + q16); ae[hsel][hf] = *(const LAS float*)(L + L_ACS + r * 512 + (16 * ts + 15) * 4); }
#pragma unroll
            for (int hsel = 0; hsel < 2; ++hsel) { const int r = CH + hsel; const float dsk = hsel ? dsk1 : dsk0; float v[8];
#pragma unroll
                for (int hf = 0; hf < 2; ++hf) { const int ts = 2 * kk + hf;
                    if (ts < gl) { const float el = __expf(acl[hsel] - ae[hsel][hf]);
#pragma unroll
                        for (int j = 0; j < 4; ++j) v[4 * hf + j] = cbt[ts][j] * el * es[hsel][hf][j]; }
                    else if (ts == gl) { const f32x4 asd = *(const LAS f32x4*)(L + L_ACS + r * 512 + lq), dsd = *(const LAS f32x4*)(L + L_DT + r * 512 + lq);
#pragma unroll
                        for (int j = 0; j < 4; ++j) { const float arg = fminf(acl[hsel] - asd[j], 0.f); const float cd = cbt[ts][j] * dsd[j]; const float m = cd * __expf(arg);
                            v[4 * hf + j] = (j < dq) ? m : ((j == dq) ? (cd + dsk) : 0.f); } }
                    else {
#pragma unroll
                        for (int j = 0; j < 4; ++j) v[4 * hf + j] = 0.f; } }
                mfrag[hsel][kk] = pack8(v); }
            if (kk == 1) __builtin_amdgcn_sched_barrier(0);
        }
    }
    {
        SSD_LANE(); SSD_PR();
        int cbase = lt * 4096; OPAQUE(cbase);
        int lq = (lrow0 + 4 * q) * 4; OPAQUE(lq);
        bf16x8 cfrag[4];
#pragma unroll
        for (int ks = 0; ks < 4; ++ks) cfrag[ks] = *(const LAS bf16x8*)(L + L_C + cbase + pr[ks]);
#pragma unroll
        for (int cp = 0; cp < 3; ++cp) { bf16x8 f0[4], f1[4];
#pragma unroll
            for (int ks = 0; ks < 4; ++ks) { f0[ks] = *(const LAS bf16x8*)(L + L_S + (96 * CH + 32 * cp) * 256 + pr[ks]); f1[ks] = *(const LAS bf16x8*)(L + L_S + (96 * CH + 32 * cp + 16) * 256 + pr[ks]); }
            f32x4 a0 = (f32x4){0.f, 0.f, 0.f, 0.f}, a1 = a0;
#pragma unroll
            for (int ks = 0; ks < 4; ++ks) { a0 = MFMA16(cfrag[ks], f0[ks], a0); a1 = MFMA16(cfrag[ks], f1[ks], a1); }
            yacc[2 * cp] = a0; yacc[2 * cp + 1] = a1; }
#pragma unroll
        for (int hsel = 0; hsel < 2; ++hsel) { const f32x4 ac4 = *(const LAS f32x4*)(L + L_ACS + (CH + hsel) * 512 + lq); const f32x4 e = (f32x4){__expf(ac4[0]), __expf(ac4[1]), __expf(ac4[2]), __expf(ac4[3])};
#pragma unroll
            for (int ct = 0; ct < 6; ++ct) if ((((6 * CH + ct) >> 2) - CH) == hsel) yacc[ct] = yacc[ct] * e; }
    }
#pragma unroll
    for (int hsel = 0; hsel < 2; ++hsel) { const float cd = __expf(*(const LAS float*)(L + L_ACS + (CH + hsel) * 512 + 127 * 4));
#pragma unroll
        for (int ct = 0; ct < 6; ++ct) if ((((6 * CH + ct) >> 2) - CH) == hsel) { sacc[0][ct] = sacc[0][ct] * cd; sacc[1][ct] = sacc[1][ct] * cd; } }
    __builtin_amdgcn_sched_barrier(0);
    SSD_LANE();
    int q16 = 16 * q; OPAQUE(q16);
    const int r4 = 4 * q + qp;
    int tb[2], tx[4];
    { const int fr = swz16(r4), xr = swz8(r4);
#pragma unroll
      for (int nt2 = 0; nt2 < 2; ++nt2) { tb[nt2] = r4 * 256 + 8 * (pp & 1) + (((2 * (2 * lt + nt2) + (pp >> 1)) ^ fr) << 4); OPAQUE(tb[nt2]); }
#pragma unroll
      for (int pt = 0; pt < 4; ++pt) { tx[pt] = r4 * 128 + 8 * (pp & 1) + (((2 * pt + (pp >> 1)) ^ xr) << 4); OPAQUE(tx[pt]); } }
    if (xwait) { asm volatile("s_waitcnt vmcnt(6)" ::: "memory"); SBAR(); }
#pragma unroll
    for (int kk = 0; kk < 4; ++kk) {
        bf16x8 bts[2][2];
        { bf16x8 btf[2];
#pragma unroll
          for (int nt2 = 0; nt2 < 2; ++nt2) btf[nt2] = tr_pair(L + L_B + kk * 8192 + tb[nt2], L + L_B + kk * 8192 + 4096 + tb[nt2]);
#pragma unroll
          for (int hsel = 0; hsel < 2; ++hsel) { const f32x4 wl = *(const LAS f32x4*)(L + L_W + (CH + hsel) * 512 + kk * 128 + q16), wh = *(const LAS f32x4*)(L + L_W + (CH + hsel) * 512 + kk * 128 + 64 + q16);
#pragma unroll
            for (int nt2 = 0; nt2 < 2; ++nt2) { float bs[8];
#pragma unroll
                for (int e = 0; e < 4; ++e) { bs[e] = __uint_as_float((unsigned)(unsigned short)btf[nt2][e] << 16) * wl[e]; bs[4 + e] = __uint_as_float((unsigned)(unsigned short)btf[nt2][4 + e] << 16) * wh[e]; }
                bts[hsel][nt2] = pack8(bs); } } }
        __builtin_amdgcn_sched_barrier(0);
        bf16x8 xf[6];
#pragma unroll
        for (int ct = 0; ct < 6; ++ct) { const int ctg = 6 * CH + ct, r = ctg >> 2, pt = ctg & 3; xf[ct] = tr_pair(L + L_X + r * 16384 + kk * 4096 + tx[pt], L + L_X + r * 16384 + kk * 4096 + 2048 + tx[pt]); }
        const bool ydo = (2 * kk <= gl);
#pragma unroll
        for (int ct = 0; ct < 6; ++ct) { const int ctg = 6 * CH + ct, r = ctg >> 2, hsel = r - CH;
            if (ydo) yacc[ct] = MFMA16(mfrag[hsel][kk], xf[ct], yacc[ct]);
            sacc[0][ct] = MFMA16(bts[hsel][0], xf[ct], sacc[0][ct]); sacc[1][ct] = MFMA16(bts[hsel][1], xf[ct], sacc[1][ct]); }
        __builtin_amdgcn_sched_barrier(0);
    }
}

__device__ __forceinline__ void ssd_dma_bc(LAS unsigned char* L, const bf16_t* xrow, int g, int hl, int wave, int lane) {
    OPAQUE(lane);
#pragma unroll
    for (int k = 0; k < 4; ++k) { const int m = wave * 4 + k, row = 4 * m + (lane >> 4), lc = (lane & 15) ^ swz16(row & 15);
        __builtin_amdgcn_global_load_lds((const unsigned*)(xrow + 768 + g * 128 + (unsigned)(row * 1792 + lc * 8)), (LAS unsigned*)(L + L_B + m * 1024), 16, 0, 0); }
    const bf16_t* crow = xrow + 1280 + g * 128;
#pragma unroll
    for (int k = 0; k < 2; ++k) { const int m = wave * 2 + k, row = 4 * m + (lane >> 4), lc = (lane & 15) ^ swz16(row & 15); const int grow = 16 * ssd_glmap(hl, m >> 2) + (row & 15);
        __builtin_amdgcn_global_load_lds((const unsigned*)(crow + (unsigned)(grow * 1792 + lc * 8)), (LAS unsigned*)(L + L_C + m * 1024), 16, 0, 0); }
}
__device__ __forceinline__ void ssd_dma_x(LAS unsigned char* L, const bf16_t* xrow, int g, int wave, int lane) {
    OPAQUE(lane);
#pragma unroll
    for (int k = 0; k < 6; ++k) { const int m = wave * 6 + k, r = m >> 4, blk = m & 15, row = 8 * blk + (lane >> 3), lc = (lane & 7) ^ swz8(row);
        __builtin_amdgcn_global_load_lds((const unsigned*)(xrow + g * 192 + r * 64 + (unsigned)(row * 1792 + lc * 8)), (LAS unsigned*)(L + L_X + r * 16384 + blk * 1024), 16, 0, 0); }
}

__device__ __forceinline__ void p4_ssd(const Frame& F, const Params& P) {
    LAS unsigned char* L = (LAS unsigned char*)F.lds;
    const bf16_t* XA = (const bf16_t*)(P.ws + WS_XA); const float* SA = (const float*)(P.ws + WS_SA);
    const bf16_t* proj = (const bf16_t*)(P.ws + WS_PROJ); bf16_t* mix = (bf16_t*)(P.ws + WS_MIX); const float* norm_w = P.in[12]; const float* d_skip = P.in[11];
    const int lane = F.lane, lt = F.wave >> 1, ch = F.wave & 1;
    for (int u = F.vcu; u < 256; u += F.G) {
        const int b = u >> 3, g = (u >> 1) & 3, hl = u & 1;
        __syncthreads();
        { int tz = F.tid; OPAQUE(tz); unsigned zz = 0u; OPAQUE(zz);
#pragma unroll
          for (int k = 0; k < 6; ++k) *(LAS u32x4*)(L + L_S + (tz + NTHREADS * k) * 16) = (u32x4){zz, zz, zz, zz};
          if (tz < 192) *(LAS float*)(L + L_NW + tz * 4) = norm_w[g * 192 + tz]; }
        f32x4 sacc[2][6];
#pragma unroll
        for (int a = 0; a < 2; ++a)
#pragma unroll
            for (int c = 0; c < 6; ++c) sacc[a][c] = (f32x4){0.f, 0.f, 0.f, 0.f};
        const float dsk0 = d_skip[3 * g + ch], dsk1 = d_skip[3 * g + ch + 1];
        const size_t tokb = (size_t)b * SEQ;
#define SSD_ROLES int t3_ = F.tid; OPAQUE(t3_); const int orow = t3_ >> 3, oseg = t3_ & 7, oc0 = g * 192 + oseg * 24; const int ogrow = 16 * ssd_glmap(hl, orow >> 4) + (orow & 15); (void)orow; (void)oseg; (void)oc0; (void)ogrow
#define SSD_DMA_SMALL(bc_) do { if (F.wave < 6) { int ln2_ = lane; OPAQUE(ln2_); __builtin_amdgcn_global_load_lds((const unsigned*)(SA + ((size_t)(bc_) * 4 + g) * 1536 + F.wave * 256 + ln2_ * 4), (LAS unsigned*)(L + L_DT + F.wave * 1024), 16, 0, 0); } } while (0)
        ssd_dma_bc(L, XA + tokb * 1792, g, hl, F.wave, lane); ssd_dma_x(L, XA + tokb * 1792, g, F.wave, lane);
        u32x4 zr[3];
        SSD_DMA_SMALL(b * 16);
        { SSD_ROLES;
          const bf16_t* zp = proj + tokb * NPROJ + (unsigned)(ogrow * NPROJ + COL_Z + oc0);
#pragma unroll
          for (int k = 0; k < 3; ++k) zr[k] = *(const u32x4*)(zp + 8 * k); }
        for (int ck = 0; ck < 16; ++ck) {
            const size_t tok0 = tokb + ck * 128;
            SSD_ROLES;
            if (ck == 0) asm volatile("s_waitcnt vmcnt(0)" ::: "memory"); else asm volatile("s_waitcnt vmcnt(12)" ::: "memory");
            SBAR();
            f32x4 yacc[6];
            if (ch == 0) ssd_compute<0>(L, lt, hl, lane, sacc, yacc, dsk0, dsk1, true); else ssd_compute<1>(L, lt, hl, lane, sacc, yacc, dsk0, dsk1, true);
            SBAR();
            float gz[24];
#pragma unroll
            for (int k = 0; k < 3; ++k) { gz[8 * k + 0] = siluf_(bf_lo(zr[k].x)); gz[8 * k + 1] = siluf_(bf_hi(zr[k].x)); gz[8 * k + 2] = siluf_(bf_lo(zr[k].y)); gz[8 * k + 3] = siluf_(bf_hi(zr[k].y));
                gz[8 * k + 4] = siluf_(bf_lo(zr[k].z)); gz[8 * k + 5] = siluf_(bf_hi(zr[k].z)); gz[8 * k + 6] = siluf_(bf_lo(zr[k].w)); gz[8 * k + 7] = siluf_(bf_hi(zr[k].w)); }
#pragma unroll
            for (int k = 0; k < 24; ++k) asm volatile("" : "+v"(gz[k]) :: "memory");
            if (ck < 15) {
                SSD_DMA_SMALL(b * 16 + ck + 1);
                ssd_dma_bc(L, XA + (tok0 + 128) * 1792, g, hl, F.wave, lane);
            }
            { int l2 = lane; OPAQUE(l2); const int i = l2 & 15, q = l2 >> 4;
#pragma unroll
            for (int nt2 = 0; nt2 < 2; ++nt2)
#pragma unroll
                for (int ct = 0; ct < 6; ++ct) { const f32x4 s = sacc[nt2][ct]; u32x2 pk; pk.x = cvt_pk_bf16(s[0], s[1]); pk.y = cvt_pk_bf16(s[2], s[3]);
                    const int row = 96 * ch + 16 * ct + i, n0 = 16 * (2 * lt + nt2) + 4 * q; *(LAS u32x2*)(L + L_S + row * 256 + (((n0 >> 3) ^ swz16(i)) << 4) + 8 * ((n0 >> 2) & 1)) = pk; }
#pragma unroll
            for (int j = 0; j < 4; ++j) { const int row = 16 * lt + 4 * q + j; const int rb = L_X + row * 384;
#pragma unroll
                for (int ct = 0; ct < 6; ++ct) *(LAS bf16_t*)(L + rb + (96 * ch + 16 * ct + i) * 2) = (bf16_t)(cvt_pk_bf16(yacc[ct][j], 0.f) & 0xffffu); } }
            SBAR();
            u32x4 yr[3];
            { const int row = orow, seg = oseg; const int rb = L_X + row * 384;
#pragma unroll
              for (int k = 0; k < 3; ++k) yr[k] = *(const LAS u32x4*)(L + rb + seg * 48 + k * 16); }
            SBAR();
            if (ck < 15) ssd_dma_x(L, XA + (tok0 + 128) * 1792, g, F.wave, lane);
            asm volatile("" ::: "memory");
            { float v[24]; float ss = 0.f;
#pragma unroll
              for (int k = 0; k < 3; ++k) { v[8 * k + 0] = bf_lo(yr[k].x) * gz[8 * k + 0]; v[8 * k + 1] = bf_hi(yr[k].x) * gz[8 * k + 1]; v[8 * k + 2] = bf_lo(yr[k].y) * gz[8 * k + 2]; v[8 * k + 3] = bf_hi(yr[k].y) * gz[8 * k + 3];
                  v[8 * k + 4] = bf_lo(yr[k].z) * gz[8 * k + 4]; v[8 * k + 5] = bf_hi(yr[k].z) * gz[8 * k + 5]; v[8 * k + 6] = bf_lo(yr[k].w) * gz[8 * k + 6]; v[8 * k + 7] = bf_hi(yr[k].w) * gz[8 * k + 7]; }
#pragma unroll
              for (int k = 0; k < 24; ++k) ss += v[k] * v[k];
              ss += __shfl_xor(ss, 1); ss += __shfl_xor(ss, 2); ss += __shfl_xor(ss, 4);
              const float rstd = rsqrtf(ss * (1.f / 192.f) + EPS);
              bf16_t* op = mix + tok0 * DM + (unsigned)(ogrow * DM + 256 + oc0);
#pragma unroll
              for (int k = 0; k < 3; ++k) { const f32x4 n0 = *(const LAS f32x4*)(L + L_NW + (oseg * 24 + 8 * k) * 4), n1 = *(const LAS f32x4*)(L + L_NW + (oseg * 24 + 8 * k + 4) * 4); u32x4 pk;
                  pk.x = cvt_pk_bf16(v[8 * k] * rstd * n0[0], v[8 * k + 1] * rstd * n0[1]); pk.y = cvt_pk_bf16(v[8 * k + 2] * rstd * n0[2], v[8 * k + 3] * rstd * n0[3]);
                  pk.z = cvt_pk_bf16(v[8 * k + 4] * rstd * n1[0], v[8 * k + 5] * rstd * n1[1]); pk.w = cvt_pk_bf16(v[8 * k + 6] * rstd * n1[2], v[8 * k + 7] * rstd * n1[3]);
                  *(u32x4*)(op + 8 * k) = pk; } }
            if (ck < 15) { const bf16_t* zp = proj + (tok0 + 128) * NPROJ + (unsigned)(ogrow * NPROJ + COL_Z + oc0);
#pragma unroll
                for (int k = 0; k < 3; ++k) zr[k] = *(const u32x4*)(zp + 8 * k); }
        }
    }
}

constexpr int R_WH = 0, R_WL = 73728, R_SC = 147456, R_SH = R_SC + 4096, R_CNT = R_SH + 4096, R_LG = 0;
__device__ __forceinline__ void p5_route(const Frame& F, const Params& P) {
    LAS unsigned char* L = (LAS unsigned char*)F.lds;
    const bf16_t* x1 = (const bf16_t*)(P.ws + WS_X1); const float* mod = (const float*)(P.ws + WS_MOD); bf16_t* H = (bf16_t*)(P.ws + WS_H); const float* ss16 = (const float*)(P.ws + WS_SS16);
    const bf16_t* WRH = (const bf16_t*)(P.ws + WS_WR); const bf16_t* WRL = (const bf16_t*)(P.ws + WS_WR + 131072);
    float* gates = (float*)(P.ws + WS_SGATE); unsigned* list = (unsigned*)(P.ws + WS_LIST); unsigned* gcount = (unsigned*)(P.ws + WS_CTL) + CW_GCOUNT;
    const float* b_group = P.in[15]; const float* b_router = P.in[17];
    LAS unsigned* lcount = (LAS unsigned*)(L + R_CNT);
    LAS unsigned* lbase = lcount + 32;
    LAS unsigned* tinfo = lcount + 64;
    LAS float* twt = (LAS float*)(tinfo + 256 * 4);
    const int lane = F.lane, i = lane & 15, q = lane >> 4;
    for (int rb = F.vcu; rb < T / 256; rb += F.G) {
        const int b = rb >> 3;
        for (int idx = F.tid; idx < 36 * 128; idx += NTHREADS) { const int j = idx >> 7, c = idx & 127; const int dst = j * 2048 + ((c ^ swz16(j & 15)) << 4);
            *(LAS u32x4*)(L + R_WH + dst) = *(const u32x4*)(WRH + (size_t)j * 1024 + c * 8); *(LAS u32x4*)(L + R_WL + dst) = *(const u32x4*)(WRL + (size_t)j * 1024 + c * 8); }
        for (int idx = F.tid; idx < 256; idx += NTHREADS) { const f32x4 sc = *(const f32x4*)(mod + (size_t)b * 6144 + 4 * 1024 + idx * 4), sh = *(const f32x4*)(mod + (size_t)b * 6144 + 3 * 1024 + idx * 4);
            *(LAS f32x4*)(L + R_SC + idx * 16) = sc + 1.0f; *(LAS f32x4*)(L + R_SH + idx * 16) = sh; }
        if (F.tid < 32) lcount[F.tid] = 0u;
        __syncthreads();
        const int rowA = rb * 256 + F.wave * 32 + i;
        float rstd[2];
#pragma unroll
        for (int rt = 0; rt < 2; ++rt) { const f32x4* sp = (const f32x4*)(ss16 + (size_t)(rowA + 16 * rt) * 16); const f32x4 a = sp[0], c = sp[1], d = sp[2], e = sp[3];
            const float ss = ((a[0] + a[1]) + (a[2] + a[3])) + ((c[0] + c[1]) + (c[2] + c[3])) + ((d[0] + d[1]) + (d[2] + d[3])) + ((e[0] + e[1]) + (e[2] + e[3])); rstd[rt] = rsqrtf(ss * (1.f / DM) + EPS); }
        f32x4 acc[2][3];
#pragma unroll
        for (int rt = 0; rt < 2; ++rt)
#pragma unroll
            for (int ct = 0; ct < 3; ++ct) acc[rt][ct] = (f32x4){0.f, 0.f, 0.f, 0.f};
        int wrow[3];
#pragma unroll
        for (int ct = 0; ct < 3; ++ct) { const int j = (16 * ct + i) < 36 ? (16 * ct + i) : 35; wrow[ct] = j * 2048; }
        const int fsw = swz16(i);
        const int fswc = swz16(35 & 15);
#pragma unroll 2
        for (int s = 0; s < 32; ++s) {
            bf16x8 wh[3], wl[3];
#pragma unroll
            for (int ct = 0; ct < 3; ++ct) { const int sw = ((16 * ct + i) < 36) ? fsw : fswc; const int o = wrow[ct] + ((((4 * s + q) & ~15) | (((4 * s + q) & 15) ^ sw)) << 4);
                wh[ct] = *(const LAS bf16x8*)(L + R_WH + o); wl[ct] = *(const LAS bf16x8*)(L + R_WL + o); }
            const f32x4 sc0 = *(const LAS f32x4*)(L + R_SC + (32 * s + 8 * q) * 4), sc1 = *(const LAS f32x4*)(L + R_SC + (32 * s + 8 * q + 4) * 4);
            const f32x4 sh0 = *(const LAS f32x4*)(L + R_SH + (32 * s + 8 * q) * 4), sh1 = *(const LAS f32x4*)(L + R_SH + (32 * s + 8 * q + 4) * 4);
#pragma unroll
            for (int rt = 0; rt < 2; ++rt) { const size_t off = (size_t)(rowA + 16 * rt) * DM + 32 * s + 8 * q;
                const u32x4 xw = *(const u32x4*)(x1 + off); const f32x4 x0 = (f32x4){bf_lo(xw.x), bf_hi(xw.x), bf_lo(xw.y), bf_hi(xw.y)}, x1v = (f32x4){bf_lo(xw.z), bf_hi(xw.z), bf_lo(xw.w), bf_hi(xw.w)};
                const f32x4 h0 = x0 * rstd[rt] * sc0 + sh0, h1 = x1v * rstd[rt] * sc1 + sh1;
                u32x4 hi; hi.x = cvt_pk_bf16(h0[0], h0[1]); hi.y = cvt_pk_bf16(h0[2], h0[3]); hi.z = cvt_pk_bf16(h1[0], h1[1]); hi.w = cvt_pk_bf16(h1[2], h1[3]);
                { u32x2 h8; h8.x = cvt_pk4_fp8(h0[0], h0[1], h0[2], h0[3]); h8.y = cvt_pk4_fp8(h1[0], h1[1], h1[2], h1[3]); *(u32x2*)((unsigned char*)H + off) = h8; }
                u32x4 lo; lo.x = cvt_pk_bf16(h0[0] - bf_lo(hi.x), h0[1] - bf_hi(hi.x)); lo.y = cvt_pk_bf16(h0[2] - bf_lo(hi.y), h0[3] - bf_hi(hi.y));
                lo.z = cvt_pk_bf16(h1[0] - bf_lo(hi.z), h1[1] - bf_hi(hi.z)); lo.w = cvt_pk_bf16(h1[2] - bf_lo(hi.w), h1[3] - bf_hi(hi.w));
                const bf16x8 ah = __builtin_bit_cast(bf16x8, hi), al = __builtin_bit_cast(bf16x8, lo);
#pragma unroll
                for (int ct = 0; ct < 3; ++ct) { acc[rt][ct] = MFMA16(ah, wh[ct], acc[rt][ct]); acc[rt][ct] = MFMA16(al, wh[ct], acc[rt][ct]); acc[rt][ct] = MFMA16(ah, wl[ct], acc[rt][ct]); } }
        }
        __syncthreads();
        LAS float* lg = (LAS float*)(L + R_LG);
#pragma unroll
        for (int rt = 0; rt < 2; ++rt)
#pragma unroll
            for (int ct = 0; ct < 3; ++ct)
#pragma unroll
                for (int j = 0; j < 4; ++j) { const int col = 16 * ct + i; if (col < 36) lg[(F.wave * 32 + 16 * rt + 4 * q + j) * 37 + col] = acc[rt][ct][j]; }
        __syncthreads();
        if (F.tid < 256) {
            const int rl = F.tid; const LAS float* lr = lg + rl * 37;
            float gl[4];
#pragma unroll
            for (int k = 0; k < 4; ++k) gl[k] = lr[k] + b_group[k];
            int gi = 0; float gm = gl[0];
#pragma unroll
            for (int k = 1; k < 4; ++k) if (gl[k] > gm) { gm = gl[k]; gi = k; }
            float den = 0.f;
#pragma unroll
            for (int k = 0; k < 4; ++k) den += __expf(gl[k] - gm);
            const float pg = 1.0f / den;
            float el[8];
#pragma unroll
            for (int k = 0; k < 8; ++k) el[k] = lr[4 + gi * 8 + k] + b_router[gi * 8 + k];
            int i0 = 0; float v0 = el[0];
#pragma unroll
            for (int k = 1; k < 8; ++k) if (el[k] > v0) { v0 = el[k]; i0 = k; }
            int i1 = -1; float v1 = -3.0e38f;
#pragma unroll
            for (int k = 0; k < 8; ++k) if (k != i0 && el[k] > v1) { v1 = el[k]; i1 = k; }
            const float ex = __expf(v1 - v0); const float w0 = pg / (1.0f + ex), w1 = pg * ex / (1.0f + ex);
            const int e0 = gi * 8 + i0, e1 = gi * 8 + i1; const unsigned r0 = atomicAdd((unsigned*)&lcount[e0], 1u), r1 = atomicAdd((unsigned*)&lcount[e1], 1u);
            tinfo[rl * 4 + 0] = (unsigned)e0 | ((unsigned)e1 << 8); tinfo[rl * 4 + 1] = r0; tinfo[rl * 4 + 2] = r1; twt[rl * 2] = w0; twt[rl * 2 + 1] = w1;
        }
        __syncthreads();
        if (F.tid < 32) lbase[F.tid] = atomicAdd(&gcount[64 * F.tid], lcount[F.tid]);
        __syncthreads();
        if (F.tid < 256) { const int rl = F.tid, row = rb * 256 + rl; const unsigned ee = tinfo[rl * 4], e0 = ee & 255u, e1 = ee >> 8;
            const size_t s0 = (size_t)e0 * ECAP + lbase[e0] + tinfo[rl * 4 + 1], s1 = (size_t)e1 * ECAP + lbase[e1] + tinfo[rl * 4 + 2];
            list[s0] = (unsigned)row * 2u; list[s1] = (unsigned)row * 2u + 1u; gates[s0] = twt[rl * 2]; gates[s1] = twt[rl * 2 + 1]; }
        __syncthreads();
    }
}

__device__ __forceinline__ void p8_final(const Frame& F, const Params& P) {
    const bf16_t* x1 = (const bf16_t*)(P.ws + WS_X1); const unsigned char* Y0 = P.ws + WS_Y0; const unsigned char* Y1 = P.ws + WS_Y1; const float* fw = P.in[20]; const float* mod = (const float*)(P.ws + WS_MOD);
    f32x4 wv[4];
#pragma unroll
    for (int j = 0; j < 4; ++j) wv[j] = ((const f32x4*)fw)[F.lane + 64 * j];
    for (int row0 = F.gw * 2; row0 < T; row0 += F.NGW * 2) {
        const f32x4* g2 = (const f32x4*)(mod + (size_t)(row0 >> 11) * 6144 + 5 * 1024) + F.lane;
        u32x2 xw[2][4]; unsigned a[2][4], c[2][4];
#pragma unroll
        for (int r = 0; r < 2; ++r) { const u32x2* xr = (const u32x2*)(x1 + (size_t)(row0 + r) * DM) + F.lane; const unsigned* y0 = (const unsigned*)(Y0 + (size_t)(row0 + r) * DM) + F.lane; const unsigned* y1 = (const unsigned*)(Y1 + (size_t)(row0 + r) * DM) + F.lane;
#pragma unroll
            for (int j = 0; j < 4; ++j) { xw[r][j] = __builtin_nontemporal_load(xr + 64 * j); a[r][j] = __builtin_nontemporal_load(y0 + 64 * j); c[r][j] = __builtin_nontemporal_load(y1 + 64 * j); } }
        f32x4 g[4];
#pragma unroll
        for (int j = 0; j < 4; ++j) g[j] = g2[64 * j];
#pragma unroll
        for (int r = 0; r < 2; ++r) { f32x4 v[4]; float s = 0.f;
#pragma unroll
            for (int j = 0; j < 4; ++j) { v[j] = (f32x4){bf_lo(xw[r][j].x), bf_hi(xw[r][j].x), bf_lo(xw[r][j].y), bf_hi(xw[r][j].y)};
                const f32x2 a01 = __builtin_amdgcn_cvt_pk_f32_fp8((int)a[r][j], false), a23 = __builtin_amdgcn_cvt_pk_f32_fp8((int)a[r][j], true), c01 = __builtin_amdgcn_cvt_pk_f32_fp8((int)c[r][j], false), c23 = __builtin_amdgcn_cvt_pk_f32_fp8((int)c[r][j], true);
                v[j][0] += g[j][0] * (a01[0] + c01[0]); v[j][1] += g[j][1] * (a01[1] + c01[1]); v[j][2] += g[j][2] * (a23[0] + c23[0]); v[j][3] += g[j][3] * (a23[1] + c23[1]);
                s += (v[j][0] * v[j][0] + v[j][1] * v[j][1]) + (v[j][2] * v[j][2] + v[j][3] * v[j][3]); }
            const float rstd = rsqrtf(wave_sum(s) * (1.f / DM) + EPS);
            f32x4* o = (f32x4*)(P.out + (size_t)(row0 + r) * DM) + F.lane;
#pragma unroll
            for (int j = 0; j < 4; ++j) __builtin_nontemporal_store(v[j] * rstd * wv[j], o + 64 * j); }
    }
}

__device__ __forceinline__ void moe_prefix(const Frame& F, const Params& P, int* pref) {
    const unsigned* gcount = (const unsigned*)(P.ws + WS_CTL) + CW_GCOUNT;
    __syncthreads();
    if (F.tid == 0) { int acc = 0; for (int e = 0; e < 32; ++e) { const int c = (int)__hip_atomic_load(gcount + 64 * e, __ATOMIC_RELAXED, __HIP_MEMORY_SCOPE_AGENT); pref[e] = acc; pref[33 + e] = c; acc += (c + 255) >> 8; } pref[32] = acc; }
    __syncthreads();
}

#define XB_TMO      128
#define XB_XCNT(j)  (256  + 64 * (j))
#define XB_XSUB(j)  (1280 + 64 * (j))
#define XB_XGEN(j)  (2304 + 64 * (j))
#define XB_TOP      3328
#define XB_TOPGEN   3392
#define XCD_BAR_WORDS 3456
#define XB_SPIN_CAP (1u << 22)
__device__ __forceinline__ unsigned xb_ld(unsigned* p)              { return __hip_atomic_load(p, __ATOMIC_RELAXED, __HIP_MEMORY_SCOPE_AGENT); }
__device__ __forceinline__ unsigned xb_add(unsigned* p, unsigned v) { return __hip_atomic_fetch_add(p, v, __ATOMIC_RELAXED, __HIP_MEMORY_SCOPE_AGENT); }
__device__ __forceinline__ unsigned xb_xcc_id() { return (unsigned)__builtin_amdgcn_s_getreg((3 << 11) | 20) & 0xFu; }
#define XB_SPIN(cond, bar) do { unsigned _sp = 0; while (cond) { __builtin_amdgcn_s_sleep(1); \
    if ((++_sp & 255u) == 0u) { if (xb_ld(&(bar)[XB_TMO])) break; if (_sp > XB_SPIN_CAP) { atomicAdd(&(bar)[XB_TMO], 1u); break; } } } } while (0)
struct XcdBarrier { unsigned* bar; unsigned x; volatile LAS unsigned* st; };
__device__ __forceinline__ XcdBarrier xcd_barrier_post(unsigned* bar, volatile LAS unsigned* st) {
    XcdBarrier b; b.bar = bar; b.x = xb_xcc_id(); b.st = st;
    if (threadIdx.x == 0) (void)xb_add(&bar[XB_XCNT(b.x)], 1u);
    return b;
}
__device__ __forceinline__ void xcd_barrier_complete(unsigned* bar, unsigned x, unsigned& nloc, unsigned& nx) {
    const unsigned G = gridDim.x * gridDim.y * gridDim.z;
    unsigned sum, cnt, mine, sp = 0u;
    for (;;) {
        sum = 0u; cnt = 0u; mine = 0u;
#pragma unroll
        for (unsigned j = 0; j < 16; ++j) { const unsigned c = xb_ld(&bar[XB_XCNT(j)]); sum += c; cnt += (c > 0u) ? 1u : 0u; mine = (j == x) ? c : mine; }
        if (sum == G) break;
        __builtin_amdgcn_s_sleep(1);
        if ((++sp & 255u) == 0u) { if (xb_ld(&bar[XB_TMO])) break; if (sp > XB_SPIN_CAP) { atomicAdd(&bar[XB_TMO], 1u); break; } }
    }
    nloc = mine > 0u ? mine : 1u; nx = cnt > 0u ? cnt : 1u;
}
__device__ __forceinline__ void xcd_barrier(const XcdBarrier& b) {
    asm volatile("s_waitcnt vmcnt(0)" ::: "memory");
    __syncthreads();
    if (threadIdx.x == 0) {
        unsigned* bar = b.bar;
        __builtin_amdgcn_s_waitcnt(0);
        unsigned nloc = b.st[0], nx = b.st[1];
        if (nloc == 0u) { xcd_barrier_complete(bar, b.x, nloc, nx); b.st[0] = nloc; b.st[1] = nx; }
        const unsigned old = xb_add(&bar[XB_XSUB(b.x)], 1u);
        const unsigned gen = old / nloc;
        if (old + 1u == (gen + 1u) * nloc) {
            __builtin_amdgcn_fence(__ATOMIC_RELEASE, "agent");
            asm volatile("s_waitcnt vmcnt(0)" ::: "memory");
            const unsigned og = xb_add(&bar[XB_TOP], 1u);
            const unsigned tg = og / nx;
            if (og + 1u == (tg + 1u) * nx) xb_add(&bar[XB_TOPGEN], 1u);
            else XB_SPIN(xb_ld(&bar[XB_TOPGEN]) == tg, bar);
            __builtin_amdgcn_fence(__ATOMIC_ACQUIRE, "agent");
            xb_add(&bar[XB_XGEN(b.x)], 1u);
            asm volatile("s_waitcnt vmcnt(0)" ::: "memory");
        } else {
            XB_SPIN(xb_ld(&bar[XB_XGEN(b.x)]) == gen, bar);
            __builtin_amdgcn_fence(__ATOMIC_ACQUIRE, "agent");
            asm volatile("s_waitcnt vmcnt(0)" ::: "memory");
        }
    }
    __syncthreads();
}

__global__ void __launch_bounds__(NTHREADS, 2) fwd_kernel(Params P) {
    extern __shared__ __attribute__((aligned(16))) unsigned char lds[];
    Frame F; F.lds = lds; F.tid = threadIdx.x; F.lane = F.tid & 63; F.wave = __builtin_amdgcn_readfirstlane(F.tid >> 6);
    F.G = gridDim.x; { const int bx = blockIdx.x; F.vcu = (F.G % 8 == 0) ? (bx % 8) * (F.G / 8) + bx / 8 : bx; }
    F.gw = F.vcu * NWAVES + F.wave; F.NGW = F.G * NWAVES;
    unsigned char* ws = P.ws;
    const int lo = P.ph_lo, hi = P.ph_hi;
    volatile LAS unsigned* bst = (volatile LAS unsigned*)((LAS unsigned char*)lds + (LDS_BYTES - 64));
    if (F.tid < 2) bst[F.tid] = 0u;
    __syncthreads();
    const XcdBarrier xbar = xcd_barrier_post((unsigned*)(ws + WS_CTL) + CW_BAR, bst);
#define IN(k) (lo <= (k) && (k) < hi)
#define GRID_BAR() xcd_barrier(xbar)
#define GRID_BAR_CG() do { __syncthreads(); cooperative_groups::this_grid().sync(); } while (0)
    if (IN(0)) p0_prep(F, P);
    if (IN(0) && IN(1)) { if (P.ph_hi > 1000) GRID_BAR_CG(); else GRID_BAR(); }
    if (IN(1)) p1_modulate(F, P);
    if (IN(1) && IN(2)) GRID_BAR();
    if (IN(2)) { pg8::DenseSched S; S.init(ws + WS_H, ws + WS_WIN, T, COL_DT, 1024, F.G, (int)blockIdx.x); pg8::EpiProj E{(bf16_t*)(ws + WS_PROJ), (float*)(ws + WS_DTRAW)}; pg8::gemm_phase(( LAS unsigned char*)lds, S, E); }
    if (IN(2) && IN(3)) GRID_BAR();
    if (IN(3)) p3_conv(F, P);
    if (IN(3) && IN(4)) GRID_BAR();
    if (IN(4)) p4_ssd(F, P);
    if (IN(4) && IN(5)) GRID_BAR();
    if (IN(5)) { pg8::DenseSched S; S.init(ws + WS_MIX, ws + WS_WOUT, T, 1024, 1024, F.G, (int)blockIdx.x); pg8::EpiX1 E{P.in[0], (const float*)(ws + WS_MOD), (bf16_t*)(ws + WS_X1), (float*)(ws + WS_SS16)}; pg8::gemm_phase((LAS unsigned char*)lds, S, E); }
    if (IN(5) && IN(6)) GRID_BAR();
    if (IN(6)) p5_route(F, P);
    if (IN(6) && IN(7)) GRID_BAR();
    if (IN(7)) { int* pref = (int*)(lds + MISC_OFF); moe_prefix(F, P, pref);
        pg8::MoeSched<true> S; S.A = (const char*)(ws + WS_H); S.Bt = (const char*)(ws + WS_W13); S.K = 1024; S.nN = 4; S.G = F.G; S.c = F.vcu; S.pref = (const LAS int*)pref; S.list = (const unsigned*)(ws + WS_LIST);
        pg8::EpiAct E{(unsigned char*)(ws + WS_ACT)}; pg8::gemm_phase((LAS unsigned char*)lds, S, E); }
    if (IN(7) && IN(8)) GRID_BAR();
    if (IN(8)) { int* pref = (int*)(lds + MISC_OFF); moe_prefix(F, P, pref);
        pg8::MoeSched<false> S; S.A = (const char*)(ws + WS_ACT); S.Bt = (const char*)(ws + WS_W2); S.K = 512; S.nN = 4; S.G = F.G; S.c = F.vcu; S.pref = (const LAS int*)pref; S.list = (const unsigned*)(ws + WS_LIST);
        pg8::EpiY E{(const unsigned*)(ws + WS_LIST), (const float*)(ws + WS_SGATE), ws + WS_Y0, ws + WS_Y1}; pg8::gemm_phase((LAS unsigned char*)lds, S, E); }
    if (IN(8) && IN(9)) GRID_BAR();
    if (IN(9)) p8_final(F, P);
#undef IN
#undef GRID_BAR
#undef GRID_BAR_CG
}

extern "C" void kernel_launch(void* const* d_in, const int* in_sizes, int n_in, void* d_out, int out_size, void* d_ws, size_t ws_size, hipStream_t stream) {
    static int grid = 0;
    if (grid == 0) {
        if (n_in != 21 || out_size != T * DM || ws_size < WS_END) { fprintf(stderr, "kernel_launch: unexpected sizes n_in %d out %d ws %zu\n", n_in, out_size, ws_size); grid = -1; return; }
        int dev = 0, cus = 0;
        if (hipGetDevice(&dev) != hipSuccess || hipDeviceGetAttribute(&cus, hipDeviceAttributeMultiprocessorCount, dev) != hipSuccess) { grid = -1; return; }
        if (hipFuncSetAttribute((const void*)fwd_kernel, hipFuncAttributeMaxDynamicSharedMemorySize, LDS_BYTES) != hipSuccess) { fprintf(stderr, "kernel_launch: hipFuncSetAttribute failed\n"); grid = -1; return; }
        int per_cu = 0;
        if (hipOccupancyMaxActiveBlocksPerMultiprocessor(&per_cu, (const void*)fwd_kernel, NTHREADS, LDS_BYTES) != hipSuccess || per_cu < 1) { fprintf(stderr, "kernel_launch: occupancy query says %d blocks per CU\n", per_cu); (void)hipGetLastError(); per_cu = 1; }
        grid = cus;
    }
    if (grid < 0) return;
    (void)hipMemsetAsync((char*)d_ws + WS_CTL, 0, CTL_BYTES, stream);
    Params p{};
    for (int i = 0; i < 21; ++i) p.in[i] = (const float*)d_in[i];
    p.out = (float*)d_out; p.ws = (unsigned char*)d_ws;
    p.ph_lo = 0; p.ph_hi = 10;
    void* args[] = {&p};
    hipError_t e = hipLaunchCooperativeKernel((const void*)fwd_kernel, dim3(grid), dim3(NTHREADS), args, LDS_BYTES, stream);
    if (e != hipSuccess) fprintf(stderr, "kernel_launch: cooperative launch failed: %s (grid %d)\n", hipGetErrorString(e), grid);
}
```

```cpp
#include <hip/hip_runtime.h>
#include <hip/hip_cooperative_groups.h>
#include <cstdio>
#include <cstdint>

#ifndef MK_ONE_LAUNCH
#define MK_ONE_LAUNCH 0
#endif

#define LAS __attribute__((address_space(3)))
typedef unsigned short bf16_t;
typedef short bf16x8 __attribute__((ext_vector_type(8)));
typedef float f32x4 __attribute__((ext_vector_type(4)));
typedef float f32x2 __attribute__((ext_vector_type(2)));
typedef unsigned u32x4 __attribute__((ext_vector_type(4)));
typedef unsigned u32x2 __attribute__((ext_vector_type(2)));
typedef int i32x4 __attribute__((ext_vector_type(4)));
typedef int i32x8 __attribute__((ext_vector_type(8)));

constexpr int BATCH = 32, SEQ = 2048, DM = 1024, T = BATCH * SEQ;
constexpr int NPROJ = 3072, NPROJ_REAL = 2828;
constexpr int COL_Z = 256, COL_XS = 1024, COL_B = 1792, COL_C = 2304, COL_DT = 2816;
constexpr int NEXP = 32, FF = 512, ECAP = 65536;
constexpr int NWAVES = 8, NTHREADS = 512;
constexpr float EPS = 1e-6f;

constexpr size_t MiB = 1u << 20;
constexpr size_t WS_CTL = 0, CTL_BYTES = 1 * MiB;
constexpr size_t WS_MOD = 1 * MiB;
constexpr size_t WS_WR = 2 * MiB;
constexpr size_t WS_WDT = 2 * MiB + 512 * 1024;
constexpr size_t WS_SS16 = 4 * MiB;
constexpr size_t WS_SGATE = 120 * MiB;
constexpr size_t WS_DTRAW = 4 * MiB;
constexpr size_t WS_LIST = 8 * MiB;
constexpr size_t WS_WIN = 16 * MiB;
constexpr size_t WS_WOUT = 22 * MiB;
constexpr size_t WS_W13 = 24 * MiB;
constexpr size_t WS_W2 = 88 * MiB;
constexpr size_t WS_H = 128 * MiB;
constexpr size_t WS_PROJ = 256 * MiB;
constexpr size_t WS_MIX = 640 * MiB;
constexpr size_t WS_X1 = 768 * MiB;
constexpr size_t WS_END = 1024 * MiB;
constexpr size_t WS_XA = WS_X1;
constexpr size_t WS_SA = WS_H;
constexpr size_t WS_Y0 = 256 * MiB, WS_Y1 = 384 * MiB;
constexpr size_t WS_ACT = 512 * MiB;
constexpr int CW_GCOUNT = 256;
constexpr int CW_BAR = 4096;

constexpr int LDS_BYTES = 163840;
constexpr int MISC_OFF = 147456;

struct Params {
    const float* in[21];
    float* out;
    unsigned char* ws;
    int ph_lo, ph_hi;
};

__device__ __forceinline__ unsigned cvt_pk_bf16(float lo, float hi) { unsigned r; asm volatile("v_cvt_pk_bf16_f32 %0, %1, %2" : "=v"(r) : "v"(lo), "v"(hi)); return r; }
__device__ __forceinline__ float clamp_f8(float v) { return __builtin_fminf(__builtin_fmaxf(v, -448.f), 448.f); }
__device__ __forceinline__ unsigned cvt_pk4_fp8(float a, float b, float c, float d) {
    int w = 0; w = __builtin_amdgcn_cvt_pk_fp8_f32(clamp_f8(a), clamp_f8(b), w, false); w = __builtin_amdgcn_cvt_pk_fp8_f32(clamp_f8(c), clamp_f8(d), w, true); return (unsigned)w; }
__device__ __forceinline__ float bf_lo(unsigned u) { return __uint_as_float(u << 16); }
__device__ __forceinline__ float bf_hi(unsigned u) { return __uint_as_float(u & 0xffff0000u); }
__device__ __forceinline__ float wave_sum(float v) {
#pragma unroll
    for (int o = 1; o < 64; o <<= 1) v += __shfl_xor(v, o);
    return v;
}
__device__ __forceinline__ float sigmoidf_(float v) { return __builtin_amdgcn_rcpf(1.0f + __expf(-v)); }
__device__ __forceinline__ float siluf_(float v) { return v * sigmoidf_(v); }

namespace pg8 {
constexpr float W_F8_SCALE = 32.f, W_F8_INV = 1.f / 32.f;
constexpr int BM = 256, BK = 64, HALF = 128, HTB = HALF * BK * 2, STAGE_BYTES = 8 * HTB, NXCD = 8, WGM = 4;
__host__ __device__ __forceinline__ int lds_byte(int r, int c) { const int st = (r >> 4) * 2 + (c >> 5), rr = r & 15, cc = c & 31, ob = rr * 64 + cc * 2; return st * 1024 + (ob ^ (((ob >> 9) & 1) << 5)); }
__host__ __device__ __forceinline__ void stage_rc(int b, int& R, int& C) { const int st = b / 1024, sb = b % 1024, swz = sb ^ (((sb >> 9) & 1) << 5); R = (st >> 1) * 16 + swz / 64; C = (st & 1) * 32 + (swz % 64) / 2; }
__host__ __device__ __forceinline__ int perm32(int rho) { const int n = rho >> 4, i = rho & 15; return 8 * (i >> 2) + 4 * n + (i & 3); }

struct Unit { int pm, pn, e, cnt, slot0; };

struct DenseSched {
    const char* A; const char* Bt; int K;
    int nM, nN, nwg, G, c;
    __device__ void init(const void* A_, const void* Bt_, int M, int N, int K_, int G_, int c_) { A = (const char*)A_; Bt = (const char*)Bt_; K = K_; nM = M / BM; nN = N / BM; nwg = nM * nN; G = G_; c = c_; }
    __device__ __forceinline__ bool next(int i, Unit& u) const {
        const long L = (long)i * G + c; if (L >= nwg) return false;
        int wgid = (int)L; { const int q = nwg / NXCD, r = nwg % NXCD, xcd = wgid % NXCD, off = wgid / NXCD; wgid = (xcd < r ? xcd * (q + 1) : r * (q + 1) + (xcd - r) * q) + off; }
        const int nig = WGM * nN, gid = wgid / nig, fm = gid * WGM, gsz = (nM - fm) < WGM ? (nM - fm) : WGM;
        u.pm = fm + ((wgid % nig) % gsz); u.pn = (wgid % nig) / gsz; u.e = 0; u.cnt = 256; u.slot0 = 0; return true;
    }
    static constexpr bool FP8 = false;
    __device__ __forceinline__ int kb() const { return K * 2; }
    __device__ __forceinline__ const char* a_base() const { return A; }
    __device__ __forceinline__ void a_raw(const Unit& u, const int (&R)[2], unsigned (&raw)[2][2]) const {
#pragma unroll
        for (int h = 0; h < 2; ++h)
#pragma unroll
            for (int i = 0; i < 2; ++i) raw[h][i] = (unsigned)(u.pm * BM + h * HALF + R[i]);
    }
    __device__ __forceinline__ void a_fin(const int (&C)[2], const unsigned (&raw)[2][2], unsigned (&o)[2][2]) const {
#pragma unroll
        for (int h = 0; h < 2; ++h)
#pragma unroll
            for (int i = 0; i < 2; ++i) o[h][i] = (raw[h][i] * (unsigned)K + (unsigned)C[i]) * 2u;
    }
    __device__ __forceinline__ const char* b_ptr(const Unit& u) const { return Bt + (size_t)u.pn * BM * K * 2; }
};

template <bool GATHER>
struct MoeSched {
    static constexpr bool FP8 = true;
    __device__ __forceinline__ int kb() const { return K; }
    const char* A; const char* Bt; int K, nN, G, c;
    const LAS int* pref;
    const unsigned* list;
    __device__ __forceinline__ bool next(int i, Unit& u) const {
        const long L = (long)i * G + c; const int tot = pref[32] * nN; if (L >= tot) return false;
        const int ti = (int)L / nN; u.pn = (int)L % nN;
        int e = 0;
#pragma unroll 1
        for (int step = 16; step >= 1; step >>= 1) if (pref[e + step] <= ti) e += step;
        const int mt = ti - pref[e]; u.pm = ti; u.e = e; u.slot0 = mt * 256; const int rem = pref[33 + e] - mt * 256; u.cnt = rem < 256 ? rem : 256; return true;
    }
    __device__ __forceinline__ const char* a_base() const { return A; }
    __device__ __forceinline__ void a_raw(const Unit& u, const int (&R)[2], unsigned (&raw)[2][2]) const {
#pragma unroll
        for (int h = 0; h < 2; ++h)
#pragma unroll
            for (int i = 0; i < 2; ++i) {
                const int r = h * HALF + R[i];
                if (GATHER) { unsigned ent = 0; if (r < u.cnt) ent = list[(size_t)u.e * ECAP + u.slot0 + r]; raw[h][i] = ent >> 1; }
                else raw[h][i] = (unsigned)(u.pm * BM + r);
            }
    }
    __device__ __forceinline__ void a_fin(const int (&C)[2], const unsigned (&raw)[2][2], unsigned (&o)[2][2]) const {
#pragma unroll
        for (int h = 0; h < 2; ++h)
#pragma unroll
            for (int i = 0; i < 2; ++i) o[h][i] = raw[h][i] * (unsigned)K + (unsigned)C[i] * 2u;
    }
    __device__ __forceinline__ const char* b_ptr(const Unit& u) const { return Bt + ((size_t)u.e * (nN * BM) + (size_t)u.pn * BM) * K; }
};

template <class Epi, class Sched>
__device__ __forceinline__ void gemm_phase(LAS unsigned char* lds, const Sched& S, const Epi& E, unsigned stagger_ticks = 0u) {
    if (stagger_ticks) { const unsigned long long t0 = __builtin_amdgcn_s_memrealtime(); while ((unsigned long long)(__builtin_amdgcn_s_memrealtime() - t0) < (unsigned long long)stagger_ticks) __builtin_amdgcn_s_sleep(16); }
    const int tid = threadIdx.x, wid = __builtin_amdgcn_readfirstlane(tid >> 6), lane = tid & 63, wr = wid >> 2, wc = wid & 3, fr = lane & 15, fq = lane >> 4;
    const int KB = S.kb(), nt = KB / (BK * 2);
    int sR[2], sC[2]; unsigned voffB[2];
#pragma unroll
    for (int i = 0; i < 2; ++i) { int R, C; stage_rc(tid * 16 + i * 8192, R, C); sR[i] = R; sC[i] = C; const int Rb = Epi::PERM ? ((R & ~31) + perm32(R & 31)) : R; voffB[i] = (unsigned)(Rb * KB + C * 2); }
    const size_t kstep = (size_t)(BK * 2);
    const size_t hstep = (size_t)HALF * KB;
    const unsigned ldsw = (unsigned)wid * 1024u;
    const int aoff = lds_byte(wr * 64 + fr, fq * 8), boff = lds_byte(wc * 32 + fr, fq * 8);
#define PG8_SA(b, h) (((b) * 2 + (h)) * HTB)
#define PG8_SB(b, h) ((4 + (b) * 2 + (h)) * HTB)
#define PG8_STAGE(bufoff, gbase, voff) do { _Pragma("unroll") for (int _i = 0; _i < 2; ++_i) \
        __builtin_amdgcn_global_load_lds((const unsigned*)((const char*)(gbase) + (voff)[_i]), (LAS unsigned*)(lds + (bufoff) + ldsw + _i * 8192), 16, 0, 0); } while (0)
#define PG8_LDA(dst, b, h) do { _Pragma("unroll") for (int m = 0; m < 4; ++m) _Pragma("unroll") for (int k = 0; k < 2; ++k) { const i32x4 v_ = *(const LAS i32x4*)(lds + PG8_SA(b, h) + aoff + m * 2048 + k * 1024); if (k == 0) dst[m].lo = v_; else dst[m].hi = v_; } } while (0)
#define PG8_LDB(dst, b, h) do { _Pragma("unroll") for (int n = 0; n < 2; ++n) _Pragma("unroll") for (int k = 0; k < 2; ++k) { const i32x4 v_ = *(const LAS i32x4*)(lds + PG8_SB(b, h) + boff + n * 2048 + k * 1024); if (k == 0) dst[n].lo = v_; else dst[n].hi = v_; } } while (0)
#define PG8_MMA(ai, bj, At, Bt) do { __builtin_amdgcn_s_setprio(1); _Pragma("unroll") for (int m = 0; m < 4; ++m) _Pragma("unroll") for (int n = 0; n < 2; ++n) _Pragma("unroll") for (int k = 0; k < 2; ++k) \
        acc[ai][bj][m][n] = __builtin_amdgcn_mfma_f32_16x16x32_bf16(__builtin_bit_cast(bf16x8, k ? (i32x4)Bt[n].hi : (i32x4)Bt[n].lo), __builtin_bit_cast(bf16x8, k ? (i32x4)At[m].hi : (i32x4)At[m].lo), acc[ai][bj][m][n], 0, 0, 0); __builtin_amdgcn_s_setprio(0); } while (0)
#define PG8_MMA8(ai, bj, At, Bt) do { __builtin_amdgcn_s_setprio(1); _Pragma("unroll") for (int m = 0; m < 4; ++m) _Pragma("unroll") for (int n = 0; n < 2; ++n) { \
        asm volatile("v_mfma_f32_16x16x128_f8f6f4 %0, %1, %2, %0" : "+v"(acc[ai][bj][m][n]) : "v"(Bt[n]), "v"(At[m])); } \
        __builtin_amdgcn_s_setprio(0); } while (0)
#define PG8_MM(ai, bj, At, Bt) do { if constexpr (Sched::FP8) PG8_MMA8(ai, bj, At, Bt); else PG8_MMA(ai, bj, At, Bt); } while (0)
#define PG8_WAIT_V(n) asm volatile("s_waitcnt vmcnt(" #n ")" ::: "memory")
#define PG8_WAIT_L(n) asm volatile("s_waitcnt lgkmcnt(" #n ")" ::: "memory")
#define PG8_BAR __builtin_amdgcn_s_barrier()
#define PG8_SCHED __builtin_amdgcn_sched_barrier(0)
    Unit cur, nxt; int ui = 0;
    if (!S.next(0, cur)) return;
    f32x4 acc[2][2][4][2];
#pragma unroll
    for (int a = 0; a < 2; ++a)
#pragma unroll
        for (int b = 0; b < 2; ++b)
#pragma unroll
            for (int m = 0; m < 4; ++m)
#pragma unroll
                for (int n = 0; n < 2; ++n) acc[a][b][m][n] = (f32x4){0.f, 0.f, 0.f, 0.f};
    i32x8 At[4], B0[2], B1[2];
    unsigned aoC[2][2], aoN[2][2], rawN[2][2];
    S.a_raw(cur, sR, rawN); S.a_fin(sC, rawN, aoC);
    const char* const Ab = S.a_base();
    const char* cB = S.b_ptr(cur);
    PG8_STAGE(PG8_SB(0, 0), cB, voffB); PG8_STAGE(PG8_SB(0, 1), cB + hstep, voffB); PG8_STAGE(PG8_SA(0, 0), Ab, aoC[0]); PG8_STAGE(PG8_SA(0, 1), Ab, aoC[1]);
    if (wr == 1) PG8_BAR;
    PG8_WAIT_V(2); PG8_BAR;
    PG8_STAGE(PG8_SB(1, 0), cB + kstep, voffB); PG8_STAGE(PG8_SA(1, 0), Ab + kstep, aoC[0]); PG8_STAGE(PG8_SB(1, 1), cB + hstep + kstep, voffB);
    PG8_WAIT_V(6); PG8_BAR;
    for (;;) {
        const bool has_next = S.next(ui + 1, nxt);
        const char* nB = cB;
        if (has_next) { S.a_raw(nxt, sR, rawN); nB = S.b_ptr(nxt); }
#pragma unroll
        for (int h = 0; h < 2; ++h)
#pragma unroll
            for (int i = 0; i < 2; ++i) aoN[h][i] = aoC[h][i];
        for (int t = 0; t < nt; t += 2) {
            const bool last = (t == nt - 2);
            const char* a1 = Ab + (size_t)(t + 1) * kstep;
            const char* a2 = last ? Ab : Ab + (size_t)(t + 2) * kstep; const char* b2 = last ? nB : cB + (size_t)(t + 2) * kstep;
            const char* a3 = a2 + kstep; const char* b3 = b2 + kstep;
            if (last && has_next) {
#pragma unroll
                for (int h = 0; h < 2; ++h)
#pragma unroll
                    for (int i = 0; i < 2; ++i) asm volatile("" : "+v"(rawN[h][i]));
                S.a_fin(sC, rawN, aoN); }
            unsigned o2[2][2];
#pragma unroll
            for (int h = 0; h < 2; ++h)
#pragma unroll
                for (int i = 0; i < 2; ++i) o2[h][i] = last ? aoN[h][i] : aoC[h][i];
            PG8_LDB(B0, 0, 0); PG8_LDB(B1, 0, 1); PG8_SCHED; PG8_LDA(At, 0, 0); PG8_STAGE(PG8_SA(1, 1), a1, aoC[1]);
            PG8_WAIT_V(8); PG8_WAIT_L(0); PG8_BAR; PG8_MM(0, 0, At, B0); PG8_MM(0, 1, At, B1); PG8_BAR; PG8_SCHED;
            PG8_LDA(At, 0, 1); PG8_STAGE(PG8_SB(0, 0), b2, voffB); PG8_STAGE(PG8_SB(0, 1), b2 + hstep, voffB); PG8_STAGE(PG8_SA(0, 0), a2, o2[0]);
            PG8_WAIT_V(8); PG8_WAIT_L(0); PG8_BAR; PG8_MM(1, 0, At, B0); PG8_MM(1, 1, At, B1); PG8_BAR; PG8_SCHED;
            PG8_LDB(B0, 1, 0); PG8_LDB(B1, 1, 1); PG8_SCHED; PG8_LDA(At, 1, 0); PG8_STAGE(PG8_SA(0, 1), a2, o2[1]);
            PG8_WAIT_V(8); PG8_WAIT_L(0); PG8_BAR; PG8_MM(0, 0, At, B0); PG8_MM(0, 1, At, B1); PG8_BAR; PG8_SCHED;
            PG8_LDA(At, 1, 1); PG8_STAGE(PG8_SB(1, 0), b3, voffB); PG8_STAGE(PG8_SB(1, 1), b3 + hstep, voffB); PG8_STAGE(PG8_SA(1, 0), a3, o2[0]);
            PG8_WAIT_V(8); PG8_WAIT_L(0); PG8_BAR; PG8_MM(1, 0, At, B0); PG8_MM(1, 1, At, B1); PG8_BAR; PG8_SCHED;
        }
        if constexpr (Sched::FP8) asm volatile("s_nop 15\n\ts_nop 7" ::: "memory");
        if (wr == 0) PG8_BAR;
        E(acc, cur, wr, wc, fr, fq);
        if (!has_next) break;
#pragma unroll
        for (int a = 0; a < 2; ++a)
#pragma unroll
            for (int b = 0; b < 2; ++b)
#pragma unroll
                for (int m = 0; m < 4; ++m)
#pragma unroll
                    for (int n = 0; n < 2; ++n) acc[a][b][m][n] = (f32x4){0.f, 0.f, 0.f, 0.f};
        cur = nxt; cB = nB; ++ui;
#pragma unroll
        for (int h = 0; h < 2; ++h)
#pragma unroll
            for (int i = 0; i < 2; ++i) aoC[h][i] = aoN[h][i];
        if (wr == 1) PG8_BAR;
    }
    PG8_WAIT_V(0);
    PG8_BAR;
#undef PG8_SA
#undef PG8_SB
#undef PG8_STAGE
#undef PG8_LDA
#undef PG8_LDB
#undef PG8_MMA
#undef PG8_MMA8
#undef PG8_MM
#undef PG8_WAIT_V
#undef PG8_WAIT_L
#undef PG8_BAR
#undef PG8_SCHED
}

struct EpiProj {
    static constexpr bool PERM = true;
    bf16_t* O; float* dtraw;
    __device__ __forceinline__ void operator()(const f32x4 (&acc)[2][2][4][2], const Unit& u, int wr, int wc, int fr, int fq) const {
        const int row0 = u.pm * BM + wr * 64 + fr, col0 = u.pn * BM + wc * 32 + 8 * fq;
#pragma unroll
        for (int ai = 0; ai < 2; ++ai)
#pragma unroll
            for (int m = 0; m < 4; ++m) { const int row = row0 + ai * HALF + m * 16; bf16_t* rowp = O + (size_t)row * NPROJ + col0;
#pragma unroll
                for (int bj = 0; bj < 2; ++bj) { const f32x4 v0 = acc[ai][bj][m][0], v1 = acc[ai][bj][m][1];
                    u32x4 w; w.x = cvt_pk_bf16(v0[0], v0[1]); w.y = cvt_pk_bf16(v0[2], v0[3]); w.z = cvt_pk_bf16(v1[0], v1[1]); w.w = cvt_pk_bf16(v1[2], v1[3]);
                    __builtin_nontemporal_store(w, (u32x4*)(rowp + bj * HALF)); } }
    }
};
struct EpiX1 {
    static constexpr bool PERM = true;
    const float* x; const float* mod; bf16_t* x1; float* ss16;
    __device__ __forceinline__ void operator()(const f32x4 (&acc)[2][2][4][2], const Unit& u, int wr, int wc, int fr, int fq) const {
        const int row0 = u.pm * BM + wr * 64 + fr, col0 = u.pn * BM + wc * 32 + 8 * fq; const int b = (u.pm * BM) >> 11;
        f32x4 gv[2][2];
#pragma unroll
        for (int bj = 0; bj < 2; ++bj)
#pragma unroll
            for (int n = 0; n < 2; ++n) gv[bj][n] = *(const f32x4*)(mod + (size_t)b * 6144 + 2 * 1024 + col0 + bj * HALF + n * 4);
#pragma unroll
        for (int ai = 0; ai < 2; ++ai) {
            f32x4 xa[4][2], xb[4][2];
#pragma unroll
            for (int m = 0; m < 4; ++m) { const size_t off = (size_t)(row0 + ai * HALF + m * 16) * DM + col0;
#pragma unroll
                for (int bj = 0; bj < 2; ++bj) { xa[m][bj] = *(const f32x4*)(x + off + bj * HALF); xb[m][bj] = *(const f32x4*)(x + off + bj * HALF + 4); } }
#pragma unroll
            for (int m = 0; m < 4; ++m) { const int row = row0 + ai * HALF + m * 16; const size_t off = (size_t)row * DM + col0; float ss = 0.f;
#pragma unroll
                for (int bj = 0; bj < 2; ++bj) {
                    const f32x4 o0 = xa[m][bj] + gv[bj][0] * acc[ai][bj][m][0], o1 = xb[m][bj] + gv[bj][1] * acc[ai][bj][m][1];
                    u32x4 w; w.x = cvt_pk_bf16(o0[0], o0[1]); w.y = cvt_pk_bf16(o0[2], o0[3]); w.z = cvt_pk_bf16(o1[0], o1[1]); w.w = cvt_pk_bf16(o1[2], o1[3]);
                    *(u32x4*)(x1 + off + bj * HALF) = w;
                    ss += ((o0[0] * o0[0] + o0[1] * o0[1]) + (o0[2] * o0[2] + o0[3] * o0[3])) + ((o1[0] * o1[0] + o1[1] * o1[1]) + (o1[2] * o1[2] + o1[3] * o1[3])); }
                ss += __shfl_xor(ss, 16); ss += __shfl_xor(ss, 32);
                if (fq == 0) ss16[(size_t)row * 16 + u.pn * 4 + wc] = ss; }
        }
    }
};
struct EpiAct {
    static constexpr bool PERM = true;
    unsigned char* act;
    __device__ __forceinline__ void operator()(const f32x4 (&acc)[2][2][4][2], const Unit& u, int wr, int wc, int fr, int fq) const {
        const int row0 = u.pm * BM + wr * 64 + fr, col0 = u.pn * HALF + wc * 32 + 8 * fq; const int odd = fq & 1;
#pragma unroll
        for (int ai = 0; ai < 2; ++ai)
#pragma unroll
            for (int mp = 0; mp < 2; ++mp) { u32x2 w[2];
#pragma unroll
                for (int mm = 0; mm < 2; ++mm) { const int m = 2 * mp + mm; float o[8];
#pragma unroll
                    for (int n = 0; n < 2; ++n)
#pragma unroll
                        for (int i = 0; i < 4; ++i) { const float a = acc[ai][0][m][n][i] * W_F8_INV, b = acc[ai][1][m][n][i] * W_F8_INV; o[n * 4 + i] = siluf_(a) * b; }
                    w[mm].x = cvt_pk4_fp8(o[0], o[1], o[2], o[3]); w[mm].y = cvt_pk4_fp8(o[4], o[5], o[6], o[7]); }
                const auto sx = __builtin_amdgcn_permlane16_swap(w[0].x, w[1].x, false, false), sy = __builtin_amdgcn_permlane16_swap(w[0].y, w[1].y, false, false);
                u32x4 v; v.x = sx[0]; v.y = sy[0]; v.z = sx[1]; v.w = sy[1];
                *(u32x4*)(act + (size_t)(row0 + ai * HALF + (2 * mp + odd) * 16) * FF + col0 - 8 * odd) = v; }
    }
};
struct EpiY {
    static constexpr bool PERM = true;
    const unsigned* list; const float* gates; unsigned char* Y0; unsigned char* Y1;
    __device__ __forceinline__ void operator()(const f32x4 (&acc)[2][2][4][2], const Unit& u, int wr, int wc, int fr, int fq) const {
        const int col0 = u.pn * BM + wc * 32 + 8 * fq; const size_t sb = (size_t)u.e * ECAP + u.slot0; const int odd = fq & 1;
        unsigned ent[2][4]; float gt[2][4];
#pragma unroll
        for (int ai = 0; ai < 2; ++ai)
#pragma unroll
            for (int m = 0; m < 4; ++m) { const int r = ai * HALF + wr * 64 + m * 16 + fr; const int rc = r < u.cnt ? r : 0; ent[ai][m] = list[sb + rc]; gt[ai][m] = gates[sb + rc]; }
#pragma unroll
        for (int ai = 0; ai < 2; ++ai)
#pragma unroll
            for (int m = 0; m < 4; ++m) { const int r = ai * HALF + wr * 64 + m * 16 + fr;
                const unsigned tok = ent[ai][m] >> 1; const float gate = gt[ai][m] * W_F8_INV; u32x2 w[2];
#pragma unroll
                for (int bj = 0; bj < 2; ++bj) { const f32x4 v0 = acc[ai][bj][m][0] * gate, v1 = acc[ai][bj][m][1] * gate;
                    w[bj].x = cvt_pk4_fp8(v0[0], v0[1], v0[2], v0[3]); w[bj].y = cvt_pk4_fp8(v1[0], v1[1], v1[2], v1[3]); }
                const auto sx = __builtin_amdgcn_permlane16_swap(w[0].x, w[1].x, false, false), sy = __builtin_amdgcn_permlane16_swap(w[0].y, w[1].y, false, false);
                u32x4 v; v.x = sx[0]; v.y = sy[0]; v.z = sx[1]; v.w = sy[1];
                if (r < u.cnt) *(u32x4*)(((ent[ai][m] & 1u) ? Y1 : Y0) + (size_t)tok * DM + col0 + (odd ? HALF - 8 : 0)) = v; }
    }
};
}

struct Frame {
    unsigned char* lds; int tid, lane, wave, vcu, G, gw, NGW;
};

struct TrItem { const float* src; bf16_t* dst; int ldw, nrel, K, f8; };
__device__ __forceinline__ void tr_load(const TrItem& t, int lane, f32x4 (&v)[8]) {
    const int c4 = (lane & 7) * 4;
#pragma unroll
    for (int i = 0; i < 8; ++i) { const int kk = (lane >> 3) + 8 * i; v[i] = (c4 < t.nrel) ? *(const f32x4*)(t.src + (size_t)kk * t.ldw + c4) : (f32x4){0.f, 0.f, 0.f, 0.f}; }
}
__device__ __forceinline__ void tr_to_lds(const f32x4 (&v)[8], float* scr, int lane) {
    const int c4 = (lane & 7) * 4;
#pragma unroll
    for (int i = 0; i < 8; ++i) { const int kk = (lane >> 3) + 8 * i; float* p = scr + kk * 33 + c4; p[0] = v[i][0]; p[1] = v[i][1]; p[2] = v[i][2]; p[3] = v[i][3]; }
    asm volatile("s_waitcnt lgkmcnt(0)" ::: "memory");
}
__device__ __forceinline__ void tr_store(const TrItem& t, const float* scr, int lane) {
    const int c = lane & 7;
#pragma unroll
    for (int j = 0; j < 4; ++j) { const int n = (lane >> 3) + 8 * j; const float* s = scr + (8 * c) * 33 + n;
        u32x4 o; o.x = cvt_pk_bf16(s[0 * 33], s[1 * 33]); o.y = cvt_pk_bf16(s[2 * 33], s[3 * 33]); o.z = cvt_pk_bf16(s[4 * 33], s[5 * 33]); o.w = cvt_pk_bf16(s[6 * 33], s[7 * 33]);
        if (t.f8) { u32x2 o8; o8.x = cvt_pk4_fp8(s[0 * 33] * pg8::W_F8_SCALE, s[1 * 33] * pg8::W_F8_SCALE, s[2 * 33] * pg8::W_F8_SCALE, s[3 * 33] * pg8::W_F8_SCALE);
            o8.y = cvt_pk4_fp8(s[4 * 33] * pg8::W_F8_SCALE, s[5 * 33] * pg8::W_F8_SCALE, s[6 * 33] * pg8::W_F8_SCALE, s[7 * 33] * pg8::W_F8_SCALE);
            *(u32x2*)((unsigned char*)t.dst + (size_t)n * t.K + 8 * c) = o8; }
        else *(u32x4*)(t.dst + (size_t)n * t.K + 8 * c) = o; }
    asm volatile("s_waitcnt lgkmcnt(0)" ::: "memory");
}
__device__ __forceinline__ void p0_prep(const Frame& F, const Params& P) {
    unsigned char* ws = P.ws;
    {
        float* sct = (float*)F.lds;
        const float* c = P.in[1];
        for (int idx = F.tid; idx < 32 * 1024; idx += NTHREADS) { const int b = idx >> 10, k = idx & 1023; sct[k * 32 + (((b & ~3) ^ ((k & 7) << 2)) | (b & 3))] = siluf_(c[idx]); }
        __syncthreads();
        const float* w_ada = P.in[2]; const float* b_ada = P.in[3]; float* mod = (float*)(ws + WS_MOD);
        for (int cg = F.vcu; cg < 256; cg += F.G) {
            const int j = F.tid % 24, kg = F.tid / 24;
            float acc[32];
#pragma unroll
            for (int b = 0; b < 32; ++b) acc[b] = 0.f;
            if (kg < 16) {
                for (int kb = 0; kb < 4; ++kb) { float wv[16];
#pragma unroll
                    for (int kk = 0; kk < 16; ++kk) wv[kk] = w_ada[(size_t)(kg * 64 + kb * 16 + kk) * 6144 + cg * 24 + j];
#pragma unroll
                    for (int kk = 0; kk < 16; ++kk) { const int k = kg * 64 + kb * 16 + kk; const float w = wv[kk];
#pragma unroll
                        for (int q = 0; q < 8; ++q) { const f32x4 s = *(const f32x4*)(sct + k * 32 + ((4 * q) ^ ((k & 7) << 2))); acc[4 * q] += s[0] * w; acc[4 * q + 1] += s[1] * w; acc[4 * q + 2] += s[2] * w; acc[4 * q + 3] += s[3] * w; } } }
            }
            float* px = (float*)(F.lds + 131072);
            float tot[2] = {0.f, 0.f};
#pragma unroll 1
            for (int half = 0; half < 2; ++half) {
                if (kg < 16 && (kg >> 3) == half) {
#pragma unroll
                    for (int b = 0; b < 32; ++b) px[b * 192 + (kg & 7) * 24 + j] = acc[b];
                }
                __syncthreads();
#pragma unroll
                for (int r = 0; r < 2; ++r) { const int o = F.tid + r * 512; if (o < 768) { float s = 0.f;
#pragma unroll
                        for (int q = 0; q < 8; ++q) s += px[(o / 24) * 192 + q * 24 + (o % 24)]; tot[r] += s; } }
                __syncthreads();
            }
#pragma unroll
            for (int r = 0; r < 2; ++r) { const int o = F.tid + r * 512; if (o < 768) { const int jj = o % 24, b = o / 24; mod[(size_t)b * 6144 + cg * 24 + jj] = tot[r] + b_ada[cg * 24 + jj]; } }
        }
        __syncthreads();
    }
    {
        float* scr = (float*)(F.lds + F.wave * 16384);
        const float* w_in = P.in[4]; const float* w_out = P.in[13]; const float* w13 = P.in[18]; const float* w2 = P.in[19];
        bf16_t* WIN = (bf16_t*)(ws + WS_WIN); bf16_t* WOUT = (bf16_t*)(ws + WS_WOUT); bf16_t* W13 = (bf16_t*)(ws + WS_W13); bf16_t* W2 = (bf16_t*)(ws + WS_W2);
        constexpr int I0 = 16 * 80, I1 = 16 * 32, I2 = 32 * 16 * 32, I3 = 32 * 8 * 32, NIT = I0 + I1 + I2 + I3;
        auto decode = [&](int it) -> TrItem {
            TrItem t; int r = it;
            if (r < I0) { const int kb = r / 80, nb = 8 + r % 80, n0 = nb * 32; t.src = w_in + (size_t)kb * 64 * NPROJ_REAL + n0; t.ldw = NPROJ_REAL; t.nrel = NPROJ_REAL - n0; t.dst = WIN + (size_t)n0 * 1024 + kb * 64; t.K = 1024; t.f8 = 0; return t; } r -= I0;
            if (r < I1) { const int kb = r / 32, nb = r % 32, n0 = nb * 32; t.src = w_out + (size_t)kb * 64 * 1024 + n0; t.ldw = 1024; t.nrel = 32; t.dst = WOUT + (size_t)n0 * 1024 + kb * 64; t.K = 1024; t.f8 = 0; return t; } r -= I1;
            if (r < I2) { const int e = r / 512, q = r % 512, kb = q / 32, nb = q % 32; const int n0 = nb * 32, bj = n0 >> 9, rem = n0 & 511, pn = rem >> 7, j0 = rem & 127;
                t.src = w13 + (size_t)e * 1024 * 1024 + (size_t)kb * 64 * 1024 + n0; t.ldw = 1024; t.nrel = 32; t.dst = (bf16_t*)((unsigned char*)W13 + (size_t)e * 1024 * 1024 + (size_t)(pn * 256 + bj * 128 + j0) * 1024 + kb * 64); t.K = 1024; t.f8 = 1; return t; } r -= I2;
            { const int e = r / 256, q = r % 256, kb = q / 32, nb = q % 32, n0 = nb * 32;
                t.src = w2 + (size_t)e * 512 * 1024 + (size_t)kb * 64 * 1024 + n0; t.ldw = 1024; t.nrel = 32; t.dst = (bf16_t*)((unsigned char*)W2 + (size_t)e * 1024 * 512 + (size_t)n0 * 512 + kb * 64); t.K = 512; t.f8 = 1; return t; }
        };
        int it = F.gw; f32x4 v[8]; TrItem cur;
        if (it < NIT) { cur = decode(it); tr_load(cur, F.lane, v); }
        while (it < NIT) {
            tr_to_lds(v, scr, F.lane);
            const int nx = it + F.NGW; TrItem nxt = cur;
            if (nx < NIT) { nxt = decode(nx); tr_load(nxt, F.lane, v); }
            tr_store(cur, scr, F.lane);
            cur = nxt; it = nx;
        }
    }
    {
        const float* w_in = P.in[4]; const float* w_pool = P.in[5]; const float* pscale = P.in[6]; bf16_t* WIN = (bf16_t*)(ws + WS_WIN);
        for (int idx = F.vcu * NTHREADS + F.tid; idx < 256 * 1024; idx += F.G * NTHREADS) {
            const int n = idx >> 10, k = idx & 1023, g = n >> 6, d = n & 63; const float* wi = w_in + (size_t)k * NPROJ_REAL + g * 64; const float* wp = w_pool + (size_t)g * 4096 + d;
            float s = 0.f;
#pragma unroll 8
            for (int cc = 0; cc < 64; ++cc) s += wi[cc] * wp[cc * 64];
            s *= pscale[n];
            WIN[(size_t)n * 1024 + k] = (bf16_t)(cvt_pk_bf16(s, 0.f) & 0xffffu);
        }
    }
    {
        const float* wg = P.in[14]; const float* wrt = P.in[16]; bf16_t* WRH = (bf16_t*)(ws + WS_WR); bf16_t* WRL = (bf16_t*)(ws + WS_WR + 131072);
        { const float* w_in = P.in[4]; float* WDT = (float*)(ws + WS_WDT); for (int idx = F.vcu * NTHREADS + F.tid; idx < 12 * 1024; idx += F.G * NTHREADS) { const int j = idx >> 10, k = idx & 1023; WDT[idx] = w_in[(size_t)k * NPROJ_REAL + COL_DT + j]; } }
        for (int idx = F.vcu * NTHREADS + F.tid; idx < 36 * 1024; idx += F.G * NTHREADS) { const int j = idx >> 10, k = idx & 1023; const float w = (j < 4) ? wg[k * 4 + j] : wrt[k * 32 + (j - 4)];
            const unsigned hi = cvt_pk_bf16(w, 0.f) & 0xffffu; const float lo = w - __uint_as_float(hi << 16); WRH[idx] = (bf16_t)hi; WRL[idx] = (bf16_t)(cvt_pk_bf16(lo, 0.f) & 0xffffu); }
    }
}

__device__ __forceinline__ void p1_modulate(const Frame& F, const Params& P) {
    const float* x = P.in[0]; const float* mod = (const float*)(P.ws + WS_MOD); bf16_t* H = (bf16_t*)(P.ws + WS_H); float* dtraw = (float*)(P.ws + WS_DTRAW);
    float* wdt = (float*)F.lds;
    for (int idx = F.tid; idx < 12 * 256; idx += NTHREADS) ((f32x4*)wdt)[idx] = ((const f32x4*)(P.ws + WS_WDT))[idx];
    __syncthreads();
    const int lane = F.lane;
    f32x4 v[2][4], vn[2][4];
    { const int row0 = F.gw * 2; if (row0 < T) {
#pragma unroll
        for (int r = 0; r < 2; ++r) { const f32x4* xr = (const f32x4*)(x + (size_t)(row0 + r) * DM) + lane;
#pragma unroll
            for (int j = 0; j < 4; ++j) v[r][j] = __builtin_nontemporal_load(xr + 64 * j); } } }
    for (int row0 = F.gw * 2; row0 < T; row0 += F.NGW * 2) {
        const int b = row0 >> 11; float s[2] = {0.f, 0.f};
        { const int rn = row0 + F.NGW * 2; if (rn < T) {
#pragma unroll
            for (int r = 0; r < 2; ++r) { const f32x4* xr = (const f32x4*)(x + (size_t)(rn + r) * DM) + lane;
#pragma unroll
                for (int j = 0; j < 4; ++j) vn[r][j] = __builtin_nontemporal_load(xr + 64 * j); } } }
        const f32x4* sh = (const f32x4*)(mod + (size_t)b * 6144) + lane; const f32x4* sc = (const f32x4*)(mod + (size_t)b * 6144 + 1024) + lane;
        f32x4 a[4], m[4];
#pragma unroll
        for (int j = 0; j < 4; ++j) { a[j] = sh[64 * j]; m[j] = sc[64 * j] + 1.0f; }
#pragma unroll
        for (int r = 0; r < 2; ++r) {
#pragma unroll
            for (int j = 0; j < 4; ++j) s[r] += (v[r][j][0] * v[r][j][0] + v[r][j][1] * v[r][j][1]) + (v[r][j][2] * v[r][j][2] + v[r][j][3] * v[r][j][3]);
            const float rstd = rsqrtf(wave_sum(s[r]) * (1.f / DM) + EPS);
            u32x2* o = (u32x2*)(H + (size_t)(row0 + r) * DM) + lane;
#pragma unroll
            for (int j = 0; j < 4; ++j) { v[r][j] = v[r][j] * rstd * m[j] + a[j]; u32x2 w; w.x = cvt_pk_bf16(v[r][j][0], v[r][j][1]); w.y = cvt_pk_bf16(v[r][j][2], v[r][j][3]); o[64 * j] = w; } }
        float pv[32];
#pragma unroll
        for (int c = 0; c < 16; ++c) { float p0 = 0.f, p1 = 0.f;
            if (c < 12) {
#pragma unroll
                for (int j = 0; j < 4; ++j) { const f32x4 w4 = *(const f32x4*)(wdt + c * 1024 + 256 * j + 4 * lane);
                    p0 += (w4[0] * v[0][j][0] + w4[1] * v[0][j][1]) + (w4[2] * v[0][j][2] + w4[3] * v[0][j][3]); p1 += (w4[0] * v[1][j][0] + w4[1] * v[1][j][1]) + (w4[2] * v[1][j][2] + w4[3] * v[1][j][3]); } }
            pv[c] = p0; pv[16 + c] = p1; }
#pragma unroll
        for (int k = 0; k < 16; ++k) { const bool hi = (lane & 16) != 0; const float mine = hi ? pv[k + 16] : pv[k], send = hi ? pv[k] : pv[k + 16]; pv[k] = mine + __shfl_xor(send, 16); }
#pragma unroll
        for (int k = 0; k < 8; ++k) { const bool hi = (lane & 8) != 0; const float mine = hi ? pv[k + 8] : pv[k], send = hi ? pv[k] : pv[k + 8]; pv[k] = mine + __shfl_xor(send, 8); }
#pragma unroll
        for (int k = 0; k < 4; ++k) { const bool hi = (lane & 4) != 0; const float mine = hi ? pv[k + 4] : pv[k], send = hi ? pv[k] : pv[k + 4]; pv[k] = mine + __shfl_xor(send, 4); }
#pragma unroll
        for (int k = 0; k < 2; ++k) { const bool hi = (lane & 2) != 0; const float mine = hi ? pv[k + 2] : pv[k], send = hi ? pv[k] : pv[k + 2]; pv[k] = mine + __shfl_xor(send, 2); }
        { const bool hi = (lane & 1) != 0; const float mine = hi ? pv[1] : pv[0], send = hi ? pv[0] : pv[1]; pv[0] = mine + __shfl_xor(send, 1); }
        const float tot = pv[0] + __shfl_xor(pv[0], 32);
        if (lane < 32 && (lane & 15) < 12) dtraw[(size_t)(row0 + (lane >> 4)) * 16 + (lane & 15)] = tot;
#pragma unroll
        for (int r = 0; r < 2; ++r)
#pragma unroll
            for (int j = 0; j < 4; ++j) v[r][j] = vn[r][j];
    }
}

template <int W>
__device__ __forceinline__ void pool_item(const bf16_t* src, bf16_t* dst, int t0) {
    u32x4 hist[W - 1], cur[16];
#pragma unroll
    for (int i = 0; i < 16; ++i) cur[i] = *(const u32x4*)(src + (size_t)i * NPROJ);
    if (t0 > 0) {
#pragma unroll
        for (int h = 0; h < W - 1; ++h) hist[h] = *(const u32x4*)(src - (size_t)(W - 1 - h) * NPROJ); }
    else {
#pragma unroll
        for (int h = 0; h < W - 1; ++h) hist[h] = (u32x4){0u, 0u, 0u, 0u}; }
#define UNP8P(dst, v) do { dst[0] = bf_lo(v.x); dst[1] = bf_hi(v.x); dst[2] = bf_lo(v.y); dst[3] = bf_hi(v.y); dst[4] = bf_lo(v.z); dst[5] = bf_hi(v.z); dst[6] = bf_lo(v.w); dst[7] = bf_hi(v.w); } while (0)
    float sum[8];
#pragma unroll
    for (int k = 0; k < 8; ++k) sum[k] = 0.f;
#pragma unroll
    for (int h = 0; h < W - 1; ++h) { float e[8]; UNP8P(e, hist[h]);
#pragma unroll
        for (int k = 0; k < 8; ++k) sum[k] += e[k]; }
#pragma unroll
    for (int i = 0; i < 16; ++i) {
        float c[8]; UNP8P(c, cur[i]);
#pragma unroll
        for (int k = 0; k < 8; ++k) sum[k] += c[k];
        if (i >= 1) { float o[8]; if (i <= W - 1) UNP8P(o, hist[i - 1 < W - 1 ? i - 1 : 0]); else UNP8P(o, cur[i - W >= 0 ? i - W : 0]);
#pragma unroll
            for (int k = 0; k < 8; ++k) sum[k] -= o[k]; }
        const int cnt = (t0 > 0) ? W : ((i + 1) < W ? (i + 1) : W); const float inv = 1.0f / (float)cnt;
        u32x4 pk; pk.x = cvt_pk_bf16(sum[0] * inv - c[0], sum[1] * inv - c[1]); pk.y = cvt_pk_bf16(sum[2] * inv - c[2], sum[3] * inv - c[3]);
        pk.z = cvt_pk_bf16(sum[4] * inv - c[4], sum[5] * inv - c[5]); pk.w = cvt_pk_bf16(sum[6] * inv - c[6], sum[7] * inv - c[7]);
        *(u32x4*)(dst + (size_t)i * DM) = pk;
    }
#undef UNP8P
}

__device__ __forceinline__ void p3_conv(const Frame& F, const Params& P) {
    const bf16_t* proj = (const bf16_t*)(P.ws + WS_PROJ); bf16_t* XA = (bf16_t*)(P.ws + WS_XA);
    const float* conv_w = P.in[7]; const float* conv_b = P.in[8];
    if (F.wave < 2) {
        const float* dtraw = (const float*)(P.ws + WS_DTRAW); float* SA = (float*)(P.ws + WS_SA);
        const float* dt_bias = P.in[9]; const float* a_log = P.in[10];
        for (int bc = F.vcu * 2 + F.wave; bc < BATCH * 16; bc += F.G * 2) {
            const int h = F.lane < 48 ? (F.lane >> 2) : 11, seg = F.lane & 3; const float a = -__expf(a_log[h]), dtb = dt_bias[h];
            const float* src = dtraw + ((size_t)bc * 128 + 32 * seg) * 16 + h;
            float raw[32], dt[32], cs[32];
#pragma unroll
            for (int j = 0; j < 32; ++j) raw[j] = src[j * 16];
            float run = 0.f;
#pragma unroll
            for (int j = 0; j < 32; ++j) { const float v = raw[j] + dtb; dt[j] = v > 20.f ? v : log1pf(__expf(v)); run += dt[j] * a; cs[j] = run; }
            const float s0 = __shfl(run, (F.lane & ~3) + 0), s1 = __shfl(run, (F.lane & ~3) + 1), s2 = __shfl(run, (F.lane & ~3) + 2), s3 = __shfl(run, (F.lane & ~3) + 3);
            const float base = (seg > 0 ? s0 : 0.f) + (seg > 1 ? s1 : 0.f) + (seg > 2 ? s2 : 0.f); const float a127 = ((s0 + s1) + s2) + s3;
            if (F.lane < 48) {
                float* dst = SA + ((size_t)bc * 4 + h / 3) * 1536 + (h % 3) * 128 + 32 * seg;
#pragma unroll
                for (int j4 = 0; j4 < 8; ++j4) { f32x4 vd, va, vw, ve;
#pragma unroll
                    for (int e = 0; e < 4; ++e) { const int j = 4 * j4 + e; const float ac = base + cs[j], ae = base + cs[j | 15]; vd[e] = dt[j]; va[e] = ac; vw[e] = dt[j] * __expf(a127 - ac); ve[e] = dt[j] * __expf(ae - ac); }
                    *(f32x4*)(dst + 4 * j4) = vd; *(f32x4*)(dst + 384 + 4 * j4) = va; *(f32x4*)(dst + 768 + 4 * j4) = vw; *(f32x4*)(dst + 1152 + 4 * j4) = ve; }
            }
        }
    }
    {
        constexpr int NITEM = (T / 16) * 224; const int stride = F.G * NTHREADS;
        int item = F.vcu * NTHREADS + F.tid;
        u32x4 raw[19];
        auto load_item = [&](int it, u32x4 (&r)[19]) {
            const int cg = it % 224, rr = it / 224, ch = cg * 8, row0 = rr * 16, t0 = row0 & (SEQ - 1);
            const bf16_t* src = proj + (size_t)row0 * NPROJ + COL_XS + ch;
#pragma unroll
            for (int i = 0; i < 16; ++i) r[3 + i] = __builtin_nontemporal_load((const u32x4*)(src + (size_t)i * NPROJ));
            if (t0 >= 3) {
#pragma unroll
                for (int i = 0; i < 3; ++i) r[i] = *(const u32x4*)(src - (size_t)(3 - i) * NPROJ); }
            else { r[0] = (u32x4){0u, 0u, 0u, 0u}; r[1] = r[0]; r[2] = r[0]; }
        };
        if (item < NITEM) load_item(item, raw);
        while (item < NITEM) {
            const int cg = item % 224, rr = item / 224, ch = cg * 8, row0 = rr * 16;
            const int nxt = item + stride;
            u32x4 raw2[19];
            if (nxt < NITEM) load_item(nxt, raw2);
            float w[4][8], bs[8];
#pragma unroll
            for (int j = 0; j < 4; ++j) { const f32x4 a = *(const f32x4*)(conv_w + j * 1792 + ch), c = *(const f32x4*)(conv_w + j * 1792 + ch + 4);
#pragma unroll
                for (int k = 0; k < 4; ++k) { w[j][k] = a[k]; w[j][4 + k] = c[k]; } }
            { const f32x4 a = *(const f32x4*)(conv_b + ch), c = *(const f32x4*)(conv_b + ch + 4);
#pragma unroll
                for (int k = 0; k < 4; ++k) { bs[k] = a[k]; bs[4 + k] = c[k]; } }
#define UNP8(dst, v) do { dst[0] = bf_lo(v.x); dst[1] = bf_hi(v.x); dst[2] = bf_lo(v.y); dst[3] = bf_hi(v.y); dst[4] = bf_lo(v.z); dst[5] = bf_hi(v.z); dst[6] = bf_lo(v.w); dst[7] = bf_hi(v.w); } while (0)
            float r0[8], r1[8], r2[8];
            UNP8(r0, raw[0]); UNP8(r1, raw[1]); UNP8(r2, raw[2]);
#pragma unroll
            for (int i = 0; i < 16; ++i) {
                float cur[8]; UNP8(cur, raw[3 + i]); float o[8];
#pragma unroll
                for (int k = 0; k < 8; ++k) { const float v = bs[k] + w[0][k] * r0[k] + w[1][k] * r1[k] + w[2][k] * r2[k] + w[3][k] * cur[k]; o[k] = siluf_(v); r0[k] = r1[k]; r1[k] = r2[k]; r2[k] = cur[k]; }
                u32x4 pk; pk.x = cvt_pk_bf16(o[0], o[1]); pk.y = cvt_pk_bf16(o[2], o[3]); pk.z = cvt_pk_bf16(o[4], o[5]); pk.w = cvt_pk_bf16(o[6], o[7]);
                *(u32x4*)(XA + (size_t)(row0 + i) * 1792 + ch) = pk;
            }
#pragma unroll
            for (int i = 0; i < 19; ++i) raw[i] = raw2[i];
            item = nxt;
        }
    }
    { bf16_t* mix = (bf16_t*)(P.ws + WS_MIX);
      for (int p = F.vcu * NTHREADS + F.tid; p < (T / 16) * 32; p += F.G * NTHREADS) {
        const int c8 = p & 7, rr8 = (p >> 3) & 7, grp = (p >> 6) & 3, rrblk = p >> 8; const int rr = rrblk * 8 + rr8, row0 = rr * 16, t0 = row0 & (SEQ - 1), col = grp * 64 + c8 * 8;
        const bf16_t* src = proj + (size_t)row0 * NPROJ + col; bf16_t* dst = mix + (size_t)row0 * DM + col;
        if (grp == 0) pool_item<2>(src, dst, t0); else if (grp == 1) pool_item<4>(src, dst, t0); else if (grp == 2) pool_item<8>(src, dst, t0); else pool_item<16>(src, dst, t0);
      } }
#undef UNP8
}

constexpr int L_B = 0, L_C = 32768, L_X = 49152, L_S = 98304, L_DT = 147456, L_ACS = L_DT + 1536, L_W = L_ACS + 1536, L_ES = L_W + 1536, L_NW = L_ES + 1536, L_T = L_NW + 768;
static_assert(L_T <= LDS_BYTES - 64, "SSD LDS map");
typedef short v4i16 __attribute__((ext_vector_type(4)));
__device__ __forceinline__ int swz16(int r) { const int h = (r >> 3) & 1; return ((((r & 7) + 4 * h) & 7) << 1) | h; }
__device__ __forceinline__ int swz8(int row) { return ((row >> 1) & 3) << 1; }
__device__ __forceinline__ bf16x8 tr_pair(LAS unsigned char* a0, LAS unsigned char* a1) {
    const v4i16 lo = __builtin_amdgcn_ds_read_tr16_b64_v4i16((LAS v4i16*)a0), hi = __builtin_amdgcn_ds_read_tr16_b64_v4i16((LAS v4i16*)a1);
    return (bf16x8){lo[0], lo[1], lo[2], lo[3], hi[0], hi[1], hi[2], hi[3]};
}
__device__ __forceinline__ bf16x8 pack8(const float (&v)[8]) {
    u32x4 p; p.x = cvt_pk_bf16(v[0], v[1]); p.y = cvt_pk_bf16(v[2], v[3]); p.z = cvt_pk_bf16(v[4], v[5]); p.w = cvt_pk_bf16(v[6], v[7]);
    return __builtin_bit_cast(bf16x8, p);
}
#define MFMA16(a, b, c) __builtin_amdgcn_mfma_f32_16x16x32_bf16((a), (b), (c), 0, 0, 0)
#define OPAQUE(x) asm volatile("" : "+v"(x))
#define SBAR() do { asm volatile("s_waitcnt lgkmcnt(0)" ::: "memory"); __builtin_amdgcn_s_barrier(); asm volatile("" ::: "memory"); } while (0)

__device__ __forceinline__ int ssd_glmap(int hl, int lt) { return hl ? (lt == 0 ? 2 : (lt == 1 ? 3 : (lt == 2 ? 5 : 4))) : (lt == 0 ? 0 : (lt == 1 ? 1 : (lt == 2 ? 7 : 6))); }
#define SSD_LANE() int ln_ = lane; OPAQUE(ln_); const int i = ln_ & 15, q = ln_ >> 4, qp = i >> 2, pp = ln_ & 3; (void)qp; (void)pp
#define SSD_PR() int pr[4]; { const int fsw = swz16(i); _Pragma("unroll") for (int ks = 0; ks < 4; ++ks) { pr[ks] = i * 256 + (((4 * ks + q) ^ fsw) << 4); OPAQUE(pr[ks]); } }
template <int CH>
__device__ __forceinline__ void ssd_compute(LAS unsigned char* L, int lt, int hl, int lane, f32x4 (&sacc)[2][6], f32x4 (&yacc)[6], float dsk0, float dsk1, bool xwait) {
    const int gl = ssd_glmap(hl, lt);
    const int lrow0 = 16 * gl;
    f32x4 cbt[8];
    {
        SSD_LANE(); SSD_PR();
        int cbase = lt * 4096; OPAQUE(cbase);
        bf16x8 cfrag[4];
#pragma unroll
        for (int ks = 0; ks < 4; ++ks) cfrag[ks] = *(const LAS bf16x8*)(L + L_C + cbase + pr[ks]);
#pragma unroll
        for (int tp = 0; tp < 4; ++tp) {
            f32x4 a0 = (f32x4){0.f, 0.f, 0.f, 0.f}, a1 = a0;
            if (2 * tp <= gl) {
                bf16x8 f0[4], f1[4];
#pragma unroll
                for (int ks = 0; ks < 4; ++ks) { f0[ks] = *(const LAS bf16x8*)(L + L_B + (2 * tp) * 4096 + pr[ks]); f1[ks] = *(const LAS bf16x8*)(L + L_B + (2 * tp + 1) * 4096 + pr[ks]); }
#pragma unroll
                for (int ks = 0; ks < 4; ++ks) { a0 = MFMA16(f0[ks], cfrag[ks], a0); a1 = MFMA16(f1[ks], cfrag[ks], a1); }
            }
            cbt[2 * tp] = a0; cbt[2 * tp + 1] = a1;
            __builtin_amdgcn_sched_barrier(0);
        }
    }
    bf16x8 mfrag[2][4];
    {
        SSD_LANE();
        int q16 = 16 * q; OPAQUE(q16);
        int lq = (lrow0 + 4 * q) * 4; OPAQUE(lq);
        int li = (lrow0 + i) * 4; OPAQUE(li);
        int dq = i - 4 * q; OPAQUE(dq);
        float acl[2];
#pragma unroll
        for (int hsel = 0; hsel < 2; ++hsel) acl[hsel] = *(const LAS float*)(L + L_ACS + (CH + hsel) * 512 + li);
#pragma unroll
        for (int kk = 0; kk < 4; ++kk) {
            f32x4 es[2][2]; float ae[2][2];
#pragma unroll
            for (int hsel = 0; hsel < 2; ++hsel)
#pragma unroll
                for (int hf = 0; hf < 2; ++hf) { const int ts = 2 * kk + hf, r = CH + hsel; es[hsel][hf] = *(const LAS f32x4*)(L + L_ES + r * 512 + ts * 64 + q16); ae[hsel][hf] = *(const LAS float*)(L + L_ACS + r * 512 + (16 * ts + 15) * 4); }
#pragma unroll
            for (int hsel = 0; hsel < 2; ++hsel) { const int r = CH + hsel; const float dsk = hsel ? dsk1 : dsk0; float v[8];
#pragma unroll
                for (int hf = 0; hf < 2; ++hf) { const int ts = 2 * kk + hf;
                    if (ts < gl) { const float el = __expf(acl[hsel] - ae[hsel][hf]);
#pragma unroll
                        for (int j = 0; j < 4; ++j) v[4 * hf + j] = cbt[ts][j] * el * es[hsel][hf][j]; }
                    else if (ts == gl) { const f32x4 asd = *(const LAS f32x4*)(L + L_ACS + r * 512 + lq), dsd = *(const LAS f32x4*)(L + L_DT + r * 512 + lq);
#pragma unroll
                        for (int j = 0; j < 4; ++j) { const float arg = fminf(acl[hsel] - asd[j], 0.f); const float cd = cbt[ts][j] * dsd[j]; const float m = cd * __expf(arg);
                            v[4 * hf + j] = (j < dq) ? m : ((j == dq) ? (cd + dsk) : 0.f); } }
                    else {
#pragma unroll
                        for (int j = 0; j < 4; ++j) v[4 * hf + j] = 0.f; } }
                mfrag[hsel][kk] = pack8(v); }
            if (kk == 1) __builtin_amdgcn_sched_barrier(0);
        }
    }
    {
        SSD_LANE(); SSD_PR();
        int cbase = lt * 4096; OPAQUE(cbase);
        int lq = (lrow0 + 4 * q) * 4; OPAQUE(lq);
        bf16x8 cfrag[4];
#pragma unroll
        for (int ks = 0; ks < 4; ++ks) cfrag[ks] = *(const LAS bf16x8*)(L + L_C + cbase + pr[ks]);
#pragma unroll
        for (int cp = 0; cp < 3; ++cp) { bf16x8 f0[4], f1[4];
#pragma unroll
            for (int ks = 0; ks < 4; ++ks) { f0[ks] = *(const LAS bf16x8*)(L + L_S + (96 * CH + 32 * cp) * 256 + pr[ks]); f1[ks] = *(const LAS bf16x8*)(L + L_S + (96 * CH + 32 * cp + 16) * 256 + pr[ks]); }
            f32x4 a0 = (f32x4){0.f, 0.f, 0.f, 0.f}, a1 = a0;
#pragma unroll
            for (int ks = 0; ks < 4; ++ks) { a0 = MFMA16(cfrag[ks], f0[ks], a0); a1 = MFMA16(cfrag[ks], f1[ks], a1); }
            yacc[2 * cp] = a0; yacc[2 * cp + 1] = a1; }
#pragma unroll
        for (int hsel = 0; hsel < 2; ++hsel) { const f32x4 ac4 = *(const LAS f32x4*)(L + L_ACS + (CH + hsel) * 512 + lq); const f32x4 e = (f32x4){__expf(ac4[0]), __expf(ac4[1]), __expf(ac4[2]), __expf(ac4[3])};
#pragma unroll
            for (int ct = 0; ct < 6; ++ct) if ((((6 * CH + ct) >> 2) - CH) == hsel) yacc[ct] = yacc[ct] * e; }
    }
#pragma unroll
    for (int hsel = 0; hsel < 2; ++hsel) { const float cd = __expf(*(const LAS float*)(L + L_ACS + (CH + hsel) * 512 + 127 * 4));
#pragma unroll
        for (int ct = 0; ct < 6; ++ct) if ((((6 * CH + ct) >> 2) - CH) == hsel) { sacc[0][ct] = sacc[0][ct] * cd; sacc[1][ct] = sacc[1][ct] * cd; } }
    __builtin_amdgcn_sched_barrier(0);
    SSD_LANE();
    int q16 = 16 * q; OPAQUE(q16);
    const int r4 = 4 * q + qp;
    int tb[2], tx[4];
    { const int fr = swz16(r4), xr = swz8(r4);
#pragma unroll
      for (int nt2 = 0; nt2 < 2; ++nt2) { tb[nt2] = r4 * 256 + 8 * (pp & 1) + (((2 * (2 * lt + nt2) + (pp >> 1)) ^ fr) << 4); OPAQUE(tb[nt2]); }
#pragma unroll
      for (int pt = 0; pt < 4; ++pt) { tx[pt] = r4 * 128 + 8 * (pp & 1) + (((2 * pt + (pp >> 1)) ^ xr) << 4); OPAQUE(tx[pt]); } }
    if (xwait) { asm volatile("s_waitcnt vmcnt(6)" ::: "memory"); SBAR(); }
#pragma unroll
    for (int kk = 0; kk < 4; ++kk) {
        bf16x8 bts[2][2];
        { bf16x8 btf[2];
#pragma unroll
          for (int nt2 = 0; nt2 < 2; ++nt2) btf[nt2] = tr_pair(L + L_B + kk * 8192 + tb[nt2], L + L_B + kk * 8192 + 4096 + tb[nt2]);
#pragma unroll
          for (int hsel = 0; hsel < 2; ++hsel) { const f32x4 wl = *(const LAS f32x4*)(L + L_W + (CH + hsel) * 512 + kk * 128 + q16), wh = *(const LAS f32x4*)(L + L_W + (CH + hsel) * 512 + kk * 128 + 64 + q16);
#pragma unroll
            for (int nt2 = 0; nt2 < 2; ++nt2) { float bs[8];
#pragma unroll
                for (int e = 0; e < 4; ++e) { bs[e] = __uint_as_float((unsigned)(unsigned short)btf[nt2][e] << 16) * wl[e]; bs[4 + e] = __uint_as_float((unsigned)(unsigned short)btf[nt2][4 + e] << 16) * wh[e]; }
                bts[hsel][nt2] = pack8(bs); } } }
        __builtin_amdgcn_sched_barrier(0);
        bf16x8 xf[6];
#pragma unroll
        for (int ct = 0; ct < 6; ++ct) { const int ctg = 6 * CH + ct, r = ctg >> 2, pt = ctg & 3; xf[ct] = tr_pair(L + L_X + r * 16384 + kk * 4096 + tx[pt], L + L_X + r * 16384 + kk * 4096 + 2048 + tx[pt]); }
        const bool ydo = (2 * kk <= gl);
#pragma unroll
        for (int ct = 0; ct < 6; ++ct) { const int ctg = 6 * CH + ct, r = ctg >> 2, hsel = r - CH;
            if (ydo) yacc[ct] = MFMA16(mfrag[hsel][kk], xf[ct], yacc[ct]);
            sacc[0][ct] = MFMA16(bts[hsel][0], xf[ct], sacc[0][ct]); sacc[1][ct] = MFMA16(bts[hsel][1], xf[ct], sacc[1][ct]); }
        __builtin_amdgcn_sched_barrier(0);
    }
}

__device__ __forceinline__ void ssd_dma_bc(LAS unsigned char* L, const bf16_t* xrow, int g, int hl, int wave, int lane) {
    OPAQUE(lane);
#pragma unroll
    for (int k = 0; k < 4; ++k) { const int m = wave * 4 + k, row = 4 * m + (lane >> 4), lc = (lane & 15) ^ swz16(row & 15);
        __builtin_amdgcn_global_load_lds((const unsigned*)(xrow + 768 + g * 128 + (unsigned)(row * 1792 + lc * 8)), (LAS unsigned*)(L + L_B + m * 1024), 16, 0, 0); }
    const bf16_t* crow = xrow + 1280 + g * 128;
#pragma unroll
    for (int k = 0; k < 2; ++k) { const int m = wave * 2 + k, row = 4 * m + (lane >> 4), lc = (lane & 15) ^ swz16(row & 15); const int grow = 16 * ssd_glmap(hl, m >> 2) + (row & 15);
        __builtin_amdgcn_global_load_lds((const unsigned*)(crow + (unsigned)(grow * 1792 + lc * 8)), (LAS unsigned*)(L + L_C + m * 1024), 16, 0, 0); }
}
__device__ __forceinline__ void ssd_dma_x(LAS unsigned char* L, const bf16_t* xrow, int g, int wave, int lane) {
    OPAQUE(lane);
#pragma unroll
    for (int k = 0; k < 6; ++k) { const int m = wave * 6 + k, r = m >> 4, blk = m & 15, row = 8 * blk + (lane >> 3), lc = (lane & 7) ^ swz8(row);
        __builtin_amdgcn_global_load_lds((const unsigned*)(xrow + g * 192 + r * 64 + (unsigned)(row * 1792 + lc * 8)), (LAS unsigned*)(L + L_X + r * 16384 + blk * 1024), 16, 0, 0); }
}

__device__ __forceinline__ void p4_ssd(const Frame& F, const Params& P) {
    LAS unsigned char* L = (LAS unsigned char*)F.lds;
    const bf16_t* XA = (const bf16_t*)(P.ws + WS_XA); const float* SA = (const float*)(P.ws + WS_SA);
    const bf16_t* proj = (const bf16_t*)(P.ws + WS_PROJ); bf16_t* mix = (bf16_t*)(P.ws + WS_MIX); const float* norm_w = P.in[12]; const float* d_skip = P.in[11];
    const int lane = F.lane, lt = F.wave >> 1, ch = F.wave & 1;
    for (int u = F.vcu; u < 256; u += F.G) {
        const int b = u >> 3, g = (u >> 1) & 3, hl = u & 1;
        __syncthreads();
        { int tz = F.tid; OPAQUE(tz); unsigned zz = 0u; OPAQUE(zz);
#pragma unroll
          for (int k = 0; k < 6; ++k) *(LAS u32x4*)(L + L_S + (tz + NTHREADS * k) * 16) = (u32x4){zz, zz, zz, zz};
          if (tz < 192) *(LAS float*)(L + L_NW + tz * 4) = norm_w[g * 192 + tz]; }
        f32x4 sacc[2][6];
#pragma unroll
        for (int a = 0; a < 2; ++a)
#pragma unroll
            for (int c = 0; c < 6; ++c) sacc[a][c] = (f32x4){0.f, 0.f, 0.f, 0.f};
        const float dsk0 = d_skip[3 * g + ch], dsk1 = d_skip[3 * g + ch + 1];
        const size_t tokb = (size_t)b * SEQ;
#define SSD_ROLES int t3_ = F.tid; OPAQUE(t3_); const int orow = t3_ >> 3, oseg = t3_ & 7, oc0 = g * 192 + oseg * 24; const int ogrow = 16 * ssd_glmap(hl, orow >> 4) + (orow & 15); (void)orow; (void)oseg; (void)oc0; (void)ogrow
#define SSD_DMA_SMALL(bc_) do { if (F.wave < 6) { int ln2_ = lane; OPAQUE(ln2_); __builtin_amdgcn_global_load_lds((const unsigned*)(SA + ((size_t)(bc_) * 4 + g) * 1536 + F.wave * 256 + ln2_ * 4), (LAS unsigned*)(L + L_DT + F.wave * 1024), 16, 0, 0); } } while (0)
        ssd_dma_bc(L, XA + tokb * 1792, g, hl, F.wave, lane); ssd_dma_x(L, XA + tokb * 1792, g, F.wave, lane);
        u32x4 zr[3];
        SSD_DMA_SMALL(b * 16);
        { SSD_ROLES;
          const bf16_t* zp = proj + tokb * NPROJ + (unsigned)(ogrow * NPROJ + COL_Z + oc0);
#pragma unroll
          for (int k = 0; k < 3; ++k) zr[k] = *(const u32x4*)(zp + 8 * k); }
        for (int ck = 0; ck < 16; ++ck) {
            const size_t tok0 = tokb + ck * 128;
            SSD_ROLES;
            if (ck == 0) asm volatile("s_waitcnt vmcnt(0)" ::: "memory"); else asm volatile("s_waitcnt vmcnt(12)" ::: "memory");
            SBAR();
            f32x4 yacc[6];
            if (ch == 0) ssd_compute<0>(L, lt, hl, lane, sacc, yacc, dsk0, dsk1, true); else ssd_compute<1>(L, lt, hl, lane, sacc, yacc, dsk0, dsk1, true);
            SBAR();
            float gz[24];
#pragma unroll
            for (int k = 0; k < 3; ++k) { gz[8 * k + 0] = siluf_(bf_lo(zr[k].x)); gz[8 * k + 1] = siluf_(bf_hi(zr[k].x)); gz[8 * k + 2] = siluf_(bf_lo(zr[k].y)); gz[8 * k + 3] = siluf_(bf_hi(zr[k].y));
                gz[8 * k + 4] = siluf_(bf_lo(zr[k].z)); gz[8 * k + 5] = siluf_(bf_hi(zr[k].z)); gz[8 * k + 6] = siluf_(bf_lo(zr[k].w)); gz[8 * k + 7] = siluf_(bf_hi(zr[k].w)); }
#pragma unroll
            for (int k = 0; k < 24; ++k) asm volatile("" : "+v"(gz[k]) :: "memory");
            if (ck < 15) {
                SSD_DMA_SMALL(b * 16 + ck + 1);
                ssd_dma_bc(L, XA + (tok0 + 128) * 1792, g, hl, F.wave, lane);
            }
            { int l2 = lane; OPAQUE(l2); const int i = l2 & 15, q = l2 >> 4;
#pragma unroll
            for (int nt2 = 0; nt2 < 2; ++nt2)
#pragma unroll
                for (int ct = 0; ct < 6; ++ct) { const f32x4 s = sacc[nt2][ct]; u32x2 pk; pk.x = cvt_pk_bf16(s[0], s[1]); pk.y = cvt_pk_bf16(s[2], s[3]);
                    const int row = 96 * ch + 16 * ct + i, n0 = 16 * (2 * lt + nt2) + 4 * q; *(LAS u32x2*)(L + L_S + row * 256 + (((n0 >> 3) ^ swz16(i)) << 4) + 8 * ((n0 >> 2) & 1)) = pk; }
#pragma unroll
            for (int j = 0; j < 4; ++j) { const int row = 16 * lt + 4 * q + j; const int rb = L_X + row * 384;
#pragma unroll
                for (int ct = 0; ct < 6; ++ct) *(LAS bf16_t*)(L + rb + (96 * ch + 16 * ct + i) * 2) = (bf16_t)(cvt_pk_bf16(yacc[ct][j], 0.f) & 0xffffu); } }
            SBAR();
            u32x4 yr[3];
            { const int row = orow, seg = oseg; const int rb = L_X + row * 384;
#pragma unroll
              for (int k = 0; k < 3; ++k) yr[k] = *(const LAS u32x4*)(L + rb + seg * 48 + k * 16); }
            SBAR();
            if (ck < 15) ssd_dma_x(L, XA + (tok0 + 128) * 1792, g, F.wave, lane);
            asm volatile("" ::: "memory");
            { float v[24]; float ss = 0.f;
#pragma unroll
              for (int k = 0; k < 3; ++k) { v[8 * k + 0] = bf_lo(yr[k].x) * gz[8 * k + 0]; v[8 * k + 1] = bf_hi(yr[k].x) * gz[8 * k + 1]; v[8 * k + 2] = bf_lo(yr[k].y) * gz[8 * k + 2]; v[8 * k + 3] = bf_hi(yr[k].y) * gz[8 * k + 3];
                  v[8 * k + 4] = bf_lo(yr[k].z) * gz[8 * k + 4]; v[8 * k + 5] = bf_hi(yr[k].z) * gz[8 * k + 5]; v[8 * k + 6] = bf_lo(yr[k].w) * gz[8 * k + 6]; v[8 * k + 7] = bf_hi(yr[k].w) * gz[8 * k + 7]; }
#pragma unroll
              for (int k = 0; k < 24; ++k) ss += v[k] * v[k];
              ss += __shfl_xor(ss, 1); ss += __shfl_xor(ss, 2); ss += __shfl_xor(ss, 4);
              const float rstd = rsqrtf(ss * (1.f / 192.f) + EPS);
              bf16_t* op = mix + tok0 * DM + (unsigned)(ogrow * DM + 256 + oc0);
#pragma unroll
              for (int k = 0; k < 3; ++k) { const f32x4 n0 = *(const LAS f32x4*)(L + L_NW + (oseg * 24 + 8 * k) * 4), n1 = *(const LAS f32x4*)(L + L_NW + (oseg * 24 + 8 * k + 4) * 4); u32x4 pk;
                  pk.x = cvt_pk_bf16(v[8 * k] * rstd * n0[0], v[8 * k + 1] * rstd * n0[1]); pk.y = cvt_pk_bf16(v[8 * k + 2] * rstd * n0[2], v[8 * k + 3] * rstd * n0[3]);
                  pk.z = cvt_pk_bf16(v[8 * k + 4] * rstd * n1[0], v[8 * k + 5] * rstd * n1[1]); pk.w = cvt_pk_bf16(v[8 * k + 6] * rstd * n1[2], v[8 * k + 7] * rstd * n1[3]);
                  *(u32x4*)(op + 8 * k) = pk; } }
            if (ck < 15) { const bf16_t* zp = proj + (tok0 + 128) * NPROJ + (unsigned)(ogrow * NPROJ + COL_Z + oc0);
#pragma unroll
                for (int k = 0; k < 3; ++k) zr[k] = *(const u32x4*)(zp + 8 * k); }
        }
    }
}

constexpr int R_WH = 0, R_WL = 73728, R_SC = 147456, R_SH = R_SC + 4096, R_CNT = R_SH + 4096, R_LG = 0;
__device__ __forceinline__ void p5_route(const Frame& F, const Params& P) {
    LAS unsigned char* L = (LAS unsigned char*)F.lds;
    const bf16_t* x1 = (const bf16_t*)(P.ws + WS_X1); const float* mod = (const float*)(P.ws + WS_MOD); bf16_t* H = (bf16_t*)(P.ws + WS_H); const float* ss16 = (const float*)(P.ws + WS_SS16);
    const bf16_t* WRH = (const bf16_t*)(P.ws + WS_WR); const bf16_t* WRL = (const bf16_t*)(P.ws + WS_WR + 131072);
    float* gates = (float*)(P.ws + WS_SGATE); unsigned* list = (unsigned*)(P.ws + WS_LIST); unsigned* gcount = (unsigned*)(P.ws + WS_CTL) + CW_GCOUNT;
    const float* b_group = P.in[15]; const float* b_router = P.in[17];
    LAS unsigned* lcount = (LAS unsigned*)(L + R_CNT);
    LAS unsigned* lbase = lcount + 32;
    LAS unsigned* tinfo = lcount + 64;
    LAS float* twt = (LAS float*)(tinfo + 256 * 4);
    const int lane = F.lane, i = lane & 15, q = lane >> 4;
    for (int rb = F.vcu; rb < T / 256; rb += F.G) {
        const int b = rb >> 3;
        for (int idx = F.tid; idx < 36 * 128; idx += NTHREADS) { const int j = idx >> 7, c = idx & 127; const int dst = j * 2048 + ((c ^ swz16(j & 15)) << 4);
            *(LAS u32x4*)(L + R_WH + dst) = *(const u32x4*)(WRH + (size_t)j * 1024 + c * 8); *(LAS u32x4*)(L + R_WL + dst) = *(const u32x4*)(WRL + (size_t)j * 1024 + c * 8); }
        for (int idx = F.tid; idx < 256; idx += NTHREADS) { const f32x4 sc = *(const f32x4*)(mod + (size_t)b * 6144 + 4 * 1024 + idx * 4), sh = *(const f32x4*)(mod + (size_t)b * 6144 + 3 * 1024 + idx * 4);
            *(LAS f32x4*)(L + R_SC + idx * 16) = sc + 1.0f; *(LAS f32x4*)(L + R_SH + idx * 16) = sh; }
        if (F.tid < 32) lcount[F.tid] = 0u;
        __syncthreads();
        const int rowA = rb * 256 + F.wave * 32 + i;
        float rstd[2];
#pragma unroll
        for (int rt = 0; rt < 2; ++rt) { const f32x4* sp = (const f32x4*)(ss16 + (size_t)(rowA + 16 * rt) * 16); const f32x4 a = sp[0], c = sp[1], d = sp[2], e = sp[3];
            const float ss = ((a[0] + a[1]) + (a[2] + a[3])) + ((c[0] + c[1]) + (c[2] + c[3])) + ((d[0] + d[1]) + (d[2] + d[3])) + ((e[0] + e[1]) + (e[2] + e[3])); rstd[rt] = rsqrtf(ss * (1.f / DM) + EPS); }
        f32x4 acc[2][3];
#pragma unroll
        for (int rt = 0; rt < 2; ++rt)
#pragma unroll
            for (int ct = 0; ct < 3; ++ct) acc[rt][ct] = (f32x4){0.f, 0.f, 0.f, 0.f};
        int wrow[3];
#pragma unroll
        for (int ct = 0; ct < 3; ++ct) { const int j = (16 * ct + i) < 36 ? (16 * ct + i) : 35; wrow[ct] = j * 2048; }
        const int fsw = swz16(i);
        const int fswc = swz16(35 & 15);
#pragma unroll 2
        for (int s = 0; s < 32; ++s) {
            bf16x8 wh[3], wl[3];
#pragma unroll
            for (int ct = 0; ct < 3; ++ct) { const int sw = ((16 * ct + i) < 36) ? fsw : fswc; const int o = wrow[ct] + ((((4 * s + q) & ~15) | (((4 * s + q) & 15) ^ sw)) << 4);
                wh[ct] = *(const LAS bf16x8*)(L + R_WH + o); wl[ct] = *(const LAS bf16x8*)(L + R_WL + o); }
            const f32x4 sc0 = *(const LAS f32x4*)(L + R_SC + (32 * s + 8 * q) * 4), sc1 = *(const LAS f32x4*)(L + R_SC + (32 * s + 8 * q + 4) * 4);
            const f32x4 sh0 = *(const LAS f32x4*)(L + R_SH + (32 * s + 8 * q) * 4), sh1 = *(const LAS f32x4*)(L + R_SH + (32 * s + 8 * q + 4) * 4);
#pragma unroll
            for (int rt = 0; rt < 2; ++rt) { const size_t off = (size_t)(rowA + 16 * rt) * DM + 32 * s + 8 * q;
                const u32x4 xw = *(const u32x4*)(x1 + off); const f32x4 x0 = (f32x4){bf_lo(xw.x), bf_hi(xw.x), bf_lo(xw.y), bf_hi(xw.y)}, x1v = (f32x4){bf_lo(xw.z), bf_hi(xw.z), bf_lo(xw.w), bf_hi(xw.w)};
                const f32x4 h0 = x0 * rstd[rt] * sc0 + sh0, h1 = x1v * rstd[rt] * sc1 + sh1;
                u32x4 hi; hi.x = cvt_pk_bf16(h0[0], h0[1]); hi.y = cvt_pk_bf16(h0[2], h0[3]); hi.z = cvt_pk_bf16(h1[0], h1[1]); hi.w = cvt_pk_bf16(h1[2], h1[3]);
                { u32x2 h8; h8.x = cvt_pk4_fp8(h0[0], h0[1], h0[2], h0[3]); h8.y = cvt_pk4_fp8(h1[0], h1[1], h1[2], h1[3]); *(u32x2*)((unsigned char*)H + off) = h8; }
                u32x4 lo; lo.x = cvt_pk_bf16(h0[0] - bf_lo(hi.x), h0[1] - bf_hi(hi.x)); lo.y = cvt_pk_bf16(h0[2] - bf_lo(hi.y), h0[3] - bf_hi(hi.y));
                lo.z = cvt_pk_bf16(h1[0] - bf_lo(hi.z), h1[1] - bf_hi(hi.z)); lo.w = cvt_pk_bf16(h1[2] - bf_lo(hi.w), h1[3] - bf_hi(hi.w));
                const bf16x8 ah = __builtin_bit_cast(bf16x8, hi), al = __builtin_bit_cast(bf16x8, lo);
#pragma unroll
                for (int ct = 0; ct < 3; ++ct) { acc[rt][ct] = MFMA16(ah, wh[ct], acc[rt][ct]); acc[rt][ct] = MFMA16(al, wh[ct], acc[rt][ct]); acc[rt][ct] = MFMA16(ah, wl[ct], acc[rt][ct]); } }
        }
        __syncthreads();
        LAS float* lg = (LAS float*)(L + R_LG);
#pragma unroll
        for (int rt = 0; rt < 2; ++rt)
#pragma unroll
            for (int ct = 0; ct < 3; ++ct)
#pragma unroll
                for (int j = 0; j < 4; ++j) { const int col = 16 * ct + i; if (col < 36) lg[(F.wave * 32 + 16 * rt + 4 * q + j) * 37 + col] = acc[rt][ct][j]; }
        __syncthreads();
        if (F.tid < 256) {
            const int rl = F.tid; const LAS float* lr = lg + rl * 37;
            float gl[4];
#pragma unroll
            for (int k = 0; k < 4; ++k) gl[k] = lr[k] + b_group[k];
            int gi = 0; float gm = gl[0];
#pragma unroll
            for (int k = 1; k < 4; ++k) if (gl[k] > gm) { gm = gl[k]; gi = k; }
            float den = 0.f;
#pragma unroll
            for (int k = 0; k < 4; ++k) den += __expf(gl[k] - gm);
            const float pg = 1.0f / den;
            float el[8];
#pragma unroll
            for (int k = 0; k < 8; ++k) el[k] = lr[4 + gi * 8 + k] + b_router[gi * 8 + k];
            int i0 = 0; float v0 = el[0];
#pragma unroll
            for (int k = 1; k < 8; ++k) if (el[k] > v0) { v0 = el[k]; i0 = k; }
            int i1 = -1; float v1 = -3.0e38f;
#pragma unroll
            for (int k = 0; k < 8; ++k) if (k != i0 && el[k] > v1) { v1 = el[k]; i1 = k; }
            const float ex = __expf(v1 - v0); const float w0 = pg / (1.0f + ex), w1 = pg * ex / (1.0f + ex);
            const int e0 = gi * 8 + i0, e1 = gi * 8 + i1; const unsigned r0 = atomicAdd((unsigned*)&lcount[e0], 1u), r1 = atomicAdd((unsigned*)&lcount[e1], 1u);
            tinfo[rl * 4 + 0] = (unsigned)e0 | ((unsigned)e1 << 8); tinfo[rl * 4 + 1] = r0; tinfo[rl * 4 + 2] = r1; twt[rl * 2] = w0; twt[rl * 2 + 1] = w1;
        }
        __syncthreads();
        if (F.tid < 32) lbase[F.tid] = atomicAdd(&gcount[64 * F.tid], lcount[F.tid]);
        __syncthreads();
        if (F.tid < 256) { const int rl = F.tid, row = rb * 256 + rl; const unsigned ee = tinfo[rl * 4], e0 = ee & 255u, e1 = ee >> 8;
            const size_t s0 = (size_t)e0 * ECAP + lbase[e0] + tinfo[rl * 4 + 1], s1 = (size_t)e1 * ECAP + lbase[e1] + tinfo[rl * 4 + 2];
            list[s0] = (unsigned)row * 2u; list[s1] = (unsigned)row * 2u + 1u; gates[s0] = twt[rl * 2]; gates[s1] = twt[rl * 2 + 1]; }
        __syncthreads();
    }
}

__device__ __forceinline__ void p8_final(const Frame& F, const Params& P) {
    const bf16_t* x1 = (const bf16_t*)(P.ws + WS_X1); const unsigned char* Y0 = P.ws + WS_Y0; const unsigned char* Y1 = P.ws + WS_Y1; const float* fw = P.in[20]; const float* mod = (const float*)(P.ws + WS_MOD);
    f32x4 wv[4];
#pragma unroll
    for (int j = 0; j < 4; ++j) wv[j] = ((const f32x4*)fw)[F.lane + 64 * j];
    for (int row0 = F.gw * 2; row0 < T; row0 += F.NGW * 2) {
        const f32x4* g2 = (const f32x4*)(mod + (size_t)(row0 >> 11) * 6144 + 5 * 1024) + F.lane;
        u32x2 xw[2][4]; unsigned a[2][4], c[2][4];
#pragma unroll
        for (int r = 0; r < 2; ++r) { const u32x2* xr = (const u32x2*)(x1 + (size_t)(row0 + r) * DM) + F.lane; const unsigned* y0 = (const unsigned*)(Y0 + (size_t)(row0 + r) * DM) + F.lane; const unsigned* y1 = (const unsigned*)(Y1 + (size_t)(row0 + r) * DM) + F.lane;
#pragma unroll
            for (int j = 0; j < 4; ++j) { xw[r][j] = __builtin_nontemporal_load(xr + 64 * j); a[r][j] = __builtin_nontemporal_load(y0 + 64 * j); c[r][j] = __builtin_nontemporal_load(y1 + 64 * j); } }
        f32x4 g[4];
#pragma unroll
        for (int j = 0; j < 4; ++j) g[j] = g2[64 * j];
#pragma unroll
        for (int r = 0; r < 2; ++r) { f32x4 v[4]; float s = 0.f;
#pragma unroll
            for (int j = 0; j < 4; ++j) { v[j] = (f32x4){bf_lo(xw[r][j].x), bf_hi(xw[r][j].x), bf_lo(xw[r][j].y), bf_hi(xw[r][j].y)};
                const f32x2 a01 = __builtin_amdgcn_cvt_pk_f32_fp8((int)a[r][j], false), a23 = __builtin_amdgcn_cvt_pk_f32_fp8((int)a[r][j], true), c01 = __builtin_amdgcn_cvt_pk_f32_fp8((int)c[r][j], false), c23 = __builtin_amdgcn_cvt_pk_f32_fp8((int)c[r][j], true);
                v[j][0] += g[j][0] * (a01[0] + c01[0]); v[j][1] += g[j][1] * (a01[1] + c01[1]); v[j][2] += g[j][2] * (a23[0] + c23[0]); v[j][3] += g[j][3] * (a23[1] + c23[1]);
                s += (v[j][0] * v[j][0] + v[j][1] * v[j][1]) + (v[j][2] * v[j][2] + v[j][3] * v[j][3]); }
            const float rstd = rsqrtf(wave_sum(s) * (1.f / DM) + EPS);
            f32x4* o = (f32x4*)(P.out + (size_t)(row0 + r) * DM) + F.lane;
#pragma unroll
            for (int j = 0; j < 4; ++j) __builtin_nontemporal_store(v[j] * rstd * wv[j], o + 64 * j); }
    }
}

__device__ __forceinline__ void moe_prefix(const Frame& F, const Params& P, int* pref) {
    const unsigned* gcount = (const unsigned*)(P.ws + WS_CTL) + CW_GCOUNT;
    __syncthreads();
    if (F.tid == 0) { int acc = 0; for (int e = 0; e < 32; ++e) { const int c = (int)__hip_atomic_load(gcount + 64 * e, __ATOMIC_RELAXED, __HIP_MEMORY_SCOPE_AGENT); pref[e] = acc; pref[33 + e] = c; acc += (c + 255) >> 8; } pref[32] = acc; }
    __syncthreads();
}

#define XB_TMO      128
#define XB_XCNT(j)  (256  + 64 * (j))
#define XB_XSUB(j)  (1280 + 64 * (j))
#define XB_XGEN(j)  (2304 + 64 * (j))
#define XB_TOP      3328
#define XB_TOPGEN   3392
#define XCD_BAR_WORDS 3456
#define XB_SPIN_CAP (1u << 22)
__device__ __forceinline__ unsigned xb_ld(unsigned* p)              { return __hip_atomic_load(p, __ATOMIC_RELAXED, __HIP_MEMORY_SCOPE_AGENT); }
__device__ __forceinline__ unsigned xb_add(unsigned* p, unsigned v) { return __hip_atomic_fetch_add(p, v, __ATOMIC_RELAXED, __HIP_MEMORY_SCOPE_AGENT); }
__device__ __forceinline__ unsigned xb_xcc_id() { return (unsigned)__builtin_amdgcn_s_getreg((3 << 11) | 20) & 0xFu; }
#define XB_SPIN(cond, bar) do { unsigned _sp = 0; while (cond) { __builtin_amdgcn_s_sleep(1); \
    if ((++_sp & 255u) == 0u) { if (xb_ld(&(bar)[XB_TMO])) break; if (_sp > XB_SPIN_CAP) { atomicAdd(&(bar)[XB_TMO], 1u); break; } } } } while (0)
struct XcdBarrier { unsigned* bar; unsigned x; volatile LAS unsigned* st; };
__device__ __forceinline__ XcdBarrier xcd_barrier_post(unsigned* bar, volatile LAS unsigned* st) {
    XcdBarrier b; b.bar = bar; b.x = xb_xcc_id(); b.st = st;
    if (threadIdx.x == 0) (void)xb_add(&bar[XB_XCNT(b.x)], 1u);
    return b;
}
__device__ __forceinline__ void xcd_barrier_complete(unsigned* bar, unsigned x, unsigned& nloc, unsigned& nx) {
    const unsigned G = gridDim.x * gridDim.y * gridDim.z;
    unsigned sum, cnt, mine, sp = 0u;
    for (;;) {
        sum = 0u; cnt = 0u; mine = 0u;
#pragma unroll
        for (unsigned j = 0; j < 16; ++j) { const unsigned c = xb_ld(&bar[XB_XCNT(j)]); sum += c; cnt += (c > 0u) ? 1u : 0u; mine = (j == x) ? c : mine; }
        if (sum == G) break;
        __builtin_amdgcn_s_sleep(1);
        if ((++sp & 255u) == 0u) { if (xb_ld(&bar[XB_TMO])) break; if (sp > XB_SPIN_CAP) { atomicAdd(&bar[XB_TMO], 1u); break; } }
    }
    nloc = mine > 0u ? mine : 1u; nx = cnt > 0u ? cnt : 1u;
}
__device__ __forceinline__ void xcd_barrier(const XcdBarrier& b) {
    asm volatile("s_waitcnt vmcnt(0)" ::: "memory");
    __syncthreads();
    if (threadIdx.x == 0) {
        unsigned* bar = b.bar;
        __builtin_amdgcn_s_waitcnt(0);
        unsigned nloc = b.st[0], nx = b.st[1];
        if (nloc == 0u) { xcd_barrier_complete(bar, b.x, nloc, nx); b.st[0] = nloc; b.st[1] = nx; }
        const unsigned old = xb_add(&bar[XB_XSUB(b.x)], 1u);
        const unsigned gen = old / nloc;
        if (old + 1u == (gen + 1u) * nloc) {
            __builtin_amdgcn_fence(__ATOMIC_RELEASE, "agent");
            asm volatile("s_waitcnt vmcnt(0)" ::: "memory");
            const unsigned og = xb_add(&bar[XB_TOP], 1u);
            const unsigned tg = og / nx;
            if (og + 1u == (tg + 1u) * nx) xb_add(&bar[XB_TOPGEN], 1u);
            else XB_SPIN(xb_ld(&bar[XB_TOPGEN]) == tg, bar);
            __builtin_amdgcn_fence(__ATOMIC_ACQUIRE, "agent");
            xb_add(&bar[XB_XGEN(b.x)], 1u);
            asm volatile("s_waitcnt vmcnt(0)" ::: "memory");
        } else {
            XB_SPIN(xb_ld(&bar[XB_XGEN(b.x)]) == gen, bar);
            __builtin_amdgcn_fence(__ATOMIC_ACQUIRE, "agent");
            asm volatile("s_waitcnt vmcnt(0)" ::: "memory");
        }
    }
    __syncthreads();
}

__global__ void __launch_bounds__(NTHREADS, 2) fwd_kernel(Params P) {
    extern __shared__ __attribute__((aligned(16))) unsigned char lds[];
    Frame F; F.lds = lds; F.tid = threadIdx.x; F.lane = F.tid & 63; F.wave = __builtin_amdgcn_readfirstlane(F.tid >> 6);
    F.G = gridDim.x; { const int bx = blockIdx.x; F.vcu = (F.G % 8 == 0) ? (bx % 8) * (F.G / 8) + bx / 8 : bx; }
    F.gw = F.vcu * NWAVES + F.wave; F.NGW = F.G * NWAVES;
    unsigned char* ws = P.ws;
    const int lo = P.ph_lo, hi = P.ph_hi;
    volatile LAS unsigned* bst = (volatile LAS unsigned*)((LAS unsigned char*)lds + (LDS_BYTES - 64));
    if (F.tid < 2) bst[F.tid] = 0u;
    __syncthreads();
    const XcdBarrier xbar = xcd_barrier_post((unsigned*)(ws + WS_CTL) + CW_BAR, bst);
#define IN(k) (lo <= (k) && (k) < hi)
#define GRID_BAR() xcd_barrier(xbar)
#define GRID_BAR_CG() do { __syncthreads(); cooperative_groups::this_grid().sync(); } while (0)
    if (IN(0)) p0_prep(F, P);
    if (IN(0) && IN(1)) { if (P.ph_hi > 1000) GRID_BAR_CG(); else GRID_BAR(); }
    if (IN(1)) p1_modulate(F, P);
    if (IN(1) && IN(2)) GRID_BAR();
    if (IN(2)) { pg8::DenseSched S; S.init(ws + WS_H, ws + WS_WIN, T, COL_DT, 1024, F.G, (int)blockIdx.x); pg8::EpiProj E{(bf16_t*)(ws + WS_PROJ), (float*)(ws + WS_DTRAW)}; pg8::gemm_phase(( LAS unsigned char*)lds, S, E); }
    if (IN(2) && IN(3)) GRID_BAR();
    if (IN(3)) p3_conv(F, P);
    if (IN(3) && IN(4)) GRID_BAR();
    if (IN(4)) p4_ssd(F, P);
    if (IN(4) && IN(5)) GRID_BAR();
    if (IN(5)) { pg8::DenseSched S; S.init(ws + WS_MIX, ws + WS_WOUT, T, 1024, 1024, F.G, (int)blockIdx.x); pg8::EpiX1 E{P.in[0], (const float*)(ws + WS_MOD), (bf16_t*)(ws + WS_X1), (float*)(ws + WS_SS16)}; pg8::gemm_phase((LAS unsigned char*)lds, S, E); }
    if (IN(5) && IN(6)) GRID_BAR();
    if (IN(6)) p5_route(F, P);
    if (IN(6) && IN(7)) GRID_BAR();
    if (IN(7)) { int* pref = (int*)(lds + MISC_OFF); moe_prefix(F, P, pref);
        pg8::MoeSched<true> S; S.A = (const char*)(ws + WS_H); S.Bt = (const char*)(ws + WS_W13); S.K = 1024; S.nN = 4; S.G = F.G; S.c = F.vcu; S.pref = (const LAS int*)pref; S.list = (const unsigned*)(ws + WS_LIST);
        pg8::EpiAct E{(unsigned char*)(ws + WS_ACT)}; pg8::gemm_phase((LAS unsigned char*)lds, S, E); }
    if (IN(7) && IN(8)) GRID_BAR();
    if (IN(8)) { int* pref = (int*)(lds + MISC_OFF); moe_prefix(F, P, pref);
        pg8::MoeSched<false> S; S.A = (const char*)(ws + WS_ACT); S.Bt = (const char*)(ws + WS_W2); S.K = 512; S.nN = 4; S.G = F.G; S.c = F.vcu; S.pref = (const LAS int*)pref; S.list = (const unsigned*)(ws + WS_LIST);
        pg8::EpiY E{(const unsigned*)(ws + WS_LIST), (const float*)(ws + WS_SGATE), ws + WS_Y0, ws + WS_Y1}; pg8::gemm_phase((LAS unsigned char*)lds, S, E); }
    if (IN(8) && IN(9)) GRID_BAR();
    if (IN(9)) p8_final(F, P);
#undef IN
#undef GRID_BAR
#undef GRID_BAR_CG
}

extern "C" void kernel_launch(void* const* d_in, const int* in_sizes, int n_in, void* d_out, int out_size, void* d_ws, size_t ws_size, hipStream_t stream) {
    static int grid = 0;
    if (grid == 0) {
        if (n_in != 21 || out_size != T * DM || ws_size < WS_END) { fprintf(stderr, "kernel_launch: unexpected sizes n_in %d out %d ws %zu\n", n_in, out_size, ws_size); grid = -1; return; }
        int dev = 0, cus = 0;
        if (hipGetDevice(&dev) != hipSuccess || hipDeviceGetAttribute(&cus, hipDeviceAttributeMultiprocessorCount, dev) != hipSuccess) { grid = -1; return; }
        if (hipFuncSetAttribute((const void*)fwd_kernel, hipFuncAttributeMaxDynamicSharedMemorySize, LDS_BYTES) != hipSuccess) { fprintf(stderr, "kernel_launch: hipFuncSetAttribute failed\n"); grid = -1; return; }
        int per_cu = 0;
        if (hipOccupancyMaxActiveBlocksPerMultiprocessor(&per_cu, (const void*)fwd_kernel, NTHREADS, LDS_BYTES) != hipSuccess || per_cu < 1) { fprintf(stderr, "kernel_launch: occupancy query says %d blocks per CU\n", per_cu); (void)hipGetLastError(); per_cu = 1; }
        grid = cus;
    }
    if (grid < 0) return;
    (void)hipMemsetAsync((char*)d_ws + WS_CTL, 0, CTL_BYTES, stream);
    Params p{};
    for (int i = 0; i < 21; ++i) p.in[i] = (const float*)d_in[i];
    p.out = (float*)d_out; p.ws = (unsigned char*)d_ws;
    p.ph_lo = 0; p.ph_hi = 10;
    void* args[] = {&p};
    hipError_t e = hipLaunchCooperativeKernel((const void*)fwd_kernel, dim3(grid), dim3(NTHREADS), args, LDS_BYTES, stream);
    if (e != hipSuccess) fprintf(stderr, "kernel_launch: cooperative launch failed: %s (grid %d)\n", hipGetErrorString(e), grid);
}
```

```cpp
#include <hip/hip_runtime.h>
#include <hip/hip_cooperative_groups.h>
#include <cstdio>
#include <cstdint>

#ifndef MK_ONE_LAUNCH
#define MK_ONE_LAUNCH 0
#endif

#define LAS __attribute__((address_space(3)))
typedef unsigned short bf16_t;
typedef short bf16x8 __attribute__((ext_vector_type(8)));
typedef float f32x4 __attribute__((ext_vector_type(4)));
typedef float f32x2 __attribute__((ext_vector_type(2)));
typedef unsigned u32x4 __attribute__((ext_vector_type(4)));
typedef unsigned u32x2 __attribute__((ext_vector_type(2)));
typedef int i32x4 __attribute__((ext_vector_type(4)));
typedef int i32x8 __attribute__((ext_vector_type(8)));

constexpr int BATCH = 32, SEQ = 2048, DM = 1024, T = BATCH * SEQ;
constexpr int NPROJ = 3072, NPROJ_REAL = 2828;
constexpr int COL_Z = 256, COL_XS = 1024, COL_B = 1792, COL_C = 2304, COL_DT = 2816;
constexpr int NEXP = 32, FF = 512, ECAP = 65536;
constexpr int NWAVES = 8, NTHREADS = 512;
constexpr float EPS = 1e-6f;

constexpr size_t MiB = 1u << 20;
constexpr size_t WS_CTL = 0, CTL_BYTES = 1 * MiB;
constexpr size_t WS_MOD = 1 * MiB;
constexpr size_t WS_WR = 2 * MiB;
constexpr size_t WS_WDT = 2 * MiB + 512 * 1024;
constexpr size_t WS_SS16 = 4 * MiB;
constexpr size_t WS_SGATE = 120 * MiB;
constexpr size_t WS_DTRAW = 4 * MiB;
constexpr size_t WS_LIST = 8 * MiB;
constexpr size_t WS_WIN = 16 * MiB;
constexpr size_t WS_WOUT = 22 * MiB;
constexpr size_t WS_W13 = 24 * MiB;
constexpr size_t WS_W2 = 88 * MiB;
constexpr size_t WS_H = 128 * MiB;
constexpr size_t WS_PROJ = 256 * MiB;
constexpr size_t WS_MIX = 640 * MiB;
constexpr size_t WS_X1 = 768 * MiB;
constexpr size_t WS_END = 1024 * MiB;
constexpr size_t WS_XA = WS_X1;
constexpr size_t WS_SA = WS_H;
constexpr size_t WS_Y0 = 256 * MiB, WS_Y1 = 384 * MiB;
constexpr size_t WS_ACT = 512 * MiB;
constexpr int CW_GCOUNT = 256;
constexpr int CW_BAR = 4096;

constexpr int LDS_BYTES = 163840;
constexpr int MISC_OFF = 147456;

struct Params {
    const float* in[21];
    float* out;
    unsigned char* ws;
    int ph_lo, ph_hi;
};

__device__ __forceinline__ unsigned cvt_pk_bf16(float lo, float hi) { unsigned r; asm volatile("v_cvt_pk_bf16_f32 %0, %1, %2" : "=v"(r) : "v"(lo), "v"(hi)); return r; }
__device__ __forceinline__ float clamp_f8(float v) { return __builtin_fminf(__builtin_fmaxf(v, -448.f), 448.f); }
__device__ __forceinline__ unsigned cvt_pk4_fp8(float a, float b, float c, float d) {
    int w = 0; w = __builtin_amdgcn_cvt_pk_fp8_f32(clamp_f8(a), clamp_f8(b), w, false); w = __builtin_amdgcn_cvt_pk_fp8_f32(clamp_f8(c), clamp_f8(d), w, true); return (unsigned)w; }
__device__ __forceinline__ float bf_lo(unsigned u) { return __uint_as_float(u << 16); }
__device__ __forceinline__ float bf_hi(unsigned u) { return __uint_as_float(u & 0xffff0000u); }
__device__ __forceinline__ float wave_sum(float v) {
#pragma unroll
    for (int o = 1; o < 64; o <<= 1) v += __shfl_xor(v, o);
    return v;
}
__device__ __forceinline__ float sigmoidf_(float v) { return __builtin_amdgcn_rcpf(1.0f + __expf(-v)); }
__device__ __forceinline__ float siluf_(float v) { return v * sigmoidf_(v); }

namespace pg8 {
constexpr float W_F8_SCALE = 32.f, W_F8_INV = 1.f / 32.f;
constexpr int BM = 256, BK = 64, HALF = 128, HTB = HALF * BK * 2, STAGE_BYTES = 8 * HTB, NXCD = 8, WGM = 4;
__host__ __device__ __forceinline__ int lds_byte(int r, int c) { const int st = (r >> 4) * 2 + (c >> 5), rr = r & 15, cc = c & 31, ob = rr * 64 + cc * 2; return st * 1024 + (ob ^ (((ob >> 9) & 1) << 5)); }
__host__ __device__ __forceinline__ void stage_rc(int b, int& R, int& C) { const int st = b / 1024, sb = b % 1024, swz = sb ^ (((sb >> 9) & 1) << 5); R = (st >> 1) * 16 + swz / 64; C = (st & 1) * 32 + (swz % 64) / 2; }
__host__ __device__ __forceinline__ int perm32(int rho) { const int n = rho >> 4, i = rho & 15; return 8 * (i >> 2) + 4 * n + (i & 3); }

struct Unit { int pm, pn, e, cnt, slot0; };

struct DenseSched {
    const char* A; const char* Bt; int K;
    int nM, nN, nwg, G, c;
    __device__ void init(const void* A_, const void* Bt_, int M, int N, int K_, int G_, int c_) { A = (const char*)A_; Bt = (const char*)Bt_; K = K_; nM = M / BM; nN = N / BM; nwg = nM * nN; G = G_; c = c_; }
    __device__ __forceinline__ bool next(int i, Unit& u) const {
        const long L = (long)i * G + c; if (L >= nwg) return false;
        int wgid = (int)L; { const int q = nwg / NXCD, r = nwg % NXCD, xcd = wgid % NXCD, off = wgid / NXCD; wgid = (xcd < r ? xcd * (q + 1) : r * (q + 1) + (xcd - r) * q) + off; }
        const int nig = WGM * nN, gid = wgid / nig, fm = gid * WGM, gsz = (nM - fm) < WGM ? (nM - fm) : WGM;
        u.pm = fm + ((wgid % nig) % gsz); u.pn = (wgid % nig) / gsz; u.e = 0; u.cnt = 256; u.slot0 = 0; return true;
    }
    static constexpr bool FP8 = false;
    __device__ __forceinline__ int kb() const { return K * 2; }
    __device__ __forceinline__ const char* a_base() const { return A; }
    __device__ __forceinline__ void a_raw(const Unit& u, const int (&R)[2], unsigned (&raw)[2][2]) const {
#pragma unroll
        for (int h = 0; h < 2; ++h)
#pragma unroll
            for (int i = 0; i < 2; ++i) raw[h][i] = (unsigned)(u.pm * BM + h * HALF + R[i]);
    }
    __device__ __forceinline__ void a_fin(const int (&C)[2], const unsigned (&raw)[2][2], unsigned (&o)[2][2]) const {
#pragma unroll
        for (int h = 0; h < 2; ++h)
#pragma unroll
            for (int i = 0; i < 2; ++i) o[h][i] = (raw[h][i] * (unsigned)K + (unsigned)C[i]) * 2u;
    }
    __device__ __forceinline__ const char* b_ptr(const Unit& u) const { return Bt + (size_t)u.pn * BM * K * 2; }
};

template <bool GATHER>
struct MoeSched {
    static constexpr bool FP8 = true;
    __device__ __forceinline__ int kb() const { return K; }
    const char* A; const char* Bt; int K, nN, G, c;
    const LAS int* pref;
    const unsigned* list;
    __device__ __forceinline__ bool next(int i, Unit& u) const {
        const long L = (long)i * G + c; const int tot = pref[32] * nN; if (L >= tot) return false;
        const int ti = (int)L / nN; u.pn = (int)L % nN;
        int e = 0;
#pragma unroll 1
        for (int step = 16; step >= 1; step >>= 1) if (pref[e + step] <= ti) e += step;
        const int mt = ti - pref[e]; u.pm = ti; u.e = e; u.slot0 = mt * 256; const int rem = pref[33 + e] - mt * 256; u.cnt = rem < 256 ? rem : 256; return true;
    }
    __device__ __forceinline__ const char* a_base() const { return A; }
    __device__ __forceinline__ void a_raw(const Unit& u, const int (&R)[2], unsigned (&raw)[2][2]) const {
#pragma unroll
        for (int h = 0; h < 2; ++h)
#pragma unroll
            for (int i = 0; i < 2; ++i) {
                const int r = h * HALF + R[i];
                if (GATHER) { unsigned ent = 0; if (r < u.cnt) ent = list[(size_t)u.e * ECAP + u.slot0 + r]; raw[h][i] = ent >> 1; }
                else raw[h][i] = (unsigned)(u.pm * BM + r);
            }
    }
    __device__ __forceinline__ void a_fin(const int (&C)[2], const unsigned (&raw)[2][2], unsigned (&o)[2][2]) const {
#pragma unroll
        for (int h = 0; h < 2; ++h)
#pragma unroll
            for (int i = 0; i < 2; ++i) o[h][i] = raw[h][i] * (unsigned)K + (unsigned)C[i] * 2u;
    }
    __device__ __forceinline__ const char* b_ptr(const Unit& u) const { return Bt + ((size_t)u.e * (nN * BM) + (size_t)u.pn * BM) * K; }
};

template <class Epi, class Sched>
__device__ __forceinline__ void gemm_phase(LAS unsigned char* lds, const Sched& S, const Epi& E, unsigned stagger_ticks = 0u) {
    if (stagger_ticks) { const unsigned long long t0 = __builtin_amdgcn_s_memrealtime(); while ((unsigned long long)(__builtin_amdgcn_s_memrealtime() - t0) < (unsigned long long)stagger_ticks) __builtin_amdgcn_s_sleep(16); }
    const int tid = threadIdx.x, wid = __builtin_amdgcn_readfirstlane(tid >> 6), lane = tid & 63, wr = wid >> 2, wc = wid & 3, fr = lane & 15, fq = lane >> 4;
    const int KB = S.kb(), nt = KB / (BK * 2);
    int sR[2], sC[2]; unsigned voffB[2];
#pragma unroll
    for (int i = 0; i < 2; ++i) { int R, C; stage_rc(tid * 16 + i * 8192, R, C); sR[i] = R; sC[i] = C; const int Rb = Epi::PERM ? ((R & ~31) + perm32(R & 31)) : R; voffB[i] = (unsigned)(Rb * KB + C * 2); }
    const size_t kstep = (size_t)(BK * 2);
    const size_t hstep = (size_t)HALF * KB;
    const unsigned ldsw = (unsigned)wid * 1024u;
    const int aoff = lds_byte(wr * 64 + fr, fq * 8), boff = lds_byte(wc * 32 + fr, fq * 8);
#define PG8_SA(b, h) (((b) * 2 + (h)) * HTB)
#define PG8_SB(b, h) ((4 + (b) * 2 + (h)) * HTB)
#define PG8_STAGE(bufoff, gbase, voff) do { _Pragma("unroll") for (int _i = 0; _i < 2; ++_i) \
        __builtin_amdgcn_global_load_lds((const unsigned*)((const char*)(gbase) + (voff)[_i]), (LAS unsigned*)(lds + (bufoff) + ldsw + _i * 8192), 16, 0, 0); } while (0)
#define PG8_LDA(dst, b, h) do { _Pragma("unroll") for (int m = 0; m < 4; ++m) _Pragma("unroll") for (int k = 0; k < 2; ++k) { const i32x4 v_ = *(const LAS i32x4*)(lds + PG8_SA(b, h) + aoff + m * 2048 + k * 1024); if (k == 0) dst[m].lo = v_; else dst[m].hi = v_; } } while (0)
#define PG8_LDB(dst, b, h) do { _Pragma("unroll") for (int n = 0; n < 2; ++n) _Pragma("unroll") for (int k = 0; k < 2; ++k) { const i32x4 v_ = *(const LAS i32x4*)(lds + PG8_SB(b, h) + boff + n * 2048 + k * 1024); if (k == 0) dst[n].lo = v_; else dst[n].hi = v_; } } while (0)
#define PG8_MMA(ai, bj, At, Bt) do { __builtin_amdgcn_s_setprio(1); _Pragma("unroll") for (int m = 0; m < 4; ++m) _Pragma("unroll") for (int n = 0; n < 2; ++n) _Pragma("unroll") for (int k = 0; k < 2; ++k) \
        acc[ai][bj][m][n] = __builtin_amdgcn_mfma_f32_16x16x32_bf16(__builtin_bit_cast(bf16x8, k ? (i32x4)Bt[n].hi : (i32x4)Bt[n].lo), __builtin_bit_cast(bf16x8, k ? (i32x4)At[m].hi : (i32x4)At[m].lo), acc[ai][bj][m][n], 0, 0, 0); __builtin_amdgcn_s_setprio(0); } while (0)
#define PG8_MMA8(ai, bj, At, Bt) do { __builtin_amdgcn_s_setprio(1); _Pragma("unroll") for (int m = 0; m < 4; ++m) _Pragma("unroll") for (int n = 0; n < 2; ++n) { \
        asm volatile("v_mfma_f32_16x16x128_f8f6f4 %0, %1, %2, %0" : "+v"(acc[ai][bj][m][n]) : "v"(Bt[n]), "v"(At[m])); } \
        __builtin_amdgcn_s_setprio(0); } while (0)
#define PG8_MM(ai, bj, At, Bt) do { if constexpr (Sched::FP8) PG8_MMA8(ai, bj, At, Bt); else PG8_MMA(ai, bj, At, Bt); } while (0)
#define PG8_WAIT_V(n) asm volatile("s_waitcnt vmcnt(" #n ")" ::: "memory")
#define PG8_WAIT_L(n) asm volatile("s_waitcnt lgkmcnt(" #n ")" ::: "memory")
#define PG8_BAR __builtin_amdgcn_s_barrier()
#define PG8_SCHED __builtin_amdgcn_sched_barrier(0)
    Unit cur, nxt; int ui = 0;
    if (!S.next(0, cur)) return;
    f32x4 acc[2][2][4][2];
#pragma unroll
    for (int a = 0; a < 2; ++a)
#pragma unroll
        for (int b = 0; b < 2; ++b)
#pragma unroll
            for (int m = 0; m < 4; ++m)
#pragma unroll
                for (int n = 0; n < 2; ++n) acc[a][b][m][n] = (f32x4){0.f, 0.f, 0.f, 0.f};
    i32x8 At[4], B0[2], B1[2];
    unsigned aoC[2][2], aoN[2][2], rawN[2][2];
    S.a_raw(cur, sR, rawN); S.a_fin(sC, rawN, aoC);
    const char* const Ab = S.a_base();
    const char* cB = S.b_ptr(cur);
    PG8_STAGE(PG8_SB(0, 0), cB, voffB); PG8_STAGE(PG8_SB(0, 1), cB + hstep, voffB); PG8_STAGE(PG8_SA(0, 0), Ab, aoC[0]); PG8_STAGE(PG8_SA(0, 1), Ab, aoC[1]);
    if (wr == 1) PG8_BAR;
    PG8_WAIT_V(2); PG8_BAR;
    PG8_STAGE(PG8_SB(1, 0), cB + kstep, voffB); PG8_STAGE(PG8_SA(1, 0), Ab + kstep, aoC[0]); PG8_STAGE(PG8_SB(1, 1), cB + hstep + kstep, voffB);
    PG8_WAIT_V(6); PG8_BAR;
    for (;;) {
        const bool has_next = S.next(ui + 1, nxt);
        const char* nB = cB;
        if (has_next) { S.a_raw(nxt, sR, rawN); nB = S.b_ptr(nxt); }
#pragma unroll
        for (int h = 0; h < 2; ++h)
#pragma unroll
            for (int i = 0; i < 2; ++i) aoN[h][i] = aoC[h][i];
        for (int t = 0; t < nt; t += 2) {
            const bool last = (t == nt - 2);
            const char* a1 = Ab + (size_t)(t + 1) * kstep;
            const char* a2 = last ? Ab : Ab + (size_t)(t + 2) * kstep; const char* b2 = last ? nB : cB + (size_t)(t + 2) * kstep;
            const char* a3 = a2 + kstep; const char* b3 = b2 + kstep;
            if (last && has_next) {
#pragma unroll
                for (int h = 0; h < 2; ++h)
#pragma unroll
                    for (int i = 0; i < 2; ++i) asm volatile("" : "+v"(rawN[h][i]));
                S.a_fin(sC, rawN, aoN); }
            unsigned o2[2][2];
#pragma unroll
            for (int h = 0; h < 2; ++h)
#pragma unroll
                for (int i = 0; i < 2; ++i) o2[h][i] = last ? aoN[h][i] : aoC[h][i];
            PG8_LDB(B0, 0, 0); PG8_LDB(B1, 0, 1); PG8_SCHED; PG8_LDA(At, 0, 0); PG8_STAGE(PG8_SA(1, 1), a1, aoC[1]);
            PG8_WAIT_V(8); PG8_WAIT_L(0); PG8_BAR; PG8_MM(0, 0, At, B0); PG8_MM(0, 1, At, B1); PG8_BAR; PG8_SCHED;
            PG8_LDA(At, 0, 1); PG8_STAGE(PG8_SB(0, 0), b2, voffB); PG8_STAGE(PG8_SB(0, 1), b2 + hstep, voffB); PG8_STAGE(PG8_SA(0, 0), a2, o2[0]);
            PG8_WAIT_V(8); PG8_WAIT_L(0); PG8_BAR; PG8_MM(1, 0, At, B0); PG8_MM(1, 1, At, B1); PG8_BAR; PG8_SCHED;
            PG8_LDB(B0, 1, 0); PG8_LDB(B1, 1, 1); PG8_SCHED; PG8_LDA(At, 1, 0); PG8_STAGE(PG8_SA(0, 1), a2, o2[1]);
            PG8_WAIT_V(8); PG8_WAIT_L(0); PG8_BAR; PG8_MM(0, 0, At, B0); PG8_MM(0, 1, At, B1); PG8_BAR; PG8_SCHED;
            PG8_LDA(At, 1, 1); PG8_STAGE(PG8_SB(1, 0), b3, voffB); PG8_STAGE(PG8_SB(1, 1), b3 + hstep, voffB); PG8_STAGE(PG8_SA(1, 0), a3, o2[0]);
            PG8_WAIT_V(8); PG8_WAIT_L(0); PG8_BAR; PG8_MM(1, 0, At, B0); PG8_MM(1, 1, At, B1); PG8_BAR; PG8_SCHED;
        }
        if constexpr (Sched::FP8) asm volatile("s_nop 15\n\ts_nop 7" ::: "memory");
        if (wr == 0) PG8_BAR;
        E(acc, cur, wr, wc, fr, fq);
        if (!has_next) break;
#pragma unroll
        for (int a = 0; a < 2; ++a)
#pragma unroll
            for (int b = 0; b < 2; ++b)
#pragma unroll
                for (int m = 0; m < 4; ++m)
#pragma unroll
                    for (int n = 0; n < 2; ++n) acc[a][b][m][n] = (f32x4){0.f, 0.f, 0.f, 0.f};
        cur = nxt; cB = nB; ++ui;
#pragma unroll
        for (int h = 0; h < 2; ++h)
#pragma unroll
            for (int i = 0; i < 2; ++i) aoC[h][i] = aoN[h][i];
        if (wr == 1) PG8_BAR;
    }
    PG8_WAIT_V(0);
    PG8_BAR;
#undef PG8_SA
#undef PG8_SB
#undef PG8_STAGE
#undef PG8_LDA
#undef PG8_LDB
#undef PG8_MMA
#undef PG8_MMA8
#undef PG8_MM
#undef PG8_WAIT_V
#undef PG8_WAIT_L
#undef PG8_BAR
#undef PG8_SCHED
}

struct EpiProj {
    static constexpr bool PERM = true, PRE = false;
    bf16_t* O; bf16_t* XA; const float* cw; const float* cb;
    static __device__ __forceinline__ float dpp_shr(float old, float v, int k) {
        const int o = __float_as_int(old), x = __float_as_int(v);
        return __int_as_float(k == 1 ? __builtin_amdgcn_update_dpp(o, x, 0x111, 0xF, 0xF, false) : (k == 2 ? __builtin_amdgcn_update_dpp(o, x, 0x112, 0xF, 0xF, false) : __builtin_amdgcn_update_dpp(o, x, 0x113, 0xF, 0xF, false))); }
    static __device__ __forceinline__ float dpp_ror(float v, int k) {
        const int x = __float_as_int(v);
        return __int_as_float(k == 1 ? __builtin_amdgcn_update_dpp(0, x, 0x121, 0xF, 0xF, false) : (k == 2 ? __builtin_amdgcn_update_dpp(0, x, 0x122, 0xF, 0xF, false) : __builtin_amdgcn_update_dpp(0, x, 0x123, 0xF, 0xF, false))); }
    __device__ __forceinline__ void operator()(const f32x4 (&acc)[2][2][4][2], const Unit& u, int wr, int wc, int fr, int fq) const {
        const int row0 = u.pm * BM + wr * 64 + fr, col0 = u.pn * BM + wc * 32 + 8 * fq;
        if (u.pn < 4) {
#pragma unroll
            for (int ai = 0; ai < 2; ++ai)
#pragma unroll
                for (int m = 0; m < 4; ++m) { const int row = row0 + ai * HALF + m * 16; bf16_t* rowp = O + (size_t)row * NPROJ + col0;
#pragma unroll
                    for (int bj = 0; bj < 2; ++bj) { const f32x4 v0 = acc[ai][bj][m][0], v1 = acc[ai][bj][m][1];
                        u32x4 w; w.x = cvt_pk_bf16(v0[0], v0[1]); w.y = cvt_pk_bf16(v0[2], v0[3]); w.z = cvt_pk_bf16(v1[0], v1[1]); w.w = cvt_pk_bf16(v1[2], v1[3]);
                        __builtin_nontemporal_store(w, (u32x4*)(rowp + bj * HALF)); } }
        } else {
            const int xc0 = col0 - COL_XS;
#pragma unroll
            for (int bj = 0; bj < 2; ++bj) {
#pragma unroll
                for (int ai = 0; ai < 2; ++ai) {
                    __builtin_amdgcn_sched_barrier(0);
                    unsigned pkc[4][2][2], pkr[2][2][2];
#pragma unroll
                    for (int n = 0; n < 2; ++n) {
                        f32x4 w[4]; const f32x4 bs = *(const f32x4*)(cb + xc0 + bj * HALF + 4 * n);
#pragma unroll
                        for (int j = 0; j < 4; ++j) w[j] = *(const f32x4*)(cw + j * 1792 + xc0 + bj * HALF + 4 * n);
                        f32x4 pr[3];
#pragma unroll
                        for (int k = 0; k < 3; ++k) pr[k] = (f32x4){0.f, 0.f, 0.f, 0.f};
#pragma unroll
                        for (int m = 0; m < 4; ++m) { float o[4]; const f32x4 x = acc[ai][bj][m][n];
#pragma unroll
                            for (int e = 0; e < 4; ++e) {
                                const float s1 = dpp_shr(pr[0][e], x[e], 1), s2 = dpp_shr(pr[1][e], x[e], 2), s3 = dpp_shr(pr[2][e], x[e], 3);
                                pr[0][e] = dpp_ror(x[e], 1); pr[1][e] = dpp_ror(x[e], 2); pr[2][e] = dpp_ror(x[e], 3);
                                const float v = bs[e] + w[0][e] * s3 + w[1][e] * s2 + w[2][e] * s1 + w[3][e] * x[e]; o[e] = siluf_(v); }
                            pkc[m][n][0] = cvt_pk_bf16(o[0], o[1]); pkc[m][n][1] = cvt_pk_bf16(o[2], o[3]);
                            if (m == 0 || m == 3) { pkr[m ? 1 : 0][n][0] = cvt_pk_bf16(x[0], x[1]); pkr[m ? 1 : 0][n][1] = cvt_pk_bf16(x[2], x[3]); } }
                    }
#pragma unroll
                    for (int m = 0; m < 4; ++m) { const int row = row0 + ai * HALF + m * 16;
                        u32x4 pc; pc.x = pkc[m][0][0]; pc.y = pkc[m][0][1]; pc.z = pkc[m][1][0]; pc.w = pkc[m][1][1];
                        bf16_t* xp = XA + (size_t)row * 1792 + xc0 + bj * HALF;
                        if (m == 0 || m == 3) {
                            u32x4 pw; pw.x = pkr[m ? 1 : 0][0][0]; pw.y = pkr[m ? 1 : 0][0][1]; pw.z = pkr[m ? 1 : 0][1][0]; pw.w = pkr[m ? 1 : 0][1][1];
                            bf16_t* rp = O + (size_t)row * NPROJ + col0 + bj * HALF;
                            if (m == 0) { if (fr >= 3) __builtin_nontemporal_store(pc, (u32x4*)xp); else *(u32x4*)rp = pw; }
                            else { __builtin_nontemporal_store(pc, (u32x4*)xp); if (fr >= 13) *(u32x4*)rp = pw; }
                        } else __builtin_nontemporal_store(pc, (u32x4*)xp);
                    }
                }
            }
        }
    }
};
struct EpiX1 {
    static constexpr bool PERM = true;
    const float* x; const float* mod; bf16_t* x1; float* ss16;
    __device__ __forceinline__ void operator()(const f32x4 (&acc)[2][2][4][2], const Unit& u, int wr, int wc, int fr, int fq) const {
        const int row0 = u.pm * BM + wr * 64 + fr, col0 = u.pn * BM + wc * 32 + 8 * fq; const int b = (u.pm * BM) >> 11;
        f32x4 gv[2][2];
#pragma unroll
        for (int bj = 0; bj < 2; ++bj)
#pragma unroll
            for (int n = 0; n < 2; ++n) gv[bj][n] = *(const f32x4*)(mod + (size_t)b * 6144 + 2 * 1024 + col0 + bj * HALF + n * 4);
#pragma unroll
        for (int ai = 0; ai < 2; ++ai) {
            f32x4 xa[4][2], xb[4][2];
#pragma unroll
            for (int m = 0; m < 4; ++m) { const size_t off = (size_t)(row0 + ai * HALF + m * 16) * DM + col0;
#pragma unroll
                for (int bj = 0; bj < 2; ++bj) { xa[m][bj] = *(const f32x4*)(x + off + bj * HALF); xb[m][bj] = *(const f32x4*)(x + off + bj * HALF + 4); } }
#pragma unroll
            for (int m = 0; m < 4; ++m) { const int row = row0 + ai * HALF + m * 16; const size_t off = (size_t)row * DM + col0; float ss = 0.f;
#pragma unroll
                for (int bj = 0; bj < 2; ++bj) {
                    const f32x4 o0 = xa[m][bj] + gv[bj][0] * acc[ai][bj][m][0], o1 = xb[m][bj] + gv[bj][1] * acc[ai][bj][m][1];
                    u32x4 w; w.x = cvt_pk_bf16(o0[0], o0[1]); w.y = cvt_pk_bf16(o0[2], o0[3]); w.z = cvt_pk_bf16(o1[0], o1[1]); w.w = cvt_pk_bf16(o1[2], o1[3]);
                    *(u32x4*)(x1 + off + bj * HALF) = w;
                    ss += ((o0[0] * o0[0] + o0[1] * o0[1]) + (o0[2] * o0[2] + o0[3] * o0[3])) + ((o1[0] * o1[0] + o1[1] * o1[1]) + (o1[2] * o1[2] + o1[3] * o1[3])); }
                ss += __shfl_xor(ss, 16); ss += __shfl_xor(ss, 32);
                if (fq == 0) ss16[(size_t)row * 16 + u.pn * 4 + wc] = ss; }
        }
    }
};
struct EpiAct {
    static constexpr bool PERM = true;
    unsigned char* act;
    __device__ __forceinline__ void operator()(const f32x4 (&acc)[2][2][4][2], const Unit& u, int wr, int wc, int fr, int fq) const {
        const int row0 = u.pm * BM + wr * 64 + fr, col0 = u.pn * HALF + wc * 32 + 8 * fq; const int odd = fq & 1;
#pragma unroll
        for (int ai = 0; ai < 2; ++ai)
#pragma unroll
            for (int mp = 0; mp < 2; ++mp) { u32x2 w[2];
#pragma unroll
                for (int mm = 0; mm < 2; ++mm) { const int m = 2 * mp + mm; float o[8];
#pragma unroll
                    for (int n = 0; n < 2; ++n)
#pragma unroll
                        for (int i = 0; i < 4; ++i) { const float a = acc[ai][0][m][n][i] * W_F8_INV, b = acc[ai][1][m][n][i] * W_F8_INV; o[n * 4 + i] = siluf_(a) * b; }
                    w[mm].x = cvt_pk4_fp8(o[0], o[1], o[2], o[3]); w[mm].y = cvt_pk4_fp8(o[4], o[5], o[6], o[7]); }
                const auto sx = __builtin_amdgcn_permlane16_swap(w[0].x, w[1].x, false, false), sy = __builtin_amdgcn_permlane16_swap(w[0].y, w[1].y, false, false);
                u32x4 v; v.x = sx[0]; v.y = sy[0]; v.z = sx[1]; v.w = sy[1];
                *(u32x4*)(act + (size_t)(row0 + ai * HALF + (2 * mp + odd) * 16) * FF + col0 - 8 * odd) = v; }
    }
};
struct EpiY {
    static constexpr bool PERM = true;
    const unsigned* list; const float* gates; unsigned char* Y0; unsigned char* Y1;
    __device__ __forceinline__ void operator()(const f32x4 (&acc)[2][2][4][2], const Unit& u, int wr, int wc, int fr, int fq) const {
        const int col0 = u.pn * BM + wc * 32 + 8 * fq; const size_t sb = (size_t)u.e * ECAP + u.slot0; const int odd = fq & 1;
        unsigned ent[2][4]; float gt[2][4];
#pragma unroll
        for (int ai = 0; ai < 2; ++ai)
#pragma unroll
            for (int m = 0; m < 4; ++m) { const int r = ai * HALF + wr * 64 + m * 16 + fr; const int rc = r < u.cnt ? r : 0; ent[ai][m] = list[sb + rc]; gt[ai][m] = gates[sb + rc]; }
#pragma unroll
        for (int ai = 0; ai < 2; ++ai)
#pragma unroll
            for (int m = 0; m < 4; ++m) { const int r = ai * HALF + wr * 64 + m * 16 + fr;
                const unsigned tok = ent[ai][m] >> 1; const float gate = gt[ai][m] * W_F8_INV; u32x2 w[2];
#pragma unroll
                for (int bj = 0; bj < 2; ++bj) { const f32x4 v0 = acc[ai][bj][m][0] * gate, v1 = acc[ai][bj][m][1] * gate;
                    w[bj].x = cvt_pk4_fp8(v0[0], v0[1], v0[2], v0[3]); w[bj].y = cvt_pk4_fp8(v1[0], v1[1], v1[2], v1[3]); }
                const auto sx = __builtin_amdgcn_permlane16_swap(w[0].x, w[1].x, false, false), sy = __builtin_amdgcn_permlane16_swap(w[0].y, w[1].y, false, false);
                u32x4 v; v.x = sx[0]; v.y = sy[0]; v.z = sx[1]; v.w = sy[1];
                if (r < u.cnt) *(u32x4*)(((ent[ai][m] & 1u) ? Y1 : Y0) + (size_t)tok * DM + col0 + (odd ? HALF - 8 : 0)) = v; }
    }
};
}

struct Frame {
    unsigned char* lds; int tid, lane, wave, vcu, G, gw, NGW;
};

struct TrItem { const float* src; bf16_t* dst; int ldw, nrel, K, f8; };
__device__ __forceinline__ void tr_load(const TrItem& t, int lane, f32x4 (&v)[8]) {
    const int c4 = (lane & 7) * 4;
#pragma unroll
    for (int i = 0; i < 8; ++i) { const int kk = (lane >> 3) + 8 * i; v[i] = (c4 < t.nrel) ? *(const f32x4*)(t.src + (size_t)kk * t.ldw + c4) : (f32x4){0.f, 0.f, 0.f, 0.f}; }
}
__device__ __forceinline__ void tr_to_lds(const f32x4 (&v)[8], float* scr, int lane) {
    const int c4 = (lane & 7) * 4;
#pragma unroll
    for (int i = 0; i < 8; ++i) { const int kk = (lane >> 3) + 8 * i; float* p = scr + kk * 33 + c4; p[0] = v[i][0]; p[1] = v[i][1]; p[2] = v[i][2]; p[3] = v[i][3]; }
    asm volatile("s_waitcnt lgkmcnt(0)" ::: "memory");
}
__device__ __forceinline__ void tr_store(const TrItem& t, const float* scr, int lane) {
    const int c = lane & 7;
#pragma unroll
    for (int j = 0; j < 4; ++j) { const int n = (lane >> 3) + 8 * j; const float* s = scr + (8 * c) * 33 + n;
        u32x4 o; o.x = cvt_pk_bf16(s[0 * 33], s[1 * 33]); o.y = cvt_pk_bf16(s[2 * 33], s[3 * 33]); o.z = cvt_pk_bf16(s[4 * 33], s[5 * 33]); o.w = cvt_pk_bf16(s[6 * 33], s[7 * 33]);
        if (t.f8) { u32x2 o8; o8.x = cvt_pk4_fp8(s[0 * 33] * pg8::W_F8_SCALE, s[1 * 33] * pg8::W_F8_SCALE, s[2 * 33] * pg8::W_F8_SCALE, s[3 * 33] * pg8::W_F8_SCALE);
            o8.y = cvt_pk4_fp8(s[4 * 33] * pg8::W_F8_SCALE, s[5 * 33] * pg8::W_F8_SCALE, s[6 * 33] * pg8::W_F8_SCALE, s[7 * 33] * pg8::W_F8_SCALE);
            *(u32x2*)((unsigned char*)t.dst + (size_t)n * t.K + 8 * c) = o8; }
        else *(u32x4*)(t.dst + (size_t)n * t.K + 8 * c) = o; }
    asm volatile("s_waitcnt lgkmcnt(0)" ::: "memory");
}
__device__ __forceinline__ void p0_prep(const Frame& F, const Params& P) {
    unsigned char* ws = P.ws;
    {
        float* sct = (float*)F.lds;
        const float* c = P.in[1];
        for (int idx = F.tid; idx < 32 * 1024; idx += NTHREADS) { const int b = idx >> 10, k = idx & 1023; sct[k * 32 + (((b & ~3) ^ ((k & 7) << 2)) | (b & 3))] = siluf_(c[idx]); }
        __syncthreads();
        const float* w_ada = P.in[2]; const float* b_ada = P.in[3]; float* mod = (float*)(ws + WS_MOD);
        for (int cg = F.vcu; cg < 256; cg += F.G) {
            const int j = F.tid % 24, kg = F.tid / 24;
            float acc[32];
#pragma unroll
            for (int b = 0; b < 32; ++b) acc[b] = 0.f;
            if (kg < 16) {
                for (int kb = 0; kb < 4; ++kb) { float wv[16];
#pragma unroll
                    for (int kk = 0; kk < 16; ++kk) wv[kk] = w_ada[(size_t)(kg * 64 + kb * 16 + kk) * 6144 + cg * 24 + j];
#pragma unroll
                    for (int kk = 0; kk < 16; ++kk) { const int k = kg * 64 + kb * 16 + kk; const float w = wv[kk];
#pragma unroll
                        for (int q = 0; q < 8; ++q) { const f32x4 s = *(const f32x4*)(sct + k * 32 + ((4 * q) ^ ((k & 7) << 2))); acc[4 * q] += s[0] * w; acc[4 * q + 1] += s[1] * w; acc[4 * q + 2] += s[2] * w; acc[4 * q + 3] += s[3] * w; } } }
            }
            float* px = (float*)(F.lds + 131072);
            float tot[2] = {0.f, 0.f};
#pragma unroll 1
            for (int half = 0; half < 2; ++half) {
                if (kg < 16 && (kg >> 3) == half) {
#pragma unroll
                    for (int b = 0; b < 32; ++b) px[b * 192 + (kg & 7) * 24 + j] = acc[b];
                }
                __syncthreads();
#pragma unroll
                for (int r = 0; r < 2; ++r) { const int o = F.tid + r * 512; if (o < 768) { float s = 0.f;
#pragma unroll
                        for (int q = 0; q < 8; ++q) s += px[(o / 24) * 192 + q * 24 + (o % 24)]; tot[r] += s; } }
                __syncthreads();
            }
#pragma unroll
            for (int r = 0; r < 2; ++r) { const int o = F.tid + r * 512; if (o < 768) { const int jj = o % 24, b = o / 24; mod[(size_t)b * 6144 + cg * 24 + jj] = tot[r] + b_ada[cg * 24 + jj]; } }
        }
        __syncthreads();
    }
    {
        float* scr = (float*)(F.lds + F.wave * 16384);
        const float* w_in = P.in[4]; const float* w_out = P.in[13]; const float* w13 = P.in[18]; const float* w2 = P.in[19];
        bf16_t* WIN = (bf16_t*)(ws + WS_WIN); bf16_t* WOUT = (bf16_t*)(ws + WS_WOUT); bf16_t* W13 = (bf16_t*)(ws + WS_W13); bf16_t* W2 = (bf16_t*)(ws + WS_W2);
        constexpr int I0 = 16 * 80, I1 = 16 * 32, I2 = 32 * 16 * 32, I3 = 32 * 8 * 32, NIT = I0 + I1 + I2 + I3;
        auto decode = [&](int it) -> TrItem {
            TrItem t; int r = it;
            if (r < I0) { const int kb = r / 80, nb = 8 + r % 80, n0 = nb * 32; t.src = w_in + (size_t)kb * 64 * NPROJ_REAL + n0; t.ldw = NPROJ_REAL; t.nrel = NPROJ_REAL - n0; t.dst = WIN + (size_t)n0 * 1024 + kb * 64; t.K = 1024; t.f8 = 0; return t; } r -= I0;
            if (r < I1) { const int kb = r / 32, nb = r % 32, n0 = nb * 32; t.src = w_out + (size_t)kb * 64 * 1024 + n0; t.ldw = 1024; t.nrel = 32; t.dst = WOUT + (size_t)n0 * 1024 + kb * 64; t.K = 1024; t.f8 = 0; return t; } r -= I1;
            if (r < I2) { const int e = r / 512, q = r % 512, kb = q / 32, nb = q % 32; const int n0 = nb * 32, bj = n0 >> 9, rem = n0 & 511, pn = rem >> 7, j0 = rem & 127;
                t.src = w13 + (size_t)e * 1024 * 1024 + (size_t)kb * 64 * 1024 + n0; t.ldw = 1024; t.nrel = 32; t.dst = (bf16_t*)((unsigned char*)W13 + (size_t)e * 1024 * 1024 + (size_t)(pn * 256 + bj * 128 + j0) * 1024 + kb * 64); t.K = 1024; t.f8 = 1; return t; } r -= I2;
            { const int e = r / 256, q = r % 256, kb = q / 32, nb = q % 32, n0 = nb * 32;
                t.src = w2 + (size_t)e * 512 * 1024 + (size_t)kb * 64 * 1024 + n0; t.ldw = 1024; t.nrel = 32; t.dst = (bf16_t*)((unsigned char*)W2 + (size_t)e * 1024 * 512 + (size_t)n0 * 512 + kb * 64); t.K = 512; t.f8 = 1; return t; }
        };
        int it = F.gw; f32x4 v[8]; TrItem cur;
        if (it < NIT) { cur = decode(it); tr_load(cur, F.lane, v); }
        while (it < NIT) {
            tr_to_lds(v, scr, F.lane);
            const int nx = it + F.NGW; TrItem nxt = cur;
            if (nx < NIT) { nxt = decode(nx); tr_load(nxt, F.lane, v); }
            tr_store(cur, scr, F.lane);
            cur = nxt; it = nx;
        }
    }
    {
        const float* w_in = P.in[4]; const float* w_pool = P.in[5]; const float* pscale = P.in[6]; bf16_t* WIN = (bf16_t*)(ws + WS_WIN);
        for (int idx = F.vcu * NTHREADS + F.tid; idx < 256 * 1024; idx += F.G * NTHREADS) {
            const int n = idx >> 10, k = idx & 1023, g = n >> 6, d = n & 63; const float* wi = w_in + (size_t)k * NPROJ_REAL + g * 64; const float* wp = w_pool + (size_t)g * 4096 + d;
            float s = 0.f;
#pragma unroll 8
            for (int cc = 0; cc < 64; ++cc) s += wi[cc] * wp[cc * 64];
            s *= pscale[n];
            WIN[(size_t)n * 1024 + k] = (bf16_t)(cvt_pk_bf16(s, 0.f) & 0xffffu);
        }
    }
    {
        const float* wg = P.in[14]; const float* wrt = P.in[16]; bf16_t* WRH = (bf16_t*)(ws + WS_WR); bf16_t* WRL = (bf16_t*)(ws + WS_WR + 131072);
        { const float* w_in = P.in[4]; float* WDT = (float*)(ws + WS_WDT); for (int idx = F.vcu * NTHREADS + F.tid; idx < 12 * 1024; idx += F.G * NTHREADS) { const int j = idx >> 10, k = idx & 1023; WDT[idx] = w_in[(size_t)k * NPROJ_REAL + COL_DT + j]; } }
        for (int idx = F.vcu * NTHREADS + F.tid; idx < 36 * 1024; idx += F.G * NTHREADS) { const int j = idx >> 10, k = idx & 1023; const float w = (j < 4) ? wg[k * 4 + j] : wrt[k * 32 + (j - 4)];
            const unsigned hi = cvt_pk_bf16(w, 0.f) & 0xffffu; const float lo = w - __uint_as_float(hi << 16); WRH[idx] = (bf16_t)hi; WRL[idx] = (bf16_t)(cvt_pk_bf16(lo, 0.f) & 0xffffu); }
    }
}

__device__ __forceinline__ void p1_modulate(const Frame& F, const Params& P) {
    const float* x = P.in[0]; const float* mod = (const float*)(P.ws + WS_MOD); bf16_t* H = (bf16_t*)(P.ws + WS_H); float* dtraw = (float*)(P.ws + WS_DTRAW);
    float* wdt = (float*)F.lds;
    for (int idx = F.tid; idx < 12 * 256; idx += NTHREADS) ((f32x4*)wdt)[idx] = ((const f32x4*)(P.ws + WS_WDT))[idx];
    __syncthreads();
    const int lane = F.lane;
    f32x4 v[2][4], vn[2][4];
    { const int row0 = F.gw * 2; if (row0 < T) {
#pragma unroll
        for (int r = 0; r < 2; ++r) { const f32x4* xr = (const f32x4*)(x + (size_t)(row0 + r) * DM) + lane;
#pragma unroll
            for (int j = 0; j < 4; ++j) v[r][j] = __builtin_nontemporal_load(xr + 64 * j); } } }
    for (int row0 = F.gw * 2; row0 < T; row0 += F.NGW * 2) {
        const int b = row0 >> 11; float s[2] = {0.f, 0.f};
        { const int rn = row0 + F.NGW * 2; if (rn < T) {
#pragma unroll
            for (int r = 0; r < 2; ++r) { const f32x4* xr = (const f32x4*)(x + (size_t)(rn + r) * DM) + lane;
#pragma unroll
                for (int j = 0; j < 4; ++j) vn[r][j] = __builtin_nontemporal_load(xr + 64 * j); } } }
        const f32x4* sh = (const f32x4*)(mod + (size_t)b * 6144) + lane; const f32x4* sc = (const f32x4*)(mod + (size_t)b * 6144 + 1024) + lane;
        f32x4 a[4], m[4];
#pragma unroll
        for (int j = 0; j < 4; ++j) { a[j] = sh[64 * j]; m[j] = sc[64 * j] + 1.0f; }
#pragma unroll
        for (int r = 0; r < 2; ++r) {
#pragma unroll
            for (int j = 0; j < 4; ++j) s[r] += (v[r][j][0] * v[r][j][0] + v[r][j][1] * v[r][j][1]) + (v[r][j][2] * v[r][j][2] + v[r][j][3] * v[r][j][3]);
            const float rstd = rsqrtf(wave_sum(s[r]) * (1.f / DM) + EPS);
            u32x2* o = (u32x2*)(H + (size_t)(row0 + r) * DM) + lane;
#pragma unroll
            for (int j = 0; j < 4; ++j) { v[r][j] = v[r][j] * rstd * m[j] + a[j]; u32x2 w; w.x = cvt_pk_bf16(v[r][j][0], v[r][j][1]); w.y = cvt_pk_bf16(v[r][j][2], v[r][j][3]); o[64 * j] = w; } }
        float pv[32];
#pragma unroll
        for (int c = 0; c < 16; ++c) { float p0 = 0.f, p1 = 0.f;
            if (c < 12) {
#pragma unroll
                for (int j = 0; j < 4; ++j) { const f32x4 w4 = *(const f32x4*)(wdt + c * 1024 + 256 * j + 4 * lane);
                    p0 += (w4[0] * v[0][j][0] + w4[1] * v[0][j][1]) + (w4[2] * v[0][j][2] + w4[3] * v[0][j][3]); p1 += (w4[0] * v[1][j][0] + w4[1] * v[1][j][1]) + (w4[2] * v[1][j][2] + w4[3] * v[1][j][3]); } }
            pv[c] = p0; pv[16 + c] = p1; }
#pragma unroll
        for (int k = 0; k < 16; ++k) { const bool hi = (lane & 16) != 0; const float mine = hi ? pv[k + 16] : pv[k], send = hi ? pv[k] : pv[k + 16]; pv[k] = mine + __shfl_xor(send, 16); }
#pragma unroll
        for (int k = 0; k < 8; ++k) { const bool hi = (lane & 8) != 0; const float mine = hi ? pv[k + 8] : pv[k], send = hi ? pv[k] : pv[k + 8]; pv[k] = mine + __shfl_xor(send, 8); }
#pragma unroll
        for (int k = 0; k < 4; ++k) { const bool hi = (lane & 4) != 0; const float mine = hi ? pv[k + 4] : pv[k], send = hi ? pv[k] : pv[k + 4]; pv[k] = mine + __shfl_xor(send, 4); }
#pragma unroll
        for (int k = 0; k < 2; ++k) { const bool hi = (lane & 2) != 0; const float mine = hi ? pv[k + 2] : pv[k], send = hi ? pv[k] : pv[k + 2]; pv[k] = mine + __shfl_xor(send, 2); }
        { const bool hi = (lane & 1) != 0; const float mine = hi ? pv[1] : pv[0], send = hi ? pv[0] : pv[1]; pv[0] = mine + __shfl_xor(send, 1); }
        const float tot = pv[0] + __shfl_xor(pv[0], 32);
        if (lane < 32 && (lane & 15) < 12) dtraw[(size_t)(row0 + (lane >> 4)) * 16 + (lane & 15)] = tot;
#pragma unroll
        for (int r = 0; r < 2; ++r)
#pragma unroll
            for (int j = 0; j < 4; ++j) v[r][j] = vn[r][j];
    }
}

template <int W>
__device__ __forceinline__ void pool_item(const bf16_t* src, bf16_t* dst, int t0) {
    u32x4 hist[W - 1], cur[16];
#pragma unroll
    for (int i = 0; i < 16; ++i) cur[i] = *(const u32x4*)(src + (size_t)i * NPROJ);
    if (t0 > 0) {
#pragma unroll
        for (int h = 0; h < W - 1; ++h) hist[h] = *(const u32x4*)(src - (size_t)(W - 1 - h) * NPROJ); }
    else {
#pragma unroll
        for (int h = 0; h < W - 1; ++h) hist[h] = (u32x4){0u, 0u, 0u, 0u}; }
#define UNP8P(dst, v) do { dst[0] = bf_lo(v.x); dst[1] = bf_hi(v.x); dst[2] = bf_lo(v.y); dst[3] = bf_hi(v.y); dst[4] = bf_lo(v.z); dst[5] = bf_hi(v.z); dst[6] = bf_lo(v.w); dst[7] = bf_hi(v.w); } while (0)
    float sum[8];
#pragma unroll
    for (int k = 0; k < 8; ++k) sum[k] = 0.f;
#pragma unroll
    for (int h = 0; h < W - 1; ++h) { float e[8]; UNP8P(e, hist[h]);
#pragma unroll
        for (int k = 0; k < 8; ++k) sum[k] += e[k]; }
#pragma unroll
    for (int i = 0; i < 16; ++i) {
        float c[8]; UNP8P(c, cur[i]);
#pragma unroll
        for (int k = 0; k < 8; ++k) sum[k] += c[k];
        if (i >= 1) { float o[8]; if (i <= W - 1) UNP8P(o, hist[i - 1 < W - 1 ? i - 1 : 0]); else UNP8P(o, cur[i - W >= 0 ? i - W : 0]);
#pragma unroll
            for (int k = 0; k < 8; ++k) sum[k] -= o[k]; }
        const int cnt = (t0 > 0) ? W : ((i + 1) < W ? (i + 1) : W); const float inv = 1.0f / (float)cnt;
        u32x4 pk; pk.x = cvt_pk_bf16(sum[0] * inv - c[0], sum[1] * inv - c[1]); pk.y = cvt_pk_bf16(sum[2] * inv - c[2], sum[3] * inv - c[3]);
        pk.z = cvt_pk_bf16(sum[4] * inv - c[4], sum[5] * inv - c[5]); pk.w = cvt_pk_bf16(sum[6] * inv - c[6], sum[7] * inv - c[7]);
        *(u32x4*)(dst + (size_t)i * DM) = pk;
    }
#undef UNP8P
}

__device__ __forceinline__ void p3_conv(const Frame& F, const Params& P) {
    const bf16_t* proj = (const bf16_t*)(P.ws + WS_PROJ); bf16_t* XA = (bf16_t*)(P.ws + WS_XA);
    const float* conv_w = P.in[7]; const float* conv_b = P.in[8];
    if (F.wave < 2) {
        const float* dtraw = (const float*)(P.ws + WS_DTRAW); float* SA = (float*)(P.ws + WS_SA);
        const float* dt_bias = P.in[9]; const float* a_log = P.in[10];
        for (int bc = F.vcu * 2 + F.wave; bc < BATCH * 16; bc += F.G * 2) {
            const int h = F.lane < 48 ? (F.lane >> 2) : 11, seg = F.lane & 3; const float a = -__expf(a_log[h]), dtb = dt_bias[h];
            const float* src = dtraw + ((size_t)bc * 128 + 32 * seg) * 16 + h;
            float raw[32], dt[32], cs[32];
#pragma unroll
            for (int j = 0; j < 32; ++j) raw[j] = src[j * 16];
            float run = 0.f;
#pragma unroll
            for (int j = 0; j < 32; ++j) { const float v = raw[j] + dtb; dt[j] = v > 20.f ? v : log1pf(__expf(v)); run += dt[j] * a; cs[j] = run; }
            const float s0 = __shfl(run, (F.lane & ~3) + 0), s1 = __shfl(run, (F.lane & ~3) + 1), s2 = __shfl(run, (F.lane & ~3) + 2), s3 = __shfl(run, (F.lane & ~3) + 3);
            const float base = (seg > 0 ? s0 : 0.f) + (seg > 1 ? s1 : 0.f) + (seg > 2 ? s2 : 0.f); const float a127 = ((s0 + s1) + s2) + s3;
            if (F.lane < 48) {
                float* dst = SA + ((size_t)bc * 4 + h / 3) * 1536 + (h % 3) * 128 + 32 * seg;
#pragma unroll
                for (int j4 = 0; j4 < 8; ++j4) { f32x4 vd, va, vw, ve;
#pragma unroll
                    for (int e = 0; e < 4; ++e) { const int j = 4 * j4 + e; const float ac = base + cs[j], ae = base + cs[j | 15]; vd[e] = dt[j]; va[e] = ac; vw[e] = dt[j] * __expf(a127 - ac); ve[e] = dt[j] * __expf(ae - ac); }
                    *(f32x4*)(dst + 4 * j4) = vd; *(f32x4*)(dst + 384 + 4 * j4) = va; *(f32x4*)(dst + 768 + 4 * j4) = vw; *(f32x4*)(dst + 1152 + 4 * j4) = ve; }
            }
        }
    }
    {
        constexpr int NITEM = (T / 64) * 224;
        for (int item = F.vcu * NTHREADS + F.tid; item < NITEM; item += F.G * NTHREADS) {
            const int cg = item % 224, jb = item / 224, ch = cg * 8, row0 = jb * 64, t0 = row0 & (SEQ - 1);
            const bf16_t* src = proj + (size_t)row0 * NPROJ + COL_XS + ch;
            u32x4 raw[6];
#pragma unroll
            for (int i = 0; i < 3; ++i) raw[3 + i] = *(const u32x4*)(src + (size_t)i * NPROJ);
            if (t0 >= 3) {
#pragma unroll
                for (int i = 0; i < 3; ++i) raw[i] = *(const u32x4*)(src - (size_t)(3 - i) * NPROJ); }
            else { raw[0] = (u32x4){0u, 0u, 0u, 0u}; raw[1] = raw[0]; raw[2] = raw[0]; }
            float w[4][8], bs[8];
#pragma unroll
            for (int j = 0; j < 4; ++j) { const f32x4 a = *(const f32x4*)(conv_w + j * 1792 + ch), c = *(const f32x4*)(conv_w + j * 1792 + ch + 4);
#pragma unroll
                for (int k = 0; k < 4; ++k) { w[j][k] = a[k]; w[j][4 + k] = c[k]; } }
            { const f32x4 a = *(const f32x4*)(conv_b + ch), c = *(const f32x4*)(conv_b + ch + 4);
#pragma unroll
                for (int k = 0; k < 4; ++k) { bs[k] = a[k]; bs[4 + k] = c[k]; } }
#define UNP8(dst, v) do { dst[0] = bf_lo(v.x); dst[1] = bf_hi(v.x); dst[2] = bf_lo(v.y); dst[3] = bf_hi(v.y); dst[4] = bf_lo(v.z); dst[5] = bf_hi(v.z); dst[6] = bf_lo(v.w); dst[7] = bf_hi(v.w); } while (0)
            float r0[8], r1[8], r2[8];
            UNP8(r0, raw[0]); UNP8(r1, raw[1]); UNP8(r2, raw[2]);
#pragma unroll
            for (int i = 0; i < 3; ++i) {
                float cur[8]; UNP8(cur, raw[3 + i]); float o[8];
#pragma unroll
                for (int k = 0; k < 8; ++k) { const float v = bs[k] + w[0][k] * r0[k] + w[1][k] * r1[k] + w[2][k] * r2[k] + w[3][k] * cur[k]; o[k] = siluf_(v); r0[k] = r1[k]; r1[k] = r2[k]; r2[k] = cur[k]; }
                u32x4 pk; pk.x = cvt_pk_bf16(o[0], o[1]); pk.y = cvt_pk_bf16(o[2], o[3]); pk.z = cvt_pk_bf16(o[4], o[5]); pk.w = cvt_pk_bf16(o[6], o[7]);
                *(u32x4*)(XA + (size_t)(row0 + i) * 1792 + ch) = pk;
            }
        }
    }
    { bf16_t* mix = (bf16_t*)(P.ws + WS_MIX);
      for (int p = F.vcu * NTHREADS + F.tid; p < (T / 16) * 32; p += F.G * NTHREADS) {
        const int c8 = p & 7, rr8 = (p >> 3) & 7, grp = (p >> 6) & 3, rrblk = p >> 8; const int rr = rrblk * 8 + rr8, row0 = rr * 16, t0 = row0 & (SEQ - 1), col = grp * 64 + c8 * 8;
        const bf16_t* src = proj + (size_t)row0 * NPROJ + col; bf16_t* dst = mix + (size_t)row0 * DM + col;
        if (grp == 0) pool_item<2>(src, dst, t0); else if (grp == 1) pool_item<4>(src, dst, t0); else if (grp == 2) pool_item<8>(src, dst, t0); else pool_item<16>(src, dst, t0);
      } }
#undef UNP8
}

constexpr int L_B = 0, L_C = 32768, L_X = 49152, L_S = 98304, L_DT = 147456, L_ACS = L_DT + 1536, L_W = L_ACS + 1536, L_ES = L_W + 1536, L_NW = L_ES + 1536, L_T = L_NW + 768;
static_assert(L_T <= LDS_BYTES - 64, "SSD LDS map");
typedef short v4i16 __attribute__((ext_vector_type(4)));
__device__ __forceinline__ int swz16(int r) { const int h = (r >> 3) & 1; return ((((r & 7) + 4 * h) & 7) << 1) | h; }
__device__ __forceinline__ int swz8(int row) { return ((row >> 1) & 3) << 1; }
__device__ __forceinline__ bf16x8 tr_pair(LAS unsigned char* a0, LAS unsigned char* a1) {
    const v4i16 lo = __builtin_amdgcn_ds_read_tr16_b64_v4i16((LAS v4i16*)a0), hi = __builtin_amdgcn_ds_read_tr16_b64_v4i16((LAS v4i16*)a1);
    return (bf16x8){lo[0], lo[1], lo[2], lo[3], hi[0], hi[1], hi[2], hi[3]};
}
__device__ __forceinline__ bf16x8 pack8(const float (&v)[8]) {
    u32x4 p; p.x = cvt_pk_bf16(v[0], v[1]); p.y = cvt_pk_bf16(v[2], v[3]); p.z = cvt_pk_bf16(v[4], v[5]); p.w = cvt_pk_bf16(v[6], v[7]);
    return __builtin_bit_cast(bf16x8, p);
}
#define MFMA16(a, b, c) __builtin_amdgcn_mfma_f32_16x16x32_bf16((a), (b), (c), 0, 0, 0)
#define OPAQUE(x) asm volatile("" : "+v"(x))
#define SBAR() do { asm volatile("s_waitcnt lgkmcnt(0)" ::: "memory"); __builtin_amdgcn_s_barrier(); asm volatile("" ::: "memory"); } while (0)

__device__ __forceinline__ int ssd_glmap(int hl, int lt) { return hl ? (lt == 0 ? 2 : (lt == 1 ? 3 : (lt == 2 ? 5 : 4))) : (lt == 0 ? 0 : (lt == 1 ? 1 : (lt == 2 ? 7 : 6))); }
#define SSD_LANE() int ln_ = lane; OPAQUE(ln_); const int i = ln_ & 15, q = ln_ >> 4, qp = i >> 2, pp = ln_ & 3; (void)qp; (void)pp
#define SSD_PR() int pr[4]; { const int fsw = swz16(i); _Pragma("unroll") for (int ks = 0; ks < 4; ++ks) { pr[ks] = i * 256 + (((4 * ks + q) ^ fsw) << 4); OPAQUE(pr[ks]); } }
template <int CH>
__device__ __forceinline__ void ssd_compute(LAS unsigned char* L, int lt, int hl, int lane, f32x4 (&sacc)[2][6], f32x4 (&yacc)[6], float dsk0, float dsk1, bool xwait) {
    const int gl = ssd_glmap(hl, lt);
    const int lrow0 = 16 * gl;
    f32x4 cbt[8];
    {
        SSD_LANE(); SSD_PR();
        int cbase = lt * 4096; OPAQUE(cbase);
        bf16x8 cfrag[4];
#pragma unroll
        for (int ks = 0; ks < 4; ++ks) cfrag[ks] = *(const LAS bf16x8*)(L + L_C + cbase + pr[ks]);
#pragma unroll
        for (int tp = 0; tp < 4; ++tp) {
            f32x4 a0 = (f32x4){0.f, 0.f, 0.f, 0.f}, a1 = a0;
            if (2 * tp <= gl) {
                bf16x8 f0[4], f1[4];
#pragma unroll
                for (int ks = 0; ks < 4; ++ks) { f0[ks] = *(const LAS bf16x8*)(L + L_B + (2 * tp) * 4096 + pr[ks]); f1[ks] = *(const LAS bf16x8*)(L + L_B + (2 * tp + 1) * 4096 + pr[ks]); }
#pragma unroll
                for (int ks = 0; ks < 4; ++ks) { a0 = MFMA16(f0[ks], cfrag[ks], a0); a1 = MFMA16(f1[ks], cfrag[ks], a1); }
            }
            cbt[2 * tp] = a0; cbt[2 * tp + 1] = a1;
            __builtin_amdgcn_sched_barrier(0);
        }
    }
    bf16x8 mfrag[2][4];
    {
        SSD_LANE();
        int q16 = 16 * q; OPAQUE(q16);
        int lq = (lrow0 + 4 * q) * 4; OPAQUE(lq);
        int li = (lrow0 + i) * 4; OPAQUE(li);
        int dq = i - 4 * q; OPAQUE(dq);
        float acl[2];
#pragma unroll
        for (int hsel = 0; hsel < 2; ++hsel) acl[hsel] = *(const LAS float*)(L + L_ACS + (CH + hsel) * 512 + li);
#pragma unroll
        for (int kk = 0; kk < 4; ++kk) {
            f32x4 es[2][2]; float ae[2][2];
#pragma unroll
            for (int hsel = 0; hsel < 2; ++hsel)
#pragma unroll
                for (int hf = 0; hf < 2; ++hf) { const int ts = 2 * kk + hf, r = CH + hsel; es[hsel][hf] = *(const LAS f32x4*)(L + L_ES + r * 512 + ts * 64 + q16); ae[hsel][hf] = *(const LAS float*)(L + L_ACS + r * 512 + (16 * ts + 15) * 4); }
#pragma unroll
            for (int hsel = 0; hsel < 2; ++hsel) { const int r = CH + hsel; const float dsk = hsel ? dsk1 : dsk0; float v[8];
#pragma unroll
                for (int hf = 0; hf < 2; ++hf) { const int ts = 2 * kk + hf;
                    if (ts < gl) { const float el = __expf(acl[hsel] - ae[hsel][hf]);
#pragma unroll
                        for (int j = 0; j < 4; ++j) v[4 * hf + j] = cbt[ts][j] * el * es[hsel][hf][j]; }
                    else if (ts == gl) { const f32x4 asd = *(const LAS f32x4*)(L + L_ACS + r * 512 + lq), dsd = *(const LAS f32x4*)(L + L_DT + r * 512 + lq);
#pragma unroll
                        for (int j = 0; j < 4; ++j) { const float arg = fminf(acl[hsel] - asd[j], 0.f); const float cd = cbt[ts][j] * dsd[j]; const float m = cd * __expf(arg);
                            v[4 * hf + j] = (j < dq) ? m : ((j == dq) ? (cd + dsk) : 0.f); } }
                    else {
#pragma unroll
                        for (int j = 0; j < 4; ++j) v[4 * hf + j] = 0.f; } }
                mfrag[hsel][kk] = pack8(v); }
            if (kk == 1) __builtin_amdgcn_sched_barrier(0);
        }
    }
    {
        SSD_LANE(); SSD_PR();
        int cbase = lt * 4096; OPAQUE(cbase);
        int lq = (lrow0 + 4 * q) * 4; OPAQUE(lq);
        bf16x8 cfrag[4];
#pragma unroll
        for (int ks = 0; ks < 4; ++ks) cfrag[ks] = *(const LAS bf16x8*)(L + L_C + cbase + pr[ks]);
#pragma unroll
        for (int cp = 0; cp < 3; ++cp) { bf16x8 f0[4], f1[4];
#pragma unroll
            for (int ks = 0; ks < 4; ++ks) { f0[ks] = *(const LAS bf16x8*)(L + L_S + (96 * CH + 32 * cp) * 256 + pr[ks]); f1[ks] = *(const LAS bf16x8*)(L + L_S + (96 * CH + 32 * cp + 16) * 256 + pr[ks]); }
            f32x4 a0 = (f32x4){0.f, 0.f, 0.f, 0.f}, a1 = a0;
#pragma unroll
            for (int ks = 0; ks < 4; ++ks) { a0 = MFMA16(cfrag[ks], f0[ks], a0); a1 = MFMA16(cfrag[ks], f1[ks], a1); }
            yacc[2 * cp] = a0; yacc[2 * cp + 1] = a1; }
#pragma unroll
        for (int hsel = 0; hsel < 2; ++hsel) { const f32x4 ac4 = *(const LAS f32x4*)(L + L_ACS + (CH + hsel) * 512 + lq); const f32x4 e = (f32x4){__expf(ac4[0]), __expf(ac4[1]), __expf(ac4[2]), __expf(ac4[3])};
#pragma unroll
            for (int ct = 0; ct < 6; ++ct) if ((((6 * CH + ct) >> 2) - CH) == hsel) yacc[ct] = yacc[ct] * e; }
    }
#pragma unroll
    for (int hsel = 0; hsel < 2; ++hsel) { const float cd = __expf(*(const LAS float*)(L + L_ACS + (CH + hsel) * 512 + 127 * 4));
#pragma unroll
        for (int ct = 0; ct < 6; ++ct) if ((((6 * CH + ct) >> 2) - CH) == hsel) { sacc[0][ct] = sacc[0][ct] * cd; sacc[1][ct] = sacc[1][ct] * cd; } }
    __builtin_amdgcn_sched_barrier(0);
    SSD_LANE();
    int q16 = 16 * q; OPAQUE(q16);
    const int r4 = 4 * q + qp;
    int tb[2], tx[4];
    { const int fr = swz16(r4), xr = swz8(r4);
#pragma unroll
      for (int nt2 = 0; nt2 < 2; ++nt2) { tb[nt2] = r4 * 256 + 8 * (pp & 1) + (((2 * (2 * lt + nt2) + (pp >> 1)) ^ fr) << 4); OPAQUE(tb[nt2]); }
#pragma unroll
      for (int pt = 0; pt < 4; ++pt) { tx[pt] = r4 * 128 + 8 * (pp & 1) + (((2 * pt + (pp >> 1)) ^ xr) << 4); OPAQUE(tx[pt]); } }
    if (xwait) { asm volatile("s_waitcnt vmcnt(6)" ::: "memory"); SBAR(); }
#pragma unroll
    for (int kk = 0; kk < 4; ++kk) {
        bf16x8 bts[2][2];
        { bf16x8 btf[2];
#pragma unroll
          for (int nt2 = 0; nt2 < 2; ++nt2) btf[nt2] = tr_pair(L + L_B + kk * 8192 + tb[nt2], L + L_B + kk * 8192 + 4096 + tb[nt2]);
#pragma unroll
          for (int hsel = 0; hsel < 2; ++hsel) { const f32x4 wl = *(const LAS f32x4*)(L + L_W + (CH + hsel) * 512 + kk * 128 + q16), wh = *(const LAS f32x4*)(L + L_W + (CH + hsel) * 512 + kk * 128 + 64 + q16);
#pragma unroll
            for (int nt2 = 0; nt2 < 2; ++nt2) { float bs[8];
#pragma unroll
                for (int e = 0; e < 4; ++e) { bs[e] = __uint_as_float((unsigned)(unsigned short)btf[nt2][e] << 16) * wl[e]; bs[4 + e] = __uint_as_float((unsigned)(unsigned short)btf[nt2][4 + e] << 16) * wh[e]; }
                bts[hsel][nt2] = pack8(bs); } } }
        __builtin_amdgcn_sched_barrier(0);
        bf16x8 xf[6];
#pragma unroll
        for (int ct = 0; ct < 6; ++ct) { const int ctg = 6 * CH + ct, r = ctg >> 2, pt = ctg & 3; xf[ct] = tr_pair(L + L_X + r * 16384 + kk * 4096 + tx[pt], L + L_X + r * 16384 + kk * 4096 + 2048 + tx[pt]); }
        const bool ydo = (2 * kk <= gl);
#pragma unroll
        for (int ct = 0; ct < 6; ++ct) { const int ctg = 6 * CH + ct, r = ctg >> 2, hsel = r - CH;
            if (ydo) yacc[ct] = MFMA16(mfrag[hsel][kk], xf[ct], yacc[ct]);
            sacc[0][ct] = MFMA16(bts[hsel][0], xf[ct], sacc[0][ct]); sacc[1][ct] = MFMA16(bts[hsel][1], xf[ct], sacc[1][ct]); }
        __builtin_amdgcn_sched_barrier(0);
    }
}

__device__ __forceinline__ void ssd_dma_bc(LAS unsigned char* L, const bf16_t* xrow, int g, int hl, int wave, int lane) {
    OPAQUE(lane);
#pragma unroll
    for (int k = 0; k < 4; ++k) { const int m = wave * 4 + k, row = 4 * m + (lane >> 4), lc = (lane & 15) ^ swz16(row & 15);
        __builtin_amdgcn_global_load_lds((const unsigned*)(xrow + 768 + g * 128 + (unsigned)(row * 1792 + lc * 8)), (LAS unsigned*)(L + L_B + m * 1024), 16, 0, 0); }
    const bf16_t* crow = xrow + 1280 + g * 128;
#pragma unroll
    for (int k = 0; k < 2; ++k) { const int m = wave * 2 + k, row = 4 * m + (lane >> 4), lc = (lane & 15) ^ swz16(row & 15); const int grow = 16 * ssd_glmap(hl, m >> 2) + (row & 15);
        __builtin_amdgcn_global_load_lds((const unsigned*)(crow + (unsigned)(grow * 1792 + lc * 8)), (LAS unsigned*)(L + L_C + m * 1024), 16, 0, 0); }
}
__device__ __forceinline__ void ssd_dma_x(LAS unsigned char* L, const bf16_t* xrow, int g, int wave, int lane) {
    OPAQUE(lane);
#pragma unroll
    for (int k = 0; k < 6; ++k) { const int m = wave * 6 + k, r = m >> 4, blk = m & 15, row = 8 * blk + (lane >> 3), lc = (lane & 7) ^ swz8(row);
        __builtin_amdgcn_global_load_lds((const unsigned*)(xrow + g * 192 + r * 64 + (unsigned)(row * 1792 + lc * 8)), (LAS unsigned*)(L + L_X + r * 16384 + blk * 1024), 16, 0, 0); }
}

__device__ __forceinline__ void p4_ssd(const Frame& F, const Params& P) {
    LAS unsigned char* L = (LAS unsigned char*)F.lds;
    const bf16_t* XA = (const bf16_t*)(P.ws + WS_XA); const float* SA = (const float*)(P.ws + WS_SA);
    const bf16_t* proj = (const bf16_t*)(P.ws + WS_PROJ); bf16_t* mix = (bf16_t*)(P.ws + WS_MIX); const float* norm_w = P.in[12]; const float* d_skip = P.in[11];
    const int lane = F.lane, lt = F.wave >> 1, ch = F.wave & 1;
    for (int u = F.vcu; u < 256; u += F.G) {
        const int b = u >> 3, g = (u >> 1) & 3, hl = u & 1;
        __syncthreads();
        { int tz = F.tid; OPAQUE(tz); unsigned zz = 0u; OPAQUE(zz);
#pragma unroll
          for (int k = 0; k < 6; ++k) *(LAS u32x4*)(L + L_S + (tz + NTHREADS * k) * 16) = (u32x4){zz, zz, zz, zz};
          if (tz < 192) *(LAS float*)(L + L_NW + tz * 4) = norm_w[g * 192 + tz]; }
        f32x4 sacc[2][6];
#pragma unroll
        for (int a = 0; a < 2; ++a)
#pragma unroll
            for (int c = 0; c < 6; ++c) sacc[a][c] = (f32x4){0.f, 0.f, 0.f, 0.f};
        const float dsk0 = d_skip[3 * g + ch], dsk1 = d_skip[3 * g + ch + 1];
        const size_t tokb = (size_t)b * SEQ;
#define SSD_ROLES int t3_ = F.tid; OPAQUE(t3_); const int orow = t3_ >> 3, oseg = t3_ & 7, oc0 = g * 192 + oseg * 24; const int ogrow = 16 * ssd_glmap(hl, orow >> 4) + (orow & 15); (void)orow; (void)oseg; (void)oc0; (void)ogrow
#define SSD_DMA_SMALL(bc_) do { if (F.wave < 6) { int ln2_ = lane; OPAQUE(ln2_); __builtin_amdgcn_global_load_lds((const unsigned*)(SA + ((size_t)(bc_) * 4 + g) * 1536 + F.wave * 256 + ln2_ * 4), (LAS unsigned*)(L + L_DT + F.wave * 1024), 16, 0, 0); } } while (0)
        ssd_dma_bc(L, XA + tokb * 1792, g, hl, F.wave, lane); ssd_dma_x(L, XA + tokb * 1792, g, F.wave, lane);
        u32x4 zr[3];
        SSD_DMA_SMALL(b * 16);
        { SSD_ROLES;
          const bf16_t* zp = proj + tokb * NPROJ + (unsigned)(ogrow * NPROJ + COL_Z + oc0);
#pragma unroll
          for (int k = 0; k < 3; ++k) zr[k] = *(const u32x4*)(zp + 8 * k); }
        for (int ck = 0; ck < 16; ++ck) {
            const size_t tok0 = tokb + ck * 128;
            SSD_ROLES;
            if (ck == 0) asm volatile("s_waitcnt vmcnt(0)" ::: "memory"); else asm volatile("s_waitcnt vmcnt(12)" ::: "memory");
            SBAR();
            f32x4 yacc[6];
            if (ch == 0) ssd_compute<0>(L, lt, hl, lane, sacc, yacc, dsk0, dsk1, true); else ssd_compute<1>(L, lt, hl, lane, sacc, yacc, dsk0, dsk1, true);
            SBAR();
            float gz[24];
#pragma unroll
            for (int k = 0; k < 3; ++k) { gz[8 * k + 0] = siluf_(bf_lo(zr[k].x)); gz[8 * k + 1] = siluf_(bf_hi(zr[k].x)); gz[8 * k + 2] = siluf_(bf_lo(zr[k].y)); gz[8 * k + 3] = siluf_(bf_hi(zr[k].y));
                gz[8 * k + 4] = siluf_(bf_lo(zr[k].z)); gz[8 * k + 5] = siluf_(bf_hi(zr[k].z)); gz[8 * k + 6] = siluf_(bf_lo(zr[k].w)); gz[8 * k + 7] = siluf_(bf_hi(zr[k].w)); }
#pragma unroll
            for (int k = 0; k < 24; ++k) asm volatile("" : "+v"(gz[k]) :: "memory");
            if (ck < 15) {
                SSD_DMA_SMALL(b * 16 + ck + 1);
                ssd_dma_bc(L, XA + (tok0 + 128) * 1792, g, hl, F.wave, lane);
            }
            { int l2 = lane; OPAQUE(l2); const int i = l2 & 15, q = l2 >> 4;
#pragma unroll
            for (int nt2 = 0; nt2 < 2; ++nt2)
#pragma unroll
                for (int ct = 0; ct < 6; ++ct) { const f32x4 s = sacc[nt2][ct]; u32x2 pk; pk.x = cvt_pk_bf16(s[0], s[1]); pk.y = cvt_pk_bf16(s[2], s[3]);
                    const int row = 96 * ch + 16 * ct + i, n0 = 16 * (2 * lt + nt2) + 4 * q; *(LAS u32x2*)(L + L_S + row * 256 + (((n0 >> 3) ^ swz16(i)) << 4) + 8 * ((n0 >> 2) & 1)) = pk; }
#pragma unroll
            for (int j = 0; j < 4; ++j) { const int row = 16 * lt + 4 * q + j; const int rb = L_X + row * 384;
#pragma unroll
                for (int ct = 0; ct < 6; ++ct) *(LAS bf16_t*)(L + rb + (96 * ch + 16 * ct + i) * 2) = (bf16_t)(cvt_pk_bf16(yacc[ct][j], 0.f) & 0xffffu); } }
            SBAR();
            u32x4 yr[3];
            { const int row = orow, seg = oseg; const int rb = L_X + row * 384;
#pragma unroll
              for (int k = 0; k < 3; ++k) yr[k] = *(const LAS u32x4*)(L + rb + seg * 48 + k * 16); }
            SBAR();
            if (ck < 15) ssd_dma_x(L, XA + (tok0 + 128) * 1792, g, F.wave, lane);
            asm volatile("" ::: "memory");
            { float v[24]; float ss = 0.f;
#pragma unroll
              for (int k = 0; k < 3; ++k) { v[8 * k + 0] = bf_lo(yr[k].x) * gz[8 * k + 0]; v[8 * k + 1] = bf_hi(yr[k].x) * gz[8 * k + 1]; v[8 * k + 2] = bf_lo(yr[k].y) * gz[8 * k + 2]; v[8 * k + 3] = bf_hi(yr[k].y) * gz[8 * k + 3];
                  v[8 * k + 4] = bf_lo(yr[k].z) * gz[8 * k + 4]; v[8 * k + 5] = bf_hi(yr[k].z) * gz[8 * k + 5]; v[8 * k + 6] = bf_lo(yr[k].w) * gz[8 * k + 6]; v[8 * k + 7] = bf_hi(yr[k].w) * gz[8 * k + 7]; }
#pragma unroll
              for (int k = 0; k < 24; ++k) ss += v[k] * v[k];
              ss += __shfl_xor(ss, 1); ss += __shfl_xor(ss, 2); ss += __shfl_xor(ss, 4);
              const float rstd = rsqrtf(ss * (1.f / 192.f) + EPS);
              bf16_t* op = mix + tok0 * DM + (unsigned)(ogrow * DM + 256 + oc0);
#pragma unroll
              for (int k = 0; k < 3; ++k) { const f32x4 n0 = *(const LAS f32x4*)(L + L_NW + (oseg * 24 + 8 * k) * 4), n1 = *(const LAS f32x4*)(L + L_NW + (oseg * 24 + 8 * k + 4) * 4); u32x4 pk;
                  pk.x = cvt_pk_bf16(v[8 * k] * rstd * n0[0], v[8 * k + 1] * rstd * n0[1]); pk.y = cvt_pk_bf16(v[8 * k + 2] * rstd * n0[2], v[8 * k + 3] * rstd * n0[3]);
                  pk.z = cvt_pk_bf16(v[8 * k + 4] * rstd * n1[0], v[8 * k + 5] * rstd * n1[1]); pk.w = cvt_pk_bf16(v[8 * k + 6] * rstd * n1[2], v[8 * k + 7] * rstd * n1[3]);
                  *(u32x4*)(op + 8 * k) = pk; } }
            if (ck < 15) { const bf16_t* zp = proj + (tok0 + 128) * NPROJ + (unsigned)(ogrow * NPROJ + COL_Z + oc0);
#pragma unroll
                for (int k = 0; k < 3; ++k) zr[k] = *(const u32x4*)(zp + 8 * k); }
        }
    }
}

constexpr int R_WH = 0, R_WL = 73728, R_SC = 147456, R_SH = R_SC + 4096, R_CNT = R_SH + 4096, R_LG = 0;
__device__ __forceinline__ void p5_route(const Frame& F, const Params& P) {
    LAS unsigned char* L = (LAS unsigned char*)F.lds;
    const bf16_t* x1 = (const bf16_t*)(P.ws + WS_X1); const float* mod = (const float*)(P.ws + WS_MOD); bf16_t* H = (bf16_t*)(P.ws + WS_H); const float* ss16 = (const float*)(P.ws + WS_SS16);
    const bf16_t* WRH = (const bf16_t*)(P.ws + WS_WR); const bf16_t* WRL = (const bf16_t*)(P.ws + WS_WR + 131072);
    float* gates = (float*)(P.ws + WS_SGATE); unsigned* list = (unsigned*)(P.ws + WS_LIST); unsigned* gcount = (unsigned*)(P.ws + WS_CTL) + CW_GCOUNT;
    const float* b_group = P.in[15]; const float* b_router = P.in[17];
    LAS unsigned* lcount = (LAS unsigned*)(L + R_CNT);
    LAS unsigned* lbase = lcount + 32;
    LAS unsigned* tinfo = lcount + 64;
    LAS float* twt = (LAS float*)(tinfo + 256 * 4);
    const int lane = F.lane, i = lane & 15, q = lane >> 4;
    for (int rb = F.vcu; rb < T / 256; rb += F.G) {
        const int b = rb >> 3;
        for (int idx = F.tid; idx < 36 * 128; idx += NTHREADS) { const int j = idx >> 7, c = idx & 127; const int dst = j * 2048 + ((c ^ swz16(j & 15)) << 4);
            *(LAS u32x4*)(L + R_WH + dst) = *(const u32x4*)(WRH + (size_t)j * 1024 + c * 8); *(LAS u32x4*)(L + R_WL + dst) = *(const u32x4*)(WRL + (size_t)j * 1024 + c * 8); }
        for (int idx = F.tid; idx < 256; idx += NTHREADS) { const f32x4 sc = *(const f32x4*)(mod + (size_t)b * 6144 + 4 * 1024 + idx * 4), sh = *(const f32x4*)(mod + (size_t)b * 6144 + 3 * 1024 + idx * 4);
            *(LAS f32x4*)(L + R_SC + idx * 16) = sc + 1.0f; *(LAS f32x4*)(L + R_SH + idx * 16) = sh; }
        if (F.tid < 32) lcount[F.tid] = 0u;
        __syncthreads();
        const int rowA = rb * 256 + F.wave * 32 + i;
        float rstd[2];
#pragma unroll
        for (int rt = 0; rt < 2; ++rt) { const f32x4* sp = (const f32x4*)(ss16 + (size_t)(rowA + 16 * rt) * 16); const f32x4 a = sp[0], c = sp[1], d = sp[2], e = sp[3];
            const float ss = ((a[0] + a[1]) + (a[2] + a[3])) + ((c[0] + c[1]) + (c[2] + c[3])) + ((d[0] + d[1]) + (d[2] + d[3])) + ((e[0] + e[1]) + (e[2] + e[3])); rstd[rt] = rsqrtf(ss * (1.f / DM) + EPS); }
        f32x4 acc[2][3];
#pragma unroll
        for (int rt = 0; rt < 2; ++rt)
#pragma unroll
            for (int ct = 0; ct < 3; ++ct) acc[rt][ct] = (f32x4){0.f, 0.f, 0.f, 0.f};
        int wrow[3];
#pragma unroll
        for (int ct = 0; ct < 3; ++ct) { const int j = (16 * ct + i) < 36 ? (16 * ct + i) : 35; wrow[ct] = j * 2048; }
        const int fsw = swz16(i);
        const int fswc = swz16(35 & 15);
#pragma unroll 2
        for (int s = 0; s < 32; ++s) {
            bf16x8 wh[3], wl[3];
#pragma unroll
            for (int ct = 0; ct < 3; ++ct) { const int sw = ((16 * ct + i) < 36) ? fsw : fswc; const int o = wrow[ct] + ((((4 * s + q) & ~15) | (((4 * s + q) & 15) ^ sw)) << 4);
                wh[ct] = *(const LAS bf16x8*)(L + R_WH + o); wl[ct] = *(const LAS bf16x8*)(L + R_WL + o); }
            const f32x4 sc0 = *(const LAS f32x4*)(L + R_SC + (32 * s + 8 * q) * 4), sc1 = *(const LAS f32x4*)(L + R_SC + (32 * s + 8 * q + 4) * 4);
            const f32x4 sh0 = *(const LAS f32x4*)(L + R_SH + (32 * s + 8 * q) * 4), sh1 = *(const LAS f32x4*)(L + R_SH + (32 * s + 8 * q + 4) * 4);
#pragma unroll
            for (int rt = 0; rt < 2; ++rt) { const size_t off = (size_t)(rowA + 16 * rt) * DM + 32 * s + 8 * q;
                const u32x4 xw = *(const u32x4*)(x1 + off); const f32x4 x0 = (f32x4){bf_lo(xw.x), bf_hi(xw.x), bf_lo(xw.y), bf_hi(xw.y)}, x1v = (f32x4){bf_lo(xw.z), bf_hi(xw.z), bf_lo(xw.w), bf_hi(xw.w)};
                const f32x4 h0 = x0 * rstd[rt] * sc0 + sh0, h1 = x1v * rstd[rt] * sc1 + sh1;
                u32x4 hi; hi.x = cvt_pk_bf16(h0[0], h0[1]); hi.y = cvt_pk_bf16(h0[2], h0[3]); hi.z = cvt_pk_bf16(h1[0], h1[1]); hi.w = cvt_pk_bf16(h1[2], h1[3]);
                { u32x2 h8; h8.x = cvt_pk4_fp8(h0[0], h0[1], h0[2], h0[3]); h8.y = cvt_pk4_fp8(h1[0], h1[1], h1[2], h1[3]); *(u32x2*)((unsigned char*)H + off) = h8; }
                u32x4 lo; lo.x = cvt_pk_bf16(h0[0] - bf_lo(hi.x), h0[1] - bf_hi(hi.x)); lo.y = cvt_pk_bf16(h0[2] - bf_lo(hi.y), h0[3] - bf_hi(hi.y));
                lo.z = cvt_pk_bf16(h1[0] - bf_lo(hi.z), h1[1] - bf_hi(hi.z)); lo.w = cvt_pk_bf16(h1[2] - bf_lo(hi.w), h1[3] - bf_hi(hi.w));
                const bf16x8 ah = __builtin_bit_cast(bf16x8, hi), al = __builtin_bit_cast(bf16x8, lo);
#pragma unroll
                for (int ct = 0; ct < 3; ++ct) { acc[rt][ct] = MFMA16(ah, wh[ct], acc[rt][ct]); acc[rt][ct] = MFMA16(al, wh[ct], acc[rt][ct]); acc[rt][ct] = MFMA16(ah, wl[ct], acc[rt][ct]); } }
        }
        __syncthreads();
        LAS float* lg = (LAS float*)(L + R_LG);
#pragma unroll
        for (int rt = 0; rt < 2; ++rt)
#pragma unroll
            for (int ct = 0; ct < 3; ++ct)
#pragma unroll
                for (int j = 0; j < 4; ++j) { const int col = 16 * ct + i; if (col < 36) lg[(F.wave * 32 + 16 * rt + 4 * q + j) * 37 + col] = acc[rt][ct][j]; }
        __syncthreads();
        if (F.tid < 256) {
            const int rl = F.tid; const LAS float* lr = lg + rl * 37;
            float gl[4];
#pragma unroll
            for (int k = 0; k < 4; ++k) gl[k] = lr[k] + b_group[k];
            int gi = 0; float gm = gl[0];
#pragma unroll
            for (int k = 1; k < 4; ++k) if (gl[k] > gm) { gm = gl[k]; gi = k; }
            float den = 0.f;
#pragma unroll
            for (int k = 0; k < 4; ++k) den += __expf(gl[k] - gm);
            const float pg = 1.0f / den;
            float el[8];
#pragma unroll
            for (int k = 0; k < 8; ++k) el[k] = lr[4 + gi * 8 + k] + b_router[gi * 8 + k];
            int i0 = 0; float v0 = el[0];
#pragma unroll
            for (int k = 1; k < 8; ++k) if (el[k] > v0) { v0 = el[k]; i0 = k; }
            int i1 = -1; float v1 = -3.0e38f;
#pragma unroll
            for (int k = 0; k < 8; ++k) if (k != i0 && el[k] > v1) { v1 = el[k]; i1 = k; }
            const float ex = __expf(v1 - v0); const float w0 = pg / (1.0f + ex), w1 = pg * ex / (1.0f + ex);
            const int e0 = gi * 8 + i0, e1 = gi * 8 + i1; const unsigned r0 = atomicAdd((unsigned*)&lcount[e0], 1u), r1 = atomicAdd((unsigned*)&lcount[e1], 1u);
            tinfo[rl * 4 + 0] = (unsigned)e0 | ((unsigned)e1 << 8); tinfo[rl * 4 + 1] = r0; tinfo[rl * 4 + 2] = r1; twt[rl * 2] = w0; twt[rl * 2 + 1] = w1;
        }
        __syncthreads();
        if (F.tid < 32) lbase[F.tid] = atomicAdd(&gcount[64 * F.tid], lcount[F.tid]);
        __syncthreads();
        if (F.tid < 256) { const int rl = F.tid, row = rb * 256 + rl; const unsigned ee = tinfo[rl * 4], e0 = ee & 255u, e1 = ee >> 8;
            const size_t s0 = (size_t)e0 * ECAP + lbase[e0] + tinfo[rl * 4 + 1], s1 = (size_t)e1 * ECAP + lbase[e1] + tinfo[rl * 4 + 2];
            list[s0] = (unsigned)row * 2u; list[s1] = (unsigned)row * 2u + 1u; gates[s0] = twt[rl * 2]; gates[s1] = twt[rl * 2 + 1]; }
        __syncthreads();
    }
}

__device__ __forceinline__ void p8_final(const Frame& F, const Params& P) {
    const bf16_t* x1 = (const bf16_t*)(P.ws + WS_X1); const unsigned char* Y0 = P.ws + WS_Y0; const unsigned char* Y1 = P.ws + WS_Y1; const float* fw = P.in[20]; const float* mod = (const float*)(P.ws + WS_MOD);
    f32x4 wv[4];
#pragma unroll
    for (int j = 0; j < 4; ++j) wv[j] = ((const f32x4*)fw)[F.lane + 64 * j];
    for (int row0 = F.gw * 2; row0 < T; row0 += F.NGW * 2) {
        const f32x4* g2 = (const f32x4*)(mod + (size_t)(row0 >> 11) * 6144 + 5 * 1024) + F.lane;
        u32x2 xw[2][4]; unsigned a[2][4], c[2][4];
#pragma unroll
        for (int r = 0; r < 2; ++r) { const u32x2* xr = (const u32x2*)(x1 + (size_t)(row0 + r) * DM) + F.lane; const unsigned* y0 = (const unsigned*)(Y0 + (size_t)(row0 + r) * DM) + F.lane; const unsigned* y1 = (const unsigned*)(Y1 + (size_t)(row0 + r) * DM) + F.lane;
#pragma unroll
            for (int j = 0; j < 4; ++j) { xw[r][j] = __builtin_nontemporal_load(xr + 64 * j); a[r][j] = __builtin_nontemporal_load(y0 + 64 * j); c[r][j] = __builtin_nontemporal_load(y1 + 64 * j); } }
        f32x4 g[4];
#pragma unroll
        for (int j = 0; j < 4; ++j) g[j] = g2[64 * j];
#pragma unroll
        for (int r = 0; r < 2; ++r) { f32x4 v[4]; float s = 0.f;
#pragma unroll
            for (int j = 0; j < 4; ++j) { v[j] = (f32x4){bf_lo(xw[r][j].x), bf_hi(xw[r][j].x), bf_lo(xw[r][j].y), bf_hi(xw[r][j].y)};
                const f32x2 a01 = __builtin_amdgcn_cvt_pk_f32_fp8((int)a[r][j], false), a23 = __builtin_amdgcn_cvt_pk_f32_fp8((int)a[r][j], true), c01 = __builtin_amdgcn_cvt_pk_f32_fp8((int)c[r][j], false), c23 = __builtin_amdgcn_cvt_pk_f32_fp8((int)c[r][j], true);
                v[j][0] += g[j][0] * (a01[0] + c01[0]); v[j][1] += g[j][1] * (a01[1] + c01[1]); v[j][2] += g[j][2] * (a23[0] + c23[0]); v[j][3] += g[j][3] * (a23[1] + c23[1]);
                s += (v[j][0] * v[j][0] + v[j][1] * v[j][1]) + (v[j][2] * v[j][2] + v[j][3] * v[j][3]); }
            const float rstd = rsqrtf(wave_sum(s) * (1.f / DM) + EPS);
            f32x4* o = (f32x4*)(P.out + (size_t)(row0 + r) * DM) + F.lane;
#pragma unroll
            for (int j = 0; j < 4; ++j) __builtin_nontemporal_store(v[j] * rstd * wv[j], o + 64 * j); }
    }
}

__device__ __forceinline__ void moe_prefix(const Frame& F, const Params& P, int* pref) {
    const unsigned* gcount = (const unsigned*)(P.ws + WS_CTL) + CW_GCOUNT;
    __syncthreads();
    if (F.tid == 0) { int acc = 0; for (int e = 0; e < 32; ++e) { const int c = (int)__hip_atomic_load(gcount + 64 * e, __ATOMIC_RELAXED, __HIP_MEMORY_SCOPE_AGENT); pref[e] = acc; pref[33 + e] = c; acc += (c + 255) >> 8; } pref[32] = acc; }
    __syncthreads();
}

#define XB_TMO      128
#define XB_XCNT(j)  (256  + 64 * (j))
#define XB_XSUB(j)  (1280 + 64 * (j))
#define XB_XGEN(j)  (2304 + 64 * (j))
#define XB_TOP      3328
#define XB_TOPGEN   3392
#define XCD_BAR_WORDS 3456
#define XB_SPIN_CAP (1u << 22)
__device__ __forceinline__ unsigned xb_ld(unsigned* p)              { return __hip_atomic_load(p, __ATOMIC_RELAXED, __HIP_MEMORY_SCOPE_AGENT); }
__device__ __forceinline__ unsigned xb_add(unsigned* p, unsigned v) { return __hip_atomic_fetch_add(p, v, __ATOMIC_RELAXED, __HIP_MEMORY_SCOPE_AGENT); }
__device__ __forceinline__ unsigned xb_xcc_id() { return (unsigned)__builtin_amdgcn_s_getreg((3 << 11) | 20) & 0xFu; }
#define XB_SPIN(cond, bar) do { unsigned _sp = 0; while (cond) { __builtin_amdgcn_s_sleep(1); \
    if ((++_sp & 255u) == 0u) { if (xb_ld(&(bar)[XB_TMO])) break; if (_sp > XB_SPIN_CAP) { atomicAdd(&(bar)[XB_TMO], 1u); break; } } } } while (0)
struct XcdBarrier { unsigned* bar; unsigned x; volatile LAS unsigned* st; };
__device__ __forceinline__ XcdBarrier xcd_barrier_post(unsigned* bar, volatile LAS unsigned* st) {
    XcdBarrier b; b.bar = bar; b.x = xb_xcc_id(); b.st = st;
    if (threadIdx.x == 0) (void)xb_add(&bar[XB_XCNT(b.x)], 1u);
    return b;
}
__device__ __forceinline__ void xcd_barrier_complete(unsigned* bar, unsigned x, unsigned& nloc, unsigned& nx) {
    const unsigned G = gridDim.x * gridDim.y * gridDim.z;
    unsigned sum, cnt, mine, sp = 0u;
    for (;;) {
        sum = 0u; cnt = 0u; mine = 0u;
#pragma unroll
        for (unsigned j = 0; j < 16; ++j) { const unsigned c = xb_ld(&bar[XB_XCNT(j)]); sum += c; cnt += (c > 0u) ? 1u : 0u; mine = (j == x) ? c : mine; }
        if (sum == G) break;
        __builtin_amdgcn_s_sleep(1);
        if ((++sp & 255u) == 0u) { if (xb_ld(&bar[XB_TMO])) break; if (sp > XB_SPIN_CAP) { atomicAdd(&bar[XB_TMO], 1u); break; } }
    }
    nloc = mine > 0u ? mine : 1u; nx = cnt > 0u ? cnt : 1u;
}
__device__ __forceinline__ void xcd_barrier(const XcdBarrier& b) {
    asm volatile("s_waitcnt vmcnt(0)" ::: "memory");
    __syncthreads();
    if (threadIdx.x == 0) {
        unsigned* bar = b.bar;
        __builtin_amdgcn_s_waitcnt(0);
        unsigned nloc = b.st[0], nx = b.st[1];
        if (nloc == 0u) { xcd_barrier_complete(bar, b.x, nloc, nx); b.st[0] = nloc; b.st[1] = nx; }
        const unsigned old = xb_add(&bar[XB_XSUB(b.x)], 1u);
        const unsigned gen = old / nloc;
        if (old + 1u == (gen + 1u) * nloc) {
            __builtin_amdgcn_fence(__ATOMIC_RELEASE, "agent");
            asm volatile("s_waitcnt vmcnt(0)" ::: "memory");
            const unsigned og = xb_add(&bar[XB_TOP], 1u);
            const unsigned tg = og / nx;
            if (og + 1u == (tg + 1u) * nx) xb_add(&bar[XB_TOPGEN], 1u);
            else XB_SPIN(xb_ld(&bar[XB_TOPGEN]) == tg, bar);
            __builtin_amdgcn_fence(__ATOMIC_ACQUIRE, "agent");
            xb_add(&bar[XB_XGEN(b.x)], 1u);
            asm volatile("s_waitcnt vmcnt(0)" ::: "memory");
        } else {
            XB_SPIN(xb_ld(&bar[XB_XGEN(b.x)]) == gen, bar);
            __builtin_amdgcn_fence(__ATOMIC_ACQUIRE, "agent");
            asm volatile("s_waitcnt vmcnt(0)" ::: "memory");
        }
    }
    __syncthreads();
}

__global__ void __launch_bounds__(NTHREADS, 2) fwd_kernel(Params P) {
    extern __shared__ __attribute__((aligned(16))) unsigned char lds[];
    Frame F; F.lds = lds; F.tid = threadIdx.x; F.lane = F.tid & 63; F.wave = __builtin_amdgcn_readfirstlane(F.tid >> 6);
    F.G = gridDim.x; { const int bx = blockIdx.x; F.vcu = (F.G % 8 == 0) ? (bx % 8) * (F.G / 8) + bx / 8 : bx; }
    F.gw = F.vcu * NWAVES + F.wave; F.NGW = F.G * NWAVES;
    unsigned char* ws = P.ws;
    const int lo = P.ph_lo, hi = P.ph_hi;
    volatile LAS unsigned* bst = (volatile LAS unsigned*)((LAS unsigned char*)lds + (LDS_BYTES - 64));
    if (F.tid < 2) bst[F.tid] = 0u;
    __syncthreads();
    const XcdBarrier xbar = xcd_barrier_post((unsigned*)(ws + WS_CTL) + CW_BAR, bst);
#define IN(k) (lo <= (k) && (k) < hi)
#define GRID_BAR() xcd_barrier(xbar)
#define GRID_BAR_CG() do { __syncthreads(); cooperative_groups::this_grid().sync(); } while (0)
    if (IN(0)) p0_prep(F, P);
    if (IN(0) && IN(1)) { if (P.ph_hi > 1000) GRID_BAR_CG(); else GRID_BAR(); }
    if (IN(1)) p1_modulate(F, P);
    if (IN(1) && IN(2)) GRID_BAR();
    if (IN(2)) { pg8::DenseSched S; S.init(ws + WS_H, ws + WS_WIN, T, COL_DT, 1024, F.G, (int)blockIdx.x); pg8::EpiProj E{(bf16_t*)(ws + WS_PROJ), (bf16_t*)(ws + WS_XA), P.in[7], P.in[8]}; pg8::gemm_phase(( LAS unsigned char*)lds, S, E); }
    if (IN(2) && IN(3)) GRID_BAR();
    if (IN(3)) p3_conv(F, P);
    if (IN(3) && IN(4)) GRID_BAR();
    if (IN(4)) p4_ssd(F, P);
    if (IN(4) && IN(5)) GRID_BAR();
    if (IN(5)) { pg8::DenseSched S; S.init(ws + WS_MIX, ws + WS_WOUT, T, 1024, 1024, F.G, (int)blockIdx.x); pg8::EpiX1 E{P.in[0], (const float*)(ws + WS_MOD), (bf16_t*)(ws + WS_X1), (float*)(ws + WS_SS16)}; pg8::gemm_phase((LAS unsigned char*)lds, S, E); }
    if (IN(5) && IN(6)) GRID_BAR();
    if (IN(6)) p5_route(F, P);
    if (IN(6) && IN(7)) GRID_BAR();
    if (IN(7)) { int* pref = (int*)(lds + MISC_OFF); moe_prefix(F, P, pref);
        pg8::MoeSched<true> S; S.A = (const char*)(ws + WS_H); S.Bt = (const char*)(ws + WS_W13); S.K = 1024; S.nN = 4; S.G = F.G; S.c = F.vcu; S.pref = (const LAS int*)pref; S.list = (const unsigned*)(ws + WS_LIST);
        pg8::EpiAct E{(unsigned char*)(ws + WS_ACT)}; pg8::gemm_phase((LAS unsigned char*)lds, S, E); }
    if (IN(7) && IN(8)) GRID_BAR();
    if (IN(8)) { int* pref = (int*)(lds + MISC_OFF); moe_prefix(F, P, pref);
        pg8::MoeSched<false> S; S.A = (const char*)(ws + WS_ACT); S.Bt = (const char*)(ws + WS_W2); S.K = 512; S.nN = 4; S.G = F.G; S.c = F.vcu; S.pref = (const LAS int*)pref; S.list = (const unsigned*)(ws + WS_LIST);
        pg8::EpiY E{(const unsigned*)(ws + WS_LIST), (const float*)(ws + WS_SGATE), ws + WS_Y0, ws + WS_Y1}; pg8::gemm_phase((LAS unsigned char*)lds, S, E); }
    if (IN(8) && IN(9)) GRID_BAR();
    if (IN(9)) p8_final(F, P);
#undef IN
#undef GRID_BAR
#undef GRID_BAR_CG
}

extern "C" void kernel_launch(void* const* d_in, const int* in_sizes, int n_in, void* d_out, int out_size, void* d_ws, size_t ws_size, hipStream_t stream) {
    static int grid = 0;
    if (grid == 0) {
        if (n_in != 21 || out_size != T * DM || ws_size < WS_END) { fprintf(stderr, "kernel_launch: unexpected sizes n_in %d out %d ws %zu\n", n_in, out_size, ws_size); grid = -1; return; }
        int dev = 0, cus = 0;
        if (hipGetDevice(&dev) != hipSuccess || hipDeviceGetAttribute(&cus, hipDeviceAttributeMultiprocessorCount, dev) != hipSuccess) { grid = -1; return; }
        if (hipFuncSetAttribute((const void*)fwd_kernel, hipFuncAttributeMaxDynamicSharedMemorySize, LDS_BYTES) != hipSuccess) { fprintf(stderr, "kernel_launch: hipFuncSetAttribute failed\n"); grid = -1; return; }
        int per_cu = 0;
        if (hipOccupancyMaxActiveBlocksPerMultiprocessor(&per_cu, (const void*)fwd_kernel, NTHREADS, LDS_BYTES) != hipSuccess || per_cu < 1) { fprintf(stderr, "kernel_launch: occupancy query says %d blocks per CU\n", per_cu); (void)hipGetLastError(); per_cu = 1; }
        grid = cus;
    }
    if (grid < 0) return;
    (void)hipMemsetAsync((char*)d_ws + WS_CTL, 0, CTL_BYTES, stream);
    Params p{};
    for (int i = 0; i < 21; ++i) p.in[i] = (const float*)d_in[i];
    p.out = (float*)d_out; p.ws = (unsigned char*)d_ws;
    p.ph_lo = 0; p.ph_hi = 10;
    void* args[] = {&p};
    hipError_t e = hipLaunchCooperativeKernel((const void*)fwd_kernel, dim3(grid), dim3(NTHREADS), args, LDS_BYTES, stream);
    if (e != hipSuccess) fprintf(stderr, "kernel_launch: cooperative launch failed: %s (grid %d)\n", hipGetErrorString(e), grid);
}
```

```cpp
#include <hip/hip_runtime.h>
#include <hip/hip_cooperative_groups.h>
#include <cstdio>
#include <cstdint>
#include <type_traits>

#ifndef MK_ONE_LAUNCH
#define MK_ONE_LAUNCH 0
#endif

#define LAS __attribute__((address_space(3)))
typedef unsigned short bf16_t;
typedef short bf16x8 __attribute__((ext_vector_type(8)));
typedef float f32x4 __attribute__((ext_vector_type(4)));
typedef float f32x2 __attribute__((ext_vector_type(2)));
typedef unsigned u32x4 __attribute__((ext_vector_type(4)));
typedef unsigned u32x2 __attribute__((ext_vector_type(2)));
typedef int i32x4 __attribute__((ext_vector_type(4)));
typedef int i32x8 __attribute__((ext_vector_type(8)));

constexpr int BATCH = 32, SEQ = 2048, DM = 1024, T = BATCH * SEQ;
constexpr int NPROJ = 3072, NPROJ_REAL = 2828;
constexpr int COL_Z = 256, COL_XS = 1024, COL_B = 1792, COL_C = 2304, COL_DT = 2816;
constexpr int NEXP = 32, FF = 512, ECAP = 65536;
constexpr int NWAVES = 8, NTHREADS = 512;
constexpr float EPS = 1e-6f;

constexpr size_t MiB = 1u << 20;
constexpr size_t WS_CTL = 0, CTL_BYTES = 1 * MiB;
constexpr size_t WS_MOD = 1 * MiB;
constexpr size_t WS_WR = 2 * MiB;
constexpr size_t WS_WDT = 2 * MiB + 512 * 1024;
constexpr size_t WS_SS16 = 4 * MiB;
constexpr size_t WS_SGATE = 120 * MiB;
constexpr size_t WS_DTRAW = 4 * MiB;
constexpr size_t WS_LIST = 8 * MiB;
constexpr size_t WS_WIN = 16 * MiB;
constexpr size_t WS_WOUT = 22 * MiB;
constexpr size_t WS_W13 = 24 * MiB;
constexpr size_t WS_W2 = 88 * MiB;
constexpr size_t WS_H = 128 * MiB;
constexpr size_t WS_PROJ = 256 * MiB;
constexpr size_t WS_MIX = 640 * MiB;
constexpr size_t WS_X1 = 768 * MiB;
constexpr size_t WS_END = 1024 * MiB;
constexpr size_t WS_XA = WS_X1;
constexpr size_t WS_SA = WS_H;
constexpr size_t WS_Y0 = 256 * MiB, WS_Y1 = 384 * MiB;
constexpr size_t WS_ACT = 512 * MiB;
constexpr int CW_GCOUNT = 256;
constexpr int CW_BAR = 4096;

constexpr int LDS_BYTES = 163840;
constexpr int MISC_OFF = 147456;

struct Params {
    const float* in[21];
    float* out;
    unsigned char* ws;
    int ph_lo, ph_hi;
};

__device__ __forceinline__ unsigned cvt_pk_bf16(float lo, float hi) { unsigned r; asm volatile("v_cvt_pk_bf16_f32 %0, %1, %2" : "=v"(r) : "v"(lo), "v"(hi)); return r; }
__device__ __forceinline__ float clamp_f8(float v) { return __builtin_amdgcn_fmed3f(v, -448.f, 448.f); }
__device__ __forceinline__ unsigned cvt_pk4_fp8(float a, float b, float c, float d) {
    int w = 0; w = __builtin_amdgcn_cvt_pk_fp8_f32(clamp_f8(a), clamp_f8(b), w, false); w = __builtin_amdgcn_cvt_pk_fp8_f32(clamp_f8(c), clamp_f8(d), w, true); return (unsigned)w; }
__device__ __forceinline__ float bf_lo(unsigned u) { return __uint_as_float(u << 16); }
__device__ __forceinline__ float bf_hi(unsigned u) { return __uint_as_float(u & 0xffff0000u); }
__device__ __forceinline__ float wave_sum(float v) {
#pragma unroll
    for (int o = 1; o < 64; o <<= 1) v += __shfl_xor(v, o);
    return v;
}
__device__ __forceinline__ float sigmoidf_(float v) { return __builtin_amdgcn_rcpf(1.0f + __expf(-v)); }
__device__ __forceinline__ float siluf_(float v) { return v * sigmoidf_(v); }

namespace pg8 {
constexpr float W_F8_SCALE = 32.f, W_F8_INV = 1.f / 32.f;
constexpr int BM = 256, BK = 64, HALF = 128, HTB = HALF * BK * 2, STAGE_BYTES = 8 * HTB, NXCD = 8, WGM = 4;
__host__ __device__ __forceinline__ int lds_byte(int r, int c) { const int st = (r >> 4) * 2 + (c >> 5), rr = r & 15, cc = c & 31, ob = rr * 64 + cc * 2; return st * 1024 + (ob ^ (((ob >> 9) & 1) << 5)); }
__host__ __device__ __forceinline__ void stage_rc(int b, int& R, int& C) { const int st = b / 1024, sb = b % 1024, swz = sb ^ (((sb >> 9) & 1) << 5); R = (st >> 1) * 16 + swz / 64; C = (st & 1) * 32 + (swz % 64) / 2; }
__host__ __device__ __forceinline__ int perm32(int rho) { const int n = rho >> 4, i = rho & 15; return 8 * (i >> 2) + 4 * n + (i & 3); }

struct Unit { int pm, pn, e, cnt, slot0; };

template <int NN>
struct DenseSched {
    const char* A; const char* Bt; int K;
    static constexpr int nM = 256, nN = NN, nwg = nM * NN; int G, c;
    static_assert(nwg % NXCD == 0 && nM % WGM == 0, "dense order");
    __device__ void init(const void* A_, const void* Bt_, int M, int N, int K_, int G_, int c_) { A = (const char*)A_; Bt = (const char*)Bt_; K = K_; G = G_; c = c_; (void)M; (void)N; }
    __device__ __forceinline__ bool next(int i, Unit& u) const {
        const int L = i * G + c; if (L >= nwg) return false;
        const int wgid = (L % NXCD) * (nwg / NXCD) + L / NXCD;
        constexpr int nig = WGM * NN; const int gid = wgid / nig, w = wgid % nig;
        u.pm = gid * WGM + (w % WGM); u.pn = w / WGM; u.e = 0; u.cnt = 256; u.slot0 = 0; return true;
    }
    static constexpr bool FP8 = false;
    __device__ __forceinline__ int kb() const { return K * 2; }
    __device__ __forceinline__ const char* a_base() const { return A; }
    __device__ __forceinline__ void a_raw(const Unit& u, const int (&R)[2], unsigned (&raw)[2][2]) const {
#pragma unroll
        for (int h = 0; h < 2; ++h)
#pragma unroll
            for (int i = 0; i < 2; ++i) raw[h][i] = (unsigned)(u.pm * BM + h * HALF + R[i]);
    }
    __device__ __forceinline__ void a_fin(const int (&C)[2], const unsigned (&raw)[2][2], unsigned (&o)[2][2]) const {
#pragma unroll
        for (int h = 0; h < 2; ++h)
#pragma unroll
            for (int i = 0; i < 2; ++i) o[h][i] = (raw[h][i] * (unsigned)K + (unsigned)C[i]) * 2u;
    }
    __device__ __forceinline__ const char* b_ptr(const Unit& u) const { return Bt + (size_t)u.pn * BM * K * 2; }
};

template <bool GATHER>
struct MoeSched {
    static constexpr bool FP8 = true;
    __device__ __forceinline__ int kb() const { return K; }
    const char* A; const char* Bt; int K, nN, G, c;
    const LAS int* pref;
    const unsigned* list;
    __device__ __forceinline__ bool next(int i, Unit& u) const {
        const int L = i * G + c; const int tot = pref[32] * 4; if (L >= tot) return false;
        const int ti = L >> 2; u.pn = L & 3;
        const int le = threadIdx.x & 31; const int plo = pref[le], phi = pref[le + 1];
        const int e = (int)__builtin_ctzll(__ballot(plo <= ti && ti < phi) | (1ull << 63)) & 31;
        const int mt = ti - pref[e]; u.pm = ti; u.e = e; u.slot0 = mt * 256; const int rem = pref[33 + e] - mt * 256; u.cnt = rem < 256 ? rem : 256; return true;
    }
    __device__ __forceinline__ const char* a_base() const { return A; }
    __device__ __forceinline__ void a_raw(const Unit& u, const int (&R)[2], unsigned (&raw)[2][2]) const {
#pragma unroll
        for (int h = 0; h < 2; ++h)
#pragma unroll
            for (int i = 0; i < 2; ++i) {
                const int r = h * HALF + R[i];
                if (GATHER) { unsigned ent = 0; if (r < u.cnt) ent = list[(size_t)u.e * ECAP + u.slot0 + r]; raw[h][i] = ent >> 1; }
                else raw[h][i] = (unsigned)(u.pm * BM + r);
            }
    }
    __device__ __forceinline__ void a_fin(const int (&C)[2], const unsigned (&raw)[2][2], unsigned (&o)[2][2]) const {
#pragma unroll
        for (int h = 0; h < 2; ++h)
#pragma unroll
            for (int i = 0; i < 2; ++i) o[h][i] = raw[h][i] * (unsigned)K + (unsigned)C[i] * 2u;
    }
    __device__ __forceinline__ const char* b_ptr(const Unit& u) const { return Bt + ((size_t)u.e * (nN * BM) + (size_t)u.pn * BM) * K; }
};

template <class Epi, class Sched>
__device__ __forceinline__ void gemm_phase(LAS unsigned char* lds, const Sched& S, const Epi& E, unsigned stagger_ticks = 0u) {
    if (stagger_ticks) { const unsigned long long t0 = __builtin_amdgcn_s_memrealtime(); while ((unsigned long long)(__builtin_amdgcn_s_memrealtime() - t0) < (unsigned long long)stagger_ticks) __builtin_amdgcn_s_sleep(16); }
    const int tid = threadIdx.x, wid = __builtin_amdgcn_readfirstlane(tid >> 6), lane = tid & 63, wr = wid >> 2, wc = wid & 3, fr = lane & 15, fq = lane >> 4;
    const int KB = S.kb(), nt = KB / (BK * 2);
    int sR[2], sC[2]; unsigned voffB[2];
#pragma unroll
    for (int i = 0; i < 2; ++i) { int R, C; stage_rc(tid * 16 + i * 8192, R, C); sR[i] = R; sC[i] = C; const int Rb = Epi::PERM ? ((R & ~31) + perm32(R & 31)) : R; voffB[i] = (unsigned)(Rb * KB + C * 2); }
    const size_t kstep = (size_t)(BK * 2);
    const size_t hstep = (size_t)HALF * KB;
    const unsigned ldsw = (unsigned)wid * 1024u;
    const int aoff = lds_byte(wr * 64 + fr, fq * 8), boff = lds_byte(wc * 32 + fr, fq * 8);
#define PG8_SA(b, h) (((b) * 2 + (h)) * HTB)
#define PG8_SB(b, h) ((4 + (b) * 2 + (h)) * HTB)
#define PG8_STAGE(bufoff, gbase, voff) do { _Pragma("unroll") for (int _i = 0; _i < 2; ++_i) \
        __builtin_amdgcn_global_load_lds((const unsigned*)((const char*)(gbase) + (voff)[_i]), (LAS unsigned*)(lds + (bufoff) + ldsw + _i * 8192), 16, 0, 0); } while (0)
#define PG8_LDA(dst, b, h) do { _Pragma("unroll") for (int m = 0; m < 4; ++m) _Pragma("unroll") for (int k = 0; k < 2; ++k) { const i32x4 v_ = *(const LAS i32x4*)(lds + PG8_SA(b, h) + aoff + m * 2048 + k * 1024); if (k == 0) dst[m].lo = v_; else dst[m].hi = v_; } } while (0)
#define PG8_LDB(dst, b, h) do { _Pragma("unroll") for (int n = 0; n < 2; ++n) _Pragma("unroll") for (int k = 0; k < 2; ++k) { const i32x4 v_ = *(const LAS i32x4*)(lds + PG8_SB(b, h) + boff + n * 2048 + k * 1024); if (k == 0) dst[n].lo = v_; else dst[n].hi = v_; } } while (0)
#define PG8_MMA(ai, bj, At, Bt) do { __builtin_amdgcn_s_setprio(1); _Pragma("unroll") for (int m = 0; m < 4; ++m) _Pragma("unroll") for (int n = 0; n < 2; ++n) _Pragma("unroll") for (int k = 0; k < 2; ++k) \
        acc[ai][bj][m][n] = __builtin_amdgcn_mfma_f32_16x16x32_bf16(__builtin_bit_cast(bf16x8, k ? (i32x4)Bt[n].hi : (i32x4)Bt[n].lo), __builtin_bit_cast(bf16x8, k ? (i32x4)At[m].hi : (i32x4)At[m].lo), acc[ai][bj][m][n], 0, 0, 0); __builtin_amdgcn_s_setprio(0); } while (0)
#define PG8_MMA8(ai, bj, At, Bt) do { __builtin_amdgcn_s_setprio(1); _Pragma("unroll") for (int m = 0; m < 4; ++m) _Pragma("unroll") for (int n = 0; n < 2; ++n) { \
        asm volatile("v_mfma_f32_16x16x128_f8f6f4 %0, %1, %2, %0" : "+v"(acc[ai][bj][m][n]) : "v"(Bt[n]), "v"(At[m])); } \
        __builtin_amdgcn_s_setprio(0); } while (0)
#define PG8_MM(ai, bj, At, Bt) do { if constexpr (Sched::FP8) PG8_MMA8(ai, bj, At, Bt); else PG8_MMA(ai, bj, At, Bt); } while (0)
#define PG8_WAIT_V(n) asm volatile("s_waitcnt vmcnt(" #n ")" ::: "memory")
#define PG8_WAIT_L(n) asm volatile("s_waitcnt lgkmcnt(" #n ")" ::: "memory")
#define PG8_BAR __builtin_amdgcn_s_barrier()
#define PG8_SCHED __builtin_amdgcn_sched_barrier(0)
    Unit cur, nxt; int ui = 0;
    if (!S.next(0, cur)) return;
    f32x4 acc[2][2][4][2];
#pragma unroll
    for (int a = 0; a < 2; ++a)
#pragma unroll
        for (int b = 0; b < 2; ++b)
#pragma unroll
            for (int m = 0; m < 4; ++m)
#pragma unroll
                for (int n = 0; n < 2; ++n) acc[a][b][m][n] = (f32x4){0.f, 0.f, 0.f, 0.f};
    i32x8 At[4], B0[2], B1[2];
    unsigned aoC[2][2], aoN[2][2], rawN[2][2];
    S.a_raw(cur, sR, rawN); S.a_fin(sC, rawN, aoC);
    const char* const Ab = S.a_base();
    const char* cB = S.b_ptr(cur);
    PG8_STAGE(PG8_SB(0, 0), cB, voffB); PG8_STAGE(PG8_SB(0, 1), cB + hstep, voffB); PG8_STAGE(PG8_SA(0, 0), Ab, aoC[0]); PG8_STAGE(PG8_SA(0, 1), Ab, aoC[1]);
    if (wr == 1) PG8_BAR;
    PG8_WAIT_V(2); PG8_BAR;
    PG8_STAGE(PG8_SB(1, 0), cB + kstep, voffB); PG8_STAGE(PG8_SA(1, 0), Ab + kstep, aoC[0]); PG8_STAGE(PG8_SB(1, 1), cB + hstep + kstep, voffB);
    PG8_WAIT_V(6); PG8_BAR;
    for (;;) {
        const bool has_next = S.next(ui + 1, nxt);
        const char* nB = cB;
        LAS unsigned char* const lpre = lds + (ui & 1) * 5120;
        if constexpr (Epi::PRE) E.pre_issue(cur, lpre, wid, lane);
        if (has_next) { S.a_raw(nxt, sR, rawN); nB = S.b_ptr(nxt); }
#pragma unroll
        for (int h = 0; h < 2; ++h)
#pragma unroll
            for (int i = 0; i < 2; ++i) aoN[h][i] = aoC[h][i];
        for (int t = 0; t < nt; t += 2) {
            const bool last = (t == nt - 2);
            const char* a1 = Ab + (size_t)(t + 1) * kstep;
            const char* a2 = last ? Ab : Ab + (size_t)(t + 2) * kstep; const char* b2 = last ? nB : cB + (size_t)(t + 2) * kstep;
            const char* a3 = a2 + kstep; const char* b3 = b2 + kstep;
            if (last && has_next) {
#pragma unroll
                for (int h = 0; h < 2; ++h)
#pragma unroll
                    for (int i = 0; i < 2; ++i) asm volatile("" : "+v"(rawN[h][i]));
                S.a_fin(sC, rawN, aoN); }
            unsigned o2[2][2];
#pragma unroll
            for (int h = 0; h < 2; ++h)
#pragma unroll
                for (int i = 0; i < 2; ++i) o2[h][i] = last ? aoN[h][i] : aoC[h][i];
            PG8_LDB(B0, 0, 0); PG8_LDB(B1, 0, 1); PG8_SCHED; PG8_LDA(At, 0, 0); PG8_STAGE(PG8_SA(1, 1), a1, aoC[1]);
            PG8_WAIT_V(8); PG8_WAIT_L(0); PG8_BAR; PG8_MM(0, 0, At, B0); PG8_MM(0, 1, At, B1); PG8_BAR; PG8_SCHED;
            PG8_LDA(At, 0, 1); PG8_STAGE(PG8_SB(0, 0), b2, voffB); PG8_STAGE(PG8_SB(0, 1), b2 + hstep, voffB); PG8_STAGE(PG8_SA(0, 0), a2, o2[0]);
            PG8_WAIT_V(8); PG8_WAIT_L(0); PG8_BAR; PG8_MM(1, 0, At, B0); PG8_MM(1, 1, At, B1); PG8_BAR; PG8_SCHED;
            PG8_LDB(B0, 1, 0); PG8_LDB(B1, 1, 1); PG8_SCHED; PG8_LDA(At, 1, 0); PG8_STAGE(PG8_SA(0, 1), a2, o2[1]);
            PG8_WAIT_V(8); PG8_WAIT_L(0); PG8_BAR; PG8_MM(0, 0, At, B0); PG8_MM(0, 1, At, B1); PG8_BAR; PG8_SCHED;
            PG8_LDA(At, 1, 1); PG8_STAGE(PG8_SB(1, 0), b3, voffB); PG8_STAGE(PG8_SB(1, 1), b3 + hstep, voffB); PG8_STAGE(PG8_SA(1, 0), a3, o2[0]);
            PG8_WAIT_V(8); PG8_WAIT_L(0); PG8_BAR; PG8_MM(1, 0, At, B0); PG8_MM(1, 1, At, B1); PG8_BAR; PG8_SCHED;
        }
        if constexpr (Sched::FP8) asm volatile("s_nop 15\n\ts_nop 7" ::: "memory");
        if (wr == 0) PG8_BAR;
        { int ln_ = lane; asm volatile("" : "+v"(ln_));
          E(acc, cur, wr, wc, ln_ & 15, ln_ >> 4, lpre); }
        if (!has_next) break;
#pragma unroll
        for (int a = 0; a < 2; ++a)
#pragma unroll
            for (int b = 0; b < 2; ++b)
#pragma unroll
                for (int m = 0; m < 4; ++m)
#pragma unroll
                    for (int n = 0; n < 2; ++n) acc[a][b][m][n] = (f32x4){0.f, 0.f, 0.f, 0.f};
        cur = nxt; cB = nB; ++ui;
#pragma unroll
        for (int h = 0; h < 2; ++h)
#pragma unroll
            for (int i = 0; i < 2; ++i) aoC[h][i] = aoN[h][i];
        if (wr == 1) PG8_BAR;
    }
    PG8_WAIT_V(0);
    PG8_BAR;
#undef PG8_SA
#undef PG8_SB
#undef PG8_STAGE
#undef PG8_LDA
#undef PG8_LDB
#undef PG8_MMA
#undef PG8_MMA8
#undef PG8_MM
#undef PG8_WAIT_V
#undef PG8_WAIT_L
#undef PG8_BAR
#undef PG8_SCHED
}

struct EpiProj {
    static constexpr bool PERM = true, PRE = true;
    bf16_t* O; bf16_t* XA; const float* cw; const float* cb;
    static constexpr int PRE_OFF = 147456 + 1024;
    __device__ __forceinline__ void pre_issue(const Unit& u, LAS unsigned char* lds, int wid, int lane) const {
        if (u.pn >= 4 && wid < 5) { const float* src = (wid < 4 ? cw + wid * 1792 : cb) + (u.pn * BM - COL_XS); int l4 = lane; asm volatile("" : "+v"(l4)); l4 *= 4;
            __builtin_amdgcn_global_load_lds((const unsigned*)(src + l4), (LAS unsigned*)(lds + PRE_OFF + wid * 1024), 16, 0, 0); } }
#define FMAC_DPP(v_, x_, w_, ctrl_) asm("v_fmac_f32_dpp %0, %1, %2 " ctrl_ " row_mask:0xf bank_mask:0xf bound_ctrl:1" : "+v"(v_) : "v"(x_), "v"(w_))
    __device__ __forceinline__ void operator()(const f32x4 (&acc)[2][2][4][2], const Unit& u, int wr, int wc, int fr, int fq, LAS unsigned char* lds) const {
        const int row0 = u.pm * BM + wr * 64 + fr, col0 = u.pn * BM + wc * 32 + 8 * fq;
        if (u.pn < 4) {
#pragma unroll
            for (int ai = 0; ai < 2; ++ai)
#pragma unroll
                for (int m = 0; m < 4; ++m) { const int row = row0 + ai * HALF + m * 16; bf16_t* rowp = O + (size_t)row * NPROJ + col0;
#pragma unroll
                    for (int bj = 0; bj < 2; ++bj) { f32x4 v0 = acc[ai][bj][m][0], v1 = acc[ai][bj][m][1];
                        if (u.pn >= 1) {
                            const f32x4 t0 = v0 * (-1.4426950408889634f), t1 = v1 * (-1.4426950408889634f); f32x4 e0, e1;
#pragma unroll
                            for (int e = 0; e < 4; ++e) { e0[e] = __builtin_amdgcn_exp2f(t0[e]); e1[e] = __builtin_amdgcn_exp2f(t1[e]); }
                            e0 = e0 + 1.0f; e1 = e1 + 1.0f;
#pragma unroll
                            for (int e = 0; e < 4; ++e) { e0[e] = __builtin_amdgcn_rcpf(e0[e]); e1[e] = __builtin_amdgcn_rcpf(e1[e]); }
                            v0 = v0 * e0; v1 = v1 * e1; }
                        u32x4 w; w.x = cvt_pk_bf16(v0[0], v0[1]); w.y = cvt_pk_bf16(v0[2], v0[3]); w.z = cvt_pk_bf16(v1[0], v1[1]); w.w = cvt_pk_bf16(v1[2], v1[3]);
                        __builtin_nontemporal_store(w, (u32x4*)(rowp + bj * HALF)); } }
        } else {
            const int xc0 = col0 - COL_XS;
#pragma unroll
            for (int bj = 0; bj < 2; ++bj) {
#pragma unroll
                for (int ai = 0; ai < 2; ++ai) {
                    __builtin_amdgcn_sched_barrier(0);
                    unsigned pkc[4][2][2], pkr[2][2][2];
#pragma unroll
                    for (int n = 0; n < 2; ++n) {
                        const int lc = PRE_OFF + (bj * HALF + wc * 32 + 8 * fq + 4 * n) * 4;
                        f32x4 w[4]; const f32x4 bs = *(const LAS f32x4*)(lds + lc + 4 * 1024);
#pragma unroll
                        for (int j = 0; j < 4; ++j) w[j] = *(const LAS f32x4*)(lds + lc + j * 1024);
#pragma unroll
                        for (int m = 0; m < 4; ++m) { float o[4]; const f32x4 x = acc[ai][bj][m][n];
#pragma unroll
                            for (int ep = 0; ep < 2; ++ep) {
                                f32x2 v2 = (f32x2){bs[2 * ep], bs[2 * ep + 1]} + (f32x2){w[3][2 * ep], w[3][2 * ep + 1]} * (f32x2){x[2 * ep], x[2 * ep + 1]};
#pragma unroll
                                for (int h = 0; h < 2; ++h) { const int e = 2 * ep + h; float v = v2[h];
                                    FMAC_DPP(v, x[e], w[2][e], "row_shr:1"); FMAC_DPP(v, x[e], w[1][e], "row_shr:2"); FMAC_DPP(v, x[e], w[0][e], "row_shr:3");
                                    if (m > 0) { const float xp = acc[ai][bj][m > 0 ? m - 1 : 0][n][e]; FMAC_DPP(v, xp, w[2][e], "row_shl:15"); FMAC_DPP(v, xp, w[1][e], "row_shl:14"); FMAC_DPP(v, xp, w[0][e], "row_shl:13"); }
                                    v2[h] = v; }
                                const f32x2 t = v2 * (-1.4426950408889634f); const f32x2 ex = (f32x2){__builtin_amdgcn_exp2f(t[0]), __builtin_amdgcn_exp2f(t[1])};
                                const f32x2 d = ex + 1.0f; const f32x2 r = (f32x2){__builtin_amdgcn_rcpf(d[0]), __builtin_amdgcn_rcpf(d[1])};
                                const f32x2 q = v2 * r; o[2 * ep] = q[0]; o[2 * ep + 1] = q[1]; }
                            pkc[m][n][0] = cvt_pk_bf16(o[0], o[1]); pkc[m][n][1] = cvt_pk_bf16(o[2], o[3]);
                            if (m == 0 || m == 3) { pkr[m ? 1 : 0][n][0] = cvt_pk_bf16(x[0], x[1]); pkr[m ? 1 : 0][n][1] = cvt_pk_bf16(x[2], x[3]); } }
                    }
#pragma unroll
                    for (int m = 0; m < 4; ++m) { const int row = row0 + ai * HALF + m * 16;
                        u32x4 pc; pc.x = pkc[m][0][0]; pc.y = pkc[m][0][1]; pc.z = pkc[m][1][0]; pc.w = pkc[m][1][1];
                        bf16_t* xp = XA + (size_t)row * 1792 + xc0 + bj * HALF;
                        if (m == 0 || m == 3) {
                            u32x4 pw; pw.x = pkr[m ? 1 : 0][0][0]; pw.y = pkr[m ? 1 : 0][0][1]; pw.z = pkr[m ? 1 : 0][1][0]; pw.w = pkr[m ? 1 : 0][1][1];
                            bf16_t* rp = O + (size_t)row * NPROJ + col0 + bj * HALF;
                            if (m == 0) { if (fr >= 3) __builtin_nontemporal_store(pc, (u32x4*)xp); else *(u32x4*)rp = pw; }
                            else { __builtin_nontemporal_store(pc, (u32x4*)xp); if (fr >= 13) *(u32x4*)rp = pw; }
                        } else __builtin_nontemporal_store(pc, (u32x4*)xp);
                    }
                }
            }
        }
    }
};
struct EpiX1 {
    static constexpr bool PERM = true, PRE = false;
    const float* x; const float* mod; bf16_t* x1; float* ss16;
    __device__ __forceinline__ void operator()(const f32x4 (&acc)[2][2][4][2], const Unit& u, int wr, int wc, int fr, int fq, LAS unsigned char* lds) const {
        const int row0 = u.pm * BM + wr * 64 + fr, col0 = u.pn * BM + wc * 32 + 8 * fq; const int b = (u.pm * BM) >> 11;
        f32x4 gv[2][2];
#pragma unroll
        for (int bj = 0; bj < 2; ++bj)
#pragma unroll
            for (int n = 0; n < 2; ++n) gv[bj][n] = *(const f32x4*)(mod + (size_t)b * 6144 + 2 * 1024 + col0 + bj * HALF + n * 4);
#pragma unroll
        for (int ai = 0; ai < 2; ++ai) {
            f32x4 xa[4][2], xb[4][2];
#pragma unroll
            for (int m = 0; m < 4; ++m) { const size_t off = (size_t)(row0 + ai * HALF + m * 16) * DM + col0;
#pragma unroll
                for (int bj = 0; bj < 2; ++bj) { xa[m][bj] = *(const f32x4*)(x + off + bj * HALF); xb[m][bj] = *(const f32x4*)(x + off + bj * HALF + 4); } }
#pragma unroll
            for (int m = 0; m < 4; ++m) { const int row = row0 + ai * HALF + m * 16; const size_t off = (size_t)row * DM + col0; float ss = 0.f;
#pragma unroll
                for (int bj = 0; bj < 2; ++bj) {
                    const f32x4 o0 = xa[m][bj] + gv[bj][0] * acc[ai][bj][m][0], o1 = xb[m][bj] + gv[bj][1] * acc[ai][bj][m][1];
                    u32x4 w; w.x = cvt_pk_bf16(o0[0], o0[1]); w.y = cvt_pk_bf16(o0[2], o0[3]); w.z = cvt_pk_bf16(o1[0], o1[1]); w.w = cvt_pk_bf16(o1[2], o1[3]);
                    *(u32x4*)(x1 + off + bj * HALF) = w;
                    ss += ((o0[0] * o0[0] + o0[1] * o0[1]) + (o0[2] * o0[2] + o0[3] * o0[3])) + ((o1[0] * o1[0] + o1[1] * o1[1]) + (o1[2] * o1[2] + o1[3] * o1[3])); }
                ss += __shfl_xor(ss, 16); ss += __shfl_xor(ss, 32);
                if (fq == 0) ss16[(size_t)(u.pn * 4 + wc) * T + row] = ss; }
        }
    }
};
struct EpiAct {
    static constexpr bool PERM = true, PRE = false;
    unsigned char* act;
    __device__ __forceinline__ void operator()(const f32x4 (&acc)[2][2][4][2], const Unit& u, int wr, int wc, int fr, int fq, LAS unsigned char* lds) const {
        const int row0 = u.pm * BM + wr * 64 + fr, col0 = u.pn * HALF + wc * 32 + 8 * fq; const int odd = fq & 1;
#pragma unroll
        for (int ai = 0; ai < 2; ++ai)
#pragma unroll
            for (int mp = 0; mp < 2; ++mp) { u32x2 w[2];
#pragma unroll
                for (int mm = 0; mm < 2; ++mm) { const int m = 2 * mp + mm; float o[8];
#pragma unroll
                    for (int n = 0; n < 2; ++n)
#pragma unroll
                        for (int ip = 0; ip < 2; ++ip) {
                            const f32x2 A2 = (f32x2){acc[ai][0][m][n][2 * ip], acc[ai][0][m][n][2 * ip + 1]}, B2 = (f32x2){acc[ai][1][m][n][2 * ip], acc[ai][1][m][n][2 * ip + 1]};
                            const f32x2 t = A2 * (-W_F8_INV * 1.4426950408889634f); const f32x2 e = (f32x2){__builtin_amdgcn_exp2f(t[0]), __builtin_amdgcn_exp2f(t[1])};
                            const f32x2 d = e * (W_F8_SCALE * W_F8_SCALE) + (W_F8_SCALE * W_F8_SCALE); const f32x2 r = (f32x2){__builtin_amdgcn_rcpf(d[0]), __builtin_amdgcn_rcpf(d[1])};
                            const f32x2 q = (A2 * B2) * r; o[n * 4 + 2 * ip] = q[0]; o[n * 4 + 2 * ip + 1] = q[1]; }
                    w[mm].x = cvt_pk4_fp8(o[0], o[1], o[2], o[3]); w[mm].y = cvt_pk4_fp8(o[4], o[5], o[6], o[7]); }
                const auto sx = __builtin_amdgcn_permlane16_swap(w[0].x, w[1].x, false, false), sy = __builtin_amdgcn_permlane16_swap(w[0].y, w[1].y, false, false);
                u32x4 v; v.x = sx[0]; v.y = sy[0]; v.z = sx[1]; v.w = sy[1];
                *(u32x4*)(act + (size_t)(row0 + ai * HALF + (2 * mp + odd) * 16) * FF + col0 - 8 * odd) = v; }
    }
};
struct EpiY {
    static constexpr bool PERM = true, PRE = true;
    const unsigned* list; const float* gates; unsigned char* Y0; unsigned char* Y1;
    static constexpr int PRE_OFF = 147456 + 1024;
    __device__ __forceinline__ void pre_issue(const Unit& u, LAS unsigned char* lds, int wid, int lane) const {
        if (wid < 2) { const unsigned* src = (wid == 0 ? list : (const unsigned*)gates) + (size_t)u.e * ECAP + u.slot0; int l4 = lane; asm volatile("" : "+v"(l4)); l4 *= 4;
            __builtin_amdgcn_global_load_lds(src + l4, (LAS unsigned*)(lds + PRE_OFF + wid * 1024), 16, 0, 0); } }
    __device__ __forceinline__ void operator()(const f32x4 (&acc)[2][2][4][2], const Unit& u, int wr, int wc, int fr, int fq, LAS unsigned char* lds) const {
        const int col0 = u.pn * BM + wc * 32 + 8 * fq; const int odd = fq & 1;
        unsigned ent[2][4]; float gt[2][4];
#pragma unroll
        for (int ai = 0; ai < 2; ++ai)
#pragma unroll
            for (int m = 0; m < 4; ++m) { const int r = ai * HALF + wr * 64 + m * 16 + fr; ent[ai][m] = *(const LAS unsigned*)(lds + PRE_OFF + r * 4); gt[ai][m] = *(const LAS float*)(lds + PRE_OFF + 1024 + r * 4); }
#pragma unroll
        for (int ai = 0; ai < 2; ++ai)
#pragma unroll
            for (int m = 0; m < 4; ++m) { const int r = ai * HALF + wr * 64 + m * 16 + fr;
                const unsigned tok = ent[ai][m] >> 1; const float gate = gt[ai][m] * W_F8_INV; u32x2 w[2];
#pragma unroll
                for (int bj = 0; bj < 2; ++bj) { const f32x4 v0 = acc[ai][bj][m][0] * gate, v1 = acc[ai][bj][m][1] * gate;
                    w[bj].x = cvt_pk4_fp8(v0[0], v0[1], v0[2], v0[3]); w[bj].y = cvt_pk4_fp8(v1[0], v1[1], v1[2], v1[3]); }
                const auto sx = __builtin_amdgcn_permlane16_swap(w[0].x, w[1].x, false, false), sy = __builtin_amdgcn_permlane16_swap(w[0].y, w[1].y, false, false);
                u32x4 v; v.x = sx[0]; v.y = sy[0]; v.z = sx[1]; v.w = sy[1];
                if (r < u.cnt) *(u32x4*)(((ent[ai][m] & 1u) ? Y1 : Y0) + (size_t)tok * DM + col0 + (odd ? HALF - 8 : 0)) = v; }
    }
};
}

struct Frame {
    unsigned char* lds; int tid, lane, wave, vcu, G, gw, NGW;
};

struct TrItem { const float* src; bf16_t* dst; int ldw, nrel, K, f8; };
__device__ __forceinline__ void tr_load(const TrItem& t, int lane, f32x4 (&v)[8]) {
    const int c4 = (lane & 7) * 4;
#pragma unroll
    for (int i = 0; i < 8; ++i) { const int kk = (lane >> 3) + 8 * i; v[i] = (c4 < t.nrel) ? __builtin_nontemporal_load((const f32x4*)(t.src + (size_t)kk * t.ldw + c4)) : (f32x4){0.f, 0.f, 0.f, 0.f}; }
}
__device__ __forceinline__ void tr_to_lds(const f32x4 (&v)[8], float* scr, int lane) {
    const int c4 = (lane & 7) * 4;
#pragma unroll
    for (int i = 0; i < 8; ++i) { const int kk = (lane >> 3) + 8 * i; float* p = scr + kk * 33 + c4; p[0] = v[i][0]; p[1] = v[i][1]; p[2] = v[i][2]; p[3] = v[i][3]; }
    asm volatile("s_waitcnt lgkmcnt(0)" ::: "memory");
}
__device__ __forceinline__ void tr_store(const TrItem& t, const float* scr, int lane) {
    const int c = lane & 7;
#pragma unroll
    for (int j = 0; j < 4; ++j) { const int n = (lane >> 3) + 8 * j; const float* s = scr + (8 * c) * 33 + n;
        u32x4 o; o.x = cvt_pk_bf16(s[0 * 33], s[1 * 33]); o.y = cvt_pk_bf16(s[2 * 33], s[3 * 33]); o.z = cvt_pk_bf16(s[4 * 33], s[5 * 33]); o.w = cvt_pk_bf16(s[6 * 33], s[7 * 33]);
        if (t.f8) { u32x2 o8; o8.x = cvt_pk4_fp8(s[0 * 33] * pg8::W_F8_SCALE, s[1 * 33] * pg8::W_F8_SCALE, s[2 * 33] * pg8::W_F8_SCALE, s[3 * 33] * pg8::W_F8_SCALE);
            o8.y = cvt_pk4_fp8(s[4 * 33] * pg8::W_F8_SCALE, s[5 * 33] * pg8::W_F8_SCALE, s[6 * 33] * pg8::W_F8_SCALE, s[7 * 33] * pg8::W_F8_SCALE);
            __builtin_nontemporal_store(o8, (u32x2*)((unsigned char*)t.dst + (size_t)n * t.K + 8 * c)); }
        else *(u32x4*)(t.dst + (size_t)n * t.K + 8 * c) = o; }
    asm volatile("s_waitcnt lgkmcnt(0)" ::: "memory");
}
constexpr int TR_I0 = 16 * 80, TR_I1 = 16 * 32, TR_I2 = 32 * 16 * 32, TR_I3 = 32 * 8 * 32, TR_NIT = TR_I0 + TR_I1 + TR_I2 + TR_I3, TR_MOVE13 = 4096;
__device__ __forceinline__ void tr_run(const Frame& F, const Params& P, int it_lo, int it_hi) {
    unsigned char* ws = P.ws;
    float* scr = (float*)(F.lds + F.wave * 16384);
    const float* w_in = P.in[4]; const float* w_out = P.in[13]; const float* w13 = P.in[18]; const float* w2 = P.in[19];
    bf16_t* WIN = (bf16_t*)(ws + WS_WIN); bf16_t* WOUT = (bf16_t*)(ws + WS_WOUT); bf16_t* W13 = (bf16_t*)(ws + WS_W13); bf16_t* W2 = (bf16_t*)(ws + WS_W2);
    constexpr int I0 = TR_I0, I1 = TR_I1, I2 = TR_I2;
    auto decode = [&](int it) -> TrItem {
        TrItem t; int r = it;
        if (r < I0) { const int kb = r / 80, nb = 8 + r % 80, n0 = nb * 32; t.src = w_in + (size_t)kb * 64 * NPROJ_REAL + n0; t.ldw = NPROJ_REAL; t.nrel = NPROJ_REAL - n0; t.dst = WIN + (size_t)n0 * 1024 + kb * 64; t.K = 1024; t.f8 = 0; return t; } r -= I0;
        if (r < I1) { const int kb = r / 32, nb = r % 32, n0 = nb * 32; t.src = w_out + (size_t)kb * 64 * 1024 + n0; t.ldw = 1024; t.nrel = 32; t.dst = WOUT + (size_t)n0 * 1024 + kb * 64; t.K = 1024; t.f8 = 0; return t; } r -= I1;
        if (r < I2) { const int e = r / 512, q = r % 512, kb = q / 32, nb = q % 32; const int n0 = nb * 32, bj = n0 >> 9, rem = n0 & 511, pn = rem >> 7, j0 = rem & 127;
            t.src = w13 + (size_t)e * 1024 * 1024 + (size_t)kb * 64 * 1024 + n0; t.ldw = 1024; t.nrel = 32; t.dst = (bf16_t*)((unsigned char*)W13 + (size_t)e * 1024 * 1024 + (size_t)(pn * 256 + bj * 128 + j0) * 1024 + kb * 64); t.K = 1024; t.f8 = 1; return t; } r -= I2;
        { const int e = r / 256, q = r % 256, kb = q / 32, nb = q % 32, n0 = nb * 32;
            t.src = w2 + (size_t)e * 512 * 1024 + (size_t)kb * 64 * 1024 + n0; t.ldw = 1024; t.nrel = 32; t.dst = (bf16_t*)((unsigned char*)W2 + (size_t)e * 1024 * 512 + (size_t)n0 * 512 + kb * 64); t.K = 512; t.f8 = 1; return t; }
    };
    int it = it_lo + F.gw; f32x4 v[8]; TrItem cur;
    if (it < it_hi) { cur = decode(it); tr_load(cur, F.lane, v); }
    while (it < it_hi) {
        tr_to_lds(v, scr, F.lane);
        const int nx = it + F.NGW; TrItem nxt = cur;
        if (nx < it_hi) { nxt = decode(nx); tr_load(nxt, F.lane, v); }
        tr_store(cur, scr, F.lane);
        cur = nxt; it = nx;
    }
}
__device__ __forceinline__ void p0_prep(const Frame& F, const Params& P) {
    unsigned char* ws = P.ws;
    {
        float* sct = (float*)F.lds;
        const float* c = P.in[1];
        for (int i0 = 0; i0 < 64; i0 += 16) { float cv[16];
#pragma unroll
            for (int i = 0; i < 16; ++i) cv[i] = c[F.tid + (i0 + i) * NTHREADS];
#pragma unroll
            for (int i = 0; i < 16; ++i) { const int idx = F.tid + (i0 + i) * NTHREADS; const int b = idx >> 10, k = idx & 1023; sct[k * 32 + (((b & ~3) ^ ((k & 7) << 2)) | (b & 3))] = siluf_(cv[i]); } }
        __syncthreads();
        const float* w_ada = P.in[2]; const float* b_ada = P.in[3]; float* mod = (float*)(ws + WS_MOD);
        for (int cg = F.vcu; cg < 256; cg += F.G) {
            const int j = F.tid % 24, kg = F.tid / 24;
            float acc[32];
#pragma unroll
            for (int b = 0; b < 32; ++b) acc[b] = 0.f;
            if (kg < 16) {
                for (int kb = 0; kb < 4; ++kb) { float wv[16];
#pragma unroll
                    for (int kk = 0; kk < 16; ++kk) wv[kk] = __builtin_nontemporal_load(w_ada + (size_t)(kg * 64 + kb * 16 + kk) * 6144 + cg * 24 + j);
#pragma unroll
                    for (int kk = 0; kk < 16; ++kk) { const int k = kg * 64 + kb * 16 + kk; const float w = wv[kk];
#pragma unroll
                        for (int q = 0; q < 8; ++q) { const f32x4 s = *(const f32x4*)(sct + k * 32 + ((4 * q) ^ ((k & 7) << 2))); acc[4 * q] += s[0] * w; acc[4 * q + 1] += s[1] * w; acc[4 * q + 2] += s[2] * w; acc[4 * q + 3] += s[3] * w; } } }
            }
            float* px = (float*)(F.lds + 131072);
            float tot[2] = {0.f, 0.f};
#pragma unroll 1
            for (int half = 0; half < 2; ++half) {
                if (kg < 16 && (kg >> 3) == half) {
#pragma unroll
                    for (int b = 0; b < 32; ++b) px[b * 192 + (kg & 7) * 24 + j] = acc[b];
                }
                __syncthreads();
#pragma unroll
                for (int r = 0; r < 2; ++r) { const int o = F.tid + r * 512; if (o < 768) { float s = 0.f;
#pragma unroll
                        for (int q = 0; q < 8; ++q) s += px[(o / 24) * 192 + q * 24 + (o % 24)]; tot[r] += s; } }
                __syncthreads();
            }
#pragma unroll
            for (int r = 0; r < 2; ++r) { const int o = F.tid + r * 512; if (o < 768) { const int jj = o % 24, b = o / 24; mod[(size_t)b * 6144 + cg * 24 + jj] = tot[r] + b_ada[cg * 24 + jj]; } }
        }
        __syncthreads();
    }
    tr_run(F, P, 0, TR_I0 + TR_I1 + TR_I2 - TR_MOVE13);
    {
        const float* w_in = P.in[4]; const float* w_pool = P.in[5]; const float* pscale = P.in[6]; bf16_t* WIN = (bf16_t*)(ws + WS_WIN);
        typedef const __attribute__((address_space(4))) float* cfp_t;
        for (int idx = F.vcu * NTHREADS + F.tid; idx < 256 * 1024; idx += F.G * NTHREADS) {
            const int n = __builtin_amdgcn_readfirstlane(idx >> 10), k = idx & 1023, g = n >> 6, d = n & 63;
            const float* wi = w_in + (size_t)k * NPROJ_REAL + g * 64; cfp_t wp = (cfp_t)(w_pool + (size_t)g * 4096 + d);
            float s = 0.f;
#pragma unroll
            for (int cb = 0; cb < 64; cb += 32) { f32x4 wv[8];
#pragma unroll
                for (int i = 0; i < 8; ++i) wv[i] = *(const f32x4*)(wi + cb + 4 * i);
#pragma unroll
                for (int i = 0; i < 8; ++i)
#pragma unroll
                    for (int e = 0; e < 4; ++e) s += wv[i][e] * wp[(cb + 4 * i + e) * 64]; }
            s *= pscale[n];
            WIN[(size_t)n * 1024 + k] = (bf16_t)(cvt_pk_bf16(s, 0.f) & 0xffffu);
        }
    }
    {
        const float* wg = P.in[14]; const float* wrt = P.in[16]; bf16_t* WRH = (bf16_t*)(ws + WS_WR); bf16_t* WRL = (bf16_t*)(ws + WS_WR + 131072);
        { const float* w_in = P.in[4]; float* WDT = (float*)(ws + WS_WDT); for (int idx = F.vcu * NTHREADS + F.tid; idx < 12 * 1024; idx += F.G * NTHREADS) { const int j = idx >> 10, k = idx & 1023; WDT[idx] = w_in[(size_t)k * NPROJ_REAL + COL_DT + j]; } }
        for (int idx = F.vcu * NTHREADS + F.tid; idx < 36 * 1024; idx += F.G * NTHREADS) { const int j = idx >> 10, k = idx & 1023; const float w = (j < 4) ? wg[k * 4 + j] : wrt[k * 32 + (j - 4)];
            const unsigned hi = cvt_pk_bf16(w, 0.f) & 0xffffu; const float lo = w - __uint_as_float(hi << 16); WRH[idx] = (bf16_t)hi; WRL[idx] = (bf16_t)(cvt_pk_bf16(lo, 0.f) & 0xffffu); }
    }
}

__device__ __forceinline__ void p1_modulate(const Frame& F, const Params& P) {
    const float* x = P.in[0]; const float* mod = (const float*)(P.ws + WS_MOD); bf16_t* H = (bf16_t*)(P.ws + WS_H); float* dtraw = (float*)(P.ws + WS_DTRAW);
    float* wdt = (float*)F.lds;
    { f32x4 wt[6];
#pragma unroll
      for (int i = 0; i < 6; ++i) wt[i] = ((const f32x4*)(P.ws + WS_WDT))[F.tid + i * NTHREADS];
#pragma unroll
      for (int i = 0; i < 6; ++i) ((f32x4*)wdt)[F.tid + i * NTHREADS] = wt[i]; }
    __syncthreads();
    const int lane = F.lane;
    const int WPB = F.NGW / BATCH, bw = F.gw / WPB, wl = F.gw - bw * WPB, rstep = WPB * 2;
    const int rbeg = bw * SEQ + wl * 2, rend = (bw + 1) * SEQ;
    f32x4 v[2][4], vn[2][4], a[4], m[4];
    if (bw < BATCH) { const f32x4* sh = (const f32x4*)(mod + (size_t)bw * 6144) + lane; const f32x4* sc = (const f32x4*)(mod + (size_t)bw * 6144 + 1024) + lane;
#pragma unroll
        for (int j = 0; j < 4; ++j) { a[j] = sh[64 * j]; m[j] = sc[64 * j] + 1.0f; } }
    { const int row0 = rbeg; if (bw < BATCH && row0 < rend) {
#pragma unroll
        for (int r = 0; r < 2; ++r) { const f32x4* xr = (const f32x4*)(x + (size_t)(row0 + r) * DM) + lane;
#pragma unroll
            for (int j = 0; j < 4; ++j) v[r][j] = __builtin_nontemporal_load(xr + 64 * j); } } }
    for (int row0 = rbeg; bw < BATCH && row0 < rend; row0 += rstep) {
        float s[2] = {0.f, 0.f};
        { const int rn = row0 + rstep; if (rn < rend) {
#pragma unroll
            for (int r = 0; r < 2; ++r) { const f32x4* xr = (const f32x4*)(x + (size_t)(rn + r) * DM) + lane;
#pragma unroll
                for (int j = 0; j < 4; ++j) vn[r][j] = __builtin_nontemporal_load(xr + 64 * j); } } }
#pragma unroll
        for (int r = 0; r < 2; ++r) {
#pragma unroll
            for (int j = 0; j < 4; ++j) s[r] += (v[r][j][0] * v[r][j][0] + v[r][j][1] * v[r][j][1]) + (v[r][j][2] * v[r][j][2] + v[r][j][3] * v[r][j][3]);
            const float rstd = rsqrtf(wave_sum(s[r]) * (1.f / DM) + EPS);
            u32x2* o = (u32x2*)(H + (size_t)(row0 + r) * DM) + lane;
#pragma unroll
            for (int j = 0; j < 4; ++j) { v[r][j] = v[r][j] * rstd * m[j] + a[j]; u32x2 w; w.x = cvt_pk_bf16(v[r][j][0], v[r][j][1]); w.y = cvt_pk_bf16(v[r][j][2], v[r][j][3]); o[64 * j] = w; } }
        float pv[32];
#pragma unroll
        for (int c = 0; c < 16; ++c) { float p0 = 0.f, p1 = 0.f;
            if (c < 12) {
#pragma unroll
                for (int j = 0; j < 4; ++j) { const f32x4 w4 = *(const f32x4*)(wdt + c * 1024 + 256 * j + 4 * lane);
                    p0 += (w4[0] * v[0][j][0] + w4[1] * v[0][j][1]) + (w4[2] * v[0][j][2] + w4[3] * v[0][j][3]); p1 += (w4[0] * v[1][j][0] + w4[1] * v[1][j][1]) + (w4[2] * v[1][j][2] + w4[3] * v[1][j][3]); } }
            pv[c] = p0; pv[16 + c] = p1; }
#pragma unroll
        for (int k = 0; k < 16; ++k) { const bool hi = (lane & 16) != 0; const float mine = hi ? pv[k + 16] : pv[k], send = hi ? pv[k] : pv[k + 16]; pv[k] = mine + __shfl_xor(send, 16); }
#pragma unroll
        for (int k = 0; k < 8; ++k) { const bool hi = (lane & 8) != 0; const float mine = hi ? pv[k + 8] : pv[k], send = hi ? pv[k] : pv[k + 8]; pv[k] = mine + __shfl_xor(send, 8); }
#pragma unroll
        for (int k = 0; k < 4; ++k) { const bool hi = (lane & 4) != 0; const float mine = hi ? pv[k + 4] : pv[k], send = hi ? pv[k] : pv[k + 4]; pv[k] = mine + __shfl_xor(send, 4); }
#pragma unroll
        for (int k = 0; k < 2; ++k) { const bool hi = (lane & 2) != 0; const float mine = hi ? pv[k + 2] : pv[k], send = hi ? pv[k] : pv[k + 2]; pv[k] = mine + __shfl_xor(send, 2); }
        { const bool hi = (lane & 1) != 0; const float mine = hi ? pv[1] : pv[0], send = hi ? pv[0] : pv[1]; pv[0] = mine + __shfl_xor(send, 1); }
        const float tot = pv[0] + __shfl_xor(pv[0], 32);
        if (lane < 32 && (lane & 15) < 12) dtraw[(size_t)(row0 + (lane >> 4)) * 16 + (lane & 15)] = tot;
#pragma unroll
        for (int r = 0; r < 2; ++r)
#pragma unroll
            for (int j = 0; j < 4; ++j) v[r][j] = vn[r][j];
    }
}

template <int W>
__device__ __forceinline__ void pool_item(const bf16_t* src, bf16_t* dst, int t0) {
    u32x4 hist[W - 1], cur[16];
#pragma unroll
    for (int i = 0; i < 16; ++i) cur[i] = *(const u32x4*)(src + (size_t)i * NPROJ);
    if (t0 > 0) {
#pragma unroll
        for (int h = 0; h < W - 1; ++h) hist[h] = *(const u32x4*)(src - (size_t)(W - 1 - h) * NPROJ); }
    else {
#pragma unroll
        for (int h = 0; h < W - 1; ++h) hist[h] = (u32x4){0u, 0u, 0u, 0u}; }
#define UNP8P(dst, v) do { dst[0] = bf_lo(v.x); dst[1] = bf_hi(v.x); dst[2] = bf_lo(v.y); dst[3] = bf_hi(v.y); dst[4] = bf_lo(v.z); dst[5] = bf_hi(v.z); dst[6] = bf_lo(v.w); dst[7] = bf_hi(v.w); } while (0)
    float sum[8];
#pragma unroll
    for (int k = 0; k < 8; ++k) sum[k] = 0.f;
#pragma unroll
    for (int h = 0; h < W - 1; ++h) { float e[8]; UNP8P(e, hist[h]);
#pragma unroll
        for (int k = 0; k < 8; ++k) sum[k] += e[k]; }
#pragma unroll
    for (int i = 0; i < 16; ++i) {
        float c[8]; UNP8P(c, cur[i]);
#pragma unroll
        for (int k = 0; k < 8; ++k) sum[k] += c[k];
        if (i >= 1) { float o[8]; if (i <= W - 1) UNP8P(o, hist[i - 1 < W - 1 ? i - 1 : 0]); else UNP8P(o, cur[i - W >= 0 ? i - W : 0]);
#pragma unroll
            for (int k = 0; k < 8; ++k) sum[k] -= o[k]; }
        const int cnt = (t0 > 0) ? W : ((i + 1) < W ? (i + 1) : W); const float inv = 1.0f / (float)cnt;
        u32x4 pk; pk.x = cvt_pk_bf16(sum[0] * inv - c[0], sum[1] * inv - c[1]); pk.y = cvt_pk_bf16(sum[2] * inv - c[2], sum[3] * inv - c[3]);
        pk.z = cvt_pk_bf16(sum[4] * inv - c[4], sum[5] * inv - c[5]); pk.w = cvt_pk_bf16(sum[6] * inv - c[6], sum[7] * inv - c[7]);
        *(u32x4*)(dst + (size_t)i * DM) = pk;
    }
#undef UNP8P
}

__device__ __forceinline__ void p3_conv(const Frame& F, const Params& P) {
    const bf16_t* proj = (const bf16_t*)(P.ws + WS_PROJ); bf16_t* XA = (bf16_t*)(P.ws + WS_XA);
    const float* conv_w = P.in[7]; const float* conv_b = P.in[8];
    if (F.wave < 2) {
        const float* dtraw = (const float*)(P.ws + WS_DTRAW); float* SA = (float*)(P.ws + WS_SA);
        const float* dt_bias = P.in[9]; const float* a_log = P.in[10];
        for (int bc = F.vcu * 2 + F.wave; bc < BATCH * 16; bc += F.G * 2) {
            const int h = F.lane < 48 ? (F.lane >> 2) : 11, seg = F.lane & 3; const float a = -__expf(a_log[h]), dtb = dt_bias[h];
            const float* src = dtraw + ((size_t)bc * 128 + 32 * seg) * 16 + h;
            float raw[32], dt[32], cs[32];
#pragma unroll
            for (int j = 0; j < 32; ++j) raw[j] = src[j * 16];
            float run = 0.f;
#pragma unroll
            for (int j = 0; j < 32; ++j) { const float v = raw[j] + dtb; dt[j] = v > 20.f ? v : log1pf(__expf(v)); run += dt[j] * a; cs[j] = run; }
            const float s0 = __shfl(run, (F.lane & ~3) + 0), s1 = __shfl(run, (F.lane & ~3) + 1), s2 = __shfl(run, (F.lane & ~3) + 2), s3 = __shfl(run, (F.lane & ~3) + 3);
            const float base = (seg > 0 ? s0 : 0.f) + (seg > 1 ? s1 : 0.f) + (seg > 2 ? s2 : 0.f); const float a127 = ((s0 + s1) + s2) + s3;
            if (F.lane < 48) {
                float* dst = SA + ((size_t)bc * 4 + h / 3) * 1536 + (h % 3) * 128 + 32 * seg;
#pragma unroll
                for (int j4 = 0; j4 < 8; ++j4) { f32x4 vd, va, vw, ve;
#pragma unroll
                    for (int e = 0; e < 4; ++e) { const int j = 4 * j4 + e; const float ac = base + cs[j], ae = base + cs[j | 15]; vd[e] = dt[j]; va[e] = ac; vw[e] = dt[j] * __expf(a127 - ac); ve[e] = dt[j] * __expf(ae - ac); }
                    *(f32x4*)(dst + 4 * j4) = vd; *(f32x4*)(dst + 384 + 4 * j4) = va; *(f32x4*)(dst + 768 + 4 * j4) = vw; *(f32x4*)(dst + 1152 + 4 * j4) = ve; }
            }
        }
    }
    {
        constexpr int NITEM = (T / 64) * 224;
        for (int item = F.vcu * NTHREADS + F.tid; item < NITEM; item += F.G * NTHREADS) {
            const int cg = item % 224, jb = item / 224, ch = cg * 8, row0 = jb * 64, t0 = row0 & (SEQ - 1);
            const bf16_t* src = proj + (size_t)row0 * NPROJ + COL_XS + ch;
            u32x4 raw[6];
#pragma unroll
            for (int i = 0; i < 3; ++i) raw[3 + i] = *(const u32x4*)(src + (size_t)i * NPROJ);
            if (t0 >= 3) {
#pragma unroll
                for (int i = 0; i < 3; ++i) raw[i] = *(const u32x4*)(src - (size_t)(3 - i) * NPROJ); }
            else { raw[0] = (u32x4){0u, 0u, 0u, 0u}; raw[1] = raw[0]; raw[2] = raw[0]; }
            float w[4][8], bs[8];
#pragma unroll
            for (int j = 0; j < 4; ++j) { const f32x4 a = *(const f32x4*)(conv_w + j * 1792 + ch), c = *(const f32x4*)(conv_w + j * 1792 + ch + 4);
#pragma unroll
                for (int k = 0; k < 4; ++k) { w[j][k] = a[k]; w[j][4 + k] = c[k]; } }
            { const f32x4 a = *(const f32x4*)(conv_b + ch), c = *(const f32x4*)(conv_b + ch + 4);
#pragma unroll
                for (int k = 0; k < 4; ++k) { bs[k] = a[k]; bs[4 + k] = c[k]; } }
#define UNP8(dst, v) do { dst[0] = bf_lo(v.x); dst[1] = bf_hi(v.x); dst[2] = bf_lo(v.y); dst[3] = bf_hi(v.y); dst[4] = bf_lo(v.z); dst[5] = bf_hi(v.z); dst[6] = bf_lo(v.w); dst[7] = bf_hi(v.w); } while (0)
            float r0[8], r1[8], r2[8];
            UNP8(r0, raw[0]); UNP8(r1, raw[1]); UNP8(r2, raw[2]);
#pragma unroll
            for (int i = 0; i < 3; ++i) {
                float cur[8]; UNP8(cur, raw[3 + i]); float o[8];
#pragma unroll
                for (int k = 0; k < 8; ++k) { const float v = bs[k] + w[0][k] * r0[k] + w[1][k] * r1[k] + w[2][k] * r2[k] + w[3][k] * cur[k]; o[k] = siluf_(v); r0[k] = r1[k]; r1[k] = r2[k]; r2[k] = cur[k]; }
                u32x4 pk; pk.x = cvt_pk_bf16(o[0], o[1]); pk.y = cvt_pk_bf16(o[2], o[3]); pk.z = cvt_pk_bf16(o[4], o[5]); pk.w = cvt_pk_bf16(o[6], o[7]);
                *(u32x4*)(XA + (size_t)(row0 + i) * 1792 + ch) = pk;
            }
        }
    }
    { bf16_t* mix = (bf16_t*)(P.ws + WS_MIX);
      for (int p = F.vcu * NTHREADS + F.tid; p < (T / 16) * 32; p += F.G * NTHREADS) {
        const int c8 = p & 7, rr8 = (p >> 3) & 7, grp = (p >> 6) & 3, rrblk = p >> 8; const int rr = rrblk * 8 + rr8, row0 = rr * 16, t0 = row0 & (SEQ - 1), col = grp * 64 + c8 * 8;
        const bf16_t* src = proj + (size_t)row0 * NPROJ + col; bf16_t* dst = mix + (size_t)row0 * DM + col;
        if (grp == 0) pool_item<2>(src, dst, t0); else if (grp == 1) pool_item<4>(src, dst, t0); else if (grp == 2) pool_item<8>(src, dst, t0); else pool_item<16>(src, dst, t0);
      } }
    tr_run(F, P, TR_I0 + TR_I1 + TR_I2 - TR_MOVE13, TR_NIT);
#undef UNP8
}

constexpr int L_B = 0, L_C = 32768, L_X = 49152, L_S = 98304, L_DT = 147456, L_ACS = L_DT + 1536, L_W = L_ACS + 1536, L_ES = L_W + 1536, L_NW = L_ES + 1536, L_T = L_NW + 768;
static_assert(L_T <= LDS_BYTES - 64, "SSD LDS map");
typedef short v4i16 __attribute__((ext_vector_type(4)));
__device__ __forceinline__ int swz16(int r) { const int h = (r >> 3) & 1; return ((((r & 7) + 4 * h) & 7) << 1) | h; }
__device__ __forceinline__ int swz8(int row) { return ((row >> 1) & 3) << 1; }
__device__ __forceinline__ bf16x8 tr_pair(LAS unsigned char* a0, LAS unsigned char* a1) {
    const v4i16 lo = __builtin_amdgcn_ds_read_tr16_b64_v4i16((LAS v4i16*)a0), hi = __builtin_amdgcn_ds_read_tr16_b64_v4i16((LAS v4i16*)a1);
    return (bf16x8){lo[0], lo[1], lo[2], lo[3], hi[0], hi[1], hi[2], hi[3]};
}
__device__ __forceinline__ bf16x8 pack8(const float (&v)[8]) {
    u32x4 p; p.x = cvt_pk_bf16(v[0], v[1]); p.y = cvt_pk_bf16(v[2], v[3]); p.z = cvt_pk_bf16(v[4], v[5]); p.w = cvt_pk_bf16(v[6], v[7]);
    return __builtin_bit_cast(bf16x8, p);
}
#define MFMA16(a, b, c) __builtin_amdgcn_mfma_f32_16x16x32_bf16((a), (b), (c), 0, 0, 0)
#define OPAQUE(x) asm volatile("" : "+v"(x))
#define SBAR() do { asm volatile("s_waitcnt lgkmcnt(0)" ::: "memory"); __builtin_amdgcn_s_barrier(); asm volatile("" ::: "memory"); } while (0)

__device__ __forceinline__ int ssd_glmap(int hl, int lt) { return hl ? (lt == 0 ? 2 : (lt == 1 ? 3 : (lt == 2 ? 5 : 4))) : (lt == 0 ? 0 : (lt == 1 ? 1 : (lt == 2 ? 7 : 6))); }
#define SSD_LANE() int ln_ = lane; OPAQUE(ln_); const int i = ln_ & 15, q = ln_ >> 4, qp = i >> 2, pp = ln_ & 3; (void)qp; (void)pp
#define SSD_PR() int pr[4]; { const int fsw = swz16(i); _Pragma("unroll") for (int ks = 0; ks < 4; ++ks) { pr[ks] = i * 256 + (((4 * ks + q) ^ fsw) << 4); OPAQUE(pr[ks]); } }
__device__ __forceinline__ void ssd_stage1(LAS unsigned char* L, int lt, int hl, int lane, f32x4 (&cbt)[8]) {
    const int gl = ssd_glmap(hl, lt);
    {
        SSD_LANE(); SSD_PR();
        int cbase = lt * 4096; OPAQUE(cbase);
        bf16x8 cfrag[4];
#pragma unroll
        for (int ks = 0; ks < 4; ++ks) cfrag[ks] = *(const LAS bf16x8*)(L + L_C + cbase + pr[ks]);
#pragma unroll
        for (int tp = 0; tp < 4; ++tp) {
            f32x4 a0 = (f32x4){0.f, 0.f, 0.f, 0.f}, a1 = a0;
            if (2 * tp <= gl) {
                bf16x8 f0[4], f1[4];
#pragma unroll
                for (int ks = 0; ks < 4; ++ks) f0[ks] = *(const LAS bf16x8*)(L + L_B + (2 * tp) * 4096 + pr[ks]);
                __builtin_amdgcn_sched_barrier(0);
#pragma unroll
                for (int ks = 0; ks < 4; ++ks) f1[ks] = *(const LAS bf16x8*)(L + L_B + (2 * tp + 1) * 4096 + pr[ks]);
                __builtin_amdgcn_s_setprio(1);
#pragma unroll
                for (int ks = 0; ks < 4; ++ks) a0 = MFMA16(f0[ks], cfrag[ks], a0);
#pragma unroll
                for (int ks = 0; ks < 4; ++ks) a1 = MFMA16(f1[ks], cfrag[ks], a1);
                __builtin_amdgcn_s_setprio(0);
            }
            cbt[2 * tp] = a0; cbt[2 * tp + 1] = a1;
            __builtin_amdgcn_sched_barrier(0);
        }
    }
}
template <int CH, int ORD>
__device__ __forceinline__ void ssd_compute(LAS unsigned char* L, int lt, int hl, int lane, f32x4 (&sacc)[2][6], f32x4 (&yacc)[6], f32x4 (&cbt)[8], float dsk0, float dsk1, bool xwait) {
    const int gl = ssd_glmap(hl, lt);
    const int lrow0 = 16 * gl;
    auto st3 = [&]() __attribute__((always_inline)) {
        SSD_LANE(); SSD_PR();
        int cbase = lt * 4096; OPAQUE(cbase);
        int lq = (lrow0 + 4 * q) * 4; OPAQUE(lq);
        bf16x8 cfrag[4];
#pragma unroll
        for (int ks = 0; ks < 4; ++ks) cfrag[ks] = *(const LAS bf16x8*)(L + L_C + cbase + pr[ks]);
#pragma unroll
        for (int cp = 0; cp < 3; ++cp) { bf16x8 f0[4], f1[4];
#pragma unroll
            for (int ks = 0; ks < 4; ++ks) { f0[ks] = *(const LAS bf16x8*)(L + L_S + (96 * CH + 32 * cp) * 256 + pr[ks]); f1[ks] = *(const LAS bf16x8*)(L + L_S + (96 * CH + 32 * cp + 16) * 256 + pr[ks]); }
            f32x4 a0 = (f32x4){0.f, 0.f, 0.f, 0.f}, a1 = a0;
            __builtin_amdgcn_s_setprio(1);
#pragma unroll
            for (int ks = 0; ks < 4; ++ks) { a0 = MFMA16(cfrag[ks], f0[ks], a0); a1 = MFMA16(cfrag[ks], f1[ks], a1); }
            __builtin_amdgcn_s_setprio(0);
            yacc[2 * cp] = a0; yacc[2 * cp + 1] = a1; }
#pragma unroll
        for (int hsel = 0; hsel < 2; ++hsel) { const f32x4 ac4 = *(const LAS f32x4*)(L + L_ACS + (CH + hsel) * 512 + lq); const f32x4 e = (f32x4){__expf(ac4[0]), __expf(ac4[1]), __expf(ac4[2]), __expf(ac4[3])};
#pragma unroll
            for (int ct = 0; ct < 6; ++ct) if ((((6 * CH + ct) >> 2) - CH) == hsel) yacc[ct] = yacc[ct] * e; }
    };
    if constexpr (ORD == 1) st3();
    bf16x8 mfrag[2][4];
    {
        SSD_LANE();
        int q16 = 16 * q; OPAQUE(q16);
        int lq = (lrow0 + 4 * q) * 4; OPAQUE(lq);
        int li = (lrow0 + i) * 4; OPAQUE(li);
        int dq = i - 4 * q; OPAQUE(dq);
        float acl[2];
#pragma unroll
        for (int hsel = 0; hsel < 2; ++hsel) acl[hsel] = *(const LAS float*)(L + L_ACS + (CH + hsel) * 512 + li);
#pragma unroll
        for (int kk = 0; kk < 4; ++kk) {
            f32x4 es[2][2]; float ae[2][2];
#pragma unroll
            for (int hsel = 0; hsel < 2; ++hsel)
#pragma unroll
                for (int hf = 0; hf < 2; ++hf) { const int ts = 2 * kk + hf, r = CH + hsel; es[hsel][hf] = *(const LAS f32x4*)(L + L_ES + r * 512 + ts * 64 + q16); ae[hsel][hf] = *(const LAS float*)(L + L_ACS + r * 512 + (16 * ts + 15) * 4); }
#pragma unroll
            for (int hsel = 0; hsel < 2; ++hsel) { const int r = CH + hsel; const float dsk = hsel ? dsk1 : dsk0; float v[8];
#pragma unroll
                for (int hf = 0; hf < 2; ++hf) { const int ts = 2 * kk + hf;
                    if (ts < gl) { const float el = __expf(acl[hsel] - ae[hsel][hf]);
#pragma unroll
                        for (int j = 0; j < 4; ++j) v[4 * hf + j] = cbt[ts][j] * el * es[hsel][hf][j]; }
                    else if (ts == gl) { const f32x4 asd = *(const LAS f32x4*)(L + L_ACS + r * 512 + lq), dsd = *(const LAS f32x4*)(L + L_DT + r * 512 + lq);
#pragma unroll
                        for (int j = 0; j < 4; ++j) { const float arg = fminf(acl[hsel] - asd[j], 0.f); const float cd = cbt[ts][j] * dsd[j]; const float m = cd * __expf(arg);
                            v[4 * hf + j] = (j < dq) ? m : ((j == dq) ? (cd + dsk) : 0.f); } }
                    else {
#pragma unroll
                        for (int j = 0; j < 4; ++j) v[4 * hf + j] = 0.f; } }
                mfrag[hsel][kk] = pack8(v); }
            if (kk == 1) __builtin_amdgcn_sched_barrier(0);
        }
    }
    if constexpr (ORD == 0) st3();
#pragma unroll
    for (int hsel = 0; hsel < 2; ++hsel) { const float cd = __expf(*(const LAS float*)(L + L_ACS + (CH + hsel) * 512 + 127 * 4));
#pragma unroll
        for (int ct = 0; ct < 6; ++ct) if ((((6 * CH + ct) >> 2) - CH) == hsel) { sacc[0][ct] = sacc[0][ct] * cd; sacc[1][ct] = sacc[1][ct] * cd; } }
    __builtin_amdgcn_sched_barrier(0);
    SSD_LANE();
    int q16 = 16 * q; OPAQUE(q16);
    const int r4 = 4 * q + qp;
    int tb[2], tx[4];
    { const int fr = swz16(r4), xr = swz8(r4);
#pragma unroll
      for (int nt2 = 0; nt2 < 2; ++nt2) { tb[nt2] = r4 * 256 + 8 * (pp & 1) + (((2 * (2 * lt + nt2) + (pp >> 1)) ^ fr) << 4); OPAQUE(tb[nt2]); }
#pragma unroll
      for (int pt = 0; pt < 4; ++pt) { tx[pt] = r4 * 128 + 8 * (pp & 1) + (((2 * pt + (pp >> 1)) ^ xr) << 4); OPAQUE(tx[pt]); } }
    if (ORD == 0 && xwait) { asm volatile("s_waitcnt vmcnt(0)" ::: "memory"); SBAR(); }
#pragma unroll
    for (int kk = 0; kk < 4; ++kk) {
        bf16x8 bts[2][2];
        { bf16x8 btf[2];
#pragma unroll
          for (int nt2 = 0; nt2 < 2; ++nt2) btf[nt2] = tr_pair(L + L_B + kk * 8192 + tb[nt2], L + L_B + kk * 8192 + 4096 + tb[nt2]);
#pragma unroll
          for (int hsel = 0; hsel < 2; ++hsel) { const f32x4 wl = *(const LAS f32x4*)(L + L_W + (CH + hsel) * 512 + kk * 128 + q16), wh = *(const LAS f32x4*)(L + L_W + (CH + hsel) * 512 + kk * 128 + 64 + q16);
#pragma unroll
            for (int nt2 = 0; nt2 < 2; ++nt2) { float bs[8];
#pragma unroll
                for (int e = 0; e < 4; ++e) { bs[e] = __uint_as_float((unsigned)(unsigned short)btf[nt2][e] << 16) * wl[e]; bs[4 + e] = __uint_as_float((unsigned)(unsigned short)btf[nt2][4 + e] << 16) * wh[e]; }
                bts[hsel][nt2] = pack8(bs); } } }
        __builtin_amdgcn_sched_barrier(0);
        if (ORD == 1 && kk == 0 && xwait) { asm volatile("s_waitcnt vmcnt(0)" ::: "memory"); SBAR(); }
        bf16x8 xf[6];
#pragma unroll
        for (int ct = 0; ct < 6; ++ct) { const int ctg = 6 * CH + ct, r = ctg >> 2, pt = ctg & 3; xf[ct] = tr_pair(L + L_X + r * 16384 + kk * 4096 + tx[pt], L + L_X + r * 16384 + kk * 4096 + 2048 + tx[pt]); }
        const bool ydo = (2 * kk <= gl);
        __builtin_amdgcn_s_setprio(1);
#pragma unroll
        for (int ct = 0; ct < 6; ++ct) { const int ctg = 6 * CH + ct, r = ctg >> 2, hsel = r - CH;
            if (ydo) yacc[ct] = MFMA16(mfrag[hsel][kk], xf[ct], yacc[ct]);
            sacc[0][ct] = MFMA16(bts[hsel][0], xf[ct], sacc[0][ct]); sacc[1][ct] = MFMA16(bts[hsel][1], xf[ct], sacc[1][ct]); }
        __builtin_amdgcn_s_setprio(0);
        __builtin_amdgcn_sched_barrier(0);
    }
}

__device__ __forceinline__ void ssd_dma_bc(LAS unsigned char* L, const bf16_t* xrow, int g, int hl, int wave, int lane) {
    OPAQUE(lane);
#pragma unroll
    for (int k = 0; k < 4; ++k) { const int m = wave * 4 + k, row = 4 * m + (lane >> 4), lc = (lane & 15) ^ swz16(row & 15);
        __builtin_amdgcn_global_load_lds((const unsigned*)(xrow + 768 + g * 128 + (unsigned)(row * 1792 + lc * 8)), (LAS unsigned*)(L + L_B + m * 1024), 16, 0, 0); }
    const bf16_t* crow = xrow + 1280 + g * 128;
#pragma unroll
    for (int k = 0; k < 2; ++k) { const int m = wave * 2 + k, row = 4 * m + (lane >> 4), lc = (lane & 15) ^ swz16(row & 15); const int grow = 16 * ssd_glmap(hl, m >> 2) + (row & 15);
        __builtin_amdgcn_global_load_lds((const unsigned*)(crow + (unsigned)(grow * 1792 + lc * 8)), (LAS unsigned*)(L + L_C + m * 1024), 16, 0, 0); }
}
__device__ __forceinline__ void ssd_dma_x(LAS unsigned char* L, const bf16_t* xrow, int g, int wave, int lane) {
    OPAQUE(lane);
#pragma unroll
    for (int k = 0; k < 6; ++k) { const int m = wave * 6 + k, r = m >> 4, blk = m & 15, row = 8 * blk + (lane >> 3), lc = (lane & 7) ^ swz8(row);
        __builtin_amdgcn_global_load_lds((const unsigned*)(xrow + g * 192 + r * 64 + (unsigned)(row * 1792 + lc * 8)), (LAS unsigned*)(L + L_X + r * 16384 + blk * 1024), 16, 0, 0); }
}

__device__ __forceinline__ void p4_ssd(const Frame& F, const Params& P) {
    LAS unsigned char* L = (LAS unsigned char*)F.lds;
    const bf16_t* XA = (const bf16_t*)(P.ws + WS_XA); const float* SA = (const float*)(P.ws + WS_SA);
    const bf16_t* proj = (const bf16_t*)(P.ws + WS_PROJ); bf16_t* mix = (bf16_t*)(P.ws + WS_MIX); const float* norm_w = P.in[12]; const float* d_skip = P.in[11];
    const int lane = F.lane, lt = F.wave >> 1, ch = F.wave & 1;
    for (int u = F.vcu; u < 256; u += F.G) {
        const int b = u >> 3, g = (u >> 1) & 3, hl = u & 1;
        __syncthreads();
        { int tz = F.tid; OPAQUE(tz); unsigned zz = 0u; OPAQUE(zz);
#pragma unroll
          for (int k = 0; k < 6; ++k) *(LAS u32x4*)(L + L_S + (tz + NTHREADS * k) * 16) = (u32x4){zz, zz, zz, zz};
          if (tz < 192) *(LAS float*)(L + L_NW + tz * 4) = norm_w[g * 192 + tz]; }
        f32x4 sacc[2][6];
#pragma unroll
        for (int a = 0; a < 2; ++a)
#pragma unroll
            for (int c = 0; c < 6; ++c) sacc[a][c] = (f32x4){0.f, 0.f, 0.f, 0.f};
        const float dsk0 = d_skip[3 * g + ch], dsk1 = d_skip[3 * g + ch + 1];
        const size_t tokb = (size_t)b * SEQ;
#define SSD_ROLES int t3_ = F.tid; OPAQUE(t3_); const int orow = t3_ >> 3, oseg = t3_ & 7, oc0 = g * 192 + oseg * 24; const int ogrow = 16 * ssd_glmap(hl, orow >> 4) + (orow & 15); (void)orow; (void)oseg; (void)oc0; (void)ogrow
#define SSD_DMA_SMALL(bc_) do { if (F.wave < 6) { int ln2_ = lane; OPAQUE(ln2_); __builtin_amdgcn_global_load_lds((const unsigned*)(SA + ((size_t)(bc_) * 4 + g) * 1536 + F.wave * 256 + ln2_ * 4), (LAS unsigned*)(L + L_DT + F.wave * 1024), 16, 0, 0); } } while (0)
        ssd_dma_bc(L, XA + tokb * 1792, g, hl, F.wave, lane); ssd_dma_x(L, XA + tokb * 1792, g, F.wave, lane);
        SSD_DMA_SMALL(b * 16);
        auto chunk_loop = [&](auto ordc) __attribute__((always_inline)) { constexpr int ORD = decltype(ordc)::value;
        f32x4 cbt[8];
        asm volatile("s_waitcnt vmcnt(0)" ::: "memory");
        SBAR();
        ssd_stage1(L, lt, hl, lane, cbt);
        for (int ck = 0; ck < 16; ++ck) {
            LAS unsigned char* Lq = L; asm volatile("" : "+s"(Lq));
            { LAS unsigned char* const L = Lq;
            const size_t tok0 = tokb + ck * 128;
            if (ck < 15) { int lw = lane; OPAQUE(lw);
#pragma unroll
                for (int i = 0; i < 2; ++i) { const int idx = (F.wave * 2 + i) * 64 + lw; const int row = idx / 7, part = idx - row * 7;
                    const int col = part < 2 ? (768 + g * 128 + part * 64) : (part < 4 ? (1280 + g * 128 + (part - 2) * 64) : (g * 192 + (part - 4) * 64));
                    if (idx < 896) __builtin_amdgcn_global_load_lds((const unsigned*)(XA + (tok0 + 128 + row) * 1792 + col), (LAS unsigned*)(L + L_T + 64 + (F.wave * 2 + i) * 256), 4, 0, 0); } }
            f32x4 yacc[6];
            if (ch == 0) ssd_compute<0, ORD>(L, lt, hl, lane, sacc, yacc, cbt, dsk0, dsk1, true); else ssd_compute<1, ORD>(L, lt, hl, lane, sacc, yacc, cbt, dsk0, dsk1, true);
            SBAR();
            u32x4 zr[3];
            { SSD_ROLES; const bf16_t* zp = proj + tok0 * NPROJ + (unsigned)(ogrow * NPROJ + COL_Z + oc0);
#pragma unroll
              for (int k = 0; k < 3; ++k) zr[k] = *(const u32x4*)(zp + 8 * k); }
            if (ck < 15) {
                SSD_DMA_SMALL(b * 16 + ck + 1);
                ssd_dma_bc(L, XA + (tok0 + 128) * 1792, g, hl, F.wave, lane);
            }
            { int l2 = lane; OPAQUE(l2); const int i = l2 & 15, q = l2 >> 4;
#pragma unroll
            for (int nt2 = 0; nt2 < 2; ++nt2)
#pragma unroll
                for (int ct = 0; ct < 6; ++ct) { const f32x4 s = sacc[nt2][ct]; u32x2 pk; pk.x = cvt_pk_bf16(s[0], s[1]); pk.y = cvt_pk_bf16(s[2], s[3]);
                    const int row = 96 * ch + 16 * ct + i, n0 = 16 * (2 * lt + nt2) + 4 * q; *(LAS u32x2*)(L + L_S + row * 256 + (((n0 >> 3) ^ swz16(i)) << 4) + 8 * ((n0 >> 2) & 1)) = pk; }
#pragma unroll
            for (int j = 0; j < 4; ++j) { const int row = 16 * lt + 4 * q + j; const int rb = L_X + row * 384;
#pragma unroll
                for (int ct = 0; ct < 6; ++ct) *(LAS bf16_t*)(L + rb + (96 * ch + 16 * ct + i) * 2) = (bf16_t)(cvt_pk_bf16(yacc[ct][j], 0.f) & 0xffffu); } }
            SBAR();
            u32x4 yr[3];
            { SSD_ROLES; const int row = orow, seg = oseg; const int rb = L_X + row * 384;
#pragma unroll
              for (int k = 0; k < 3; ++k) yr[k] = *(const LAS u32x4*)(L + rb + seg * 48 + k * 16); }
            SBAR();
            if (ck < 15) ssd_dma_x(L, XA + (tok0 + 128) * 1792, g, F.wave, lane);
            asm volatile("" ::: "memory");
            if (ck < 15) { asm volatile("s_waitcnt vmcnt(6)" ::: "memory"); SBAR(); }
            auto out_stage = [&]() __attribute__((always_inline)) {
            SSD_ROLES;
            { float v[24]; float ss = 0.f;
#pragma unroll
              for (int k = 0; k < 3; ++k) { v[8 * k + 0] = bf_lo(yr[k].x) * bf_lo(zr[k].x); v[8 * k + 1] = bf_hi(yr[k].x) * bf_hi(zr[k].x); v[8 * k + 2] = bf_lo(yr[k].y) * bf_lo(zr[k].y); v[8 * k + 3] = bf_hi(yr[k].y) * bf_hi(zr[k].y);
                  v[8 * k + 4] = bf_lo(yr[k].z) * bf_lo(zr[k].z); v[8 * k + 5] = bf_hi(yr[k].z) * bf_hi(zr[k].z); v[8 * k + 6] = bf_lo(yr[k].w) * bf_lo(zr[k].w); v[8 * k + 7] = bf_hi(yr[k].w) * bf_hi(zr[k].w); }
#pragma unroll
              for (int k = 0; k < 24; ++k) ss += v[k] * v[k];
              ss += __shfl_xor(ss, 1); ss += __shfl_xor(ss, 2); ss += __shfl_xor(ss, 4);
              const float rstd = rsqrtf(ss * (1.f / 192.f) + EPS);
              bf16_t* op = mix + tok0 * DM + (unsigned)(ogrow * DM + 256 + oc0);
#pragma unroll
              for (int k = 0; k < 3; ++k) { const f32x4 n0 = *(const LAS f32x4*)(L + L_NW + (oseg * 24 + 8 * k) * 4), n1 = *(const LAS f32x4*)(L + L_NW + (oseg * 24 + 8 * k + 4) * 4); u32x4 pk;
                  pk.x = cvt_pk_bf16(v[8 * k] * rstd * n0[0], v[8 * k + 1] * rstd * n0[1]); pk.y = cvt_pk_bf16(v[8 * k + 2] * rstd * n0[2], v[8 * k + 3] * rstd * n0[3]);
                  pk.z = cvt_pk_bf16(v[8 * k + 4] * rstd * n1[0], v[8 * k + 5] * rstd * n1[1]); pk.w = cvt_pk_bf16(v[8 * k + 6] * rstd * n1[2], v[8 * k + 7] * rstd * n1[3]);
                  *(u32x4*)(op + 8 * k) = pk; } }
            };
            if constexpr (ORD == 0) { if (ck < 15) ssd_stage1(L, lt, hl, lane, cbt); out_stage(); }
            else { out_stage(); if (ck < 15) ssd_stage1(L, lt, hl, lane, cbt); }
            }
        }
        };
        if (lt < 2) chunk_loop(std::integral_constant<int, 0>{}); else chunk_loop(std::integral_constant<int, 1>{});
    }
}

constexpr int R_WH = 0, R_WL = 73728, R_SC = 147456, R_SH = R_SC + 4096, R_CNT = R_SH + 4096, R_LG = 0;
__device__ __forceinline__ void p5_route(const Frame& F, const Params& P) {
    LAS unsigned char* L = (LAS unsigned char*)F.lds;
    const bf16_t* x1 = (const bf16_t*)(P.ws + WS_X1); const float* mod = (const float*)(P.ws + WS_MOD); bf16_t* H = (bf16_t*)(P.ws + WS_H); const float* ss16 = (const float*)(P.ws + WS_SS16);
    const bf16_t* WRH = (const bf16_t*)(P.ws + WS_WR); const bf16_t* WRL = (const bf16_t*)(P.ws + WS_WR + 131072);
    float* gates = (float*)(P.ws + WS_SGATE); unsigned* list = (unsigned*)(P.ws + WS_LIST); unsigned* gcount = (unsigned*)(P.ws + WS_CTL) + CW_GCOUNT;
    const float* b_group = P.in[15]; const float* b_router = P.in[17];
    LAS unsigned* lcount = (LAS unsigned*)(L + R_CNT);
    LAS unsigned* lbase = lcount + 32;
    LAS unsigned* tinfo = lcount + 64;
    LAS float* twt = (LAS float*)(tinfo + 256 * 4);
    const int lane = F.lane, i = lane & 15, q = lane >> 4;
    for (int rb = F.vcu; rb < T / 256; rb += F.G) {
        const int b = rb >> 3;
        { u32x4 wa[9], wb[9];
#pragma unroll
          for (int i = 0; i < 9; ++i) { const int idx = F.tid + i * NTHREADS, j = idx >> 7, c = idx & 127; wa[i] = *(const u32x4*)(WRH + (size_t)j * 1024 + c * 8); wb[i] = *(const u32x4*)(WRL + (size_t)j * 1024 + c * 8); }
#pragma unroll
          for (int i = 0; i < 9; ++i) { const int idx = F.tid + i * NTHREADS, j = idx >> 7, c = idx & 127; const int dst = j * 2048 + ((c ^ swz16(j & 15)) << 4);
              *(LAS u32x4*)(L + R_WH + dst) = wa[i]; *(LAS u32x4*)(L + R_WL + dst) = wb[i]; } }
        for (int idx = F.tid; idx < 256; idx += NTHREADS) { const f32x4 sc = *(const f32x4*)(mod + (size_t)b * 6144 + 4 * 1024 + idx * 4), sh = *(const f32x4*)(mod + (size_t)b * 6144 + 3 * 1024 + idx * 4);
            *(LAS f32x4*)(L + R_SC + idx * 16) = sc + 1.0f; *(LAS f32x4*)(L + R_SH + idx * 16) = sh; }
        if (F.tid < 32) lcount[F.tid] = 0u;
        __syncthreads();
        const int rowA = rb * 256 + F.wave * 32 + i;
        float rstd[2];
#pragma unroll
        for (int rt = 0; rt < 2; ++rt) { f32x4 a, c, d, e; { const float* sp = ss16 + (rowA + 16 * rt);
#pragma unroll
            for (int j = 0; j < 4; ++j) { a[j] = sp[(size_t)j * T]; c[j] = sp[(size_t)(4 + j) * T]; d[j] = sp[(size_t)(8 + j) * T]; e[j] = sp[(size_t)(12 + j) * T]; } }
            const float ss = ((a[0] + a[1]) + (a[2] + a[3])) + ((c[0] + c[1]) + (c[2] + c[3])) + ((d[0] + d[1]) + (d[2] + d[3])) + ((e[0] + e[1]) + (e[2] + e[3])); rstd[rt] = rsqrtf(ss * (1.f / DM) + EPS); }
        f32x4 acc[2][3];
#pragma unroll
        for (int rt = 0; rt < 2; ++rt)
#pragma unroll
            for (int ct = 0; ct < 3; ++ct) acc[rt][ct] = (f32x4){0.f, 0.f, 0.f, 0.f};
        int wrow[3];
#pragma unroll
        for (int ct = 0; ct < 3; ++ct) { const int j = (16 * ct + i) < 36 ? (16 * ct + i) : 35; wrow[ct] = j * 2048; }
        const int fsw = swz16(i);
        const int fswc = swz16(35 & 15);
        u32x4 xq[4][2];
#pragma unroll
        for (int s = 0; s < 4; ++s)
#pragma unroll
            for (int rt = 0; rt < 2; ++rt) xq[s][rt] = *(const u32x4*)(x1 + (size_t)(rowA + 16 * rt) * DM + 32 * s + 8 * q);
#pragma unroll 4
        for (int s = 0; s < 32; ++s) {
            bf16x8 wh[3], wl[3];
#pragma unroll
            for (int ct = 0; ct < 3; ++ct) { const int sw = ((16 * ct + i) < 36) ? fsw : fswc; const int o = wrow[ct] + ((((4 * s + q) & ~15) | (((4 * s + q) & 15) ^ sw)) << 4);
                wh[ct] = *(const LAS bf16x8*)(L + R_WH + o); wl[ct] = *(const LAS bf16x8*)(L + R_WL + o); }
            const f32x4 sc0 = *(const LAS f32x4*)(L + R_SC + (32 * s + 8 * q) * 4), sc1 = *(const LAS f32x4*)(L + R_SC + (32 * s + 8 * q + 4) * 4);
            const f32x4 sh0 = *(const LAS f32x4*)(L + R_SH + (32 * s + 8 * q) * 4), sh1 = *(const LAS f32x4*)(L + R_SH + (32 * s + 8 * q + 4) * 4);
#pragma unroll
            for (int rt = 0; rt < 2; ++rt) { const size_t off = (size_t)(rowA + 16 * rt) * DM + 32 * s + 8 * q;
                const u32x4 xw = xq[s & 3][rt]; if (s + 4 < 32) xq[s & 3][rt] = *(const u32x4*)(x1 + off + 128); const f32x4 x0 = (f32x4){bf_lo(xw.x), bf_hi(xw.x), bf_lo(xw.y), bf_hi(xw.y)}, x1v = (f32x4){bf_lo(xw.z), bf_hi(xw.z), bf_lo(xw.w), bf_hi(xw.w)};
                const f32x4 h0 = x0 * rstd[rt] * sc0 + sh0, h1 = x1v * rstd[rt] * sc1 + sh1;
                u32x4 hi; hi.x = cvt_pk_bf16(h0[0], h0[1]); hi.y = cvt_pk_bf16(h0[2], h0[3]); hi.z = cvt_pk_bf16(h1[0], h1[1]); hi.w = cvt_pk_bf16(h1[2], h1[3]);
                { u32x2 h8; h8.x = cvt_pk4_fp8(h0[0], h0[1], h0[2], h0[3]); h8.y = cvt_pk4_fp8(h1[0], h1[1], h1[2], h1[3]); *(u32x2*)((unsigned char*)H + off) = h8; }
                u32x4 lo; lo.x = cvt_pk_bf16(h0[0] - bf_lo(hi.x), h0[1] - bf_hi(hi.x)); lo.y = cvt_pk_bf16(h0[2] - bf_lo(hi.y), h0[3] - bf_hi(hi.y));
                lo.z = cvt_pk_bf16(h1[0] - bf_lo(hi.z), h1[1] - bf_hi(hi.z)); lo.w = cvt_pk_bf16(h1[2] - bf_lo(hi.w), h1[3] - bf_hi(hi.w));
                const bf16x8 ah = __builtin_bit_cast(bf16x8, hi), al = __builtin_bit_cast(bf16x8, lo);
#pragma unroll
                for (int ct = 0; ct < 3; ++ct) { acc[rt][ct] = MFMA16(ah, wh[ct], acc[rt][ct]); acc[rt][ct] = MFMA16(al, wh[ct], acc[rt][ct]); acc[rt][ct] = MFMA16(ah, wl[ct], acc[rt][ct]); } }
        }
        __syncthreads();
        LAS float* lg = (LAS float*)(L + R_LG);
#pragma unroll
        for (int rt = 0; rt < 2; ++rt)
#pragma unroll
            for (int ct = 0; ct < 3; ++ct)
#pragma unroll
                for (int j = 0; j < 4; ++j) { const int col = 16 * ct + i; if (col < 36) lg[(F.wave * 32 + 16 * rt + 4 * q + j) * 37 + col] = acc[rt][ct][j]; }
        __syncthreads();
        if (F.tid < 256) {
            const int rl = F.tid; const LAS float* lr = lg + rl * 37;
            float gl[4];
#pragma unroll
            for (int k = 0; k < 4; ++k) gl[k] = lr[k] + b_group[k];
            int gi = 0; float gm = gl[0];
#pragma unroll
            for (int k = 1; k < 4; ++k) if (gl[k] > gm) { gm = gl[k]; gi = k; }
            float den = 0.f;
#pragma unroll
            for (int k = 0; k < 4; ++k) den += __expf(gl[k] - gm);
            const float pg = 1.0f / den;
            float el[8];
#pragma unroll
            for (int k = 0; k < 8; ++k) el[k] = lr[4 + gi * 8 + k] + b_router[gi * 8 + k];
            int i0 = 0; float v0 = el[0];
#pragma unroll
            for (int k = 1; k < 8; ++k) if (el[k] > v0) { v0 = el[k]; i0 = k; }
            int i1 = -1; float v1 = -3.0e38f;
#pragma unroll
            for (int k = 0; k < 8; ++k) if (k != i0 && el[k] > v1) { v1 = el[k]; i1 = k; }
            const float ex = __expf(v1 - v0); const float w0 = pg / (1.0f + ex), w1 = pg * ex / (1.0f + ex);
            const int e0 = gi * 8 + i0, e1 = gi * 8 + i1; const unsigned r0 = atomicAdd((unsigned*)&lcount[e0], 1u), r1 = atomicAdd((unsigned*)&lcount[e1], 1u);
            tinfo[rl * 4 + 0] = (unsigned)e0 | ((unsigned)e1 << 8); tinfo[rl * 4 + 1] = r0; tinfo[rl * 4 + 2] = r1; twt[rl * 2] = w0; twt[rl * 2 + 1] = w1;
        }
        __syncthreads();
        if (F.tid < 32) lbase[F.tid] = atomicAdd(&gcount[64 * F.tid], lcount[F.tid]);
        __syncthreads();
        if (F.tid < 256) { const int rl = F.tid, row = rb * 256 + rl; const unsigned ee = tinfo[rl * 4], e0 = ee & 255u, e1 = ee >> 8;
            const size_t s0 = (size_t)e0 * ECAP + lbase[e0] + tinfo[rl * 4 + 1], s1 = (size_t)e1 * ECAP + lbase[e1] + tinfo[rl * 4 + 2];
            list[s0] = (unsigned)row * 2u; list[s1] = (unsigned)row * 2u + 1u; gates[s0] = twt[rl * 2]; gates[s1] = twt[rl * 2 + 1]; }
        __syncthreads();
    }
}

__device__ __forceinline__ void p8_final(const Frame& F, const Params& P) {
    const bf16_t* x1 = (const bf16_t*)(P.ws + WS_X1); const unsigned char* Y0 = P.ws + WS_Y0; const unsigned char* Y1 = P.ws + WS_Y1; const float* fw = P.in[20]; const float* mod = (const float*)(P.ws + WS_MOD);
    f32x4 wv[4];
#pragma unroll
    for (int j = 0; j < 4; ++j) wv[j] = ((const f32x4*)fw)[F.lane + 64 * j];
    u32x2 xw[2][4], xn[2][4]; unsigned a[2][4], c[2][4], an[2][4], cn[2][4];
#define P9_LOAD(X_, A_, C_, rw) do { if ((rw) < T) { _Pragma("unroll") for (int r = 0; r < 2; ++r) { const u32x2* xr = (const u32x2*)(x1 + (size_t)((rw) + r) * DM) + F.lane; const unsigned* y0 = (const unsigned*)(Y0 + (size_t)((rw) + r) * DM) + F.lane; const unsigned* y1 = (const unsigned*)(Y1 + (size_t)((rw) + r) * DM) + F.lane; \
        _Pragma("unroll") for (int j = 0; j < 4; ++j) { X_[r][j] = __builtin_nontemporal_load(xr + 64 * j); A_[r][j] = __builtin_nontemporal_load(y0 + 64 * j); C_[r][j] = __builtin_nontemporal_load(y1 + 64 * j); } } } } while (0)
    const int WPB = F.NGW / BATCH, bw = F.gw / WPB, wl = F.gw - bw * WPB, rstep = WPB * 2;
    const int rbeg = bw * SEQ + wl * 2, rend = (bw + 1) * SEQ;
    f32x4 g[4];
    if (bw < BATCH) { const f32x4* g2 = (const f32x4*)(mod + (size_t)bw * 6144 + 5 * 1024) + F.lane;
#pragma unroll
        for (int j = 0; j < 4; ++j) g[j] = g2[64 * j]; }
    if (bw < BATCH && rbeg < rend) P9_LOAD(xw, a, c, rbeg);
    for (int row0 = rbeg; bw < BATCH && row0 < rend; row0 += rstep) {
        if (row0 + rstep < rend) P9_LOAD(xn, an, cn, row0 + rstep);
#pragma unroll
        for (int r = 0; r < 2; ++r) { f32x4 v[4]; float s = 0.f;
#pragma unroll
            for (int j = 0; j < 4; ++j) { v[j] = (f32x4){bf_lo(xw[r][j].x), bf_hi(xw[r][j].x), bf_lo(xw[r][j].y), bf_hi(xw[r][j].y)};
                const f32x2 a01 = __builtin_amdgcn_cvt_pk_f32_fp8((int)a[r][j], false), a23 = __builtin_amdgcn_cvt_pk_f32_fp8((int)a[r][j], true), c01 = __builtin_amdgcn_cvt_pk_f32_fp8((int)c[r][j], false), c23 = __builtin_amdgcn_cvt_pk_f32_fp8((int)c[r][j], true);
                v[j][0] += g[j][0] * (a01[0] + c01[0]); v[j][1] += g[j][1] * (a01[1] + c01[1]); v[j][2] += g[j][2] * (a23[0] + c23[0]); v[j][3] += g[j][3] * (a23[1] + c23[1]);
                s += (v[j][0] * v[j][0] + v[j][1] * v[j][1]) + (v[j][2] * v[j][2] + v[j][3] * v[j][3]); }
            const float rstd = rsqrtf(wave_sum(s) * (1.f / DM) + EPS);
            f32x4* o = (f32x4*)(P.out + (size_t)(row0 + r) * DM) + F.lane;
#pragma unroll
            for (int j = 0; j < 4; ++j) __builtin_nontemporal_store(v[j] * rstd * wv[j], o + 64 * j); }
#pragma unroll
        for (int r = 0; r < 2; ++r)
#pragma unroll
            for (int j = 0; j < 4; ++j) { xw[r][j] = xn[r][j]; a[r][j] = an[r][j]; c[r][j] = cn[r][j]; }
    }
#undef P9_LOAD
}

__device__ __forceinline__ void moe_prefix(const Frame& F, const Params& P, int* pref) {
    const unsigned* gcount = (const unsigned*)(P.ws + WS_CTL) + CW_GCOUNT;
    __syncthreads();
    if (F.tid < 64) {
        const int e = F.tid & 31; const int c = (int)__hip_atomic_load(gcount + 64 * e, __ATOMIC_RELAXED, __HIP_MEMORY_SCOPE_AGENT);
        const int tl = (c + 255) >> 8; int inc = tl;
#pragma unroll
        for (int o = 1; o < 32; o <<= 1) { const int v = __shfl_up(inc, o, 32); if (e >= o) inc += v; }
        if (F.tid < 32) { pref[e] = inc - tl; pref[33 + e] = c; if (e == 31) pref[32] = inc; }
    }
    __syncthreads();
}

#define XB_TMO      128
#define XB_XCNT(j)  (256  + 64 * (j))
#define XB_XSUB(j)  (1280 + 64 * (j))
#define XB_XGEN(j)  (2304 + 64 * (j))
#define XB_TOP      3328
#define XB_TOPGEN   3392
#define XCD_BAR_WORDS 3456
#define XB_SPIN_CAP (1u << 22)
__device__ __forceinline__ unsigned xb_ld(unsigned* p)              { return __hip_atomic_load(p, __ATOMIC_RELAXED, __HIP_MEMORY_SCOPE_AGENT); }
__device__ __forceinline__ unsigned xb_add(unsigned* p, unsigned v) { return __hip_atomic_fetch_add(p, v, __ATOMIC_RELAXED, __HIP_MEMORY_SCOPE_AGENT); }
__device__ __forceinline__ unsigned xb_xcc_id() { return (unsigned)__builtin_amdgcn_s_getreg((3 << 11) | 20) & 0xFu; }
#define XB_SPIN(cond, bar) do { unsigned _sp = 0; while (cond) { __builtin_amdgcn_s_sleep(1); \
    if ((++_sp & 255u) == 0u) { if (xb_ld(&(bar)[XB_TMO])) break; if (_sp > XB_SPIN_CAP) { atomicAdd(&(bar)[XB_TMO], 1u); break; } } } } while (0)
struct XcdBarrier { unsigned* bar; unsigned x; volatile LAS unsigned* st; };
__device__ __forceinline__ XcdBarrier xcd_barrier_post(unsigned* bar, volatile LAS unsigned* st) {
    XcdBarrier b; b.bar = bar; b.x = xb_xcc_id(); b.st = st;
    if (threadIdx.x == 0) (void)xb_add(&bar[XB_XCNT(b.x)], 1u);
    return b;
}
__device__ __forceinline__ void xcd_barrier_complete(unsigned* bar, unsigned x, unsigned& nloc, unsigned& nx) {
    const unsigned G = gridDim.x * gridDim.y * gridDim.z;
    unsigned sum, cnt, mine, sp = 0u;
    for (;;) {
        sum = 0u; cnt = 0u; mine = 0u;
#pragma unroll
        for (unsigned j = 0; j < 16; ++j) { const unsigned c = xb_ld(&bar[XB_XCNT(j)]); sum += c; cnt += (c > 0u) ? 1u : 0u; mine = (j == x) ? c : mine; }
        if (sum == G) break;
        __builtin_amdgcn_s_sleep(1);
        if ((++sp & 255u) == 0u) { if (xb_ld(&bar[XB_TMO])) break; if (sp > XB_SPIN_CAP) { atomicAdd(&bar[XB_TMO], 1u); break; } }
    }
    nloc = mine > 0u ? mine : 1u; nx = cnt > 0u ? cnt : 1u;
}
__device__ __forceinline__ void xcd_barrier(const XcdBarrier& b) {
    asm volatile("s_waitcnt vmcnt(0)" ::: "memory");
    __syncthreads();
    if (threadIdx.x == 0) {
        unsigned* bar = b.bar;
        __builtin_amdgcn_s_waitcnt(0);
        unsigned nloc = b.st[0], nx = b.st[1];
        if (nloc == 0u) { xcd_barrier_complete(bar, b.x, nloc, nx); b.st[0] = nloc; b.st[1] = nx; }
        const unsigned old = xb_add(&bar[XB_XSUB(b.x)], 1u);
        const unsigned gen = old / nloc;
        if (old + 1u == (gen + 1u) * nloc) {
            __builtin_amdgcn_fence(__ATOMIC_RELEASE, "agent");
            asm volatile("s_waitcnt vmcnt(0)" ::: "memory");
            const unsigned og = xb_add(&bar[XB_TOP], 1u);
            const unsigned tg = og / nx;
            if (og + 1u == (tg + 1u) * nx) xb_add(&bar[XB_TOPGEN], 1u);
            else XB_SPIN(xb_ld(&bar[XB_TOPGEN]) == tg, bar);
            __builtin_amdgcn_fence(__ATOMIC_ACQUIRE, "agent");
            xb_add(&bar[XB_XGEN(b.x)], 1u);
            asm volatile("s_waitcnt vmcnt(0)" ::: "memory");
        } else {
            XB_SPIN(xb_ld(&bar[XB_XGEN(b.x)]) == gen, bar);
            asm volatile("buffer_inv sc0\n\ts_waitcnt vmcnt(0)" ::: "memory");
        }
    }
    __syncthreads();
}

__global__ void __launch_bounds__(NTHREADS, 2) fwd_kernel(Params P) {
    extern __shared__ __attribute__((aligned(16))) unsigned char lds[];
    Frame F; F.lds = lds; F.tid = threadIdx.x; F.lane = F.tid & 63; F.wave = __builtin_amdgcn_readfirstlane(F.tid >> 6);
    F.G = gridDim.x; { const int bx = blockIdx.x; F.vcu = (F.G % 8 == 0) ? (bx % 8) * (F.G / 8) + bx / 8 : bx; }
    F.gw = F.vcu * NWAVES + F.wave; F.NGW = F.G * NWAVES;
    unsigned char* ws = P.ws;
    const int lo = P.ph_lo, hi = P.ph_hi;
    volatile LAS unsigned* bst = (volatile LAS unsigned*)((LAS unsigned char*)lds + (LDS_BYTES - 64));
    if (F.tid < 2) bst[F.tid] = 0u;
    __syncthreads();
    const XcdBarrier xbar = xcd_barrier_post((unsigned*)(ws + WS_CTL) + CW_BAR, bst);
#define IN(k) (lo <= (k) && (k) < hi)
#define GRID_BAR() xcd_barrier(xbar)
#define GRID_BAR_CG() do { __syncthreads(); cooperative_groups::this_grid().sync(); } while (0)
    if (IN(0)) p0_prep(F, P);
    if (IN(0) && IN(1)) { if (P.ph_hi > 1000) GRID_BAR_CG(); else GRID_BAR(); }
    if (IN(1)) p1_modulate(F, P);
    if (IN(1) && IN(2)) GRID_BAR();
    if (IN(2)) { pg8::DenseSched<COL_DT / 256> S; S.init(ws + WS_H, ws + WS_WIN, T, COL_DT, 1024, F.G, (int)blockIdx.x); pg8::EpiProj E{(bf16_t*)(ws + WS_PROJ), (bf16_t*)(ws + WS_XA), P.in[7], P.in[8]}; pg8::gemm_phase(( LAS unsigned char*)lds, S, E); }
    if (IN(2) && IN(3)) GRID_BAR();
    if (IN(3)) p3_conv(F, P);
    if (IN(3) && IN(4)) GRID_BAR();
    if (IN(4)) p4_ssd(F, P);
    if (IN(4) && IN(5)) GRID_BAR();
    if (IN(5)) { pg8::DenseSched<4> S; S.init(ws + WS_MIX, ws + WS_WOUT, T, 1024, 1024, F.G, (int)blockIdx.x); pg8::EpiX1 E{P.in[0], (const float*)(ws + WS_MOD), (bf16_t*)(ws + WS_X1), (float*)(ws + WS_SS16)}; pg8::gemm_phase((LAS unsigned char*)lds, S, E); }
    if (IN(5) && IN(6)) GRID_BAR();
    if (IN(6)) p5_route(F, P);
    if (IN(6) && IN(7)) GRID_BAR();
    if (IN(7)) { int* pref = (int*)(lds + MISC_OFF); moe_prefix(F, P, pref);
        pg8::MoeSched<true> S; S.A = (const char*)(ws + WS_H); S.Bt = (const char*)(ws + WS_W13); S.K = 1024; S.nN = 4; S.G = F.G; S.c = F.vcu; S.pref = (const LAS int*)pref; S.list = (const unsigned*)(ws + WS_LIST);
        pg8::EpiAct E{(unsigned char*)(ws + WS_ACT)}; pg8::gemm_phase((LAS unsigned char*)lds, S, E); }
    if (IN(7) && IN(8)) GRID_BAR();
    if (IN(8)) { int* pref = (int*)(lds + MISC_OFF); moe_prefix(F, P, pref);
        pg8::MoeSched<false> S; S.A = (const char*)(ws + WS_ACT); S.Bt = (const char*)(ws + WS_W2); S.K = 512; S.nN = 4; S.G = F.G; S.c = F.vcu; S.pref = (const LAS int*)pref; S.list = (const unsigned*)(ws + WS_LIST);
        pg8::EpiY E{(const unsigned*)(ws + WS_LIST), (const float*)(ws + WS_SGATE), ws + WS_Y0, ws + WS_Y1}; pg8::gemm_phase((LAS unsigned char*)lds, S, E); }
    if (IN(8) && IN(9)) GRID_BAR();
    if (IN(9)) p8_final(F, P);
#undef IN
#undef GRID_BAR
#undef GRID_BAR_CG
}

extern "C" void kernel_launch(void* const* d_in, const int* in_sizes, int n_in, void* d_out, int out_size, void* d_ws, size_t ws_size, hipStream_t stream) {
    static int grid = 0;
    if (grid == 0) {
        if (n_in != 21 || out_size != T * DM || ws_size < WS_END) { fprintf(stderr, "kernel_launch: unexpected sizes n_in %d out %d ws %zu\n", n_in, out_size, ws_size); grid = -1; return; }
        int dev = 0, cus = 0;
        if (hipGetDevice(&dev) != hipSuccess || hipDeviceGetAttribute(&cus, hipDeviceAttributeMultiprocessorCount, dev) != hipSuccess) { grid = -1; return; }
        if (hipFuncSetAttribute((const void*)fwd_kernel, hipFuncAttributeMaxDynamicSharedMemorySize, LDS_BYTES) != hipSuccess) { fprintf(stderr, "kernel_launch: hipFuncSetAttribute failed\n"); grid = -1; return; }
        int per_cu = 0;
        if (hipOccupancyMaxActiveBlocksPerMultiprocessor(&per_cu, (const void*)fwd_kernel, NTHREADS, LDS_BYTES) != hipSuccess || per_cu < 1) { fprintf(stderr, "kernel_launch: occupancy query says %d blocks per CU\n", per_cu); (void)hipGetLastError(); per_cu = 1; }
        grid = cus;
    }
    if (grid < 0) return;
    (void)hipMemsetAsync((char*)d_ws + WS_CTL, 0, CTL_BYTES, stream);
    Params p{};
    for (int i = 0; i < 21; ++i) p.in[i] = (const float*)d_in[i];
    p.out = (float*)d_out; p.ws = (unsigned char*)d_ws;
    p.ph_lo = 0; p.ph_hi = 10;
    void* args[] = {&p};
    hipError_t e = hipLaunchCooperativeKernel((const void*)fwd_kernel, dim3(grid), dim3(NTHREADS), args, LDS_BYTES, stream);
    if (e != hipSuccess) fprintf(stderr, "kernel_launch: cooperative launch failed: %s (grid %d)\n", hipGetErrorString(e), grid);
}
```
